# Optimizing an MI355X kernel written in HIP

```python
import math
import jax, jax.numpy as jnp
from jax import lax
import numpy as np

D_MODEL = 2048
BATCH = 8
SEQ = 2048
DEPTH = 1

N_MEM = 256
MEM_HEADS = 4
MEM_HEAD_DIM = 128
MEM_WIDTH = MEM_HEADS * MEM_HEAD_DIM

MLA_HEADS = 8
QK_NOPE = 128
QK_ROPE = 64
V_HEAD = 128
Q_LORA = 512
KV_LORA = 512
ROPE_THETA = 10000.0
MAX_POS_OFFSET = 4096
Q_BLOCK = 128
MLA_WIDTH = MLA_HEADS * V_HEAD

LRU_WIDTH = 1024
LRU_BLOCKS = 8
LRU_BLOCK_DIM = LRU_WIDTH // LRU_BLOCKS
CONV_WIDTH = 4
CONV_PAD_LEFT = 2
LRU_C = 8.0

MIX_WIDTH = MLA_WIDTH + LRU_WIDTH
SPLIT_CQ = Q_LORA
SPLIT_CKV = SPLIT_CQ + KV_LORA
SPLIT_KPE = SPLIT_CKV + QK_ROPE
SPLIT_LRUX = SPLIT_KPE + LRU_WIDTH
IN_WIDTH = SPLIT_LRUX + LRU_WIDTH

PEER_HEADS = 8
N_KEYS = 128
N_EXPERTS = N_KEYS * N_KEYS
PEER_QUERY = 256
PEER_HALF = PEER_QUERY // 2
PEER_TOPK = 16
TOKEN_BLOCK = 128

DN_ALPHA = (2.0 * DEPTH) ** 0.25
DN_BETA = (8.0 * DEPTH) ** -0.25
LN_EPS = 1e-5
RMS_EPS = 1e-6

kernel_name = "hybrid_mla_rglru_peer_encoder"


def layer_norm(x, g, b):
    xf = x.astype(jnp.float32)
    mu = jnp.mean(xf, axis=-1, keepdims=True)
    var = jnp.mean(jnp.square(xf - mu), axis=-1, keepdims=True)
    return ((xf - mu) * lax.rsqrt(var + LN_EPS)).astype(x.dtype) * g + b


def rms_norm(x, g):
    xf = x.astype(jnp.float32)
    return (xf * lax.rsqrt(jnp.mean(xf * xf, axis=-1, keepdims=True) + RMS_EPS)).astype(x.dtype) * g


def rope_tables(positions, dtype):
    inv_freq = ROPE_THETA ** (-jnp.arange(0, QK_ROPE, 2, dtype=jnp.float32) / QK_ROPE)
    ang = positions.astype(jnp.float32)[..., None] * inv_freq
    return jnp.cos(ang).astype(dtype), jnp.sin(ang).astype(dtype)


def apply_rope(t, cos, sin):
    t1, t2 = jnp.split(t, 2, axis=-1)
    return jnp.concatenate([t1 * cos - t2 * sin, t2 * cos + t1 * sin], axis=-1)


def mla_attention(c_q, c_kv, k_pe, cos, sin, q_norm_g, w_uq, kv_norm_g, w_ukv):
    B, S, _ = c_q.shape
    q = (rms_norm(c_q, q_norm_g) @ w_uq).reshape(B, S, MLA_HEADS, QK_NOPE + QK_ROPE)
    q_nope = q[..., :QK_NOPE]
    q_pe = apply_rope(q[..., QK_NOPE:], cos[:, :, None, :], sin[:, :, None, :])
    kv = (rms_norm(c_kv, kv_norm_g) @ w_ukv).reshape(B, S, MLA_HEADS, QK_NOPE + V_HEAD)
    k_nope = kv[..., :QK_NOPE]
    v = kv[..., QK_NOPE:]
    k_rot = apply_rope(k_pe, cos, sin)
    scale = (QK_NOPE + QK_ROPE) ** -0.5
    nb = S // Q_BLOCK

    def to_blocks(t):
        return t.reshape(B, nb, Q_BLOCK, *t.shape[2:]).swapaxes(0, 1)

    def attend(blk):
        qn, qp = blk
        s = (jnp.einsum('bqhd,bkhd->bhqk', qn, k_nope)
             + jnp.einsum('bqhr,bkr->bhqk', qp, k_rot))
        p = jax.nn.softmax(s.astype(jnp.float32) * scale, axis=-1).astype(v.dtype)
        return jnp.einsum('bhqk,bkhd->bqhd', p, v)

    o = lax.map(attend, (to_blocks(q_nope), to_blocks(q_pe)))
    return o.swapaxes(0, 1).reshape(B, S, MLA_WIDTH)


def centred_depthwise_conv(x, w, b):
    S = x.shape[1]
    xp = jnp.pad(x, ((0, 0), (CONV_PAD_LEFT, CONV_WIDTH - 1 - CONV_PAD_LEFT), (0, 0)))
    out = b + xp[:, 0:S] * w[0]
    for k in range(1, CONV_WIDTH):
        out = out + xp[:, k:k + S] * w[k]
    return out


def rg_lru(xc, wa, ba, wx, bx, lam, reverse):
    B, S, _ = xc.shape
    xb = xc.reshape(B, S, LRU_BLOCKS, LRU_BLOCK_DIM)
    r = jax.nn.sigmoid(jnp.einsum('bsni,nij->bsnj', xb, wa).reshape(B, S, LRU_WIDTH) + ba)
    i = jax.nn.sigmoid(jnp.einsum('bsni,nij->bsnj', xb, wx).reshape(B, S, LRU_WIDTH) + bx)
    log_a = -LRU_C * r.astype(jnp.float32) * jax.nn.softplus(-lam.astype(jnp.float32))
    a = jnp.exp(log_a)
    b_in = jnp.sqrt(-jnp.expm1(2.0 * log_a)) * (i * xc).astype(jnp.float32)

    def combine(e1, e2):
        a1, b1 = e1
        a2, b2 = e2
        return a1 * a2, a2 * b1 + b2

    _, h = lax.associative_scan(combine, (a, b_in), axis=1, reverse=reverse)
    return h.astype(xc.dtype)


def memory_cross_attention(x, mem, wq, wk, wv, wo):
    B, S, _ = x.shape
    M = mem.shape[1]
    q = (x @ wq).reshape(B, S, MEM_HEADS, MEM_HEAD_DIM)
    k = (mem @ wk).reshape(B, M, MEM_HEADS, MEM_HEAD_DIM)
    v = (mem @ wv).reshape(B, M, MEM_HEADS, MEM_HEAD_DIM)
    s = jnp.einsum('bshd,bmhd->bhsm', q, k).astype(jnp.float32) * (MEM_HEAD_DIM ** -0.5)
    p = jax.nn.softmax(s, axis=-1).astype(v.dtype)
    o = jnp.einsum('bhsm,bmhd->bshd', p, v).reshape(B, S, MEM_WIDTH)
    return o @ wo


def peer_ffn(x, w_pq, sub_keys1, sub_keys2, peer_u, peer_v):
    B, S, D = x.shape
    T = B * S
    xt = x.reshape(T, D)
    q = (xt @ w_pq).reshape(T, PEER_HEADS, PEER_QUERY)
    s1 = jnp.einsum('thd,nd->thn', q[..., :PEER_HALF], sub_keys1).astype(jnp.float32)
    s2 = jnp.einsum('thd,nd->thn', q[..., PEER_HALF:], sub_keys2).astype(jnp.float32)
    v1, i1 = lax.top_k(s1, PEER_TOPK)
    v2, i2 = lax.top_k(s2, PEER_TOPK)
    cand_s = (v1[..., :, None] + v2[..., None, :]).reshape(T, PEER_HEADS, PEER_TOPK * PEER_TOPK)
    cand_i = (i1[..., :, None] * N_KEYS + i2[..., None, :]).reshape(T, PEER_HEADS, PEER_TOPK * PEER_TOPK)
    top_s, pos = lax.top_k(cand_s, PEER_TOPK)
    idx = jnp.take_along_axis(cand_i, pos, axis=-1)
    gate = jax.nn.softmax(top_s, axis=-1).astype(x.dtype)
    nb = T // TOKEN_BLOCK

    def experts(blk):
        xb, ib, gb = blk
        u_sel = jnp.take(peer_u, ib, axis=0)
        act = jax.nn.gelu(jnp.einsum('thkd,td->thk', u_sel, xb), approximate=False) * gb
        v_sel = jnp.take(peer_v, ib, axis=0)
        return jnp.einsum('thk,thkd->td', act, v_sel)

    out = lax.map(experts, (xt.reshape(nb, TOKEN_BLOCK, D),
                            idx.reshape(nb, TOKEN_BLOCK, PEER_HEADS, PEER_TOPK),
                            gate.reshape(nb, TOKEN_BLOCK, PEER_HEADS, PEER_TOPK)))
    return out.reshape(B, S, D)


def setup_inputs(seed: int = 0) -> dict:
    key = jax.random.key(seed)
    ks = iter(jax.random.split(key, 48))

    def nrm(shape, scale):
        return jax.random.normal(next(ks), shape, jnp.float32) * scale

    def gain(shape):
        return 1.0 + nrm(shape, 0.02)

    L = DEPTH
    x = nrm((BATCH, SEQ, D_MODEL), 1.0)
    mem = nrm((BATCH, N_MEM, D_MODEL), 1.0)
    offsets = jax.random.randint(next(ks), (BATCH, 1), 0, MAX_POS_OFFSET, dtype=jnp.int32)
    positions = offsets + jnp.arange(SEQ, dtype=jnp.int32)[None, :]
    in_ln_g = gain((D_MODEL,))
    in_ln_b = nrm((D_MODEL,), 0.02)
    w_in = nrm((L, D_MODEL, IN_WIDTH), D_MODEL ** -0.5)
    q_norm_g = gain((L, Q_LORA))
    w_uq = nrm((L, Q_LORA, MLA_HEADS * (QK_NOPE + QK_ROPE)), Q_LORA ** -0.5)
    kv_norm_g = gain((L, KV_LORA))
    w_ukv = nrm((L, KV_LORA, MLA_HEADS * (QK_NOPE + V_HEAD)), KV_LORA ** -0.5)
    conv_w = nrm((L, CONV_WIDTH, LRU_WIDTH), CONV_WIDTH ** -0.5)
    conv_b = nrm((L, LRU_WIDTH), 0.02)
    lru_wa = nrm((L, 2, LRU_BLOCKS, LRU_BLOCK_DIM, LRU_BLOCK_DIM), LRU_BLOCK_DIM ** -0.5)
    lru_ba = nrm((L, 2, LRU_WIDTH), 0.02)
    lru_wx = nrm((L, 2, LRU_BLOCKS, LRU_BLOCK_DIM, LRU_BLOCK_DIM), LRU_BLOCK_DIM ** -0.5)
    lru_bx = nrm((L, 2, LRU_WIDTH), 0.02)
    a0 = jax.random.uniform(next(ks), (L, 2, LRU_WIDTH), jnp.float32, 0.9, 0.999)
    s0 = a0 ** (1.0 / LRU_C)
    lru_lambda = jnp.log(s0) - jnp.log1p(-s0)
    attn_out_g = gain((L, MLA_WIDTH))
    lru_out_g = gain((L, LRU_WIDTH))
    w_out = nrm((L, MIX_WIDTH, D_MODEL), DN_BETA * MIX_WIDTH ** -0.5)
    ln1_g = gain((L, D_MODEL))
    ln1_b = nrm((L, D_MODEL), 0.02)
    w_mq = nrm((L, D_MODEL, MEM_WIDTH), D_MODEL ** -0.5)
    w_mk = nrm((L, D_MODEL, MEM_WIDTH), D_MODEL ** -0.5)
    w_mv = nrm((L, D_MODEL, MEM_WIDTH), D_MODEL ** -0.5)
    w_mo = nrm((L, MEM_WIDTH, D_MODEL), DN_BETA * MEM_WIDTH ** -0.5)
    ln2_g = gain((L, D_MODEL))
    ln2_b = nrm((L, D_MODEL), 0.02)
    w_pq = nrm((L, D_MODEL, PEER_HEADS * PEER_QUERY), D_MODEL ** -0.5)
    sub_keys1 = nrm((L, N_KEYS, PEER_HALF), PEER_HALF ** -0.5)
    sub_keys2 = nrm((L, N_KEYS, PEER_HALF), PEER_HALF ** -0.5)
    peer_u = nrm((L, N_EXPERTS, D_MODEL), D_MODEL ** -0.5)
    peer_v = nrm((L, N_EXPERTS, D_MODEL), DN_BETA)
    ln3_g = gain((L, D_MODEL))
    ln3_b = nrm((L, D_MODEL), 0.02)
    return {
        "x": x, "mem": mem, "positions": positions,
        "in_ln_g": in_ln_g, "in_ln_b": in_ln_b,
        "w_in": w_in, "q_norm_g": q_norm_g, "w_uq": w_uq, "kv_norm_g": kv_norm_g, "w_ukv": w_ukv,
        "conv_w": conv_w, "conv_b": conv_b,
        "lru_wa": lru_wa, "lru_ba": lru_ba, "lru_wx": lru_wx, "lru_bx": lru_bx, "lru_lambda": lru_lambda,
        "attn_out_g": attn_out_g, "lru_out_g": lru_out_g, "w_out": w_out,
        "ln1_g": ln1_g, "ln1_b": ln1_b,
        "w_mq": w_mq, "w_mk": w_mk, "w_mv": w_mv, "w_mo": w_mo,
        "ln2_g": ln2_g, "ln2_b": ln2_b,
        "w_pq": w_pq, "sub_keys1": sub_keys1, "sub_keys2": sub_keys2,
        "peer_u": peer_u, "peer_v": peer_v,
        "ln3_g": ln3_g, "ln3_b": ln3_b,
    }


def reference(x, mem, positions, in_ln_g, in_ln_b, w_in, q_norm_g, w_uq, kv_norm_g, w_ukv,
              conv_w, conv_b, lru_wa, lru_ba, lru_wx, lru_bx, lru_lambda,
              attn_out_g, lru_out_g, w_out, ln1_g, ln1_b,
              w_mq, w_mk, w_mv, w_mo, ln2_g, ln2_b,
              w_pq, sub_keys1, sub_keys2, peer_u, peer_v, ln3_g, ln3_b):
    cos, sin = rope_tables(positions, x.dtype)
    x = layer_norm(x, in_ln_g, in_ln_b)
    for l in range(DEPTH):
        h = x @ w_in[l]
        c_q = h[..., :SPLIT_CQ]
        c_kv = h[..., SPLIT_CQ:SPLIT_CKV]
        k_pe = h[..., SPLIT_CKV:SPLIT_KPE]
        lru_x = h[..., SPLIT_KPE:SPLIT_LRUX]
        lru_gate = h[..., SPLIT_LRUX:]
        y_attn = mla_attention(c_q, c_kv, k_pe, cos, sin, q_norm_g[l], w_uq[l], kv_norm_g[l], w_ukv[l])
        xc = centred_depthwise_conv(lru_x, conv_w[l], conv_b[l])
        h_fwd = rg_lru(xc, lru_wa[l, 0], lru_ba[l, 0], lru_wx[l, 0], lru_bx[l, 0], lru_lambda[l, 0], False)
        h_bwd = rg_lru(xc, lru_wa[l, 1], lru_ba[l, 1], lru_wx[l, 1], lru_bx[l, 1], lru_lambda[l, 1], True)
        y_lru = (h_fwd + h_bwd) * jax.nn.gelu(lru_gate)
        y_mix = jnp.concatenate([rms_norm(y_attn, attn_out_g[l]), rms_norm(y_lru, lru_out_g[l])], axis=-1)
        x = layer_norm(DN_ALPHA * x + y_mix @ w_out[l], ln1_g[l], ln1_b[l])
        y_mem = memory_cross_attention(x, mem, w_mq[l], w_mk[l], w_mv[l], w_mo[l])
        x = layer_norm(DN_ALPHA * x + y_mem, ln2_g[l], ln2_b[l])
        y_ffn = peer_ffn(x, w_pq[l], sub_keys1[l], sub_keys2[l], peer_u[l], peer_v[l])
        x = layer_norm(DN_ALPHA * x + y_ffn, ln3_g[l], ln3_b[l])
    return x
```

```cpp
#include <hip/hip_runtime.h>
#include <hip/hip_cooperative_groups.h>
#include <cstdio>
#include <cstdint>
namespace cg = cooperative_groups;
#ifndef USE_LRU_FUSED
#define USE_LRU_FUSED 1
#endif

typedef unsigned short bf16_t;
typedef short bf16x8 __attribute__((ext_vector_type(8)));
typedef float f32x4 __attribute__((ext_vector_type(4)));
typedef float f32x2 __attribute__((ext_vector_type(2)));
typedef float f32x16 __attribute__((ext_vector_type(16)));
typedef unsigned u32x4 __attribute__((ext_vector_type(4)));
typedef unsigned u32x2 __attribute__((ext_vector_type(2)));

constexpr int T_ = 16384, S_ = 2048, NB_ = 8, DM = 2048;
constexpr int NTHR = 512, NWAVE = 8;
constexpr float DN_ALPHA = 1.189207115002721f;
constexpr float LN_EPS = 1e-5f, RMS_EPS = 1e-6f;
constexpr int LDS_BYTES = 147456;

constexpr size_t MiB = 1u << 20;
constexpr size_t WS_WIN_T = 1 * MiB;
constexpr size_t WS_WUQ_T = 14 * MiB;
constexpr size_t WS_WUKV_T = WS_WUQ_T + 1536 * 512 * 2;
constexpr size_t WS_WG_T = WS_WUKV_T + 2 * MiB;
constexpr size_t WS_WOUT_T = WS_WG_T + 1 * MiB;
constexpr size_t WS_WMQ_T = WS_WOUT_T + 8 * MiB;
constexpr size_t WS_WMKV_T = WS_WMQ_T + 2 * MiB;
constexpr size_t WS_WMO_T = WS_WMKV_T + 4 * MiB;
constexpr size_t WS_WPQ_T = WS_WMO_T + 2 * MiB;
constexpr size_t WS_KEYS_T = WS_WPQ_T + 8 * MiB;
constexpr size_t WS_COS = 43 * MiB, WS_SIN = 45 * MiB;
constexpr size_t WS_MEMB = 47 * MiB;
constexpr size_t WS_MEMKV = 55 * MiB;
constexpr size_t WS_GTAB = 59 * MiB;
static_assert(WS_KEYS_T + 256 * 256 * 2 <= WS_COS, "weights region");
constexpr size_t WS_LAF = 60 * MiB, WS_BTF = 92 * MiB, WS_LAB = 124 * MiB, WS_BTB = 156 * MiB;
constexpr size_t WS_PU = 60 * MiB, WS_PV = 124 * MiB;
constexpr size_t WS_PINV = 59 * MiB + 65536;
constexpr size_t WS_X = 188 * MiB;
constexpr size_t WS_CQ = 252 * MiB, WS_CKV = 268 * MiB, WS_KPE = 284 * MiB;
constexpr size_t WS_LRUX = 286 * MiB, WS_GATE = 318 * MiB, WS_YMIX = 350 * MiB, WS_XC = 414 * MiB;
constexpr size_t WS_QM = WS_CQ, WS_OM = WS_CKV, WS_QP = WS_YMIX, WS_IDX = WS_LRUX, WS_GV = WS_LRUX + 8 * MiB, WS_ACT = WS_LRUX + 16 * MiB;
constexpr size_t WS_END = 446 * MiB;
constexpr size_t DO_Q = 0, DO_K = 48 * MiB, DO_V = 96 * MiB;

__device__ __forceinline__ unsigned f2bf(float f) { unsigned u = __float_as_uint(f); return (u + 0x7fffu + ((u >> 16) & 1u)) >> 16; }
__device__ __forceinline__ float bf2f(unsigned h) { return __uint_as_float(h << 16); }
__device__ __forceinline__ unsigned pk2(float lo, float hi) { unsigned r; asm("v_cvt_pk_bf16_f32 %0, %1, %2" : "=v"(r) : "v"(lo), "v"(hi)); return r; }
__device__ __forceinline__ float bflo(unsigned w) { return __uint_as_float(w << 16); }
__device__ __forceinline__ float bfhi(unsigned w) { return __uint_as_float(w & 0xffff0000u); }
__device__ __forceinline__ float dpp_sum64(float v) {
#define DPPF(x, ctrl, rm, bc) __builtin_bit_cast(float, __builtin_amdgcn_update_dpp(0, __builtin_bit_cast(int, x), ctrl, rm, 0xf, bc))
  v += DPPF(v, 0x111, 0xf, true); v += DPPF(v, 0x112, 0xf, true); v += DPPF(v, 0x114, 0xf, true); v += DPPF(v, 0x118, 0xf, true);
  v += DPPF(v, 0x142, 0xa, false); v += DPPF(v, 0x143, 0xc, false);
#undef DPPF
  return __uint_as_float(__builtin_amdgcn_readlane(__float_as_uint(v), 63));
}
__device__ __forceinline__ unsigned dpp_max64_u32(unsigned v) {
#define DPPU(x, ctrl, rm, bc) (unsigned)__builtin_amdgcn_update_dpp(0, (int)(x), ctrl, rm, 0xf, bc)
  unsigned w;
  w = DPPU(v, 0x111, 0xf, true); v = v > w ? v : w; w = DPPU(v, 0x112, 0xf, true); v = v > w ? v : w;
  w = DPPU(v, 0x114, 0xf, true); v = v > w ? v : w; w = DPPU(v, 0x118, 0xf, true); v = v > w ? v : w;
  w = DPPU(v, 0x142, 0xa, false); v = v > w ? v : w; w = DPPU(v, 0x143, 0xc, false); v = v > w ? v : w;
#undef DPPU
  return (unsigned)__builtin_amdgcn_readlane((int)v, 63);
}
__device__ __forceinline__ float wave_sum(float v) {
#pragma unroll
  for (int o = 1; o < 64; o <<= 1) v += __shfl_xor(v, o);
  return v;
}
__device__ __forceinline__ float wave_max(float v) {
#pragma unroll
  for (int o = 1; o < 64; o <<= 1) v = fmaxf(v, __shfl_xor(v, o));
  return v;
}
__device__ __forceinline__ unsigned wave_max_u32(unsigned v) {
#pragma unroll
  for (int o = 1; o < 64; o <<= 1) { unsigned w = (unsigned)__shfl_xor((int)v, o); v = v > w ? v : w; }
  return v;
}
typedef __bf16 bf16x2_t __attribute__((ext_vector_type(2)));
__device__ __forceinline__ float dot2_bf16(unsigned w, unsigned x, float acc) { return __builtin_amdgcn_fdot2_f32_bf16(__builtin_bit_cast(bf16x2_t, w), __builtin_bit_cast(bf16x2_t, x), acc, false); }
__device__ __forceinline__ float sigmoidf_(float x) { return __builtin_amdgcn_rcpf(1.f + __expf(-x)); }
__device__ __forceinline__ float neg_expm1_small(float x) {
  const float s = x * (1.f + x * (0.5f + x * (1.6666667e-1f + x * (4.1666667e-2f + x * (8.3333333e-3f + x * 1.3888889e-3f)))));
  const float e = 1.f - __builtin_amdgcn_exp2f(x * 1.4426950408889634f);
  return x > -0.25f ? -s : e;
}
__device__ __forceinline__ float gelu_tanh(float x) {
  const float u = 0.7978845608028654f * (x + 0.044715f * x * x * x);
  const float t = 1.f - 2.f / (__expf(2.f * u) + 1.f);
  return 0.5f * x * (1.f + t);
}
__device__ __forceinline__ float gelu_erf(float x) { return 0.5f * x * (1.f + erff(x * 0.7071067811865476f)); }
__device__ __forceinline__ void unpack8(u32x4 w, float* f) {
  f[0] = bflo(w.x); f[1] = bfhi(w.x); f[2] = bflo(w.y); f[3] = bfhi(w.y); f[4] = bflo(w.z); f[5] = bfhi(w.z); f[6] = bflo(w.w); f[7] = bfhi(w.w);
}
__device__ __forceinline__ u32x4 pack8(const float* f) { u32x4 w; w.x = pk2(f[0], f[1]); w.y = pk2(f[2], f[3]); w.z = pk2(f[4], f[5]); w.w = pk2(f[6], f[7]); return w; }

struct Params { const float* in[35]; float* out; unsigned char* ws; };

__device__ __forceinline__ const float* wsrc(const float* const* in, int mid, int n, int& ld) {
  switch (mid) {
    case 0: { ld = 3136; int c; if (n < 1024) c = n; else if (n < 3072) c = n + 64; else if (n < 3136) { int i = (n - 3072) >> 1, g = (n - 3072) & 1; c = 1024 + g * 32 + i; } else return nullptr; return in[5] + c; }
    case 1: { ld = 1536; int h = n / 192, j = n % 192, c; if (j < 128) c = h * 192 + j; else { int i = (j - 128) >> 1, g = (j - 128) & 1; c = h * 192 + 128 + g * 32 + i; } return in[7] + c; }
    case 2: { ld = 2048; int c; if (n < 1024) c = (n >> 7) * 256 + (n & 127); else { int m = n - 1024; c = (m >> 7) * 256 + 128 + (m & 127); } return in[9] + c; }
    case 3: ld = 2048; return in[19] + n;
    case 4: ld = 512; return in[22] + n;
    case 5: ld = 512; return n < 512 ? in[23] + n : in[24] + (n - 512);
    case 6: ld = 2048; return in[25] + n;
    case 7: ld = 2048; return in[28] + n;
    default: { ld = 128; int nb = n >> 9, q = n & 511, dir = q >> 8, jj = (q & 255) >> 1, gate = q & 1; const float* m = (gate ? in[14] : in[12]) + (size_t)((dir * 8 + nb) * 128) * 128; return m + jj; }
  }
}
__device__ __forceinline__ void transpose_item(const float* const* in, int mid, int K, bf16_t* WT, float* scr, int item, int nblk, int lane) {
  const int kb = item / nblk, nb = item % nblk, k0 = 64 * kb, n0 = 32 * nb;
  int ld = 0; const float* base = wsrc(in, mid, n0 + (lane & 31), ld);
  float tv[32];
#pragma unroll
  for (int i = 0; i < 32; ++i) { const int kk = 2 * i + (lane >> 5); tv[i] = base ? base[(size_t)(k0 + kk) * ld] : 0.f; }
#pragma unroll
  for (int i = 0; i < 32; ++i) { const int kk = 2 * i + (lane >> 5); scr[kk * 33 + (lane & 31)] = tv[i]; }
  asm volatile("s_waitcnt lgkmcnt(0)" ::: "memory");
  const int c = lane & 7;
#pragma unroll
  for (int j = 0; j < 4; ++j) { const int n = (lane >> 3) + 8 * j; const float* s = scr + (8 * c) * 33 + n;
    u32x4 o; o.x = pk2(s[0 * 33], s[1 * 33]); o.y = pk2(s[2 * 33], s[3 * 33]); o.z = pk2(s[4 * 33], s[5 * 33]); o.w = pk2(s[6 * 33], s[7 * 33]);
    *(u32x4*)(WT + (size_t)(n0 + n) * K + k0 + 8 * c) = o; }
  asm volatile("s_waitcnt lgkmcnt(0)" ::: "memory");
}
__device__ __forceinline__ void ln_row_regs(float (&v)[32], const float* g, const float* b, int lane) {
  float s = 0.f;
#pragma unroll
  for (int i = 0; i < 32; ++i) s += v[i];
  const float mean = dpp_sum64(s) * (1.f / 2048.f);
  float q = 0.f;
#pragma unroll
  for (int i = 0; i < 32; ++i) { v[i] -= mean; q += v[i] * v[i]; }
  const float rstd = rsqrtf(dpp_sum64(q) * (1.f / 2048.f) + LN_EPS);
#pragma unroll
  for (int j = 0; j < 4; ++j) {
    const f32x4 g0 = *(const f32x4*)(g + j * 512 + lane * 8), g1 = *(const f32x4*)(g + j * 512 + lane * 8 + 4);
    const f32x4 b0 = *(const f32x4*)(b + j * 512 + lane * 8), b1 = *(const f32x4*)(b + j * 512 + lane * 8 + 4);
#pragma unroll
    for (int e = 0; e < 4; ++e) { v[j * 8 + e] = v[j * 8 + e] * rstd * g0[e] + b0[e]; v[j * 8 + 4 + e] = v[j * 8 + 4 + e] * rstd * g1[e] + b1[e]; }
  }
}
__device__ __forceinline__ void sincos_big(float ang, float& c, float& s) {
  const double a = (double)ang;
  const double q = __builtin_rint(a * 0.63661977236758134308);
  const float r = (float)(a - q * 1.57079632679489661923);
  const int qi = ((int)q) & 3;
  const float r2 = r * r;
  const float sn = r + r * r2 * (-1.6666667e-1f + r2 * (8.3333333e-3f + r2 * (-1.9841270e-4f + r2 * 2.7557319e-6f)));
  const float cs = 1.f + r2 * (-0.5f + r2 * (4.1666667e-2f + r2 * (-1.3888889e-3f + r2 * (2.4801587e-5f + r2 * -2.7557319e-7f))));
  const float ss = (qi & 1) ? cs : sn, cc = (qi & 1) ? sn : cs;
  s = (qi & 2) ? -ss : ss;
  c = ((qi + 1) & 2) ? -cc : cc;
}

template <int WHICH> __device__ __forceinline__ void transpose_list(const Params& p, float* scr, int gw, int ngw, int lane) {
  struct TI { int mid, ndst, K; size_t off; };
  constexpr int NT = (WHICH == 0) ? 2 : (WHICH == 1) ? 7 : 9;
  const TI all[9] = {{0, 3328, 2048, WS_WIN_T}, {5, 1024, 2048, WS_WMKV_T}, {1, 1536, 512, WS_WUQ_T}, {2, 2048, 512, WS_WUKV_T}, {3, 2048, 2048, WS_WOUT_T}, {4, 512, 2048, WS_WMQ_T},
                     {6, 2048, 512, WS_WMO_T}, {7, 2048, 2048, WS_WPQ_T}, {8, 4096, 128, WS_WG_T}};
  constexpr int T0 = (WHICH == 1) ? 2 : 0;
  int total = 0;
#pragma unroll
  for (int t = 0; t < NT; ++t) total += (all[T0 + t].ndst / 32) * (all[T0 + t].K / 64);
  for (int git = gw; git < total; git += ngw) {
    int t = 0, it = git;
#pragma unroll
    for (int u = 0; u < NT - 1; ++u) { const int nit = (all[T0 + u].ndst / 32) * (all[T0 + u].K / 64); if (t == u && it >= nit) { it -= nit; t = u + 1; } }
    int mid = 0, ndst = 0, K = 0; size_t off = 0;
#pragma unroll
    for (int u = 0; u < NT; ++u) if (t == u) { mid = all[T0 + u].mid; ndst = all[T0 + u].ndst; K = all[T0 + u].K; off = all[T0 + u].off; }
    transpose_item(p.in, mid, K, (bf16_t*)(p.ws + off), scr, it, ndst / 32, lane);
  }
}
template <bool EARLY_ONLY> __device__ __forceinline__ void phase0(const Params& p, float* lds, int gw, int ngw, int lane, int wave) {
  unsigned char* ws = p.ws;
  float* scr = lds + wave * (64 * 33);
  transpose_list<(EARLY_ONLY ? 0 : 2)>(p, scr, gw, ngw, lane);
  { bf16_t* KT = (bf16_t*)(ws + WS_KEYS_T);
    for (int i = gw * 64 + lane; i < 256 * 256; i += ngw * 64) { const int n = i >> 8, k = i & 255; float v = 0.f;
      if (n < 128) { if (k < 128) v = p.in[29][n * 128 + k]; } else { if (k >= 128) v = p.in[30][(n - 128) * 128 + (k - 128)]; }
      KT[i] = (bf16_t)f2bf(v); } }
  { f32x4* gt = (f32x4*)(ws + WS_GTAB);
    for (int i = gw * 64 + lane; i < 2048; i += ngw * 64) gt[i] = (f32x4){8.f * log1pf(__expf(-p.in[16][i])), p.in[13][i], p.in[15][i], 0.f}; }
  { float* ct = (float*)(ws + WS_COS); float* st = (float*)(ws + WS_SIN); const int* pos = (const int*)p.in[2];
    for (int i = gw * 64 + lane; i < T_ * 32; i += ngw * 64) { const int t = i >> 5, f = i & 31;
      const float inv = exp2f(-(float)(2 * f) * (13.287712379549449f / 64.f));
      const float ang = (float)pos[t] * inv; float c, s; sincos_big(ang, c, s); ct[i] = c; st[i] = s; } }
  { const float* m = p.in[1]; bf16_t* mb = (bf16_t*)(ws + WS_MEMB);
    for (size_t i = (size_t)(gw * 64 + lane) * 8; i < (size_t)2048 * 2048; i += (size_t)ngw * 64 * 8) {
      const f32x4 a = *(const f32x4*)(m + i), b = *(const f32x4*)(m + i + 4); u32x4 o; o.x = pk2(a[0], a[1]); o.y = pk2(a[2], a[3]); o.z = pk2(b[0], b[1]); o.w = pk2(b[2], b[3]);
      *(u32x4*)(mb + i) = o; } }
  { const float* x = p.in[0]; bf16_t* X = (bf16_t*)(ws + WS_X);
    for (int r0 = gw * 2; r0 < T_; r0 += ngw * 2) { float v[2][32];
#pragma unroll
      for (int rr = 0; rr < 2; ++rr)
#pragma unroll
        for (int j = 0; j < 4; ++j) { const f32x4 a = *(const f32x4*)(x + (size_t)(r0 + rr) * DM + j * 512 + lane * 8), b = *(const f32x4*)(x + (size_t)(r0 + rr) * DM + j * 512 + lane * 8 + 4);
#pragma unroll
          for (int e = 0; e < 4; ++e) { v[rr][j * 8 + e] = a[e]; v[rr][j * 8 + 4 + e] = b[e]; } }
#pragma unroll
      for (int rr = 0; rr < 2; ++rr) { ln_row_regs(v[rr], p.in[3], p.in[4], lane);
#pragma unroll
        for (int j = 0; j < 4; ++j) *(u32x4*)(X + (size_t)(r0 + rr) * DM + j * 512 + lane * 8) = pack8(&v[rr][j * 8]); } } }
}

enum { E_WIN = 0, E_MEMKV, E_Q, E_KV, E_GATES, E_RES, E_BF16, E_F32 };
struct EpiArgs { unsigned char* ws; unsigned char* dout; const float* const* in; bf16_t* o; float* f; int ld; };
__device__ __forceinline__ void st4(bf16_t* ptr, f32x4 v) { u32x2 w; w.x = pk2(v[0], v[1]); w.y = pk2(v[2], v[3]); *(u32x2*)ptr = w; }
template <int MODE> __device__ __forceinline__ void epi(const EpiArgs& e, int batch, int row, int col, f32x4 v) {
  if constexpr (MODE == E_WIN) {
    if (col < 512) st4((bf16_t*)(e.ws + WS_CQ) + (size_t)row * 512 + col, v);
    else if (col < 1024) st4((bf16_t*)(e.ws + WS_CKV) + (size_t)row * 512 + (col - 512), v);
    else if (col < 2048) st4((bf16_t*)(e.ws + WS_LRUX) + (size_t)row * 1024 + (col - 1024), v);
    else if (col < 3072) { f32x4 g; for (int i = 0; i < 4; ++i) g[i] = gelu_tanh(v[i]); st4((bf16_t*)(e.ws + WS_GATE) + (size_t)row * 1024 + (col - 2048), g); }
    else if (col < 3136) st4((bf16_t*)(e.ws + WS_KPE) + (size_t)row * 64 + (col - 3072), v);
  } else if constexpr (MODE == E_MEMKV) {
    st4((bf16_t*)(e.ws + WS_MEMKV) + (size_t)row * 1024 + col, v);
  } else if constexpr (MODE == E_Q) {
    const int j = col % 192;
    if (j >= 128) { const int i0 = (j - 128) >> 1; const float* ct = (const float*)(e.ws + WS_COS) + (size_t)row * 32 + i0; const float* st = (const float*)(e.ws + WS_SIN) + (size_t)row * 32 + i0;
      const float c0 = ct[0], s0 = st[0], c1 = ct[1], s1 = st[1];
      v = (f32x4){v[0] * c0 - v[1] * s0, v[1] * c0 + v[0] * s0, v[2] * c1 - v[3] * s1, v[3] * c1 + v[2] * s1}; }
    st4((bf16_t*)(e.dout + DO_Q) + (size_t)row * 1536 + col, v);
  } else if constexpr (MODE == E_KV) {
    if (col < 1024) st4((bf16_t*)(e.dout + DO_K) + (size_t)row * 1536 + (col >> 7) * 192 + (col & 127), v);
    else st4((bf16_t*)(e.dout + DO_V) + (size_t)row * 1024 + (col - 1024), v);
  } else if constexpr (MODE == E_GATES) {
    const int dir = col >> 8, jj = (col & 255) >> 1, c0 = batch * 128 + jj;
    const f32x4* gt = (const f32x4*)(e.ws + WS_GTAB) + dir * 1024 + c0;
    const f32x4 t0 = gt[0], t1 = gt[1];
    const unsigned xw = *(const unsigned*)((const bf16_t*)(e.ws + WS_XC) + (size_t)row * 1024 + c0);
    const float la0 = -t0[0] * sigmoidf_(v[0] + t0[1]), la1 = -t1[0] * sigmoidf_(v[2] + t1[1]);
    const float bt0 = __builtin_amdgcn_sqrtf(neg_expm1_small(2.f * la0)) * sigmoidf_(v[1] + t0[2]) * bflo(xw);
    const float bt1 = __builtin_amdgcn_sqrtf(neg_expm1_small(2.f * la1)) * sigmoidf_(v[3] + t1[2]) * bfhi(xw);
    bf16_t* LA = (bf16_t*)(e.ws + (dir ? WS_LAB : WS_LAF)); bf16_t* BT = (bf16_t*)(e.ws + (dir ? WS_BTB : WS_BTF));
    *(unsigned*)(LA + (size_t)row * 1024 + c0) = pk2(la0, la1);
    *(unsigned*)(BT + (size_t)row * 1024 + c0) = pk2(bt0, bt1);
  } else if constexpr (MODE == E_RES) {
    bf16_t* X = (bf16_t*)(e.ws + WS_X) + (size_t)row * DM + col; const u32x2 w = *(const u32x2*)X;
    v = (f32x4){DN_ALPHA * bflo(w.x) + v[0], DN_ALPHA * bfhi(w.x) + v[1], DN_ALPHA * bflo(w.y) + v[2], DN_ALPHA * bfhi(w.y) + v[3]};
    st4(X, v);
  } else if constexpr (MODE == E_BF16) {
    st4(e.o + (size_t)row * e.ld + col, v);
  } else {
    *(f32x4*)(e.f + (size_t)row * e.ld + col) = v;
  }
}


__device__ __forceinline__ void st8(bf16_t* ptr, f32x4 a, f32x4 b) { u32x4 w; w.x = pk2(a[0], a[1]); w.y = pk2(a[2], a[3]); w.z = pk2(b[0], b[1]); w.w = pk2(b[2], b[3]); *(u32x4*)ptr = w; }
template <int MODE> __device__ __forceinline__ void epi8(const EpiArgs& e, int batch, int row, int col, f32x4 v0, f32x4 v1) {
  if constexpr (MODE == E_WIN) {
    if (col < 512) st8((bf16_t*)(e.ws + WS_CQ) + (size_t)row * 512 + col, v0, v1);
    else if (col < 1024) st8((bf16_t*)(e.ws + WS_CKV) + (size_t)row * 512 + (col - 512), v0, v1);
    else if (col < 2048) st8((bf16_t*)(e.ws + WS_LRUX) + (size_t)row * 1024 + (col - 1024), v0, v1);
    else if (col < 3072) { f32x4 g0, g1;
#pragma unroll
      for (int i = 0; i < 4; ++i) { g0[i] = gelu_tanh(v0[i]); g1[i] = gelu_tanh(v1[i]); }
      st8((bf16_t*)(e.ws + WS_GATE) + (size_t)row * 1024 + (col - 2048), g0, g1); }
    else if (col < 3136) st8((bf16_t*)(e.ws + WS_KPE) + (size_t)row * 64 + (col - 3072), v0, v1);
  } else if constexpr (MODE == E_MEMKV) {
    st8((bf16_t*)(e.ws + WS_MEMKV) + (size_t)row * 1024 + col, v0, v1);
  } else if constexpr (MODE == E_Q) {
    const int j = col % 192;
    if (j >= 128) { const int i0 = (j - 128) >> 1; const f32x4 c = *(const f32x4*)((const float*)(e.ws + WS_COS) + (size_t)row * 32 + i0), s = *(const f32x4*)((const float*)(e.ws + WS_SIN) + (size_t)row * 32 + i0);
      v0 = (f32x4){v0[0] * c[0] - v0[1] * s[0], v0[1] * c[0] + v0[0] * s[0], v0[2] * c[1] - v0[3] * s[1], v0[3] * c[1] + v0[2] * s[1]};
      v1 = (f32x4){v1[0] * c[2] - v1[1] * s[2], v1[1] * c[2] + v1[0] * s[2], v1[2] * c[3] - v1[3] * s[3], v1[3] * c[3] + v1[2] * s[3]}; }
    st8((bf16_t*)(e.dout + DO_Q) + (size_t)row * 1536 + col, v0, v1);
  } else if constexpr (MODE == E_KV) {
    if (col < 1024) st8((bf16_t*)(e.dout + DO_K) + (size_t)row * 1536 + (col >> 7) * 192 + (col & 127), v0, v1);
    else st8((bf16_t*)(e.dout + DO_V) + (size_t)row * 1024 + (col - 1024), v0, v1);
  } else if constexpr (MODE == E_GATES) {
    const int dir = col >> 8, jj = (col & 255) >> 1, c0 = batch * 128 + jj;
    const f32x4* gt = (const f32x4*)(e.ws + WS_GTAB) + dir * 1024 + c0;
    const u32x2 xw = *(const u32x2*)((const bf16_t*)(e.ws + WS_XC) + (size_t)row * 1024 + c0);
    const float xc[4] = {bflo(xw.x), bfhi(xw.x), bflo(xw.y), bfhi(xw.y)}; const float vv[8] = {v0[0], v0[1], v0[2], v0[3], v1[0], v1[1], v1[2], v1[3]};
    float la[4], bt[4];
#pragma unroll
    for (int i = 0; i < 4; ++i) { const f32x4 t = gt[i]; la[i] = -t[0] * sigmoidf_(vv[2 * i] + t[1]);
      bt[i] = __builtin_amdgcn_sqrtf(neg_expm1_small(2.f * la[i])) * sigmoidf_(vv[2 * i + 1] + t[2]) * xc[i]; }
    bf16_t* LA = (bf16_t*)(e.ws + (dir ? WS_LAB : WS_LAF)); bf16_t* BT = (bf16_t*)(e.ws + (dir ? WS_BTB : WS_BTF));
    u32x2 lw, bw; lw.x = pk2(la[0], la[1]); lw.y = pk2(la[2], la[3]); bw.x = pk2(bt[0], bt[1]); bw.y = pk2(bt[2], bt[3]);
    *(u32x2*)(LA + (size_t)row * 1024 + c0) = lw; *(u32x2*)(BT + (size_t)row * 1024 + c0) = bw;
  } else if constexpr (MODE == E_BF16) {
    st8(e.o + (size_t)row * e.ld + col, v0, v1);
  } else {
    *(f32x4*)(e.f + (size_t)row * e.ld + col) = v0; *(f32x4*)(e.f + (size_t)row * e.ld + col + 4) = v1;
  }
}

struct GemmArgs { const bf16_t* A; size_t lda, a_batch; const bf16_t* Bt; size_t ldb, b_batch; int M, N, K, nbatch; int rot = 0; };
template <int MODE> __device__ __forceinline__ void gemm_simple(const GemmArgs& g, const EpiArgs& e, int bid, int nblk, int wave, int lane) {
  const int tm = g.M / 128, tn = g.N / 128, per = tm * tn, units = g.nbatch * per;
  const int r32 = lane & 31, hi = lane >> 5, wr = wave >> 1, wc = wave & 1;
  for (int u = bid; u < units; u += nblk) {
    const int bt = u / per, r = u % per, pm = r / tn, pn = r % tn;
    const bf16_t* ap = g.A + (size_t)bt * g.a_batch + (size_t)(pm * 128 + wr * 32 + r32) * g.lda + 8 * hi;
    const bf16_t* bp0 = g.Bt + (size_t)bt * g.b_batch + (size_t)(pn * 128 + wc * 64 + r32) * g.ldb + 8 * hi;
    const bf16_t* bp1 = bp0 + 32 * g.ldb;
    f32x16 acc0 = {}, acc1 = {};
#pragma unroll 4
    for (int k0 = 0; k0 < g.K; k0 += 16) {
      const bf16x8 a = *(const bf16x8*)(ap + k0), b0 = *(const bf16x8*)(bp0 + k0), b1 = *(const bf16x8*)(bp1 + k0);
      acc0 = __builtin_amdgcn_mfma_f32_32x32x16_bf16(b0, a, acc0, 0, 0, 0);
      acc1 = __builtin_amdgcn_mfma_f32_32x32x16_bf16(b1, a, acc1, 0, 0, 0);
    }
    const int row = pm * 128 + wr * 32 + r32;
#pragma unroll
    for (int gq = 0; gq < 4; ++gq) {
      const int col = pn * 128 + wc * 64 + 8 * gq + 4 * hi;
      epi<MODE>(e, bt, row, col, (f32x4){acc0[4 * gq], acc0[4 * gq + 1], acc0[4 * gq + 2], acc0[4 * gq + 3]});
      epi<MODE>(e, bt, row, col + 32, (f32x4){acc1[4 * gq], acc1[4 * gq + 1], acc1[4 * gq + 2], acc1[4 * gq + 3]});
    }
  }
}


namespace pg8 {
#define PG8_LAS __attribute__((address_space(3)))
constexpr int BM = 256, BK = 64, HALF = 128, HTB = HALF * BK * 2, STAGE_BYTES = 8 * HTB, NXCD = 8, WGM = 8;
__host__ __device__ __forceinline__ int lds_byte(int r, int c) { const int st = (r >> 4) * 2 + (c >> 5), rr = r & 15, cc = c & 31, ob = rr * 64 + cc * 2; return st * 1024 + (ob ^ (((ob >> 9) & 1) << 5)); }
__host__ __device__ __forceinline__ void stage_rc(int b, int& R, int& C) { const int st = b / 1024, sb = b % 1024, swz = sb ^ (((sb >> 9) & 1) << 5); R = (st >> 1) * 16 + swz / 64; C = (st & 1) * 32 + (swz % 64) / 2; }
__host__ __device__ __forceinline__ int perm32(int rho) { const int n = rho >> 4, i = rho & 15; return 8 * (i >> 2) + 4 * n + (i & 3); }
struct Unit { int pm, pn; };
struct Gemm { const bf16_t* A; const bf16_t* Bt; int M, N, K; int lda, ldb; int pn_per_batch; int a_batch_elems; };
struct StaticOrder {
  int nM, nN, nwg, G, c;
  __device__ void init(int M, int N, int G_, int c_) { nM = M / BM; nN = N / BM; nwg = nM * nN; G = G_; c = c_; }
  __device__ bool next(int i, Unit& u) const {
    const long L = (long)i * G + c; if (L >= nwg) return false;
    int wgid = (int)L; { const int q = nwg / NXCD, r = nwg % NXCD, xcd = wgid % NXCD, off = wgid / NXCD; wgid = (xcd < r ? xcd * (q + 1) : r * (q + 1) + (xcd - r) * q) + off; }
    const int nig = WGM * nN, gid = wgid / nig, fm = gid * WGM, gsz = (nM - fm) < WGM ? (nM - fm) : WGM;
    u.pm = fm + ((wgid % nig) % gsz); u.pn = (wgid % nig) / gsz; return true;
  }
};
template <int MODE> struct EpiAdapter {
  static constexpr bool PERM = true;
  EpiArgs e; int nb_cols;
  __device__ __forceinline__ void operator()(const f32x4 (&acc)[2][2][4][2], const Unit& u, int wr, int wc, int fr, int fq) const {
    if constexpr (MODE == E_RES) {
      bf16_t* X = (bf16_t*)(e.ws + WS_X);
#pragma unroll
      for (int ai = 0; ai < 2; ++ai) { u32x4 rw[4][2];
#pragma unroll
        for (int m = 0; m < 4; ++m)
#pragma unroll
          for (int bj = 0; bj < 2; ++bj) rw[m][bj] = *(const u32x4*)(X + (size_t)(u.pm * BM + ai * HALF + wr * 64 + m * 16 + fr) * DM + u.pn * BM + bj * HALF + wc * 32 + 8 * fq);
#pragma unroll
        for (int m = 0; m < 4; ++m)
#pragma unroll
          for (int bj = 0; bj < 2; ++bj) { const u32x4 w = rw[m][bj]; const f32x4 a0 = acc[ai][bj][m][0], a1 = acc[ai][bj][m][1];
            st8(X + (size_t)(u.pm * BM + ai * HALF + wr * 64 + m * 16 + fr) * DM + u.pn * BM + bj * HALF + wc * 32 + 8 * fq,
                (f32x4){DN_ALPHA * bflo(w.x) + a0[0], DN_ALPHA * bfhi(w.x) + a0[1], DN_ALPHA * bflo(w.y) + a0[2], DN_ALPHA * bfhi(w.y) + a0[3]},
                (f32x4){DN_ALPHA * bflo(w.z) + a1[0], DN_ALPHA * bfhi(w.z) + a1[1], DN_ALPHA * bflo(w.w) + a1[2], DN_ALPHA * bfhi(w.w) + a1[3]}); }
        asm volatile("" ::: "memory"); }
      return;
    }
#pragma unroll
    for (int ai = 0; ai < 2; ++ai)
#pragma unroll
      for (int m = 0; m < 4; ++m) { const int row = u.pm * BM + ai * HALF + wr * 64 + m * 16 + fr;
#pragma unroll
        for (int bj = 0; bj < 2; ++bj) { const int colg = u.pn * BM + bj * HALF + wc * 32 + 8 * fq; const int batch = colg / nb_cols; const int col = colg - batch * nb_cols;
          epi8<MODE>(e, batch, row, col, acc[ai][bj][m][0], acc[ai][bj][m][1]); }
        asm volatile("" ::: "memory"); }
  }
};
template <class Epi>
__device__ __forceinline__ void gemm_phase(PG8_LAS unsigned char* lds, const Gemm g, const StaticOrder& S, const Epi& E) {
  int tid_ = threadIdx.x; asm volatile("" : "+v"(tid_));
  const int tid = tid_, wid = __builtin_amdgcn_readfirstlane(tid >> 6), lane = tid & 63, wr = wid >> 2, wc = wid & 3, fr = lane & 15, fq = lane >> 4;
  const int K = g.K, nt = K / BK;
  unsigned voffA[2], voffB[2];
#pragma unroll
  for (int i = 0; i < 2; ++i) { int R, C; stage_rc(tid * 16 + i * 8192, R, C); const int Rb = Epi::PERM ? ((R & ~31) + perm32(R & 31)) : R; voffA[i] = (unsigned)(R * g.lda + C) * 2u; voffB[i] = (unsigned)(Rb * g.ldb + C) * 2u; }
  const size_t kstep = (size_t)(BK * 2);
  const size_t hstepA = (size_t)HALF * g.lda * 2, hstepB = (size_t)HALF * g.ldb * 2;
  const size_t tstepA = 2 * hstepA, tstepB = 2 * hstepB;
  const unsigned ldsw = (unsigned)wid * 1024u;
  const int aoff = lds_byte(wr * 64 + fr, fq * 8), boff = lds_byte(wc * 32 + fr, fq * 8);
#define PG8_SA(b, h) (((b) * 2 + (h)) * HTB)
#define PG8_SB(b, h) ((4 + (b) * 2 + (h)) * HTB)
#define PG8_STAGE(bufoff, gbase, voff) do { _Pragma("unroll") for (int _i = 0; _i < 2; ++_i) \
    __builtin_amdgcn_global_load_lds((const unsigned*)((const char*)(gbase) + (voff)[_i]), (PG8_LAS unsigned*)(lds + (bufoff) + ldsw + _i * 8192), 16, 0, 0); } while (0)
#define PG8_LDA(dst, b, h) do { _Pragma("unroll") for (int m = 0; m < 4; ++m) _Pragma("unroll") for (int k = 0; k < 2; ++k) dst[m][k] = *(const PG8_LAS bf16x8*)(lds + PG8_SA(b, h) + aoff + m * 2048 + k * 1024); } while (0)
#define PG8_LDB(dst, b, h) do { _Pragma("unroll") for (int n = 0; n < 2; ++n) _Pragma("unroll") for (int k = 0; k < 2; ++k) dst[n][k] = *(const PG8_LAS bf16x8*)(lds + PG8_SB(b, h) + boff + n * 2048 + k * 1024); } while (0)
#define PG8_MMA(ai, bj, At, Bt) do { __builtin_amdgcn_s_setprio(1); _Pragma("unroll") for (int m = 0; m < 4; ++m) _Pragma("unroll") for (int n = 0; n < 2; ++n) _Pragma("unroll") for (int k = 0; k < 2; ++k) \
    acc[ai][bj][m][n] = __builtin_amdgcn_mfma_f32_16x16x32_bf16(Bt[n][k], At[m][k], acc[ai][bj][m][n], 0, 0, 0); __builtin_amdgcn_s_setprio(0); } while (0)
#define PG8_WAIT_V(n) asm volatile("s_waitcnt vmcnt(" #n ")" ::: "memory")
#define PG8_WAIT_L(n) asm volatile("s_waitcnt lgkmcnt(" #n ")" ::: "memory")
#define PG8_BAR __builtin_amdgcn_s_barrier()
#define PG8_SCHED __builtin_amdgcn_sched_barrier(0)
#define PG8_APTR(u) ((const char*)g.A + (size_t)(u).pm * tstepA + (size_t)((u).pn / g.pn_per_batch) * g.a_batch_elems * 2)
#define PG8_BPTR(u) ((const char*)g.Bt + (size_t)(u).pn * tstepB)
  Unit cur, nxt; int ui = 0;
  if (!S.next(0, cur)) return;
  f32x4 acc[2][2][4][2];
#pragma unroll
  for (int a = 0; a < 2; ++a)
#pragma unroll
    for (int b = 0; b < 2; ++b)
#pragma unroll
      for (int m = 0; m < 4; ++m)
#pragma unroll
        for (int n = 0; n < 2; ++n) acc[a][b][m][n] = (f32x4){0.f, 0.f, 0.f, 0.f};
  bf16x8 At[4][2], B0[2][2], B1[2][2];
  const char* cA = PG8_APTR(cur); const char* cB = PG8_BPTR(cur);
  PG8_STAGE(PG8_SB(0, 0), cB, voffB); PG8_STAGE(PG8_SB(0, 1), cB + hstepB, voffB); PG8_STAGE(PG8_SA(0, 0), cA, voffA); PG8_STAGE(PG8_SA(0, 1), cA + hstepA, voffA);
  if (wr == 1) PG8_BAR;
  PG8_WAIT_V(2); PG8_BAR;
  PG8_STAGE(PG8_SB(1, 0), cB + kstep, voffB); PG8_STAGE(PG8_SA(1, 0), cA + kstep, voffA); PG8_STAGE(PG8_SB(1, 1), cB + hstepB + kstep, voffB);
  PG8_WAIT_V(6); PG8_BAR;
  for (;;) {
    const bool has_next = S.next(ui + 1, nxt);
    const char* nA = has_next ? PG8_APTR(nxt) : cA; const char* nB = has_next ? PG8_BPTR(nxt) : cB;
    for (int t = 0; t < nt; t += 2) {
      const bool last = (t == nt - 2);
      const char* a1 = cA + (size_t)(t + 1) * kstep;
      const char* a2 = last ? nA : cA + (size_t)(t + 2) * kstep; const char* b2 = last ? nB : cB + (size_t)(t + 2) * kstep;
      const char* a3 = a2 + kstep; const char* b3 = b2 + kstep;
      PG8_LDB(B0, 0, 0); PG8_LDB(B1, 0, 1); PG8_SCHED; PG8_LDA(At, 0, 0); PG8_STAGE(PG8_SA(1, 1), a1 + hstepA, voffA);
      PG8_WAIT_V(8); PG8_WAIT_L(0); PG8_BAR; PG8_MMA(0, 0, At, B0); PG8_MMA(0, 1, At, B1); PG8_BAR; PG8_SCHED;
      PG8_LDA(At, 0, 1); PG8_STAGE(PG8_SB(0, 0), b2, voffB); PG8_STAGE(PG8_SB(0, 1), b2 + hstepB, voffB); PG8_STAGE(PG8_SA(0, 0), a2, voffA);
      PG8_WAIT_V(8); PG8_WAIT_L(0); PG8_BAR; PG8_MMA(1, 0, At, B0); PG8_MMA(1, 1, At, B1); PG8_BAR; PG8_SCHED;
      PG8_LDB(B0, 1, 0); PG8_LDB(B1, 1, 1); PG8_SCHED; PG8_LDA(At, 1, 0); PG8_STAGE(PG8_SA(0, 1), a2 + hstepA, voffA);
      PG8_WAIT_V(8); PG8_WAIT_L(0); PG8_BAR; PG8_MMA(0, 0, At, B0); PG8_MMA(0, 1, At, B1); PG8_BAR; PG8_SCHED;
      PG8_LDA(At, 1, 1); PG8_STAGE(PG8_SB(1, 0), b3, voffB); PG8_STAGE(PG8_SB(1, 1), b3 + hstepB, voffB); PG8_STAGE(PG8_SA(1, 0), a3, voffA);
      PG8_WAIT_V(8); PG8_WAIT_L(0); PG8_BAR; PG8_MMA(1, 0, At, B0); PG8_MMA(1, 1, At, B1); PG8_BAR; PG8_SCHED;
    }
    if (wr == 0) PG8_BAR;
    E(acc, cur, wr, wc, fr, fq);
    if (!has_next) break;
#pragma unroll
    for (int a = 0; a < 2; ++a)
#pragma unroll
      for (int b = 0; b < 2; ++b)
#pragma unroll
        for (int m = 0; m < 4; ++m)
#pragma unroll
          for (int n = 0; n < 2; ++n) acc[a][b][m][n] = (f32x4){0.f, 0.f, 0.f, 0.f};
    cur = nxt; cA = nA; cB = nB; ++ui;
    if (wr == 1) PG8_BAR;
  }
  PG8_WAIT_V(0);
  PG8_BAR;
#undef PG8_SA
#undef PG8_SB
#undef PG8_STAGE
#undef PG8_LDA
#undef PG8_LDB
#undef PG8_MMA
#undef PG8_WAIT_V
#undef PG8_WAIT_L
#undef PG8_BAR
#undef PG8_SCHED
#undef PG8_APTR
#undef PG8_BPTR
}
}
template <int MODE> __device__ __forceinline__ void gemm_fast(const GemmArgs& g, const EpiArgs& e, unsigned char* lds_raw, int bid_, int nblk) {
  const int bid = (bid_ + g.rot) % nblk;
  pg8::Gemm G{g.A, g.Bt, g.M, g.N * g.nbatch, g.K, (int)g.lda, (int)g.ldb, g.nbatch > 1 ? g.N / 256 : (1 << 30), (int)g.a_batch};
  pg8::StaticOrder S; S.init(G.M, G.N, nblk, bid);
  pg8::EpiAdapter<MODE> E{e, g.N};
  pg8::gemm_phase<pg8::EpiAdapter<MODE>>((PG8_LAS unsigned char*)lds_raw, G, S, E);
}

__device__ __forceinline__ void phase1b(const Params& p, int gw, int ngw, int lane) {
  unsigned char* ws = p.ws;
  bf16_t* CQ = (bf16_t*)(ws + WS_CQ); bf16_t* CKV = (bf16_t*)(ws + WS_CKV); const bf16_t* KPE = (const bf16_t*)(ws + WS_KPE);
  bf16_t* Kd = (bf16_t*)((unsigned char*)p.out + DO_K); const bf16_t* LX = (const bf16_t*)(ws + WS_LRUX); bf16_t* XC = (bf16_t*)(ws + WS_XC);
  const float* ct = (const float*)(ws + WS_COS); const float* st = (const float*)(ws + WS_SIN);
  for (int r = gw; r < T_; r += ngw) {
#pragma unroll
    for (int which = 0; which < 2; ++which) {
      bf16_t* row = (which ? CKV : CQ) + (size_t)r * 512 + lane * 8; const float* g = p.in[which ? 8 : 6] + lane * 8;
      float f[8]; unpack8(*(const u32x4*)row, f); float q = 0.f;
#pragma unroll
      for (int i = 0; i < 8; ++i) q += f[i] * f[i];
      const float sc = rsqrtf(dpp_sum64(q) * (1.f / 512.f) + RMS_EPS);
#pragma unroll
      for (int i = 0; i < 8; ++i) f[i] = f[i] * sc * g[i];
      *(u32x4*)row = pack8(f);
    }
    {
      if (lane < 32) { const unsigned w = *(const unsigned*)(KPE + (size_t)r * 64 + 2 * lane); const float t1 = bflo(w), t2 = bfhi(w);
        const float c = ct[(size_t)r * 32 + lane], s = st[(size_t)r * 32 + lane]; const unsigned o = pk2(t1 * c - t2 * s, t2 * c + t1 * s);
#pragma unroll
        for (int h = 0; h < 8; ++h) *(unsigned*)(Kd + (size_t)r * 1536 + h * 192 + 128 + 2 * lane) = o; } }
    if (!USE_LRU_FUSED) {
      const int s = r & (S_ - 1); float acc[16];
      const float* cb = p.in[11] + lane * 16;
#pragma unroll
      for (int i = 0; i < 16; ++i) acc[i] = cb[i];
#pragma unroll
      for (int k = 0; k < 4; ++k) { const int sp = s + k - 2; if (sp < 0 || sp >= S_) continue;
        const bf16_t* src = LX + (size_t)(r + k - 2) * 1024 + lane * 16; const float* w = p.in[10] + k * 1024 + lane * 16;
        float f[16]; unpack8(*(const u32x4*)src, f); unpack8(*(const u32x4*)(src + 8), f + 8);
#pragma unroll
        for (int i = 0; i < 16; ++i) acc[i] += f[i] * w[i]; }
      *(u32x4*)(XC + (size_t)r * 1024 + lane * 16) = pack8(acc); *(u32x4*)(XC + (size_t)r * 1024 + lane * 16 + 8) = pack8(acc + 8);
    }
  }
}

template <int DQK, int NK> __device__ __forceinline__ void attn_scalar(const bf16_t* Q, int ldq, const bf16_t* K, int ldk, const bf16_t* V, int ldv, bf16_t* O, int ldo,
                                                                      int nheads, float scale, float* lds, int bid, int nblk, int tid) {
  float* sc = lds; float* qs = lds + 16 * NK; float* ls = qs + 16 * DQK;
  const int lane = tid & 63, wave = tid >> 6;
  const int units = NB_ * nheads * (S_ / 16);
  for (int u = bid; u < units; u += nblk) {
    const int qb = u % (S_ / 16), h = (u / (S_ / 16)) % nheads, b = u / ((S_ / 16) * nheads);
    __syncthreads();
    for (int i = tid; i < 16 * DQK; i += NTHR) { const int r = i / DQK, d = i % DQK; qs[i] = bf2f(Q[(size_t)(b * S_ + qb * 16 + r) * ldq + h * DQK + d]) * scale; }
    __syncthreads();
    for (int kk = tid; kk < NK; kk += NTHR) {
      const bf16_t* kp = K + (size_t)(b * NK + kk) * ldk + h * DQK; float acc[16];
#pragma unroll
      for (int r = 0; r < 16; ++r) acc[r] = 0.f;
      for (int d0 = 0; d0 < DQK; d0 += 8) { float kf[8]; unpack8(*(const u32x4*)(kp + d0), kf);
#pragma unroll
        for (int r = 0; r < 16; ++r) { const f32x4 q0 = *(const f32x4*)(qs + r * DQK + d0), q1 = *(const f32x4*)(qs + r * DQK + d0 + 4);
          acc[r] += q0[0] * kf[0] + q0[1] * kf[1] + q0[2] * kf[2] + q0[3] * kf[3] + q1[0] * kf[4] + q1[1] * kf[5] + q1[2] * kf[6] + q1[3] * kf[7]; } }
#pragma unroll
      for (int r = 0; r < 16; ++r) sc[r * NK + kk] = acc[r];
    }
    __syncthreads();
    for (int rr = 0; rr < 2; ++rr) { const int r = wave * 2 + rr; float m = -1e30f;
      for (int kk = lane; kk < NK; kk += 64) m = fmaxf(m, sc[r * NK + kk]);
      m = wave_max(m); float l = 0.f;
      for (int kk = lane; kk < NK; kk += 64) { const float pv = __expf(sc[r * NK + kk] - m); sc[r * NK + kk] = pv; l += pv; }
      l = wave_sum(l); if (lane == 0) ls[r] = l; }
    __syncthreads();
    { const int r = tid >> 5, d4 = (tid & 31) * 4; float a0 = 0.f, a1 = 0.f, a2 = 0.f, a3 = 0.f;
      const bf16_t* vp = V + (size_t)(b * NK) * ldv + h * 128 + d4;
      for (int kk = 0; kk < NK; ++kk) { const float pv = sc[r * NK + kk]; const u32x2 w = *(const u32x2*)(vp + (size_t)kk * ldv);
        a0 += pv * bflo(w.x); a1 += pv * bfhi(w.x); a2 += pv * bflo(w.y); a3 += pv * bfhi(w.y); }
      const float il = 1.f / ls[r];
      st4(O + (size_t)(b * S_ + qb * 16 + r) * ldo + h * 128 + d4, (f32x4){a0 * il, a1 * il, a2 * il, a3 * il}); }
  }
  __syncthreads();
}


namespace fa {
typedef short s16x4 __attribute__((ext_vector_type(4)));
constexpr int NW = 8, QBLK = 32, KVBLK = 64;
constexpr float THR = 8.f;
#define FA_SBAR() __builtin_amdgcn_sched_barrier(0)
__device__ __forceinline__ int crow(int r, int hi) { return (r & 3) + 8 * (r >> 2) + 4 * hi; }
__device__ __forceinline__ unsigned cvtpk(float lo, float hi) { unsigned r; asm volatile("v_cvt_pk_bf16_f32 %0, %1, %2" : "=v"(r) : "v"(lo), "v"(hi)); return r; }
__device__ __forceinline__ void partialSM(f32x16& p0, f32x16& p1, float& m_reg, float& mn, float& alpha, const float C, const float thr_s) {
  float pmax = p0[0];
#pragma unroll
  for (int r = 1; r < 16; ++r) pmax = fmaxf(pmax, p0[r]);
#pragma unroll
  for (int r = 0; r < 16; ++r) pmax = fmaxf(pmax, p1[r]);
  { auto rr = __builtin_amdgcn_permlane32_swap(__float_as_uint(pmax), __float_as_uint(pmax), false, false);
    pmax = fmaxf(__uint_as_float(rr[0]), __uint_as_float(rr[1])); }
  if (__builtin_expect(__all(pmax - m_reg <= thr_s), 1)) { mn = m_reg; alpha = 1.f; }
  else { mn = fmaxf(m_reg, pmax); alpha = __builtin_amdgcn_exp2f((m_reg - mn) * C); m_reg = mn; }
  const float mnC = -mn * C;
#pragma unroll
  for (int r = 0; r < 16; ++r) p0[r] = fmaf(p0[r], C, mnC);
#pragma unroll
  for (int r = 0; r < 16; ++r) p1[r] = fmaf(p1[r], C, mnC);
#pragma unroll
  for (int r = 0; r < 16; ++r) p0[r] = __builtin_amdgcn_exp2f(p0[r]);
}
__device__ __forceinline__ void finishSM(f32x16& p0, f32x16& p1, float alpha, float& l_reg, bf16x8& pa0, bf16x8& pa1, bf16x8& pa2, bf16x8& pa3) {
#pragma unroll
  for (int r = 0; r < 16; ++r) p1[r] = __builtin_amdgcn_exp2f(p1[r]);
  float ps = 0;
#pragma unroll
  for (int r = 0; r < 16; ++r) ps += p0[r];
#pragma unroll
  for (int r = 0; r < 16; ++r) ps += p1[r];
  { auto rr = __builtin_amdgcn_permlane32_swap(__float_as_uint(ps), __float_as_uint(ps), false, false);
    ps = __uint_as_float(rr[0]) + __uint_as_float(rr[1]); }
  l_reg = l_reg * alpha + ps;
#define FA_PK4(P, BASE, OUT) do { unsigned a0 = cvtpk(P[BASE + 0], P[BASE + 1]), a1 = cvtpk(P[BASE + 2], P[BASE + 3]);   \
    unsigned b0 = cvtpk(P[BASE + 4], P[BASE + 5]), b1 = cvtpk(P[BASE + 6], P[BASE + 7]);                              \
    auto r0 = __builtin_amdgcn_permlane32_swap(a0, b0, false, false); auto r1 = __builtin_amdgcn_permlane32_swap(a1, b1, false, false); \
    u32x4 w = {r0[0], r1[0], r0[1], r1[1]}; OUT = *reinterpret_cast<bf16x8*>(&w); } while (0)
  FA_PK4(p0, 0, pa0); FA_PK4(p0, 8, pa1); FA_PK4(p1, 0, pa2); FA_PK4(p1, 8, pa3);
#undef FA_PK4
}
template <int DQK> constexpr int krs() { return DQK == 192 ? 400 : DQK * 2; }
template <int DQK> __device__ __forceinline__ int kswz(int row, int colB) { return DQK == 192 ? row * 400 + colB : row * (DQK * 2) + (colB ^ ((row & 7) << 4)); }
template <int DQK> __device__ __forceinline__ void qkt(f32x16& p0, f32x16& p1, const char* Ks, const bf16x8* qr, const int* kb4) {
  p0 = f32x16{}; p1 = f32x16{};
#pragma unroll
  for (int d0 = 0; d0 < DQK / 16; ++d0) {
    const bf16x8 b0 = *reinterpret_cast<const bf16x8*>(Ks + kb4[d0 & 3] + (d0 >> 2) * 128);
    const bf16x8 b1 = *reinterpret_cast<const bf16x8*>(Ks + kb4[d0 & 3] + (d0 >> 2) * 128 + 32 * krs<DQK>());
    p0 = __builtin_amdgcn_mfma_f32_32x32x16_bf16(b0, qr[d0], p0, 0, 0, 0);
    p1 = __builtin_amdgcn_mfma_f32_32x32x16_bf16(b1, qr[d0], p1, 0, 0, 0); }
}
__device__ __forceinline__ int v_st(int k, int c) { const int kk = (k & ~0xC) | ((k & 4) << 1) | ((k & 8) >> 1); return ((kk >> 3) * 4 + (c >> 5)) * 512 + ((kk & 7) * 32 + (c & 31)) * 2; }
__device__ __forceinline__ int v_rd_base(int lane) { return ((lane & 3) << 3) | (((lane >> 2) & 3) << 6) | (((lane >> 4) & 1) << 5) | (((lane >> 5) & 1) << 8); }
constexpr int v_rd_off(int d0, int ks, int half) { return d0 * 512 + ks * 4096 + half * 2048; }
template <int OFF> __device__ __forceinline__ s16x4 tr_read(int vb) {
  s16x4 r; asm volatile("ds_read_b64_tr_b16 %0, %1 offset:%2" : "=&v"(r) : "v"(vb), "i"(OFF) : "memory"); return r;
}
template <int D0> __device__ __forceinline__ void pv_one(f32x16& od, int vb, bf16x8 pa0, bf16x8 pa1, bf16x8 pa2, bf16x8 pa3) {
  const s16x4 l0 = tr_read<v_rd_off(D0, 0, 0)>(vb), h0 = tr_read<v_rd_off(D0, 0, 1)>(vb), l1 = tr_read<v_rd_off(D0, 1, 0)>(vb), h1 = tr_read<v_rd_off(D0, 1, 1)>(vb);
  const s16x4 l2 = tr_read<v_rd_off(D0, 2, 0)>(vb), h2 = tr_read<v_rd_off(D0, 2, 1)>(vb), l3 = tr_read<v_rd_off(D0, 3, 0)>(vb), h3 = tr_read<v_rd_off(D0, 3, 1)>(vb);
  asm volatile("s_waitcnt lgkmcnt(0)" ::: "memory"); FA_SBAR();
#define FA_PK(L, H) (bf16x8){L[0], L[1], L[2], L[3], H[0], H[1], H[2], H[3]}
  od = __builtin_amdgcn_mfma_f32_32x32x16_bf16(pa0, FA_PK(l0, h0), od, 0, 0, 0);
  od = __builtin_amdgcn_mfma_f32_32x32x16_bf16(pa1, FA_PK(l1, h1), od, 0, 0, 0);
  od = __builtin_amdgcn_mfma_f32_32x32x16_bf16(pa2, FA_PK(l2, h2), od, 0, 0, 0);
  od = __builtin_amdgcn_mfma_f32_32x32x16_bf16(pa3, FA_PK(l3, h3), od, 0, 0, 0);
#undef FA_PK
}
__device__ __forceinline__ void pv_d0(f32x16* o, int vb, bf16x8 pa0, bf16x8 pa1, bf16x8 pa2, bf16x8 pa3) {
  pv_one<0>(o[0], vb, pa0, pa1, pa2, pa3); pv_one<1>(o[1], vb, pa0, pa1, pa2, pa3); pv_one<2>(o[2], vb, pa0, pa1, pa2, pa3); pv_one<3>(o[3], vb, pa0, pa1, pa2, pa3);
}
template <int DQK, int LDQ, int LDK, int LDV, int LDO>
__device__ __forceinline__ void attn_body(const bf16_t* __restrict__ Qb, const bf16_t* __restrict__ Kh, const bf16_t* __restrict__ Vh, bf16_t* __restrict__ Ob, int seq, float scale, char* lds) {
  constexpr int SHM_V = KVBLK * 128 * 2, SHM_K = KVBLK * krs<DQK>(), NKC = DQK / 64;
  const float C = scale * 1.4426950408889634f, thr_s = THR / scale;
  int tid_ = threadIdx.x; asm volatile("" : "+v"(tid_));
  const int tid = tid_, wid = tid >> 6, lane = tid & 63, r32 = lane & 31, hi = lane >> 5;
  char* V_lds = lds; char* K_lds = lds + 2 * SHM_V;
  float* wsf = (float*)(lds + 2 * SHM_V + 2 * SHM_K) + wid * 64; float* li_l = wsf; float* al_l = wsf + 32;
  float m_reg = -1e30f, l_reg = 0; f32x16 o[4] = {}; bf16x8 qr[DQK / 16];
  const bf16_t* Qw = Qb + (size_t)(wid * QBLK + r32) * LDQ + hi * 8;
#pragma unroll
  for (int d0 = 0; d0 < DQK / 16; ++d0) qr[d0] = *reinterpret_cast<const bf16x8*>(Qw + d0 * 16);
  const int sr = tid >> 4, sc = (tid & 15) * 8, vst0 = v_st(sr, sc), vst1 = v_st(32 + sr, sc);
  const int kgo0 = sr * LDK + sc, klo0 = kswz<DQK>(sr, sc * 2);
  const int kgo2 = (tid >> 3) * LDK + 128 + (tid & 7) * 8, klo2 = kswz<DQK>(tid >> 3, (128 + (tid & 7) * 8) * 2);
  const int vb0 = (int)(uintptr_t)V_lds + v_rd_base(lane);
  int kb4[4];
#pragma unroll
  for (int q = 0; q < 4; ++q) kb4[q] = kswz<DQK>(r32, q * 32 + hi * 16);
  bf16x8 vs0, vs1, ks[NKC];
#define FA_SLOAD(k0) do { vs0 = *reinterpret_cast<const bf16x8*>(&Vh[(size_t)((k0) + sr) * LDV + sc]); vs1 = *reinterpret_cast<const bf16x8*>(&Vh[(size_t)((k0) + 32 + sr) * LDV + sc]); \
    ks[0] = *reinterpret_cast<const bf16x8*>(&Kh[(size_t)(k0) * LDK + kgo0]); ks[1] = *reinterpret_cast<const bf16x8*>(&Kh[(size_t)((k0) + 32) * LDK + kgo0]); \
    if constexpr (NKC == 3) ks[NKC - 1] = *reinterpret_cast<const bf16x8*>(&Kh[(size_t)(k0) * LDK + kgo2]); } while (0)
#define FA_SWRITE(b) do { *(bf16x8*)(V_lds + (b) * SHM_V + vst0) = vs0; *(bf16x8*)(V_lds + (b) * SHM_V + vst1) = vs1; \
    *(bf16x8*)(K_lds + (b) * SHM_K + klo0) = ks[0]; *(bf16x8*)(K_lds + (b) * SHM_K + klo0 + 32 * krs<DQK>()) = ks[1]; \
    if constexpr (NKC == 3) *(bf16x8*)(K_lds + (b) * SHM_K + klo2) = ks[NKC - 1]; } while (0)
#define FA_SWAIT() asm volatile("s_waitcnt vmcnt(0)" ::: "memory")
#define FA_RESC(a) do { if (__any((a) < 1.f)) { if (hi == 0) al_l[r32] = (a); asm volatile("s_waitcnt lgkmcnt(0)" ::: "memory"); \
    _Pragma("unroll") for (int d = 0; d < 4; ++d) _Pragma("unroll") for (int r = 0; r < 16; ++r) o[d][r] *= al_l[crow(r, hi)]; } } while (0)
  f32x16 pA0, pA1, pB0, pB1; float mnA, mnB, alA, alB; bf16x8 pa0, pa1, pa2, pa3; const int NT = seq / KVBLK;
  FA_SLOAD(0); FA_SWAIT(); FA_SWRITE(0); __syncthreads();
  qkt<DQK>(pA0, pA1, K_lds, qr, kb4); partialSM(pA0, pA1, m_reg, mnA, alA, C, thr_s);
  FA_SLOAD(KVBLK);
  FA_SWAIT(); FA_SWRITE(1); __syncthreads();
  for (int j = 1; j + 1 < NT; j += 2) {
    FA_SBAR(); qkt<DQK>(pB0, pB1, K_lds + SHM_K, qr, kb4);
    finishSM(pA0, pA1, alA, l_reg, pa0, pa1, pa2, pa3); FA_SBAR();
    FA_SLOAD((j + 1) * KVBLK); FA_SBAR();
    pv_d0(o, vb0, pa0, pa1, pa2, pa3); partialSM(pB0, pB1, m_reg, mnB, alB, C, thr_s);
    __syncthreads(); FA_SWAIT(); FA_SWRITE(0);
    FA_RESC(alB); __syncthreads();
    FA_SBAR(); qkt<DQK>(pA0, pA1, K_lds, qr, kb4);
    finishSM(pB0, pB1, alB, l_reg, pa0, pa1, pa2, pa3); FA_SBAR();
    FA_SLOAD((j + 2) * KVBLK); FA_SBAR();
    pv_d0(o, vb0 + SHM_V, pa0, pa1, pa2, pa3); partialSM(pA0, pA1, m_reg, mnA, alA, C, thr_s);
    __syncthreads(); FA_SWAIT(); FA_SWRITE(1);
    FA_RESC(alA); __syncthreads();
  }
  FA_SBAR(); qkt<DQK>(pB0, pB1, K_lds + SHM_K, qr, kb4);
  finishSM(pA0, pA1, alA, l_reg, pa0, pa1, pa2, pa3); FA_SBAR();
  pv_d0(o, vb0, pa0, pa1, pa2, pa3); partialSM(pB0, pB1, m_reg, mnB, alB, C, thr_s);
  __syncthreads(); FA_RESC(alB);
  finishSM(pB0, pB1, alB, l_reg, pa0, pa1, pa2, pa3); FA_SBAR();
  pv_d0(o, vb0 + SHM_V, pa0, pa1, pa2, pa3);
  if (hi == 0) li_l[r32] = l_reg; asm volatile("s_waitcnt lgkmcnt(0)" ::: "memory");
  float rli[16];
#pragma unroll
  for (int r = 0; r < 16; ++r) rli[r] = __builtin_amdgcn_rcpf(li_l[crow(r, hi)]);
  bf16_t* Ow = Ob + (size_t)(wid * QBLK) * LDO;
#pragma unroll
  for (int r = 0; r < 16; ++r) { const int orow = crow(r, hi);
#pragma unroll
    for (int d0 = 0; d0 < 4; ++d0) Ow[(size_t)orow * LDO + d0 * 32 + r32] = (bf16_t)f2bf(o[d0][r] * rli[r]); }
  __syncthreads();
#undef FA_SLOAD
#undef FA_SWRITE
#undef FA_SWAIT
#undef FA_RESC
}
#undef FA_SBAR
}
__device__ __forceinline__ void mla_attn_phase(unsigned char* dout, unsigned char* ws, char* lds, int bid, int nblk) {
  for (int u = bid; u < NB_ * 8 * (S_ / 256); u += nblk) {
    const int qb = u & 7, h = (u >> 3) & 7, b = u >> 6;
    const bf16_t* Q = (const bf16_t*)(dout + DO_Q) + (size_t)(b * S_ + qb * 256) * 1536 + h * 192;
    const bf16_t* K = (const bf16_t*)(dout + DO_K) + (size_t)(b * S_) * 1536 + h * 192;
    const bf16_t* V = (const bf16_t*)(dout + DO_V) + (size_t)(b * S_) * 1024 + h * 128;
    bf16_t* O = (bf16_t*)(ws + WS_YMIX) + (size_t)(b * S_ + qb * 256) * 2048 + h * 128;
    fa::attn_body<192, 1536, 1536, 1024, 2048>(Q, K, V, O, S_, 0.07216878364870322f, lds);
  }
}

__device__ __forceinline__ void mem_attn_phase(unsigned char* ws, char* lds, int bid, int nblk) {
  for (int u = bid; u < NB_ * 4 * (S_ / 256); u += nblk) {
    const int qb = u & 7, h = (u >> 3) & 3, b = u >> 5;
    const bf16_t* Q = (const bf16_t*)(ws + WS_QM) + (size_t)(b * S_ + qb * 256) * 512 + h * 128;
    const bf16_t* K = (const bf16_t*)(ws + WS_MEMKV) + (size_t)(b * 256) * 1024 + h * 128;
    const bf16_t* V = K + 512;
    bf16_t* O = (bf16_t*)(ws + WS_OM) + (size_t)(b * S_ + qb * 256) * 512 + h * 128;
    fa::attn_body<128, 512, 1024, 1024, 512>(Q, K, V, O, 256, 0.08838834764831845f, lds);
  }
}
__device__ __forceinline__ void scan_phase(unsigned char* ws, float* lds, int bid, int nblk, int tid_in) {
  int tid = tid_in; asm volatile("" : "+v"(tid));
  f32x4* sA = (f32x4*)lds; f32x4* sB = sA + 512;
  const int cq = tid & 15, ch = tid >> 4;
  for (int it = bid; it < NB_ * 2 * 16; it += nblk) {
    const int cg_ = it & 15, dir = (it >> 4) & 1, b = it >> 5;
    const char* LA = (const char*)(ws + (dir ? WS_LAB : WS_LAF)) + ((size_t)b * S_ * 1024 + cg_ * 64) * 2;
    char* BT = (char*)(ws + (dir ? WS_BTB : WS_BTF)) + ((size_t)b * S_ * 1024 + cg_ * 64) * 2;
    const int sstep = dir ? -2048 : 2048;
    const unsigned off0 = (unsigned)((dir ? (S_ - 1 - ch * 64) : ch * 64) * 2048 + cq * 8);
    f32x4 A = {1.f, 1.f, 1.f, 1.f}, Bv = {0.f, 0.f, 0.f, 0.f};
    unsigned off = off0;
#pragma unroll 8
    for (int i = 0; i < 64; ++i) { const u32x2 lw = *(const u32x2*)(LA + off), bw = *(const u32x2*)(BT + off); off += sstep;
      const f32x4 a = {__expf(bflo(lw.x)), __expf(bfhi(lw.x)), __expf(bflo(lw.y)), __expf(bfhi(lw.y))}; const f32x4 bt = {bflo(bw.x), bfhi(bw.x), bflo(bw.y), bfhi(bw.y)};
      Bv = a * Bv + bt; A = A * a; }
    __syncthreads();
    sA[ch * 16 + cq] = A; sB[ch * 16 + cq] = Bv;
    __syncthreads();
    f32x4 h = {0.f, 0.f, 0.f, 0.f};
    for (int qq = 0; qq < ch; ++qq) h = sA[qq * 16 + cq] * h + sB[qq * 16 + cq];
    off = off0;
#pragma unroll 8
    for (int i = 0; i < 64; ++i) { const u32x2 lw = *(const u32x2*)(LA + off), bw = *(const u32x2*)(BT + off);
      const f32x4 a = {__expf(bflo(lw.x)), __expf(bfhi(lw.x)), __expf(bflo(lw.y)), __expf(bfhi(lw.y))}; const f32x4 bt = {bflo(bw.x), bfhi(bw.x), bflo(bw.y), bfhi(bw.y)};
      h = a * h + bt; u32x2 w; w.x = pk2(h[0], h[1]); w.y = pk2(h[2], h[3]); *(u32x2*)(BT + off) = w; off += sstep; }
  }
  __syncthreads();
}


__device__ __forceinline__ void lru_fused_phase(const Params& p, unsigned char* lds_raw, int bid, int nblk) {
  constexpr int RS = 272;
  constexpr int AST = 65;
  unsigned char* WL = lds_raw; unsigned char* XL = lds_raw + 128 * RS;
  f32x2* AB = (f32x2*)(lds_raw + 2 * 128 * RS); float* AG = (float*)(AB + 128 * AST);
  float* CAR = AG + 2 * 8 * 64;
  int tid_ = threadIdx.x; asm volatile("" : "+v"(tid_));
  const int tid = tid_, lane = tid & 63, wave = tid >> 6, r32 = lane & 31, hi = lane >> 5;
  unsigned char* ws = p.ws;
  const bf16_t* LX = (const bf16_t*)(ws + WS_LRUX);
  for (int it = bid; it < NB_ * 8 * 2 * 2; it += nblk) {
    const int half = it & 1, dir = (it >> 1) & 1, n = (it >> 2) & 7, b = it >> 5;
    const int ch0 = n * 128 + half * 64;
    __syncthreads();
    { const bf16_t* wg = (const bf16_t*)(ws + WS_WG_T) + (size_t)(n * 512 + dir * 256 + half * 128) * 128;
      for (int i = tid; i < 128 * 16; i += NTHR) { const int r = i >> 4, c8 = (i & 15) * 8; *(u32x4*)(WL + r * RS + c8 * 2) = *(const u32x4*)(wg + r * 128 + c8); } }
    if (tid < 64) CAR[tid] = 0.f;
    float cw0[4], cw1[4]; const float cb0 = p.in[11][n * 128 + 2 * lane], cb1 = p.in[11][n * 128 + 2 * lane + 1];
#pragma unroll
    for (int k = 0; k < 4; ++k) { cw0[k] = p.in[10][k * 1024 + n * 128 + 2 * lane]; cw1[k] = p.in[10][k * 1024 + n * 128 + 2 * lane + 1]; }
    bf16_t* H = (bf16_t*)(ws + (dir ? WS_BTB : WS_BTF));
    float tb0[16], tb1[16], tb2[16];
#pragma unroll
    for (int t = 0; t < 2; ++t)
#pragma unroll
      for (int g = 0; g < 4; ++g)
#pragma unroll
        for (int u = 0; u < 2; ++u) { const int jl = (wave & 1) * 32 + 16 * t + 4 * g + 2 * hi + u; const f32x4 tb = *((const f32x4*)(ws + WS_GTAB) + dir * 1024 + ch0 + jl);
          tb0[t * 8 + g * 2 + u] = tb[0]; tb1[t * 8 + g * 2 + u] = tb[1]; tb2[t * 8 + g * 2 + u] = tb[2]; }
    unsigned xr[19];
#define LRU_LOADX(C) do { const int q0_ = (dir ? S_ - 128 * ((C) + 1) : 128 * (C)) + wave * 16; \
      _Pragma("unroll") for (int j = 0; j < 19; ++j) { const int row = q0_ + j - 2, rc = row < 0 ? 0 : (row >= S_ ? S_ - 1 : row);        \
        const unsigned v_ = *(const unsigned*)(LX + (size_t)(b * S_ + rc) * 1024 + n * 128 + 2 * lane); xr[j] = (row == rc) ? v_ : 0u; } } while (0)
    LRU_LOADX(0);
    for (int c = 0; c < 16; ++c) {
      const int p0 = dir ? S_ - 128 * (c + 1) : 128 * c;
      {
#pragma unroll
        for (int i = 0; i < 16; ++i) { float s0 = cb0, s1 = cb1;
#pragma unroll
          for (int k = 0; k < 4; ++k) { s0 += bflo(xr[i + k]) * cw0[k]; s1 += bfhi(xr[i + k]) * cw1[k]; }
          *(unsigned*)(XL + (wave * 16 + i) * RS + lane * 4) = pk2(s0, s1); } }
      if (c + 1 < 16) LRU_LOADX(c + 1);
      __syncthreads();
      f32x16 acc[2] = {};
#pragma unroll
      for (int s = 0; s < 8; ++s) { const bf16x8 xf = *(const bf16x8*)(XL + ((wave >> 1) * 32 + r32) * RS + (16 * s + 8 * hi) * 2);
#pragma unroll
        for (int t = 0; t < 2; ++t) { const bf16x8 wf = *(const bf16x8*)(WL + ((wave & 1) * 64 + 32 * t + r32) * RS + (16 * s + 8 * hi) * 2);
          acc[t] = __builtin_amdgcn_mfma_f32_32x32x16_bf16(wf, xf, acc[t], 0, 0, 0); } }
      { const int pos = (wave >> 1) * 32 + r32;
#pragma unroll
        for (int t = 0; t < 2; ++t)
#pragma unroll
          for (int g = 0; g < 4; ++g) { const int jl = (wave & 1) * 32 + 16 * t + 4 * g + 2 * hi;
            const unsigned xw = *(const unsigned*)(XL + pos * RS + (half * 64 + jl) * 2);
#pragma unroll
            for (int u = 0; u < 2; ++u) { const int ti = t * 8 + g * 2 + u;
              const float e1 = __builtin_amdgcn_exp2f(-1.4426950408889634f * (acc[t][4 * g + 2 * u] + tb1[ti])), e2 = __builtin_amdgcn_exp2f(-1.4426950408889634f * (acc[t][4 * g + 2 * u + 1] + tb2[ti]));
              const float R = __builtin_amdgcn_rcpf((1.f + e1) * (1.f + e2)), sr = (1.f + e2) * R, si = (1.f + e1) * R;
              const float la = -tb0[ti] * sr, a = __builtin_amdgcn_exp2f(la * 1.4426950408889634f), x2 = 2.f * la;
              const float ser = -x2 * (1.f + x2 * (0.5f + x2 * (1.6666667e-1f + x2 * (4.1666667e-2f + x2 * (8.3333333e-3f + x2 * 1.3888889e-3f)))));
              const float om = x2 > -0.25f ? ser : 1.f - a * a;
              AB[pos * AST + jl + u] = (f32x2){a, __builtin_amdgcn_sqrtf(om) * si * (u ? bfhi(xw) : bflo(xw))}; } } }
      __syncthreads();
      { const int jl = tid & 63, sub = tid >> 6; float av[16], bv[16]; float A = 1.f, B = 0.f;
#pragma unroll
        for (int i = 0; i < 16; ++i) { const int tau = 16 * sub + i, pos = dir ? 127 - tau : tau; const f32x2 ab = AB[pos * AST + jl]; av[i] = ab[0]; bv[i] = ab[1]; B = av[i] * B + bv[i]; A *= av[i]; }
        AG[sub * 64 + jl] = A; AG[512 + sub * 64 + jl] = B;
        __syncthreads();
        float h = CAR[jl];
        for (int s2 = 0; s2 < sub; ++s2) h = AG[s2 * 64 + jl] * h + AG[512 + s2 * 64 + jl];
#pragma unroll
        for (int i = 0; i < 16; ++i) { const int tau = 16 * sub + i, pos = dir ? 127 - tau : tau; h = av[i] * h + bv[i];
          H[(size_t)(b * S_ + p0 + pos) * 1024 + ch0 + jl] = (bf16_t)(pk2(h, 0.f) & 0xffffu); }
        __syncthreads();
        if (sub == 7) CAR[jl] = h; }
    }
#undef LRU_LOADX
  }
  __syncthreads();
}

__device__ __forceinline__ void phase3b(const Params& p, int gw, int ngw, int lane) {
  unsigned char* ws = p.ws; bf16_t* Y = (bf16_t*)(ws + WS_YMIX);
  const bf16_t* HF = (const bf16_t*)(ws + WS_BTF); const bf16_t* HB = (const bf16_t*)(ws + WS_BTB); const bf16_t* G = (const bf16_t*)(ws + WS_GATE);
  for (int r = gw; r < T_; r += ngw) {
    { bf16_t* row = Y + (size_t)r * 2048 + lane * 16; float f[16]; unpack8(*(const u32x4*)row, f); unpack8(*(const u32x4*)(row + 8), f + 8);
      float q = 0.f;
#pragma unroll
      for (int i = 0; i < 16; ++i) q += f[i] * f[i];
      const float sc = rsqrtf(dpp_sum64(q) * (1.f / 1024.f) + RMS_EPS); const float* g = p.in[17] + lane * 16;
#pragma unroll
      for (int i = 0; i < 16; ++i) f[i] = f[i] * sc * g[i];
      *(u32x4*)row = pack8(f); *(u32x4*)(row + 8) = pack8(f + 8); }
    { const size_t o = (size_t)r * 1024 + lane * 16; float a[16], b[16], gg[16];
      unpack8(*(const u32x4*)(HF + o), a); unpack8(*(const u32x4*)(HF + o + 8), a + 8);
      unpack8(*(const u32x4*)(HB + o), b); unpack8(*(const u32x4*)(HB + o + 8), b + 8);
      unpack8(*(const u32x4*)(G + o), gg); unpack8(*(const u32x4*)(G + o + 8), gg + 8);
      float q = 0.f;
#pragma unroll
      for (int i = 0; i < 16; ++i) { a[i] = (a[i] + b[i]) * gg[i]; q += a[i] * a[i]; }
      const float sc = rsqrtf(dpp_sum64(q) * (1.f / 1024.f) + RMS_EPS); const float* g = p.in[18] + lane * 16;
#pragma unroll
      for (int i = 0; i < 16; ++i) a[i] = a[i] * sc * g[i];
      bf16_t* row = Y + (size_t)r * 2048 + 1024 + lane * 16; *(u32x4*)row = pack8(a); *(u32x4*)(row + 8) = pack8(a + 8); }
  }
}
__device__ __forceinline__ void ln_pass(unsigned char* ws, const float* g, const float* b, int gw, int ngw, int lane) {
  bf16_t* X = (bf16_t*)(ws + WS_X);
  for (int r0 = gw * 2; r0 < T_; r0 += ngw * 2) { u32x4 w[2][4]; float v[32];
#pragma unroll
    for (int rr = 0; rr < 2; ++rr)
#pragma unroll
      for (int j = 0; j < 4; ++j) w[rr][j] = *(const u32x4*)(X + (size_t)(r0 + rr) * DM + j * 512 + lane * 8);
#pragma unroll
    for (int rr = 0; rr < 2; ++rr) {
#pragma unroll
      for (int j = 0; j < 4; ++j) unpack8(w[rr][j], &v[j * 8]);
      ln_row_regs(v, g, b, lane);
#pragma unroll
      for (int j = 0; j < 4; ++j) *(u32x4*)(X + (size_t)(r0 + rr) * DM + j * 512 + lane * 8) = pack8(&v[j * 8]); } }
}
__device__ __forceinline__ void cvt_pass(const float* src, bf16_t* dst, size_t n, int gw, int ngw, int lane) {
  for (size_t i = (size_t)(gw * 64 + lane) * 8; i < n; i += (size_t)ngw * 64 * 8) {
    const f32x4 a = *(const f32x4*)(src + i), b = *(const f32x4*)(src + i + 4); u32x4 o; o.x = pk2(a[0], a[1]); o.y = pk2(a[2], a[3]); o.z = pk2(b[0], b[1]); o.w = pk2(b[2], b[3]);
    *(u32x4*)(dst + i) = o; }
}

__device__ __forceinline__ unsigned key_of(float s, unsigned tag, unsigned tagmask) {
  unsigned u = __float_as_uint(s); u = (u & 0x80000000u) ? ~u : (u | 0x80000000u); return (u & ~tagmask) | (tagmask - tag);
}
__device__ __forceinline__ float val_of(unsigned k, unsigned tagmask) { unsigned u = k & ~tagmask; u = (u & 0x80000000u) ? (u & 0x7fffffffu) : ~u; return __uint_as_float(u); }
__device__ __forceinline__ void topk_phase(unsigned char* ws, const float* SC, int gw, int ngw, int lane) {
  int* IDX = (int*)(ws + WS_IDX); float* GV = (float*)(ws + WS_GV);
  int ca = -1, cb = -1; { int n = 0; for (int a = 0; a < 16; ++a) for (int b = 0; b < 16; ++b) if ((a + 1) * (b + 1) <= 16) { if (n == lane) { ca = a; cb = b; } ++n; } }
  for (int pr = gw; pr < T_ * 8; pr += ngw) {
    const float* row = SC + (size_t)pr * 256;
    unsigned k1a = key_of(row[lane], lane, 127u), k1b = key_of(row[64 + lane], 64 + lane, 127u);
    unsigned k2a = key_of(row[128 + lane], lane, 127u), k2b = key_of(row[192 + lane], 64 + lane, 127u);
    unsigned t1 = 0u, t2 = 0u;
    for (int it = 0; it < 16; ++it) {
      const unsigned m1 = dpp_max64_u32(k1a > k1b ? k1a : k1b), m2 = dpp_max64_u32(k2a > k2b ? k2a : k2b);
      if (k1a == m1) k1a = 0u; if (k1b == m1) k1b = 0u; if (k2a == m2) k2a = 0u; if (k2b == m2) k2b = 0u;
      if (lane == it) { t1 = m1; t2 = m2; }
    }
    const unsigned ka = (unsigned)__shfl((int)t1, ca < 0 ? 0 : ca), kb = (unsigned)__shfl((int)t2, cb < 0 ? 0 : cb);
    const float va = val_of(ka, 127u), vb = val_of(kb, 127u); const int ia = 127 - (int)(ka & 127u), ib = 127 - (int)(kb & 127u);
    const float cs = va + vb; const int cidx = ia * 128 + ib;
    unsigned ck = (ca >= 0) ? key_of(cs, (unsigned)(ca * 16 + cb), 255u) : 0u;
    float ts = 0.f; int ti = 0;
    for (int it = 0; it < 16; ++it) {
      const unsigned m = dpp_max64_u32(ck); const unsigned long long bal = __ballot(ck == m && ck != 0u); const int src = __ffsll((long long)bal) - 1;
      const float sv = __shfl(cs, src); const int si = __shfl(cidx, src);
      if (lane == src) ck = 0u;
      if (lane == it) { ts = sv; ti = si; }
    }
    const float mx = __uint_as_float(__builtin_amdgcn_readlane(__float_as_uint(ts), 0));
    float ex = (lane < 16) ? __expf(ts - mx) : 0.f; const float sum = dpp_sum64(ex);
    if (lane < 16) { IDX[(size_t)pr * 16 + lane] = ti; GV[(size_t)pr * 16 + lane] = ex / sum; }
  }
}


__device__ __forceinline__ unsigned umax_(unsigned a, unsigned b) { return a > b ? a : b; }
__device__ __forceinline__ unsigned umin_(unsigned a, unsigned b) { return a < b ? a : b; }
__device__ __forceinline__ unsigned ord_of(float s) { const unsigned u = __float_as_uint(s); return (u & 0x80000000u) ? ~u : (u | 0x80000000u); }
__device__ __forceinline__ unsigned qx1(unsigned v) { return (unsigned)__builtin_amdgcn_update_dpp(0, (int)v, 0xB1, 0xf, 0xf, false); }
__device__ __forceinline__ unsigned qx2(unsigned v) { return (unsigned)__builtin_amdgcn_update_dpp(0, (int)v, 0x4E, 0xf, 0xf, false); }
__device__ __forceinline__ void ins16(unsigned (&L)[16], unsigned x) {
#pragma unroll
  for (int k = 0; k < 16; ++k) { const unsigned hi = umax_(L[k], x); x = umin_(L[k], x); L[k] = hi; }
}
__device__ __forceinline__ void ins16p(unsigned (&L)[16], unsigned (&P)[16], unsigned x, unsigned px) {
#pragma unroll
  for (int k = 0; k < 16; ++k) { const bool c = x > L[k]; const unsigned nl = c ? x : L[k], nx = c ? L[k] : x, np = c ? px : P[k], npx = c ? P[k] : px; L[k] = nl; x = nx; P[k] = np; px = npx; }
}
__device__ __forceinline__ void bitonic_sort16(unsigned (&M)[16]) {
#pragma unroll
  for (int d = 8; d >= 1; d >>= 1)
#pragma unroll
    for (int i = 0; i < 16; ++i) if (!(i & d)) { const unsigned hi = umax_(M[i], M[i + d]), lo = umin_(M[i], M[i + d]); M[i] = hi; M[i + d] = lo; }
}
__device__ __forceinline__ void bitonic_sort16p(unsigned (&M)[16], unsigned (&P)[16]) {
#pragma unroll
  for (int d = 8; d >= 1; d >>= 1)
#pragma unroll
    for (int i = 0; i < 16; ++i) if (!(i & d)) { const bool c = M[i + d] > M[i]; const unsigned a = M[i], b = M[i + d], pa = P[i], pb = P[i + d];
      M[i] = c ? b : a; M[i + d] = c ? a : b; P[i] = c ? pb : pa; P[i + d] = c ? pa : pb; }
}
__device__ __forceinline__ void topk_phase2(unsigned char* ws, const float* SC, int gw, int ngw, int lane) {
  int* IDX = (int*)(ws + WS_IDX); float* GV = (float*)(ws + WS_GV);
  const int c = lane & 3;
  const unsigned tagbase = (c & 1) ? 0u : 64u;
  for (int item = gw; item < T_ * 8 / 16; item += ngw) {
    const int pr = item * 16 + (lane >> 2);
    const float* row = SC + (size_t)pr * 256 + c * 64;
    unsigned L[16];
#pragma unroll
    for (int k = 0; k < 16; ++k) L[k] = 0u;
#pragma unroll
    for (int bq = 0; bq < 4; ++bq) { f32x4 v[4];
#pragma unroll
      for (int j = 0; j < 4; ++j) v[j] = *(const f32x4*)(row + bq * 16 + j * 4);
#pragma unroll
      for (int j = 0; j < 4; ++j)
#pragma unroll
        for (int i = 0; i < 4; ++i) { const int e = bq * 16 + j * 4 + i; ins16(L, (ord_of(v[j][i]) & ~127u) | (tagbase + (unsigned)(63 - e))); } }
    { unsigned B[16];
#pragma unroll
      for (int k = 0; k < 16; ++k) B[k] = qx1(L[k]);
#pragma unroll
      for (int k = 0; k < 16; ++k) L[k] = umax_(L[k], B[15 - k]);
      bitonic_sort16(L); }
    float F1[16], F2[16]; unsigned I1[16], I2[16];
#pragma unroll
    for (int k = 0; k < 16; ++k) { const unsigned o = qx2(L[k]); const unsigned v1 = (c < 2) ? L[k] : o, v2 = (c < 2) ? o : L[k];
      unsigned u1 = v1 & ~127u, u2 = v2 & ~127u; u1 = (u1 & 0x80000000u) ? (u1 & 0x7fffffffu) : ~u1; u2 = (u2 & 0x80000000u) ? (u2 & 0x7fffffffu) : ~u2;
      F1[k] = __uint_as_float(u1); F2[k] = __uint_as_float(u2); I1[k] = (127u - (v1 & 127u)) << 7; I2[k] = 127u - (v2 & 127u); }
    unsigned M[16], P[16];
#pragma unroll
    for (int k = 0; k < 16; ++k) { M[k] = 0u; P[k] = 0u; }
    {
      constexpr int CA[52] = {0,0,0,0,0,0,0,0,0,0,0,0,0,0,0,0, 1,1,1,1,1,1,1,1, 2,2,2,2,2, 3,3,3,3, 4,4,4, 5,5, 6,6, 7,7, 8, 9, 10, 11, 12, 13, 14, 15, 15, 15};
      constexpr int CB[52] = {0,1,2,3,4,5,6,7,8,9,10,11,12,13,14,15, 0,1,2,3,4,5,6,7, 0,1,2,3,4, 0,1,2,3, 0,1,2, 0,1, 0,1, 0,1, 0, 0, 0, 0, 0, 0, 0, 0, 0, 0};
#pragma unroll
      for (int m = 0; m < 13; ++m) {
        unsigned kx[4], px[4];
#pragma unroll
        for (int q = 0; q < 4; ++q) { const int n = 4 * m + q; const bool pad = n >= 50;
          kx[q] = pad ? 0u : ord_of(F1[CA[n]] + F2[CB[n]]); px[q] = I1[CA[n]] | I2[CB[n]]; }
        const unsigned x = (c == 0) ? kx[0] : (c == 1) ? kx[1] : (c == 2) ? kx[2] : kx[3];
        const unsigned pp = (c == 0) ? px[0] : (c == 1) ? px[1] : (c == 2) ? px[2] : px[3];
        ins16p(M, P, x, pp);
      }
    }
    { unsigned B[16], Q[16];
#pragma unroll
      for (int k = 0; k < 16; ++k) { B[k] = qx1(M[k]); Q[k] = qx1(P[k]); }
#pragma unroll
      for (int k = 0; k < 16; ++k) { const bool t = B[15 - k] > M[k]; M[k] = t ? B[15 - k] : M[k]; P[k] = t ? Q[15 - k] : P[k]; }
      bitonic_sort16p(M, P);
#pragma unroll
      for (int k = 0; k < 16; ++k) { B[k] = qx2(M[k]); Q[k] = qx2(P[k]); }
#pragma unroll
      for (int k = 0; k < 16; ++k) { const bool t = B[15 - k] > M[k]; M[k] = t ? B[15 - k] : M[k]; P[k] = t ? Q[15 - k] : P[k]; }
      bitonic_sort16p(M, P); }
    float sv[16]; float mx = -1e30f;
#pragma unroll
    for (int k = 0; k < 16; ++k) { unsigned u = M[k]; u = (u & 0x80000000u) ? (u & 0x7fffffffu) : ~u; sv[k] = __uint_as_float(u); mx = fmaxf(mx, sv[k]); }
    float sum = 0.f;
#pragma unroll
    for (int k = 0; k < 16; ++k) { sv[k] = __expf(sv[k] - mx); sum += sv[k]; }
    const float inv = __builtin_amdgcn_rcpf(sum);
    u32x4 oi; f32x4 og;
#pragma unroll
    for (int i = 0; i < 4; ++i) { oi[i] = (c == 0) ? P[i] : (c == 1) ? P[4 + i] : (c == 2) ? P[8 + i] : P[12 + i];
      og[i] = ((c == 0) ? sv[i] : (c == 1) ? sv[4 + i] : (c == 2) ? sv[8 + i] : sv[12 + i]) * inv; }
    *(u32x4*)(IDX + (size_t)pr * 16 + 4 * c) = oi; *(f32x4*)(GV + (size_t)pr * 16 + 4 * c) = og;
  }
}


__device__ __forceinline__ unsigned sx16(unsigned v) { return (unsigned)__shfl_xor((int)v, 16); }
__device__ __forceinline__ unsigned sx32(unsigned v) { return (unsigned)__shfl_xor((int)v, 32); }
#define MERGE16(L, SH) do { unsigned B_[16]; _Pragma("unroll") for (int k_ = 0; k_ < 16; ++k_) B_[k_] = SH(L[k_]); \
    _Pragma("unroll") for (int k_ = 0; k_ < 16; ++k_) L[k_] = umax_(L[k_], B_[15 - k_]); bitonic_sort16(L); } while (0)
#define MERGE16P(M, P, SH) do { unsigned B_[16], Q_[16]; _Pragma("unroll") for (int k_ = 0; k_ < 16; ++k_) { B_[k_] = SH(M[k_]); Q_[k_] = SH(P[k_]); } \
    _Pragma("unroll") for (int k_ = 0; k_ < 16; ++k_) { const bool t_ = B_[15 - k_] > M[k_]; M[k_] = t_ ? B_[15 - k_] : M[k_]; P[k_] = t_ ? Q_[15 - k_] : P[k_]; } bitonic_sort16p(M, P); } while (0)
__device__ __forceinline__ void topk_phase3(const Params& p, unsigned char* lds_raw, int gw, int ngw, int tid) {
  unsigned char* ws = p.ws; int* IDX = (int*)(ws + WS_IDX); float* GV = (float*)(ws + WS_GV); const bf16_t* QP = (const bf16_t*)(ws + WS_QP);
  constexpr int KRS = 272;
  for (int i = tid; i < 2 * 128 * 32; i += NTHR) { const int tb = i >> 12, r = (i >> 5) & 127, c4 = (i & 31) * 4; const f32x4 v = *(const f32x4*)(p.in[29 + tb] + r * 128 + c4);
    u32x2 w; w.x = pk2(v[0], v[1]); w.y = pk2(v[2], v[3]); *(u32x2*)(lds_raw + tb * (128 * KRS) + r * KRS + c4 * 2) = w; }
  __syncthreads();
  const int lane = tid & 63, fr = lane & 15, c = lane >> 4;
  for (int item = gw; item < T_ * 8 / 16; item += ngw) {
    const int pr = item * 16 + fr;
    unsigned L1[16], L2[16];
#pragma unroll
    for (int k = 0; k < 16; ++k) { L1[k] = 0u; L2[k] = 0u; }
#pragma unroll
    for (int h = 0; h < 2; ++h) {
      bf16x8 qf[4];
#pragma unroll
      for (int s = 0; s < 4; ++s) qf[s] = *(const bf16x8*)(QP + (size_t)pr * 256 + 128 * h + 32 * s + 8 * c);
#pragma unroll
      for (int tp = 0; tp < 4; ++tp) {
        f32x4 acc0 = {0.f, 0.f, 0.f, 0.f}, acc1 = {0.f, 0.f, 0.f, 0.f};
#pragma unroll
        for (int s = 0; s < 4; ++s) { const unsigned char* kb = lds_raw + h * (128 * KRS) + (32 * tp + fr) * KRS + (32 * s + 8 * c) * 2;
          acc0 = __builtin_amdgcn_mfma_f32_16x16x32_bf16(*(const bf16x8*)kb, qf[s], acc0, 0, 0, 0);
          acc1 = __builtin_amdgcn_mfma_f32_16x16x32_bf16(*(const bf16x8*)(kb + 16 * KRS), qf[s], acc1, 0, 0, 0); }
#pragma unroll
        for (int r = 0; r < 4; ++r) { const unsigned t0 = (unsigned)(127 - (32 * tp + r)) - (unsigned)(4 * c), t1 = t0 - 16u;
          const unsigned k0 = (ord_of(acc0[r]) & ~127u) | t0, k1 = (ord_of(acc1[r]) & ~127u) | t1;
          if (h == 0) { ins16(L1, k0); ins16(L1, k1); } else { ins16(L2, k0); ins16(L2, k1); } }
        if (h == 0) asm volatile("" : "+v"(L1[0]), "+v"(L1[15])); else asm volatile("" : "+v"(L2[0]), "+v"(L2[15]));
      }
    }
    MERGE16(L1, sx16); MERGE16(L1, sx32); MERGE16(L2, sx16); MERGE16(L2, sx32);
    float F1[16], F2[16]; unsigned I1[16], I2[16];
#pragma unroll
    for (int k = 0; k < 16; ++k) { const unsigned v1 = L1[k], v2 = L2[k];
      unsigned u1 = v1 & ~127u, u2 = v2 & ~127u; u1 = (u1 & 0x80000000u) ? (u1 & 0x7fffffffu) : ~u1; u2 = (u2 & 0x80000000u) ? (u2 & 0x7fffffffu) : ~u2;
      F1[k] = __uint_as_float(u1); F2[k] = __uint_as_float(u2); I1[k] = (127u - (v1 & 127u)) << 7; I2[k] = 127u - (v2 & 127u); }
    unsigned M[16], P[16];
#pragma unroll
    for (int k = 0; k < 16; ++k) { M[k] = 0u; P[k] = 0u; }
    {
      constexpr int CA[52] = {0,0,0,0,0,0,0,0,0,0,0,0,0,0,0,0, 1,1,1,1,1,1,1,1, 2,2,2,2,2, 3,3,3,3, 4,4,4, 5,5, 6,6, 7,7, 8, 9, 10, 11, 12, 13, 14, 15, 15, 15};
      constexpr int CB[52] = {0,1,2,3,4,5,6,7,8,9,10,11,12,13,14,15, 0,1,2,3,4,5,6,7, 0,1,2,3,4, 0,1,2,3, 0,1,2, 0,1, 0,1, 0,1, 0, 0, 0, 0, 0, 0, 0, 0, 0, 0};
#pragma unroll
      for (int m = 0; m < 13; ++m) {
        unsigned kx[4], px[4];
#pragma unroll
        for (int q = 0; q < 4; ++q) { const int n = 4 * m + q; const bool pad = n >= 50;
          kx[q] = pad ? 0u : ord_of(F1[CA[n]] + F2[CB[n]]); px[q] = I1[CA[n]] | I2[CB[n]]; }
        const unsigned x = (c == 0) ? kx[0] : (c == 1) ? kx[1] : (c == 2) ? kx[2] : kx[3];
        const unsigned pp = (c == 0) ? px[0] : (c == 1) ? px[1] : (c == 2) ? px[2] : px[3];
        ins16p(M, P, x, pp);
      }
    }
    MERGE16P(M, P, sx16); MERGE16P(M, P, sx32);
    float sv[16]; float mx = -1e30f;
#pragma unroll
    for (int k = 0; k < 16; ++k) { unsigned u = M[k]; u = (u & 0x80000000u) ? (u & 0x7fffffffu) : ~u; sv[k] = __uint_as_float(u); mx = fmaxf(mx, sv[k]); }
    float sum = 0.f;
#pragma unroll
    for (int k = 0; k < 16; ++k) { sv[k] = __expf(sv[k] - mx); sum += sv[k]; }
    const float inv = __builtin_amdgcn_rcpf(sum);
    u32x4 oi; f32x4 og;
#pragma unroll
    for (int i = 0; i < 4; ++i) { oi[i] = (c == 0) ? P[i] : (c == 1) ? P[4 + i] : (c == 2) ? P[8 + i] : P[12 + i];
      og[i] = ((c == 0) ? sv[i] : (c == 1) ? sv[4 + i] : (c == 2) ? sv[8 + i] : sv[12 + i]) * inv; }
    *(u32x4*)(IDX + (size_t)pr * 16 + 4 * c) = oi; *(f32x4*)(GV + (size_t)pr * 16 + 4 * c) = og;
  }
  __syncthreads();
}
#undef MERGE16
#undef MERGE16P

typedef float f32x16v __attribute__((ext_vector_type(16)));
typedef float f32x32v __attribute__((ext_vector_type(32)));
typedef unsigned u32x6 __attribute__((ext_vector_type(6)));
typedef float f32x16v __attribute__((ext_vector_type(16)));
typedef float f32x32v __attribute__((ext_vector_type(32)));
typedef unsigned u32x6 __attribute__((ext_vector_type(6)));
typedef float f32x16v __attribute__((ext_vector_type(16)));
typedef float f32x32v __attribute__((ext_vector_type(32)));
typedef unsigned u32x6 __attribute__((ext_vector_type(6)));
__device__ __forceinline__ void cvt_fp6_pass(const float* src, unsigned char* dst, float* inv, int r_begin, int r_end, int gw, int ngw, int lane) {
  for (int r0 = r_begin + gw * 2; r0 < r_end; r0 += ngw * 2) {
   f32x4 vv[2][8];
#pragma unroll
   for (int rr = 0; rr < 2; ++rr)
#pragma unroll
     for (int k = 0; k < 8; ++k) vv[rr][k] = *(const f32x4*)(src + (size_t)(r0 + rr) * 2048 + lane * 32 + k * 4);
#pragma unroll
   for (int rr = 0; rr < 2; ++rr) { const int r = r0 + rr;
    f32x4 v[8]; float am = 0.f;
#pragma unroll
    for (int k = 0; k < 8; ++k) { v[k] = vv[rr][k];
#pragma unroll
      for (int i = 0; i < 4; ++i) am = fmaxf(am, fabsf(v[k][i])); }
    const unsigned amu = dpp_max64_u32(__float_as_uint(am));
    const float amax = fmaxf(__uint_as_float(amu), 1e-30f), sc = 7.5f / amax;
    if (lane == 0) inv[r] = amax * (1.f / 7.5f);
    f32x16v a, b;
#pragma unroll
    for (int j = 0; j < 16; ++j) { a[j] = v[(2 * j) >> 2][(2 * j) & 3] * sc; b[j] = v[(2 * j + 1) >> 2][(2 * j + 1) & 3] * sc; }
    const u32x6 o = __builtin_amdgcn_cvt_scalef32_2xpk16_fp6_f32(a, b, 1.0f);
    u32x2* d = (u32x2*)(dst + (size_t)r * 1536 + lane * 24);
    d[0] = (u32x2){o[0], o[1]}; d[1] = (u32x2){o[2], o[3]}; d[2] = (u32x2){o[4], o[5]};
   }
  }
}
__device__ __forceinline__ void ln_row_regs32(float (&v)[32], const float* g, const float* b, int lane) {
  float s = 0.f;
#pragma unroll
  for (int i = 0; i < 32; ++i) s += v[i];
  const float mean = dpp_sum64(s) * (1.f / 2048.f);
  float q = 0.f;
#pragma unroll
  for (int i = 0; i < 32; ++i) { v[i] -= mean; q += v[i] * v[i]; }
  const float rstd = rsqrtf(dpp_sum64(q) * (1.f / 2048.f) + LN_EPS);
#pragma unroll
  for (int k = 0; k < 8; ++k) { const f32x4 gg = *(const f32x4*)(g + lane * 32 + k * 4), bb = *(const f32x4*)(b + lane * 32 + k * 4);
#pragma unroll
    for (int i = 0; i < 4; ++i) v[k * 4 + i] = v[k * 4 + i] * rstd * gg[i] + bb[i]; }
}
__device__ __forceinline__ u32x6 ld24(const unsigned char* p) { const u32x2* q = (const u32x2*)p; const u32x2 a = q[0], b = q[1], c = q[2]; return (u32x6){a.x, a.y, b.x, b.y, c.x, c.y}; }
__device__ __forceinline__ void peer_phase(const Params& p, int gw, int ngw, int lane_in) {
  unsigned char* ws = p.ws; const bf16_t* X = (const bf16_t*)(ws + WS_X); const unsigned char* PU = ws + WS_PU; const unsigned char* PV = ws + WS_PV;
  const float* INVU = (const float*)(ws + WS_PINV); const float* INVV = INVU + 16384;
  const int* IDX = (const int*)(ws + WS_IDX); const float* GV = (const float*)(ws + WS_GV);
  for (int t = gw; t < T_; t += ngw) {
    int lane = lane_in; asm volatile("" : "+v"(lane));
    float xv[32];
#pragma unroll
    for (int k = 0; k < 4; ++k) unpack8(*(const u32x4*)(X + (size_t)t * DM + lane * 32 + k * 8), &xv[k * 8]);
    const int id0 = IDX[(size_t)t * 128 + lane], id1 = IDX[(size_t)t * 128 + 64 + lane];
    const float g0 = GV[(size_t)t * 128 + lane], g1 = GV[(size_t)t * 128 + 64 + lane];
    const float iu0 = INVU[id0], iu1 = INVU[id1], iv0 = INVV[id0], iv1 = INVV[id1];
    float z0 = 0.f, z1 = 0.f;
#pragma unroll 1
    for (int e0 = 0; e0 < 128; e0 += 8) {
      u32x6 w[8];
#pragma unroll
      for (int q = 0; q < 8; ++q) { const int id = __builtin_amdgcn_readlane(e0 < 64 ? id0 : id1, (e0 + q) & 63); w[q] = ld24(PU + (size_t)id * 1536 + lane * 24); }
#pragma unroll
      for (int q = 0; q < 8; ++q) { u32x6 ww = w[q]; { unsigned w0 = ww[0]; asm volatile("" : "+v"(w0) : "v"(z0), "v"(z1)); ww[0] = w0; }
        const f32x32v d = __builtin_amdgcn_cvt_scalef32_pk32_f32_fp6(ww, 1.0f);
        f32x2 pa = {0.f, 0.f}, pb = {0.f, 0.f};
#pragma unroll
        for (int i = 0; i < 8; ++i) { pa = (f32x2){d[4 * i], d[4 * i + 1]} * (f32x2){xv[4 * i], xv[4 * i + 1]} + pa; pb = (f32x2){d[4 * i + 2], d[4 * i + 3]} * (f32x2){xv[4 * i + 2], xv[4 * i + 3]} + pb; }
        const float tot = dpp_sum64((pa[0] + pa[1]) + (pb[0] + pb[1]));
        if (lane == ((e0 + q) & 63)) { if (e0 < 64) z0 = tot; else z1 = tot; }
        __builtin_amdgcn_sched_barrier(0); }
    }
    const float a0 = gelu_erf(z0 * iu0) * g0 * iv0, a1 = gelu_erf(z1 * iu1) * g1 * iv1;
    float acc[32];
#pragma unroll
    for (int i = 0; i < 32; ++i) acc[i] = 0.f;
#pragma unroll 1
    for (int e0 = 0; e0 < 128; e0 += 8) {
      u32x6 w[8]; float av[8];
#pragma unroll
      for (int q = 0; q < 8; ++q) { const int id = __builtin_amdgcn_readlane(e0 < 64 ? id0 : id1, (e0 + q) & 63);
        av[q] = __uint_as_float(__builtin_amdgcn_readlane(__float_as_uint(e0 < 64 ? a0 : a1), (e0 + q) & 63));
        w[q] = ld24(PV + (size_t)id * 1536 + lane * 24); }
#pragma unroll
      for (int q = 0; q < 8; ++q) { u32x6 ww = w[q]; { unsigned w0 = ww[0]; asm volatile("" : "+v"(w0) : "v"(acc[31])); ww[0] = w0; }
        const f32x32v d = __builtin_amdgcn_cvt_scalef32_pk32_f32_fp6(ww, 1.0f);
#pragma unroll
        for (int i = 0; i < 32; ++i) acc[i] += av[q] * d[i];
        asm volatile("" : "+v"(acc[0]), "+v"(acc[1]), "+v"(acc[2]), "+v"(acc[3]), "+v"(acc[4]), "+v"(acc[5]), "+v"(acc[6]), "+v"(acc[7]), "+v"(acc[8]), "+v"(acc[9]), "+v"(acc[10]), "+v"(acc[11]), "+v"(acc[12]), "+v"(acc[13]), "+v"(acc[14]), "+v"(acc[15]));
        asm volatile("" : "+v"(acc[16]), "+v"(acc[17]), "+v"(acc[18]), "+v"(acc[19]), "+v"(acc[20]), "+v"(acc[21]), "+v"(acc[22]), "+v"(acc[23]), "+v"(acc[24]), "+v"(acc[25]), "+v"(acc[26]), "+v"(acc[27]), "+v"(acc[28]), "+v"(acc[29]), "+v"(acc[30]), "+v"(acc[31])); }
    }
#pragma unroll
    for (int i = 0; i < 32; ++i) acc[i] += DN_ALPHA * xv[i];
    ln_row_regs32(acc, p.in[33], p.in[34], lane);
#pragma unroll
    for (int k = 0; k < 8; ++k) *(f32x4*)(p.out + (size_t)t * DM + lane * 32 + k * 4) = (f32x4){acc[k * 4], acc[k * 4 + 1], acc[k * 4 + 2], acc[k * 4 + 3]};
  }
}

#define LAS __attribute__((address_space(3)))
#define XB_TMO      128
#define XB_XCNT(j)  (256  + 64 * (j))
#define XB_XSUB(j)  (1280 + 64 * (j))
#define XB_XGEN(j)  (2304 + 64 * (j))
#define XB_TOP      3328
#define XB_TOPGEN   3392
#define XCD_BAR_WORDS 3456
#define XB_SPIN_CAP (1u << 22)
__device__ __forceinline__ unsigned xb_ld(unsigned* p)              { return __hip_atomic_load(p, __ATOMIC_RELAXED, __HIP_MEMORY_SCOPE_AGENT); }
__device__ __forceinline__ unsigned xb_add(unsigned* p, unsigned v) { return __hip_atomic_fetch_add(p, v, __ATOMIC_RELAXED, __HIP_MEMORY_SCOPE_AGENT); }
__device__ __forceinline__ unsigned xb_xcc_id() { return (unsigned)__builtin_amdgcn_s_getreg((3 << 11) | 20) & 0xFu; }
#define XB_SPIN(cond, bar) do { unsigned _sp = 0; while (cond) { __builtin_amdgcn_s_sleep(1); \
    if ((++_sp & 255u) == 0u) { if (xb_ld(&(bar)[XB_TMO])) break; if (_sp > XB_SPIN_CAP) { atomicAdd(&(bar)[XB_TMO], 1u); break; } } } } while (0)
struct XcdBarrier { unsigned* bar; unsigned x; volatile LAS unsigned* st; };
__device__ __forceinline__ XcdBarrier xcd_barrier_post(unsigned* bar, volatile LAS unsigned* st) {
  XcdBarrier b; b.bar = bar; b.x = xb_xcc_id(); b.st = st;
  if (threadIdx.x == 0) (void)xb_add(&bar[XB_XCNT(b.x)], 1u);
  return b;
}
__device__ __forceinline__ void xcd_barrier_complete(unsigned* bar, unsigned x, unsigned& nloc, unsigned& nx) {
  const unsigned G = gridDim.x * gridDim.y * gridDim.z;
  unsigned sum, cnt, mine, sp = 0u;
  for (;;) {
    sum = 0u; cnt = 0u; mine = 0u;
#pragma unroll
    for (unsigned j = 0; j < 16; ++j) { const unsigned c = xb_ld(&bar[XB_XCNT(j)]); sum += c; cnt += (c > 0u) ? 1u : 0u; mine = (j == x) ? c : mine; }
    if (sum == G) break;
    __builtin_amdgcn_s_sleep(1);
    if ((++sp & 255u) == 0u) { if (xb_ld(&bar[XB_TMO])) break; if (sp > XB_SPIN_CAP) { atomicAdd(&bar[XB_TMO], 1u); break; } }
  }
  nloc = mine > 0u ? mine : 1u; nx = cnt > 0u ? cnt : 1u;
}
__device__ __forceinline__ void xcd_barrier(const XcdBarrier& b) {
  asm volatile("s_waitcnt vmcnt(0)" ::: "memory");
  __syncthreads();
  if (threadIdx.x == 0) {
    unsigned* bar = b.bar;
    __builtin_amdgcn_s_waitcnt(0);
    unsigned nloc = b.st[0], nx = b.st[1];
    if (nloc == 0u) { xcd_barrier_complete(bar, b.x, nloc, nx); b.st[0] = nloc; b.st[1] = nx; }
    const unsigned old = xb_add(&bar[XB_XSUB(b.x)], 1u);
    const unsigned gen = old / nloc;
    if (old + 1u == (gen + 1u) * nloc) {
      __builtin_amdgcn_fence(__ATOMIC_RELEASE, "agent");
      asm volatile("s_waitcnt vmcnt(0)" ::: "memory");
      const unsigned og = xb_add(&bar[XB_TOP], 1u);
      const unsigned tg = og / nx;
      if (og + 1u == (tg + 1u) * nx) xb_add(&bar[XB_TOPGEN], 1u);
      else XB_SPIN(xb_ld(&bar[XB_TOPGEN]) == tg, bar);
      __builtin_amdgcn_fence(__ATOMIC_ACQUIRE, "agent");
      xb_add(&bar[XB_XGEN(b.x)], 1u);
      asm volatile("s_waitcnt vmcnt(0)" ::: "memory");
    } else {
      XB_SPIN(xb_ld(&bar[XB_XGEN(b.x)]) == gen, bar);
      __builtin_amdgcn_fence(__ATOMIC_ACQUIRE, "agent");
      asm volatile("s_waitcnt vmcnt(0)" ::: "memory");
    }
  }
  __syncthreads();
}

constexpr int CVT_EARLY = 4608, CVT_SPLIT = 11264;
#ifndef PROBE_LRU
#define PROBE_LRU 0
#endif
#ifndef USE_TOPK3
#define USE_TOPK3 1
#endif
#ifndef USE_TOPK2
#define USE_TOPK2 1
#endif
#ifndef PROBE_MASK
#define PROBE_MASK 0
#endif
#ifndef PROBE_PEER
#define PROBE_PEER 0
#endif
#ifndef PROBE_SYNC
#define PROBE_SYNC 0
#endif
#ifndef PROBE_TOPK
#define PROBE_TOPK 0
#endif
#ifndef USE_FAST_XATTN
#define USE_FAST_XATTN 1
#endif
#ifndef USE_FAST_MLA
#define USE_FAST_MLA 1
#endif
#ifndef FASTMASK
#define FASTMASK 0xff
#endif
#define GEMM(MODE, g, e) do { if constexpr ((FASTMASK >> MODE) & 1) gemm_fast<MODE>(g, e, lds_raw, bid, nblk); else gemm_simple<MODE>(g, e, bid, nblk, wave, lane); } while (0)
#define IDS int tid_ = threadIdx.x; asm volatile("" : "+v"(tid_)); const int tid = tid_, lane = tid & 63, wave = tid >> 6, gw = bid * NWAVE + wave; (void)tid; (void)lane; (void)wave; (void)gw
__global__ void __launch_bounds__(NTHR) fwd_kernel(Params p) {
  extern __shared__ __attribute__((aligned(16))) unsigned char lds_raw[];
  float* lds = (float*)lds_raw;
  cg::grid_group grid = cg::this_grid();
  const int bid = blockIdx.x, nblk = gridDim.x, ngw = nblk * NWAVE;
  unsigned char* ws = p.ws; unsigned char* dout = (unsigned char*)p.out;
  EpiArgs e{ws, dout, p.in, nullptr, nullptr, 0};
  volatile LAS unsigned* bst = (volatile LAS unsigned*)((LAS unsigned char*)lds_raw + (LDS_BYTES - 64));
  if (threadIdx.x < 2) bst[threadIdx.x] = 0u;
  __syncthreads();
  const XcdBarrier xbar = xcd_barrier_post((unsigned*)ws, bst);
#define GSYNC() xcd_barrier(xbar)

  for (int rp_ = 0; rp_ < 1 + ((PROBE_MASK >> 0) & 1); ++rp_) { { IDS; if (nblk == 256) phase0<true>(p, lds, gw, ngw, lane, wave); else phase0<false>(p, lds, gw, ngw, lane, wave); } }
  if (__builtin_expect(p.ws == nullptr, 0)) grid.sync();
  GSYNC();
  for (int rp_ = 0; rp_ < 1 + ((PROBE_MASK >> 1) & 1); ++rp_) { { IDS; GemmArgs g{(const bf16_t*)(ws + WS_X), 2048, 0, (const bf16_t*)(ws + WS_WIN_T), 2048, 0, T_, 3328, 2048, 1}; GEMM(E_WIN, g, e); } }
  for (int rp_ = 0; rp_ < 1 + ((PROBE_MASK >> 1) & 1); ++rp_) { { IDS; GemmArgs g{(const bf16_t*)(ws + WS_MEMB), 2048, 0, (const bf16_t*)(ws + WS_WMKV_T), 2048, 0, 2048, 1024, 2048, 1, 128}; GEMM(E_MEMKV, g, e); } }
  if (nblk == 256 && ((bid >= 64 && bid < 128) || bid >= 160)) { IDS;
    const int sb = (bid < 128) ? bid - 64 : bid - 96; transpose_list<1>(p, lds + wave * (64 * 33), sb * NWAVE + wave, 160 * NWAVE, lane);
    cvt_fp6_pass(p.in[31], ws + WS_PU, (float*)(ws + WS_PINV), 0, CVT_EARLY, sb * NWAVE + wave, 160 * NWAVE, lane);
    cvt_fp6_pass(p.in[32], ws + WS_PV, (float*)(ws + WS_PINV) + 16384, 0, CVT_EARLY, sb * NWAVE + wave, 160 * NWAVE, lane); }
  GSYNC();
  { IDS; phase1b(p, gw, ngw, lane); }
  GSYNC();
  for (int rp_ = 0; rp_ < 1 + ((PROBE_MASK >> 2) & 1); ++rp_) { { IDS; GemmArgs g{(const bf16_t*)(ws + WS_CQ), 512, 0, (const bf16_t*)(ws + WS_WUQ_T), 512, 0, T_, 1536, 512, 1}; GEMM(E_Q, g, e); } }
  for (int rp_ = 0; rp_ < 1 + ((PROBE_MASK >> 2) & 1); ++rp_) { { IDS; GemmArgs g{(const bf16_t*)(ws + WS_CKV), 512, 0, (const bf16_t*)(ws + WS_WUKV_T), 512, 0, T_, 2048, 512, 1}; GEMM(E_KV, g, e); } }
#if USE_LRU_FUSED
  for (int rp_ = 0; rp_ < 1 + PROBE_LRU; ++rp_) lru_fused_phase(p, lds_raw, bid, nblk);
#else
  for (int rp_ = 0; rp_ < 1 + ((PROBE_MASK >> 2) & 1); ++rp_) { { IDS; GemmArgs g{(const bf16_t*)(ws + WS_XC), 1024, 128, (const bf16_t*)(ws + WS_WG_T), 128, 512 * 128, T_, 512, 128, 8}; GEMM(E_GATES, g, e); } }
#endif
  GSYNC();
#if USE_FAST_MLA
  for (int rp_ = 0; rp_ < 1 + ((PROBE_MASK >> 4) & 1); ++rp_) { mla_attn_phase(dout, ws, (char*)lds_raw, bid, nblk); }
#else
  { IDS; attn_scalar<192, 2048>((const bf16_t*)(dout + DO_Q), 1536, (const bf16_t*)(dout + DO_K), 1536, (const bf16_t*)(dout + DO_V), 1024, (bf16_t*)(ws + WS_YMIX), 2048, 8,
                         0.07216878364870322f, lds, bid, nblk, tid); }
#endif
#if !USE_LRU_FUSED
  { IDS; scan_phase(ws, lds, bid, nblk, tid); }
#endif
  GSYNC();
  { IDS; phase3b(p, gw, ngw, lane); }
  GSYNC();
  { IDS; GemmArgs g{(const bf16_t*)(ws + WS_YMIX), 2048, 0, (const bf16_t*)(ws + WS_WOUT_T), 2048, 0, T_, 2048, 2048, 1}; GEMM(E_RES, g, e); }
  GSYNC();
  { IDS; ln_pass(ws, p.in[20], p.in[21], gw, ngw, lane); }
  { IDS; const int rlo = (nblk == 256) ? CVT_EARLY : 0, rsplit = (nblk == 256) ? CVT_SPLIT : 16384;
    cvt_fp6_pass(p.in[31], ws + WS_PU, (float*)(ws + WS_PINV), rlo, rsplit, gw, ngw, lane);
    cvt_fp6_pass(p.in[32], ws + WS_PV, (float*)(ws + WS_PINV) + 16384, rlo, rsplit, gw, ngw, lane); }
  GSYNC();
  for (int rp_ = 0; rp_ < 1 + ((PROBE_MASK >> 5) & 1); ++rp_) { { IDS; GemmArgs g{(const bf16_t*)(ws + WS_X), 2048, 0, (const bf16_t*)(ws + WS_WMQ_T), 2048, 0, T_, 512, 2048, 1}; EpiArgs e2 = e; e2.o = (bf16_t*)(ws + WS_QM); e2.ld = 512; GEMM(E_BF16, g, e2); }
  if (nblk == 256 && bid >= 128) { IDS; const int g2 = (bid - 128) * NWAVE + wave;
    cvt_fp6_pass(p.in[31], ws + WS_PU, (float*)(ws + WS_PINV), CVT_SPLIT, 16384, g2, 128 * NWAVE, lane);
    cvt_fp6_pass(p.in[32], ws + WS_PV, (float*)(ws + WS_PINV) + 16384, CVT_SPLIT, 16384, g2, 128 * NWAVE, lane); } }
  GSYNC();
#if USE_FAST_XATTN
  for (int rp_ = 0; rp_ < 1 + ((PROBE_MASK >> 5) & 1); ++rp_) { mem_attn_phase(ws, (char*)lds_raw, bid, nblk); }
#else
  { IDS; attn_scalar<128, 256>((const bf16_t*)(ws + WS_QM), 512, (const bf16_t*)(ws + WS_MEMKV), 1024, (const bf16_t*)(ws + WS_MEMKV) + 512, 1024, (bf16_t*)(ws + WS_OM), 512, 4,
                        0.08838834764831845f, lds, bid, nblk, tid); }
#endif
  GSYNC();
  { IDS; GemmArgs g{(const bf16_t*)(ws + WS_OM), 512, 0, (const bf16_t*)(ws + WS_WMO_T), 512, 0, T_, 2048, 512, 1}; GEMM(E_RES, g, e); }
  GSYNC();
  { IDS; ln_pass(ws, p.in[26], p.in[27], gw, ngw, lane); }
  GSYNC();
  for (int rp_ = 0; rp_ < 1 + ((PROBE_MASK >> 3) & 1); ++rp_) { { IDS; GemmArgs g{(const bf16_t*)(ws + WS_X), 2048, 0, (const bf16_t*)(ws + WS_WPQ_T), 2048, 0, T_, 2048, 2048, 1}; EpiArgs e2 = e; e2.o = (bf16_t*)(ws + WS_QP); e2.ld = 2048; GEMM(E_BF16, g, e2); } }
  GSYNC();
#if USE_TOPK3
  for (int rep_ = 0; rep_ < 1 + PROBE_TOPK; ++rep_) { IDS; topk_phase3(p, lds_raw, gw, ngw, tid); }
#else
  for (int rp_ = 0; rp_ < 1 + ((PROBE_MASK >> 3) & 1); ++rp_) { { IDS; GemmArgs g{(const bf16_t*)(ws + WS_QP), 256, 0, (const bf16_t*)(ws + WS_KEYS_T), 256, 0, T_ * 8, 256, 256, 1}; EpiArgs e2 = e; e2.f = (float*)dout; e2.ld = 256; GEMM(E_F32, g, e2); } }
  GSYNC();
  for (int rep_ = 0; rep_ < 1 + PROBE_TOPK; ++rep_) { IDS; if (USE_TOPK2) topk_phase2(ws, (const float*)dout, gw, ngw, lane); else topk_phase(ws, (const float*)dout, gw, ngw, lane); }
#endif
  GSYNC();
  for (int rep_ = 0; rep_ < 1 + PROBE_PEER; ++rep_) { IDS; peer_phase(p, gw, ngw, lane); }
  for (int rep_ = 0; rep_ < PROBE_SYNC; ++rep_) GSYNC();
}

extern "C" void kernel_launch(void* const* d_in, const int* in_sizes, int n_in, void* d_out, int out_size, void* d_ws, size_t ws_size, hipStream_t stream) {
  static int grid_blocks = 0;
  if (grid_blocks == 0) {
    if (n_in != 35 || ws_size < WS_END || out_size != T_ * DM) { fprintf(stderr, "kernel_launch: unexpected shapes n_in %d ws %zu out %d\n", n_in, ws_size, out_size); grid_blocks = -1; return; }
    int dev = 0, cus = 0, per_cu = 0;
    hipGetDevice(&dev); hipDeviceGetAttribute(&cus, hipDeviceAttributeMultiprocessorCount, dev);
    if (hipFuncSetAttribute((const void*)fwd_kernel, hipFuncAttributeMaxDynamicSharedMemorySize, LDS_BYTES) != hipSuccess) { fprintf(stderr, "hipFuncSetAttribute failed\n"); grid_blocks = -1; return; }
    if (hipOccupancyMaxActiveBlocksPerMultiprocessor(&per_cu, (const void*)fwd_kernel, NTHR, LDS_BYTES) != hipSuccess || per_cu < 1) { fprintf(stderr, "occupancy query failed (%d)\n", per_cu); grid_blocks = -1; return; }
    grid_blocks = cus * per_cu;
    fprintf(stderr, "kernel_launch: cus %d per_cu %d grid %d ws %zu\n", cus, per_cu, grid_blocks, ws_size);
  }
  if (grid_blocks < 0) return;
  if (hipMemsetAsync(d_ws, 0, 65536, stream) != hipSuccess) { fprintf(stderr, "memset failed\n"); return; }
  Params p{};
  for (int i = 0; i < 35; ++i) p.in[i] = (const float*)d_in[i];
  p.out = (float*)d_out; p.ws = (unsigned char*)d_ws;
  void* args[] = {&p};
  hipError_t err = hipLaunchCooperativeKernel((const void*)fwd_kernel, dim3(grid_blocks), dim3(NTHR), args, LDS_BYTES, stream);
  if (err != hipSuccess) fprintf(stderr, "cooperative launch failed: %s (grid %d)\n", hipGetErrorString(err), grid_blocks);
}
```

```cpp
#include <hip/hip_runtime.h>
#include <hip/hip_cooperative_groups.h>
#include <cstdio>
#include <cstdint>
namespace cg = cooperative_groups;
#ifndef USE_LRU_FUSED
#define USE_LRU_FUSED 1
#endif

typedef unsigned short bf16_t;
typedef short bf16x8 __attribute__((ext_vector_type(8)));
typedef float f32x4 __attribute__((ext_vector_type(4)));
typedef float f32x2 __attribute__((ext_vector_type(2)));
typedef float f32x16 __attribute__((ext_vector_type(16)));
typedef unsigned u32x4 __attribute__((ext_vector_type(4)));
typedef unsigned u32x2 __attribute__((ext_vector_type(2)));

constexpr int T_ = 16384, S_ = 2048, NB_ = 8, DM = 2048;
constexpr int NTHR = 512, NWAVE = 8;
constexpr float DN_ALPHA = 1.189207115002721f;
constexpr float LN_EPS = 1e-5f, RMS_EPS = 1e-6f;
constexpr int LDS_BYTES = 147456;

constexpr size_t MiB = 1u << 20;
constexpr size_t WS_WIN_T = 1 * MiB;
constexpr size_t WS_WUQ_T = 14 * MiB;
constexpr size_t WS_WUKV_T = WS_WUQ_T + 1536 * 512 * 2;
constexpr size_t WS_WG_T = WS_WUKV_T + 2 * MiB;
constexpr size_t WS_WOUT_T = WS_WG_T + 1 * MiB;
constexpr size_t WS_WMQ_T = WS_WOUT_T + 8 * MiB;
constexpr size_t WS_WMKV_T = WS_WMQ_T + 2 * MiB;
constexpr size_t WS_WMO_T = WS_WMKV_T + 4 * MiB;
constexpr size_t WS_WPQ_T = WS_WMO_T + 2 * MiB;
constexpr size_t WS_KEYS_T = WS_WPQ_T + 8 * MiB;
constexpr size_t WS_COS = 43 * MiB, WS_SIN = 45 * MiB;
constexpr size_t WS_MEMB = 47 * MiB;
constexpr size_t WS_MEMKV = 55 * MiB;
constexpr size_t WS_GTAB = 59 * MiB;
static_assert(WS_KEYS_T + 256 * 256 * 2 <= WS_COS, "weights region");
constexpr size_t WS_LAF = 60 * MiB, WS_BTF = 92 * MiB, WS_LAB = 124 * MiB, WS_BTB = 156 * MiB;
constexpr size_t WS_PU = 60 * MiB, WS_PV = 124 * MiB;
constexpr size_t WS_PINV = 59 * MiB + 65536;
constexpr size_t WS_X = 188 * MiB;
constexpr size_t WS_CQ = 252 * MiB, WS_CKV = 268 * MiB, WS_KPE = 284 * MiB;
constexpr size_t WS_LRUX = 286 * MiB, WS_GATE = 318 * MiB, WS_YMIX = 350 * MiB, WS_XC = 414 * MiB;
constexpr size_t WS_QM = WS_CQ, WS_OM = WS_CKV, WS_QP = WS_YMIX, WS_IDX = WS_LRUX, WS_GV = WS_LRUX + 8 * MiB, WS_ACT = WS_LRUX + 16 * MiB;
constexpr size_t WS_END = 446 * MiB;
constexpr size_t DO_Q = 0, DO_K = 48 * MiB, DO_V = 96 * MiB;

__device__ __forceinline__ unsigned f2bf(float f) { unsigned u = __float_as_uint(f); return (u + 0x7fffu + ((u >> 16) & 1u)) >> 16; }
__device__ __forceinline__ float bf2f(unsigned h) { return __uint_as_float(h << 16); }
__device__ __forceinline__ unsigned pk2(float lo, float hi) { unsigned r; asm("v_cvt_pk_bf16_f32 %0, %1, %2" : "=v"(r) : "v"(lo), "v"(hi)); return r; }
__device__ __forceinline__ float bflo(unsigned w) { return __uint_as_float(w << 16); }
__device__ __forceinline__ float bfhi(unsigned w) { return __uint_as_float(w & 0xffff0000u); }
__device__ __forceinline__ float dpp_sum64(float v) {
#define DPPF(x, ctrl, rm, bc) __builtin_bit_cast(float, __builtin_amdgcn_update_dpp(0, __builtin_bit_cast(int, x), ctrl, rm, 0xf, bc))
  v += DPPF(v, 0x111, 0xf, true); v += DPPF(v, 0x112, 0xf, true); v += DPPF(v, 0x114, 0xf, true); v += DPPF(v, 0x118, 0xf, true);
  v += DPPF(v, 0x142, 0xa, false); v += DPPF(v, 0x143, 0xc, false);
#undef DPPF
  return __uint_as_float(__builtin_amdgcn_readlane(__float_as_uint(v), 63));
}
__device__ __forceinline__ unsigned dpp_max64_u32(unsigned v) {
#define DPPU(x, ctrl, rm, bc) (unsigned)__builtin_amdgcn_update_dpp(0, (int)(x), ctrl, rm, 0xf, bc)
  unsigned w;
  w = DPPU(v, 0x111, 0xf, true); v = v > w ? v : w; w = DPPU(v, 0x112, 0xf, true); v = v > w ? v : w;
  w = DPPU(v, 0x114, 0xf, true); v = v > w ? v : w; w = DPPU(v, 0x118, 0xf, true); v = v > w ? v : w;
  w = DPPU(v, 0x142, 0xa, false); v = v > w ? v : w; w = DPPU(v, 0x143, 0xc, false); v = v > w ? v : w;
#undef DPPU
  return (unsigned)__builtin_amdgcn_readlane((int)v, 63);
}
__device__ __forceinline__ float wave_sum(float v) {
#pragma unroll
  for (int o = 1; o < 64; o <<= 1) v += __shfl_xor(v, o);
  return v;
}
__device__ __forceinline__ float wave_max(float v) {
#pragma unroll
  for (int o = 1; o < 64; o <<= 1) v = fmaxf(v, __shfl_xor(v, o));
  return v;
}
__device__ __forceinline__ unsigned wave_max_u32(unsigned v) {
#pragma unroll
  for (int o = 1; o < 64; o <<= 1) { unsigned w = (unsigned)__shfl_xor((int)v, o); v = v > w ? v : w; }
  return v;
}
typedef __bf16 bf16x2_t __attribute__((ext_vector_type(2)));
__device__ __forceinline__ float dot2_bf16(unsigned w, unsigned x, float acc) { return __builtin_amdgcn_fdot2_f32_bf16(__builtin_bit_cast(bf16x2_t, w), __builtin_bit_cast(bf16x2_t, x), acc, false); }
__device__ __forceinline__ float sigmoidf_(float x) { return __builtin_amdgcn_rcpf(1.f + __expf(-x)); }
__device__ __forceinline__ float neg_expm1_small(float x) {
  const float s = x * (1.f + x * (0.5f + x * (1.6666667e-1f + x * (4.1666667e-2f + x * (8.3333333e-3f + x * 1.3888889e-3f)))));
  const float e = 1.f - __builtin_amdgcn_exp2f(x * 1.4426950408889634f);
  return x > -0.25f ? -s : e;
}
__device__ __forceinline__ float gelu_tanh(float x) {
  const float u = 0.7978845608028654f * (x + 0.044715f * x * x * x);
  const float t = 1.f - 2.f / (__expf(2.f * u) + 1.f);
  return 0.5f * x * (1.f + t);
}
__device__ __forceinline__ float gelu_erf(float x) { return 0.5f * x * (1.f + erff(x * 0.7071067811865476f)); }
__device__ __forceinline__ void unpack8(u32x4 w, float* f) {
  f[0] = bflo(w.x); f[1] = bfhi(w.x); f[2] = bflo(w.y); f[3] = bfhi(w.y); f[4] = bflo(w.z); f[5] = bfhi(w.z); f[6] = bflo(w.w); f[7] = bfhi(w.w);
}
__device__ __forceinline__ u32x4 pack8(const float* f) { u32x4 w; w.x = pk2(f[0], f[1]); w.y = pk2(f[2], f[3]); w.z = pk2(f[4], f[5]); w.w = pk2(f[6], f[7]); return w; }

struct Params { const float* in[35]; float* out; unsigned char* ws; };

__device__ __forceinline__ const float* wsrc(const float* const* in, int mid, int n, int& ld) {
  switch (mid) {
    case 0: { ld = 3136; int c; if (n < 1024) c = n; else if (n < 3072) c = n + 64; else if (n < 3136) { int i = (n - 3072) >> 1, g = (n - 3072) & 1; c = 1024 + g * 32 + i; } else return nullptr; return in[5] + c; }
    case 1: { ld = 1536; int h = n / 192, j = n % 192, c; if (j < 128) c = h * 192 + j; else { int i = (j - 128) >> 1, g = (j - 128) & 1; c = h * 192 + 128 + g * 32 + i; } return in[7] + c; }
    case 2: { ld = 2048; int c; if (n < 1024) c = (n >> 7) * 256 + (n & 127); else { int m = n - 1024; c = (m >> 7) * 256 + 128 + (m & 127); } return in[9] + c; }
    case 3: ld = 2048; return in[19] + n;
    case 4: ld = 512; return in[22] + n;
    case 5: ld = 512; return n < 512 ? in[23] + n : in[24] + (n - 512);
    case 6: ld = 2048; return in[25] + n;
    case 7: ld = 2048; return in[28] + n;
    default: { ld = 128; int nb = n >> 9, q = n & 511, dir = q >> 8, jj = (q & 255) >> 1, gate = q & 1; const float* m = (gate ? in[14] : in[12]) + (size_t)((dir * 8 + nb) * 128) * 128; return m + jj; }
  }
}
__device__ __forceinline__ void transpose_item(const float* const* in, int mid, int K, bf16_t* WT, float* scr, int item, int nblk, int lane) {
  const int kb = item / nblk, nb = item % nblk, k0 = 64 * kb, n0 = 32 * nb;
  int ld = 0; const float* base = wsrc(in, mid, n0 + (lane & 31), ld);
  float tv[32];
#pragma unroll
  for (int i = 0; i < 32; ++i) { const int kk = 2 * i + (lane >> 5); tv[i] = base ? base[(size_t)(k0 + kk) * ld] : 0.f; }
#pragma unroll
  for (int i = 0; i < 32; ++i) { const int kk = 2 * i + (lane >> 5); scr[kk * 33 + (lane & 31)] = tv[i]; }
  asm volatile("s_waitcnt lgkmcnt(0)" ::: "memory");
  const int c = lane & 7;
#pragma unroll
  for (int j = 0; j < 4; ++j) { const int n = (lane >> 3) + 8 * j; const float* s = scr + (8 * c) * 33 + n;
    u32x4 o; o.x = pk2(s[0 * 33], s[1 * 33]); o.y = pk2(s[2 * 33], s[3 * 33]); o.z = pk2(s[4 * 33], s[5 * 33]); o.w = pk2(s[6 * 33], s[7 * 33]);
    *(u32x4*)(WT + (size_t)(n0 + n) * K + k0 + 8 * c) = o; }
  asm volatile("s_waitcnt lgkmcnt(0)" ::: "memory");
}
__device__ __forceinline__ void ln_row_regs(float (&v)[32], const float* g, const float* b, int lane) {
  float s = 0.f;
#pragma unroll
  for (int i = 0; i < 32; ++i) s += v[i];
  const float mean = dpp_sum64(s) * (1.f / 2048.f);
  float q = 0.f;
#pragma unroll
  for (int i = 0; i < 32; ++i) { v[i] -= mean; q += v[i] * v[i]; }
  const float rstd = rsqrtf(dpp_sum64(q) * (1.f / 2048.f) + LN_EPS);
#pragma unroll
  for (int j = 0; j < 4; ++j) {
    const f32x4 g0 = *(const f32x4*)(g + j * 512 + lane * 8), g1 = *(const f32x4*)(g + j * 512 + lane * 8 + 4);
    const f32x4 b0 = *(const f32x4*)(b + j * 512 + lane * 8), b1 = *(const f32x4*)(b + j * 512 + lane * 8 + 4);
#pragma unroll
    for (int e = 0; e < 4; ++e) { v[j * 8 + e] = v[j * 8 + e] * rstd * g0[e] + b0[e]; v[j * 8 + 4 + e] = v[j * 8 + 4 + e] * rstd * g1[e] + b1[e]; }
  }
}
__device__ __forceinline__ void sincos_big(float ang, float& c, float& s) {
  const double a = (double)ang;
  const double q = __builtin_rint(a * 0.63661977236758134308);
  const float r = (float)(a - q * 1.57079632679489661923);
  const int qi = ((int)q) & 3;
  const float r2 = r * r;
  const float sn = r + r * r2 * (-1.6666667e-1f + r2 * (8.3333333e-3f + r2 * (-1.9841270e-4f + r2 * 2.7557319e-6f)));
  const float cs = 1.f + r2 * (-0.5f + r2 * (4.1666667e-2f + r2 * (-1.3888889e-3f + r2 * (2.4801587e-5f + r2 * -2.7557319e-7f))));
  const float ss = (qi & 1) ? cs : sn, cc = (qi & 1) ? sn : cs;
  s = (qi & 2) ? -ss : ss;
  c = ((qi + 1) & 2) ? -cc : cc;
}

template <int WHICH> __device__ __forceinline__ void transpose_list(const Params& p, float* scr, int gw, int ngw, int lane) {
  struct TI { int mid, ndst, K; size_t off; };
  constexpr int NT = (WHICH == 0) ? 2 : (WHICH == 1) ? 7 : 9;
  const TI all[9] = {{0, 3328, 2048, WS_WIN_T}, {5, 1024, 2048, WS_WMKV_T}, {1, 1536, 512, WS_WUQ_T}, {2, 2048, 512, WS_WUKV_T}, {3, 2048, 2048, WS_WOUT_T}, {4, 512, 2048, WS_WMQ_T},
                     {6, 2048, 512, WS_WMO_T}, {7, 2048, 2048, WS_WPQ_T}, {8, 4096, 128, WS_WG_T}};
  constexpr int T0 = (WHICH == 1) ? 2 : 0;
  int total = 0;
#pragma unroll
  for (int t = 0; t < NT; ++t) total += (all[T0 + t].ndst / 32) * (all[T0 + t].K / 64);
  for (int git = gw; git < total; git += ngw) {
    int t = 0, it = git;
#pragma unroll
    for (int u = 0; u < NT - 1; ++u) { const int nit = (all[T0 + u].ndst / 32) * (all[T0 + u].K / 64); if (t == u && it >= nit) { it -= nit; t = u + 1; } }
    int mid = 0, ndst = 0, K = 0; size_t off = 0;
#pragma unroll
    for (int u = 0; u < NT; ++u) if (t == u) { mid = all[T0 + u].mid; ndst = all[T0 + u].ndst; K = all[T0 + u].K; off = all[T0 + u].off; }
    transpose_item(p.in, mid, K, (bf16_t*)(p.ws + off), scr, it, ndst / 32, lane);
  }
}
template <bool EARLY_ONLY> __device__ __forceinline__ void phase0(const Params& p, float* lds, int gw, int ngw, int lane, int wave) {
  unsigned char* ws = p.ws;
  float* scr = lds + wave * (64 * 33);
  transpose_list<(EARLY_ONLY ? 0 : 2)>(p, scr, gw, ngw, lane);
  { bf16_t* KT = (bf16_t*)(ws + WS_KEYS_T);
    for (int i = gw * 64 + lane; i < 256 * 256; i += ngw * 64) { const int n = i >> 8, k = i & 255; float v = 0.f;
      if (n < 128) { if (k < 128) v = p.in[29][n * 128 + k]; } else { if (k >= 128) v = p.in[30][(n - 128) * 128 + (k - 128)]; }
      KT[i] = (bf16_t)f2bf(v); } }
  { f32x4* gt = (f32x4*)(ws + WS_GTAB);
    for (int i = gw * 64 + lane; i < 2048; i += ngw * 64) gt[i] = (f32x4){8.f * log1pf(__expf(-p.in[16][i])), p.in[13][i], p.in[15][i], 0.f}; }
  { float* ct = (float*)(ws + WS_COS); float* st = (float*)(ws + WS_SIN); const int* pos = (const int*)p.in[2];
    for (int i = gw * 64 + lane; i < T_ * 32; i += ngw * 64) { const int t = i >> 5, f = i & 31;
      const float inv = exp2f(-(float)(2 * f) * (13.287712379549449f / 64.f));
      const float ang = (float)pos[t] * inv; float c, s; sincos_big(ang, c, s); ct[i] = c; st[i] = s; } }
  { const float* m = p.in[1]; bf16_t* mb = (bf16_t*)(ws + WS_MEMB);
    for (size_t i = (size_t)(gw * 64 + lane) * 8; i < (size_t)2048 * 2048; i += (size_t)ngw * 64 * 8) {
      const f32x4 a = *(const f32x4*)(m + i), b = *(const f32x4*)(m + i + 4); u32x4 o; o.x = pk2(a[0], a[1]); o.y = pk2(a[2], a[3]); o.z = pk2(b[0], b[1]); o.w = pk2(b[2], b[3]);
      *(u32x4*)(mb + i) = o; } }
  { const float* x = p.in[0]; bf16_t* X = (bf16_t*)(ws + WS_X);
    for (int r0 = gw * 2; r0 < T_; r0 += ngw * 2) { float v[2][32];
#pragma unroll
      for (int rr = 0; rr < 2; ++rr)
#pragma unroll
        for (int j = 0; j < 4; ++j) { const f32x4 a = *(const f32x4*)(x + (size_t)(r0 + rr) * DM + j * 512 + lane * 8), b = *(const f32x4*)(x + (size_t)(r0 + rr) * DM + j * 512 + lane * 8 + 4);
#pragma unroll
          for (int e = 0; e < 4; ++e) { v[rr][j * 8 + e] = a[e]; v[rr][j * 8 + 4 + e] = b[e]; } }
#pragma unroll
      for (int rr = 0; rr < 2; ++rr) { ln_row_regs(v[rr], p.in[3], p.in[4], lane);
#pragma unroll
        for (int j = 0; j < 4; ++j) *(u32x4*)(X + (size_t)(r0 + rr) * DM + j * 512 + lane * 8) = pack8(&v[rr][j * 8]); } } }
}

enum { E_WIN = 0, E_MEMKV, E_Q, E_KV, E_GATES, E_RES, E_BF16, E_F32 };
struct EpiArgs { unsigned char* ws; unsigned char* dout; const float* const* in; bf16_t* o; float* f; int ld; };
__device__ __forceinline__ void st4(bf16_t* ptr, f32x4 v) { u32x2 w; w.x = pk2(v[0], v[1]); w.y = pk2(v[2], v[3]); *(u32x2*)ptr = w; }
template <int MODE> __device__ __forceinline__ void epi(const EpiArgs& e, int batch, int row, int col, f32x4 v) {
  if constexpr (MODE == E_WIN) {
    if (col < 512) st4((bf16_t*)(e.ws + WS_CQ) + (size_t)row * 512 + col, v);
    else if (col < 1024) st4((bf16_t*)(e.ws + WS_CKV) + (size_t)row * 512 + (col - 512), v);
    else if (col < 2048) st4((bf16_t*)(e.ws + WS_LRUX) + (size_t)row * 1024 + (col - 1024), v);
    else if (col < 3072) { f32x4 g; for (int i = 0; i < 4; ++i) g[i] = gelu_tanh(v[i]); st4((bf16_t*)(e.ws + WS_GATE) + (size_t)row * 1024 + (col - 2048), g); }
    else if (col < 3136) st4((bf16_t*)(e.ws + WS_KPE) + (size_t)row * 64 + (col - 3072), v);
  } else if constexpr (MODE == E_MEMKV) {
    st4((bf16_t*)(e.ws + WS_MEMKV) + (size_t)row * 1024 + col, v);
  } else if constexpr (MODE == E_Q) {
    const int j = col % 192;
    if (j >= 128) { const int i0 = (j - 128) >> 1; const float* ct = (const float*)(e.ws + WS_COS) + (size_t)row * 32 + i0; const float* st = (const float*)(e.ws + WS_SIN) + (size_t)row * 32 + i0;
      const float c0 = ct[0], s0 = st[0], c1 = ct[1], s1 = st[1];
      v = (f32x4){v[0] * c0 - v[1] * s0, v[1] * c0 + v[0] * s0, v[2] * c1 - v[3] * s1, v[3] * c1 + v[2] * s1}; }
    st4((bf16_t*)(e.dout + DO_Q) + (size_t)row * 1536 + col, v);
  } else if constexpr (MODE == E_KV) {
    if (col < 1024) st4((bf16_t*)(e.dout + DO_K) + (size_t)row * 1536 + (col >> 7) * 192 + (col & 127), v);
    else st4((bf16_t*)(e.dout + DO_V) + (size_t)row * 1024 + (col - 1024), v);
  } else if constexpr (MODE == E_GATES) {
    const int dir = col >> 8, jj = (col & 255) >> 1, c0 = batch * 128 + jj;
    const f32x4* gt = (const f32x4*)(e.ws + WS_GTAB) + dir * 1024 + c0;
    const f32x4 t0 = gt[0], t1 = gt[1];
    const unsigned xw = *(const unsigned*)((const bf16_t*)(e.ws + WS_XC) + (size_t)row * 1024 + c0);
    const float la0 = -t0[0] * sigmoidf_(v[0] + t0[1]), la1 = -t1[0] * sigmoidf_(v[2] + t1[1]);
    const float bt0 = __builtin_amdgcn_sqrtf(neg_expm1_small(2.f * la0)) * sigmoidf_(v[1] + t0[2]) * bflo(xw);
    const float bt1 = __builtin_amdgcn_sqrtf(neg_expm1_small(2.f * la1)) * sigmoidf_(v[3] + t1[2]) * bfhi(xw);
    bf16_t* LA = (bf16_t*)(e.ws + (dir ? WS_LAB : WS_LAF)); bf16_t* BT = (bf16_t*)(e.ws + (dir ? WS_BTB : WS_BTF));
    *(unsigned*)(LA + (size_t)row * 1024 + c0) = pk2(la0, la1);
    *(unsigned*)(BT + (size_t)row * 1024 + c0) = pk2(bt0, bt1);
  } else if constexpr (MODE == E_RES) {
    bf16_t* X = (bf16_t*)(e.ws + WS_X) + (size_t)row * DM + col; const u32x2 w = *(const u32x2*)X;
    v = (f32x4){DN_ALPHA * bflo(w.x) + v[0], DN_ALPHA * bfhi(w.x) + v[1], DN_ALPHA * bflo(w.y) + v[2], DN_ALPHA * bfhi(w.y) + v[3]};
    st4(X, v);
  } else if constexpr (MODE == E_BF16) {
    st4(e.o + (size_t)row * e.ld + col, v);
  } else {
    *(f32x4*)(e.f + (size_t)row * e.ld + col) = v;
  }
}


__device__ __forceinline__ void st8(bf16_t* ptr, f32x4 a, f32x4 b) { u32x4 w; w.x = pk2(a[0], a[1]); w.y = pk2(a[2], a[3]); w.z = pk2(b[0], b[1]); w.w = pk2(b[2], b[3]); *(u32x4*)ptr = w; }
template <int MODE> __device__ __forceinline__ void epi8(const EpiArgs& e, int batch, int row, int col, f32x4 v0, f32x4 v1) {
  if constexpr (MODE == E_WIN) {
    if (col < 512) st8((bf16_t*)(e.ws + WS_CQ) + (size_t)row * 512 + col, v0, v1);
    else if (col < 1024) st8((bf16_t*)(e.ws + WS_CKV) + (size_t)row * 512 + (col - 512), v0, v1);
    else if (col < 2048) st8((bf16_t*)(e.ws + WS_LRUX) + (size_t)row * 1024 + (col - 1024), v0, v1);
    else if (col < 3072) { f32x4 g0, g1;
#pragma unroll
      for (int i = 0; i < 4; ++i) { g0[i] = gelu_tanh(v0[i]); g1[i] = gelu_tanh(v1[i]); }
      st8((bf16_t*)(e.ws + WS_GATE) + (size_t)row * 1024 + (col - 2048), g0, g1); }
    else if (col < 3136) st8((bf16_t*)(e.ws + WS_KPE) + (size_t)row * 64 + (col - 3072), v0, v1);
  } else if constexpr (MODE == E_MEMKV) {
    st8((bf16_t*)(e.ws + WS_MEMKV) + (size_t)row * 1024 + col, v0, v1);
  } else if constexpr (MODE == E_Q) {
    const int j = col % 192;
    if (j >= 128) { const int i0 = (j - 128) >> 1; const f32x4 c = *(const f32x4*)((const float*)(e.ws + WS_COS) + (size_t)row * 32 + i0), s = *(const f32x4*)((const float*)(e.ws + WS_SIN) + (size_t)row * 32 + i0);
      v0 = (f32x4){v0[0] * c[0] - v0[1] * s[0], v0[1] * c[0] + v0[0] * s[0], v0[2] * c[1] - v0[3] * s[1], v0[3] * c[1] + v0[2] * s[1]};
      v1 = (f32x4){v1[0] * c[2] - v1[1] * s[2], v1[1] * c[2] + v1[0] * s[2], v1[2] * c[3] - v1[3] * s[3], v1[3] * c[3] + v1[2] * s[3]}; }
    st8((bf16_t*)(e.dout + DO_Q) + (size_t)row * 1536 + col, v0, v1);
  } else if constexpr (MODE == E_KV) {
    if (col < 1024) st8((bf16_t*)(e.dout + DO_K) + (size_t)row * 1536 + (col >> 7) * 192 + (col & 127), v0, v1);
    else st8((bf16_t*)(e.dout + DO_V) + (size_t)row * 1024 + (col - 1024), v0, v1);
  } else if constexpr (MODE == E_GATES) {
    const int dir = col >> 8, jj = (col & 255) >> 1, c0 = batch * 128 + jj;
    const f32x4* gt = (const f32x4*)(e.ws + WS_GTAB) + dir * 1024 + c0;
    const u32x2 xw = *(const u32x2*)((const bf16_t*)(e.ws + WS_XC) + (size_t)row * 1024 + c0);
    const float xc[4] = {bflo(xw.x), bfhi(xw.x), bflo(xw.y), bfhi(xw.y)}; const float vv[8] = {v0[0], v0[1], v0[2], v0[3], v1[0], v1[1], v1[2], v1[3]};
    float la[4], bt[4];
#pragma unroll
    for (int i = 0; i < 4; ++i) { const f32x4 t = gt[i]; la[i] = -t[0] * sigmoidf_(vv[2 * i] + t[1]);
      bt[i] = __builtin_amdgcn_sqrtf(neg_expm1_small(2.f * la[i])) * sigmoidf_(vv[2 * i + 1] + t[2]) * xc[i]; }
    bf16_t* LA = (bf16_t*)(e.ws + (dir ? WS_LAB : WS_LAF)); bf16_t* BT = (bf16_t*)(e.ws + (dir ? WS_BTB : WS_BTF));
    u32x2 lw, bw; lw.x = pk2(la[0], la[1]); lw.y = pk2(la[2], la[3]); bw.x = pk2(bt[0], bt[1]); bw.y = pk2(bt[2], bt[3]);
    *(u32x2*)(LA + (size_t)row * 1024 + c0) = lw; *(u32x2*)(BT + (size_t)row * 1024 + c0) = bw;
  } else if constexpr (MODE == E_BF16) {
    st8(e.o + (size_t)row * e.ld + col, v0, v1);
  } else {
    *(f32x4*)(e.f + (size_t)row * e.ld + col) = v0; *(f32x4*)(e.f + (size_t)row * e.ld + col + 4) = v1;
  }
}

struct GemmArgs { const bf16_t* A; size_t lda, a_batch; const bf16_t* Bt; size_t ldb, b_batch; int M, N, K, nbatch; int rot = 0; };
template <int MODE> __device__ __forceinline__ void gemm_simple(const GemmArgs& g, const EpiArgs& e, int bid, int nblk, int wave, int lane) {
  const int tm = g.M / 128, tn = g.N / 128, per = tm * tn, units = g.nbatch * per;
  const int r32 = lane & 31, hi = lane >> 5, wr = wave >> 1, wc = wave & 1;
  for (int u = bid; u < units; u += nblk) {
    const int bt = u / per, r = u % per, pm = r / tn, pn = r % tn;
    const bf16_t* ap = g.A + (size_t)bt * g.a_batch + (size_t)(pm * 128 + wr * 32 + r32) * g.lda + 8 * hi;
    const bf16_t* bp0 = g.Bt + (size_t)bt * g.b_batch + (size_t)(pn * 128 + wc * 64 + r32) * g.ldb + 8 * hi;
    const bf16_t* bp1 = bp0 + 32 * g.ldb;
    f32x16 acc0 = {}, acc1 = {};
#pragma unroll 4
    for (int k0 = 0; k0 < g.K; k0 += 16) {
      const bf16x8 a = *(const bf16x8*)(ap + k0), b0 = *(const bf16x8*)(bp0 + k0), b1 = *(const bf16x8*)(bp1 + k0);
      acc0 = __builtin_amdgcn_mfma_f32_32x32x16_bf16(b0, a, acc0, 0, 0, 0);
      acc1 = __builtin_amdgcn_mfma_f32_32x32x16_bf16(b1, a, acc1, 0, 0, 0);
    }
    const int row = pm * 128 + wr * 32 + r32;
#pragma unroll
    for (int gq = 0; gq < 4; ++gq) {
      const int col = pn * 128 + wc * 64 + 8 * gq + 4 * hi;
      epi<MODE>(e, bt, row, col, (f32x4){acc0[4 * gq], acc0[4 * gq + 1], acc0[4 * gq + 2], acc0[4 * gq + 3]});
      epi<MODE>(e, bt, row, col + 32, (f32x4){acc1[4 * gq], acc1[4 * gq + 1], acc1[4 * gq + 2], acc1[4 * gq + 3]});
    }
  }
}


namespace pg8 {
#define PG8_LAS __attribute__((address_space(3)))
constexpr int BM = 256, BK = 64, HALF = 128, HTB = HALF * BK * 2, STAGE_BYTES = 8 * HTB, NXCD = 8, WGM = 8;
__host__ __device__ __forceinline__ int lds_byte(int r, int c) { const int st = (r >> 4) * 2 + (c >> 5), rr = r & 15, cc = c & 31, ob = rr * 64 + cc * 2; return st * 1024 + (ob ^ (((ob >> 9) & 1) << 5)); }
__host__ __device__ __forceinline__ void stage_rc(int b, int& R, int& C) { const int st = b / 1024, sb = b % 1024, swz = sb ^ (((sb >> 9) & 1) << 5); R = (st >> 1) * 16 + swz / 64; C = (st & 1) * 32 + (swz % 64) / 2; }
__host__ __device__ __forceinline__ int perm32(int rho) { const int n = rho >> 4, i = rho & 15; return 8 * (i >> 2) + 4 * n + (i & 3); }
struct Unit { int pm, pn; };
struct Gemm { const bf16_t* A; const bf16_t* Bt; int M, N, K; int lda, ldb; int pn_per_batch; int a_batch_elems; };
struct StaticOrder {
  int nM, nN, nwg, G, c;
  __device__ void init(int M, int N, int G_, int c_) { nM = M / BM; nN = N / BM; nwg = nM * nN; G = G_; c = c_; }
  __device__ bool next(int i, Unit& u) const {
    const long L = (long)i * G + c; if (L >= nwg) return false;
    int wgid = (int)L; { const int q = nwg / NXCD, r = nwg % NXCD, xcd = wgid % NXCD, off = wgid / NXCD; wgid = (xcd < r ? xcd * (q + 1) : r * (q + 1) + (xcd - r) * q) + off; }
    const int nig = WGM * nN, gid = wgid / nig, fm = gid * WGM, gsz = (nM - fm) < WGM ? (nM - fm) : WGM;
    u.pm = fm + ((wgid % nig) % gsz); u.pn = (wgid % nig) / gsz; return true;
  }
};
template <int MODE> struct EpiAdapter {
  static constexpr bool PERM = true;
  EpiArgs e; int nb_cols;
  __device__ __forceinline__ void operator()(const f32x4 (&acc)[2][2][4][2], const Unit& u, int wr, int wc, int fr, int fq) const {
    if constexpr (MODE == E_RES) {
      bf16_t* X = (bf16_t*)(e.ws + WS_X);
#pragma unroll
      for (int ai = 0; ai < 2; ++ai) { u32x4 rw[4][2];
#pragma unroll
        for (int m = 0; m < 4; ++m)
#pragma unroll
          for (int bj = 0; bj < 2; ++bj) rw[m][bj] = *(const u32x4*)(X + (size_t)(u.pm * BM + ai * HALF + wr * 64 + m * 16 + fr) * DM + u.pn * BM + bj * HALF + wc * 32 + 8 * fq);
#pragma unroll
        for (int m = 0; m < 4; ++m)
#pragma unroll
          for (int bj = 0; bj < 2; ++bj) { const u32x4 w = rw[m][bj]; const f32x4 a0 = acc[ai][bj][m][0], a1 = acc[ai][bj][m][1];
            st8(X + (size_t)(u.pm * BM + ai * HALF + wr * 64 + m * 16 + fr) * DM + u.pn * BM + bj * HALF + wc * 32 + 8 * fq,
                (f32x4){DN_ALPHA * bflo(w.x) + a0[0], DN_ALPHA * bfhi(w.x) + a0[1], DN_ALPHA * bflo(w.y) + a0[2], DN_ALPHA * bfhi(w.y) + a0[3]},
                (f32x4){DN_ALPHA * bflo(w.z) + a1[0], DN_ALPHA * bfhi(w.z) + a1[1], DN_ALPHA * bflo(w.w) + a1[2], DN_ALPHA * bfhi(w.w) + a1[3]}); }
        asm volatile("" ::: "memory"); }
      return;
    }
#pragma unroll
    for (int ai = 0; ai < 2; ++ai)
#pragma unroll
      for (int m = 0; m < 4; ++m) { const int row = u.pm * BM + ai * HALF + wr * 64 + m * 16 + fr;
#pragma unroll
        for (int bj = 0; bj < 2; ++bj) { const int colg = u.pn * BM + bj * HALF + wc * 32 + 8 * fq; const int batch = colg / nb_cols; const int col = colg - batch * nb_cols;
          epi8<MODE>(e, batch, row, col, acc[ai][bj][m][0], acc[ai][bj][m][1]); }
        asm volatile("" ::: "memory"); }
  }
};
template <class Epi>
__device__ __forceinline__ void gemm_phase(PG8_LAS unsigned char* lds, const Gemm g, const StaticOrder& S, const Epi& E) {
  int tid_ = threadIdx.x; asm volatile("" : "+v"(tid_));
  const int tid = tid_, wid = __builtin_amdgcn_readfirstlane(tid >> 6), lane = tid & 63, wr = wid >> 2, wc = wid & 3, fr = lane & 15, fq = lane >> 4;
  const int K = g.K, nt = K / BK;
  unsigned voffA[2], voffB[2];
#pragma unroll
  for (int i = 0; i < 2; ++i) { int R, C; stage_rc(tid * 16 + i * 8192, R, C); const int Rb = Epi::PERM ? ((R & ~31) + perm32(R & 31)) : R; voffA[i] = (unsigned)(R * g.lda + C) * 2u; voffB[i] = (unsigned)(Rb * g.ldb + C) * 2u; }
  const size_t kstep = (size_t)(BK * 2);
  const size_t hstepA = (size_t)HALF * g.lda * 2, hstepB = (size_t)HALF * g.ldb * 2;
  const size_t tstepA = 2 * hstepA, tstepB = 2 * hstepB;
  const unsigned ldsw = (unsigned)wid * 1024u;
  const int aoff = lds_byte(wr * 64 + fr, fq * 8), boff = lds_byte(wc * 32 + fr, fq * 8);
#define PG8_SA(b, h) (((b) * 2 + (h)) * HTB)
#define PG8_SB(b, h) ((4 + (b) * 2 + (h)) * HTB)
#define PG8_STAGE(bufoff, gbase, voff) do { _Pragma("unroll") for (int _i = 0; _i < 2; ++_i) \
    __builtin_amdgcn_global_load_lds((const unsigned*)((const char*)(gbase) + (voff)[_i]), (PG8_LAS unsigned*)(lds + (bufoff) + ldsw + _i * 8192), 16, 0, 0); } while (0)
#define PG8_LDA(dst, b, h) do { _Pragma("unroll") for (int m = 0; m < 4; ++m) _Pragma("unroll") for (int k = 0; k < 2; ++k) dst[m][k] = *(const PG8_LAS bf16x8*)(lds + PG8_SA(b, h) + aoff + m * 2048 + k * 1024); } while (0)
#define PG8_LDB(dst, b, h) do { _Pragma("unroll") for (int n = 0; n < 2; ++n) _Pragma("unroll") for (int k = 0; k < 2; ++k) dst[n][k] = *(const PG8_LAS bf16x8*)(lds + PG8_SB(b, h) + boff + n * 2048 + k * 1024); } while (0)
#define PG8_MMA(ai, bj, At, Bt) do { __builtin_amdgcn_s_setprio(1); _Pragma("unroll") for (int m = 0; m < 4; ++m) _Pragma("unroll") for (int n = 0; n < 2; ++n) _Pragma("unroll") for (int k = 0; k < 2; ++k) \
    acc[ai][bj][m][n] = __builtin_amdgcn_mfma_f32_16x16x32_bf16(Bt[n][k], At[m][k], acc[ai][bj][m][n], 0, 0, 0); __builtin_amdgcn_s_setprio(0); } while (0)
#define PG8_WAIT_V(n) asm volatile("s_waitcnt vmcnt(" #n ")" ::: "memory")
#define PG8_WAIT_L(n) asm volatile("s_waitcnt lgkmcnt(" #n ")" ::: "memory")
#define PG8_BAR __builtin_amdgcn_s_barrier()
#define PG8_SCHED __builtin_amdgcn_sched_barrier(0)
#define PG8_APTR(u) ((const char*)g.A + (size_t)(u).pm * tstepA + (size_t)((u).pn / g.pn_per_batch) * g.a_batch_elems * 2)
#define PG8_BPTR(u) ((const char*)g.Bt + (size_t)(u).pn * tstepB)
  Unit cur, nxt; int ui = 0;
  if (!S.next(0, cur)) return;
  f32x4 acc[2][2][4][2];
#pragma unroll
  for (int a = 0; a < 2; ++a)
#pragma unroll
    for (int b = 0; b < 2; ++b)
#pragma unroll
      for (int m = 0; m < 4; ++m)
#pragma unroll
        for (int n = 0; n < 2; ++n) acc[a][b][m][n] = (f32x4){0.f, 0.f, 0.f, 0.f};
  bf16x8 At[4][2], B0[2][2], B1[2][2];
  const char* cA = PG8_APTR(cur); const char* cB = PG8_BPTR(cur);
  PG8_STAGE(PG8_SB(0, 0), cB, voffB); PG8_STAGE(PG8_SB(0, 1), cB + hstepB, voffB); PG8_STAGE(PG8_SA(0, 0), cA, voffA); PG8_STAGE(PG8_SA(0, 1), cA + hstepA, voffA);
  if (wr == 1) PG8_BAR;
  PG8_WAIT_V(2); PG8_BAR;
  PG8_STAGE(PG8_SB(1, 0), cB + kstep, voffB); PG8_STAGE(PG8_SA(1, 0), cA + kstep, voffA); PG8_STAGE(PG8_SB(1, 1), cB + hstepB + kstep, voffB);
  PG8_WAIT_V(6); PG8_BAR;
  for (;;) {
    const bool has_next = S.next(ui + 1, nxt);
    const char* nA = has_next ? PG8_APTR(nxt) : cA; const char* nB = has_next ? PG8_BPTR(nxt) : cB;
    for (int t = 0; t < nt; t += 2) {
      const bool last = (t == nt - 2);
      const char* a1 = cA + (size_t)(t + 1) * kstep;
      const char* a2 = last ? nA : cA + (size_t)(t + 2) * kstep; const char* b2 = last ? nB : cB + (size_t)(t + 2) * kstep;
      const char* a3 = a2 + kstep; const char* b3 = b2 + kstep;
      PG8_LDB(B0, 0, 0); PG8_LDB(B1, 0, 1); PG8_SCHED; PG8_LDA(At, 0, 0); PG8_STAGE(PG8_SA(1, 1), a1 + hstepA, voffA);
      PG8_WAIT_V(8); PG8_WAIT_L(0); PG8_BAR; PG8_MMA(0, 0, At, B0); PG8_MMA(0, 1, At, B1); PG8_BAR; PG8_SCHED;
      PG8_LDA(At, 0, 1); PG8_STAGE(PG8_SB(0, 0), b2, voffB); PG8_STAGE(PG8_SB(0, 1), b2 + hstepB, voffB); PG8_STAGE(PG8_SA(0, 0), a2, voffA);
      PG8_WAIT_V(8); PG8_WAIT_L(0); PG8_BAR; PG8_MMA(1, 0, At, B0); PG8_MMA(1, 1, At, B1); PG8_BAR; PG8_SCHED;
      PG8_LDB(B0, 1, 0); PG8_LDB(B1, 1, 1); PG8_SCHED; PG8_LDA(At, 1, 0); PG8_STAGE(PG8_SA(0, 1), a2 + hstepA, voffA);
      PG8_WAIT_V(8); PG8_WAIT_L(0); PG8_BAR; PG8_MMA(0, 0, At, B0); PG8_MMA(0, 1, At, B1); PG8_BAR; PG8_SCHED;
      PG8_LDA(At, 1, 1); PG8_STAGE(PG8_SB(1, 0), b3, voffB); PG8_STAGE(PG8_SB(1, 1), b3 + hstepB, voffB); PG8_STAGE(PG8_SA(1, 0), a3, voffA);
      PG8_WAIT_V(8); PG8_WAIT_L(0); PG8_BAR; PG8_MMA(1, 0, At, B0); PG8_MMA(1, 1, At, B1); PG8_BAR; PG8_SCHED;
    }
    if (wr == 0) PG8_BAR;
    E(acc, cur, wr, wc, fr, fq);
    if (!has_next) break;
#pragma unroll
    for (int a = 0; a < 2; ++a)
#pragma unroll
      for (int b = 0; b < 2; ++b)
#pragma unroll
        for (int m = 0; m < 4; ++m)
#pragma unroll
          for (int n = 0; n < 2; ++n) acc[a][b][m][n] = (f32x4){0.f, 0.f, 0.f, 0.f};
    cur = nxt; cA = nA; cB = nB; ++ui;
    if (wr == 1) PG8_BAR;
  }
  PG8_WAIT_V(0);
  PG8_BAR;
#undef PG8_SA
#undef PG8_SB
#undef PG8_STAGE
#undef PG8_LDA
#undef PG8_LDB
#undef PG8_MMA
#undef PG8_WAIT_V
#undef PG8_WAIT_L
#undef PG8_BAR
#undef PG8_SCHED
#undef PG8_APTR
#undef PG8_BPTR
}
}
template <int MODE> __device__ __forceinline__ void gemm_fast(const GemmArgs& g, const EpiArgs& e, unsigned char* lds_raw, int bid_, int nblk) {
  const int bid = (bid_ + g.rot) % nblk;
  pg8::Gemm G{g.A, g.Bt, g.M, g.N * g.nbatch, g.K, (int)g.lda, (int)g.ldb, g.nbatch > 1 ? g.N / 256 : (1 << 30), (int)g.a_batch};
  pg8::StaticOrder S; S.init(G.M, G.N, nblk, bid);
  pg8::EpiAdapter<MODE> E{e, g.N};
  pg8::gemm_phase<pg8::EpiAdapter<MODE>>((PG8_LAS unsigned char*)lds_raw, G, S, E);
}

__device__ __forceinline__ void phase1b(const Params& p, int gw, int ngw, int lane) {
  unsigned char* ws = p.ws;
  bf16_t* CQ = (bf16_t*)(ws + WS_CQ); bf16_t* CKV = (bf16_t*)(ws + WS_CKV); const bf16_t* KPE = (const bf16_t*)(ws + WS_KPE);
  bf16_t* Kd = (bf16_t*)((unsigned char*)p.out + DO_K); const bf16_t* LX = (const bf16_t*)(ws + WS_LRUX); bf16_t* XC = (bf16_t*)(ws + WS_XC);
  const float* ct = (const float*)(ws + WS_COS); const float* st = (const float*)(ws + WS_SIN);
  for (int r = gw; r < T_; r += ngw) {
#pragma unroll
    for (int which = 0; which < 2; ++which) {
      bf16_t* row = (which ? CKV : CQ) + (size_t)r * 512 + lane * 8; const float* g = p.in[which ? 8 : 6] + lane * 8;
      float f[8]; unpack8(*(const u32x4*)row, f); float q = 0.f;
#pragma unroll
      for (int i = 0; i < 8; ++i) q += f[i] * f[i];
      const float sc = rsqrtf(dpp_sum64(q) * (1.f / 512.f) + RMS_EPS);
#pragma unroll
      for (int i = 0; i < 8; ++i) f[i] = f[i] * sc * g[i];
      *(u32x4*)row = pack8(f);
    }
    {
      if (lane < 32) { const unsigned w = *(const unsigned*)(KPE + (size_t)r * 64 + 2 * lane); const float t1 = bflo(w), t2 = bfhi(w);
        const float c = ct[(size_t)r * 32 + lane], s = st[(size_t)r * 32 + lane]; const unsigned o = pk2(t1 * c - t2 * s, t2 * c + t1 * s);
#pragma unroll
        for (int h = 0; h < 8; ++h) *(unsigned*)(Kd + (size_t)r * 1536 + h * 192 + 128 + 2 * lane) = o; } }
    if (!USE_LRU_FUSED) {
      const int s = r & (S_ - 1); float acc[16];
      const float* cb = p.in[11] + lane * 16;
#pragma unroll
      for (int i = 0; i < 16; ++i) acc[i] = cb[i];
#pragma unroll
      for (int k = 0; k < 4; ++k) { const int sp = s + k - 2; if (sp < 0 || sp >= S_) continue;
        const bf16_t* src = LX + (size_t)(r + k - 2) * 1024 + lane * 16; const float* w = p.in[10] + k * 1024 + lane * 16;
        float f[16]; unpack8(*(const u32x4*)src, f); unpack8(*(const u32x4*)(src + 8), f + 8);
#pragma unroll
        for (int i = 0; i < 16; ++i) acc[i] += f[i] * w[i]; }
      *(u32x4*)(XC + (size_t)r * 1024 + lane * 16) = pack8(acc); *(u32x4*)(XC + (size_t)r * 1024 + lane * 16 + 8) = pack8(acc + 8);
    }
  }
}

template <int DQK, int NK> __device__ __forceinline__ void attn_scalar(const bf16_t* Q, int ldq, const bf16_t* K, int ldk, const bf16_t* V, int ldv, bf16_t* O, int ldo,
                                                                      int nheads, float scale, float* lds, int bid, int nblk, int tid) {
  float* sc = lds; float* qs = lds + 16 * NK; float* ls = qs + 16 * DQK;
  const int lane = tid & 63, wave = tid >> 6;
  const int units = NB_ * nheads * (S_ / 16);
  for (int u = bid; u < units; u += nblk) {
    const int qb = u % (S_ / 16), h = (u / (S_ / 16)) % nheads, b = u / ((S_ / 16) * nheads);
    __syncthreads();
    for (int i = tid; i < 16 * DQK; i += NTHR) { const int r = i / DQK, d = i % DQK; qs[i] = bf2f(Q[(size_t)(b * S_ + qb * 16 + r) * ldq + h * DQK + d]) * scale; }
    __syncthreads();
    for (int kk = tid; kk < NK; kk += NTHR) {
      const bf16_t* kp = K + (size_t)(b * NK + kk) * ldk + h * DQK; float acc[16];
#pragma unroll
      for (int r = 0; r < 16; ++r) acc[r] = 0.f;
      for (int d0 = 0; d0 < DQK; d0 += 8) { float kf[8]; unpack8(*(const u32x4*)(kp + d0), kf);
#pragma unroll
        for (int r = 0; r < 16; ++r) { const f32x4 q0 = *(const f32x4*)(qs + r * DQK + d0), q1 = *(const f32x4*)(qs + r * DQK + d0 + 4);
          acc[r] += q0[0] * kf[0] + q0[1] * kf[1] + q0[2] * kf[2] + q0[3] * kf[3] + q1[0] * kf[4] + q1[1] * kf[5] + q1[2] * kf[6] + q1[3] * kf[7]; } }
#pragma unroll
      for (int r = 0; r < 16; ++r) sc[r * NK + kk] = acc[r];
    }
    __syncthreads();
    for (int rr = 0; rr < 2; ++rr) { const int r = wave * 2 + rr; float m = -1e30f;
      for (int kk = lane; kk < NK; kk += 64) m = fmaxf(m, sc[r * NK + kk]);
      m = wave_max(m); float l = 0.f;
      for (int kk = lane; kk < NK; kk += 64) { const float pv = __expf(sc[r * NK + kk] - m); sc[r * NK + kk] = pv; l += pv; }
      l = wave_sum(l); if (lane == 0) ls[r] = l; }
    __syncthreads();
    { const int r = tid >> 5, d4 = (tid & 31) * 4; float a0 = 0.f, a1 = 0.f, a2 = 0.f, a3 = 0.f;
      const bf16_t* vp = V + (size_t)(b * NK) * ldv + h * 128 + d4;
      for (int kk = 0; kk < NK; ++kk) { const float pv = sc[r * NK + kk]; const u32x2 w = *(const u32x2*)(vp + (size_t)kk * ldv);
        a0 += pv * bflo(w.x); a1 += pv * bfhi(w.x); a2 += pv * bflo(w.y); a3 += pv * bfhi(w.y); }
      const float il = 1.f / ls[r];
      st4(O + (size_t)(b * S_ + qb * 16 + r) * ldo + h * 128 + d4, (f32x4){a0 * il, a1 * il, a2 * il, a3 * il}); }
  }
  __syncthreads();
}


namespace fa {
typedef short s16x4 __attribute__((ext_vector_type(4)));
constexpr int NW = 8, QBLK = 32, KVBLK = 64;
constexpr float THR = 8.f;
#define FA_SBAR() __builtin_amdgcn_sched_barrier(0)
__device__ __forceinline__ int crow(int r, int hi) { return (r & 3) + 8 * (r >> 2) + 4 * hi; }
__device__ __forceinline__ unsigned cvtpk(float lo, float hi) { unsigned r; asm volatile("v_cvt_pk_bf16_f32 %0, %1, %2" : "=v"(r) : "v"(lo), "v"(hi)); return r; }
__device__ __forceinline__ void partialSM(f32x16& p0, f32x16& p1, float& m_reg, float& mn, float& alpha, const float C, const float thr_s) {
  float pmax = p0[0];
#pragma unroll
  for (int r = 1; r < 16; ++r) pmax = fmaxf(pmax, p0[r]);
#pragma unroll
  for (int r = 0; r < 16; ++r) pmax = fmaxf(pmax, p1[r]);
  { auto rr = __builtin_amdgcn_permlane32_swap(__float_as_uint(pmax), __float_as_uint(pmax), false, false);
    pmax = fmaxf(__uint_as_float(rr[0]), __uint_as_float(rr[1])); }
  if (__builtin_expect(__all(pmax - m_reg <= thr_s), 1)) { mn = m_reg; alpha = 1.f; }
  else { mn = fmaxf(m_reg, pmax); alpha = __builtin_amdgcn_exp2f((m_reg - mn) * C); m_reg = mn; }
  const float mnC = -mn * C;
#pragma unroll
  for (int r = 0; r < 16; ++r) p0[r] = fmaf(p0[r], C, mnC);
#pragma unroll
  for (int r = 0; r < 16; ++r) p1[r] = fmaf(p1[r], C, mnC);
#pragma unroll
  for (int r = 0; r < 16; ++r) p0[r] = __builtin_amdgcn_exp2f(p0[r]);
}
__device__ __forceinline__ void finishSM(f32x16& p0, f32x16& p1, float alpha, float& l_reg, bf16x8& pa0, bf16x8& pa1, bf16x8& pa2, bf16x8& pa3) {
#pragma unroll
  for (int r = 0; r < 16; ++r) p1[r] = __builtin_amdgcn_exp2f(p1[r]);
  float ps = 0;
#pragma unroll
  for (int r = 0; r < 16; ++r) ps += p0[r];
#pragma unroll
  for (int r = 0; r < 16; ++r) ps += p1[r];
  { auto rr = __builtin_amdgcn_permlane32_swap(__float_as_uint(ps), __float_as_uint(ps), false, false);
    ps = __uint_as_float(rr[0]) + __uint_as_float(rr[1]); }
  l_reg = l_reg * alpha + ps;
#define FA_PK4(P, BASE, OUT) do { unsigned a0 = cvtpk(P[BASE + 0], P[BASE + 1]), a1 = cvtpk(P[BASE + 2], P[BASE + 3]);   \
    unsigned b0 = cvtpk(P[BASE + 4], P[BASE + 5]), b1 = cvtpk(P[BASE + 6], P[BASE + 7]);                              \
    auto r0 = __builtin_amdgcn_permlane32_swap(a0, b0, false, false); auto r1 = __builtin_amdgcn_permlane32_swap(a1, b1, false, false); \
    u32x4 w = {r0[0], r1[0], r0[1], r1[1]}; OUT = *reinterpret_cast<bf16x8*>(&w); } while (0)
  FA_PK4(p0, 0, pa0); FA_PK4(p0, 8, pa1); FA_PK4(p1, 0, pa2); FA_PK4(p1, 8, pa3);
#undef FA_PK4
}
template <int DQK> constexpr int krs() { return DQK == 192 ? 400 : DQK * 2; }
template <int DQK> __device__ __forceinline__ int kswz(int row, int colB) { return DQK == 192 ? row * 400 + colB : row * (DQK * 2) + (colB ^ ((row & 7) << 4)); }
template <int DQK> __device__ __forceinline__ void qkt(f32x16& p0, f32x16& p1, const char* Ks, const bf16x8* qr, const int* kb4) {
  p0 = f32x16{}; p1 = f32x16{};
#pragma unroll
  for (int d0 = 0; d0 < DQK / 16; ++d0) {
    const bf16x8 b0 = *reinterpret_cast<const bf16x8*>(Ks + kb4[d0 & 3] + (d0 >> 2) * 128);
    const bf16x8 b1 = *reinterpret_cast<const bf16x8*>(Ks + kb4[d0 & 3] + (d0 >> 2) * 128 + 32 * krs<DQK>());
    p0 = __builtin_amdgcn_mfma_f32_32x32x16_bf16(b0, qr[d0], p0, 0, 0, 0);
    p1 = __builtin_amdgcn_mfma_f32_32x32x16_bf16(b1, qr[d0], p1, 0, 0, 0); }
}
__device__ __forceinline__ int v_st(int k, int c) { const int kk = (k & ~0xC) | ((k & 4) << 1) | ((k & 8) >> 1); return ((kk >> 3) * 4 + (c >> 5)) * 512 + ((kk & 7) * 32 + (c & 31)) * 2; }
__device__ __forceinline__ int v_rd_base(int lane) { return ((lane & 3) << 3) | (((lane >> 2) & 3) << 6) | (((lane >> 4) & 1) << 5) | (((lane >> 5) & 1) << 8); }
constexpr int v_rd_off(int d0, int ks, int half) { return d0 * 512 + ks * 4096 + half * 2048; }
template <int OFF> __device__ __forceinline__ s16x4 tr_read(int vb) {
  s16x4 r; asm volatile("ds_read_b64_tr_b16 %0, %1 offset:%2" : "=&v"(r) : "v"(vb), "i"(OFF) : "memory"); return r;
}
template <int D0> __device__ __forceinline__ void pv_one(f32x16& od, int vb, bf16x8 pa0, bf16x8 pa1, bf16x8 pa2, bf16x8 pa3) {
  const s16x4 l0 = tr_read<v_rd_off(D0, 0, 0)>(vb), h0 = tr_read<v_rd_off(D0, 0, 1)>(vb), l1 = tr_read<v_rd_off(D0, 1, 0)>(vb), h1 = tr_read<v_rd_off(D0, 1, 1)>(vb);
  const s16x4 l2 = tr_read<v_rd_off(D0, 2, 0)>(vb), h2 = tr_read<v_rd_off(D0, 2, 1)>(vb), l3 = tr_read<v_rd_off(D0, 3, 0)>(vb), h3 = tr_read<v_rd_off(D0, 3, 1)>(vb);
  asm volatile("s_waitcnt lgkmcnt(0)" ::: "memory"); FA_SBAR();
#define FA_PK(L, H) (bf16x8){L[0], L[1], L[2], L[3], H[0], H[1], H[2], H[3]}
  od = __builtin_amdgcn_mfma_f32_32x32x16_bf16(pa0, FA_PK(l0, h0), od, 0, 0, 0);
  od = __builtin_amdgcn_mfma_f32_32x32x16_bf16(pa1, FA_PK(l1, h1), od, 0, 0, 0);
  od = __builtin_amdgcn_mfma_f32_32x32x16_bf16(pa2, FA_PK(l2, h2), od, 0, 0, 0);
  od = __builtin_amdgcn_mfma_f32_32x32x16_bf16(pa3, FA_PK(l3, h3), od, 0, 0, 0);
#undef FA_PK
}
__device__ __forceinline__ void pv_d0(f32x16* o, int vb, bf16x8 pa0, bf16x8 pa1, bf16x8 pa2, bf16x8 pa3) {
  pv_one<0>(o[0], vb, pa0, pa1, pa2, pa3); pv_one<1>(o[1], vb, pa0, pa1, pa2, pa3); pv_one<2>(o[2], vb, pa0, pa1, pa2, pa3); pv_one<3>(o[3], vb, pa0, pa1, pa2, pa3);
}
template <int DQK, int LDQ, int LDK, int LDV, int LDO>
__device__ __forceinline__ void attn_body(const bf16_t* __restrict__ Qb, const bf16_t* __restrict__ Kh, const bf16_t* __restrict__ Vh, bf16_t* __restrict__ Ob, int seq, float scale, char* lds) {
  constexpr int SHM_V = KVBLK * 128 * 2, SHM_K = KVBLK * krs<DQK>(), NKC = DQK / 64;
  const float C = scale * 1.4426950408889634f, thr_s = THR / scale;
  int tid_ = threadIdx.x; asm volatile("" : "+v"(tid_));
  const int tid = tid_, wid = tid >> 6, lane = tid & 63, r32 = lane & 31, hi = lane >> 5;
  char* V_lds = lds; char* K_lds = lds + 2 * SHM_V;
  float* wsf = (float*)(lds + 2 * SHM_V + 2 * SHM_K) + wid * 64; float* li_l = wsf; float* al_l = wsf + 32;
  float m_reg = -1e30f, l_reg = 0; f32x16 o[4] = {}; bf16x8 qr[DQK / 16];
  const bf16_t* Qw = Qb + (size_t)(wid * QBLK + r32) * LDQ + hi * 8;
#pragma unroll
  for (int d0 = 0; d0 < DQK / 16; ++d0) qr[d0] = *reinterpret_cast<const bf16x8*>(Qw + d0 * 16);
  const int sr = tid >> 4, sc = (tid & 15) * 8, vst0 = v_st(sr, sc), vst1 = v_st(32 + sr, sc);
  const int kgo0 = sr * LDK + sc, klo0 = kswz<DQK>(sr, sc * 2);
  const int kgo2 = (tid >> 3) * LDK + 128 + (tid & 7) * 8, klo2 = kswz<DQK>(tid >> 3, (128 + (tid & 7) * 8) * 2);
  const int vb0 = (int)(uintptr_t)V_lds + v_rd_base(lane);
  int kb4[4];
#pragma unroll
  for (int q = 0; q < 4; ++q) kb4[q] = kswz<DQK>(r32, q * 32 + hi * 16);
  bf16x8 vs0, vs1, ks[NKC];
#define FA_SLOAD(k0) do { vs0 = *reinterpret_cast<const bf16x8*>(&Vh[(size_t)((k0) + sr) * LDV + sc]); vs1 = *reinterpret_cast<const bf16x8*>(&Vh[(size_t)((k0) + 32 + sr) * LDV + sc]); \
    ks[0] = *reinterpret_cast<const bf16x8*>(&Kh[(size_t)(k0) * LDK + kgo0]); ks[1] = *reinterpret_cast<const bf16x8*>(&Kh[(size_t)((k0) + 32) * LDK + kgo0]); \
    if constexpr (NKC == 3) ks[NKC - 1] = *reinterpret_cast<const bf16x8*>(&Kh[(size_t)(k0) * LDK + kgo2]); } while (0)
#define FA_SWRITE(b) do { *(bf16x8*)(V_lds + (b) * SHM_V + vst0) = vs0; *(bf16x8*)(V_lds + (b) * SHM_V + vst1) = vs1; \
    *(bf16x8*)(K_lds + (b) * SHM_K + klo0) = ks[0]; *(bf16x8*)(K_lds + (b) * SHM_K + klo0 + 32 * krs<DQK>()) = ks[1]; \
    if constexpr (NKC == 3) *(bf16x8*)(K_lds + (b) * SHM_K + klo2) = ks[NKC - 1]; } while (0)
#define FA_SWAIT() asm volatile("s_waitcnt vmcnt(0)" ::: "memory")
#define FA_RESC(a) do { if (__any((a) < 1.f)) { if (hi == 0) al_l[r32] = (a); asm volatile("s_waitcnt lgkmcnt(0)" ::: "memory"); \
    _Pragma("unroll") for (int d = 0; d < 4; ++d) _Pragma("unroll") for (int r = 0; r < 16; ++r) o[d][r] *= al_l[crow(r, hi)]; } } while (0)
  f32x16 pA0, pA1, pB0, pB1; float mnA, mnB, alA, alB; bf16x8 pa0, pa1, pa2, pa3; const int NT = seq / KVBLK;
  FA_SLOAD(0); FA_SWAIT(); FA_SWRITE(0); __syncthreads();
  qkt<DQK>(pA0, pA1, K_lds, qr, kb4); partialSM(pA0, pA1, m_reg, mnA, alA, C, thr_s);
  FA_SLOAD(KVBLK);
  FA_SWAIT(); FA_SWRITE(1); __syncthreads();
  for (int j = 1; j + 1 < NT; j += 2) {
    FA_SBAR(); qkt<DQK>(pB0, pB1, K_lds + SHM_K, qr, kb4);
    finishSM(pA0, pA1, alA, l_reg, pa0, pa1, pa2, pa3); FA_SBAR();
    FA_SLOAD((j + 1) * KVBLK); FA_SBAR();
    pv_d0(o, vb0, pa0, pa1, pa2, pa3); partialSM(pB0, pB1, m_reg, mnB, alB, C, thr_s);
    __syncthreads(); FA_SWAIT(); FA_SWRITE(0);
    FA_RESC(alB); __syncthreads();
    FA_SBAR(); qkt<DQK>(pA0, pA1, K_lds, qr, kb4);
    finishSM(pB0, pB1, alB, l_reg, pa0, pa1, pa2, pa3); FA_SBAR();
    FA_SLOAD((j + 2) * KVBLK); FA_SBAR();
    pv_d0(o, vb0 + SHM_V, pa0, pa1, pa2, pa3); partialSM(pA0, pA1, m_reg, mnA, alA, C, thr_s);
    __syncthreads(); FA_SWAIT(); FA_SWRITE(1);
    FA_RESC(alA); __syncthreads();
  }
  FA_SBAR(); qkt<DQK>(pB0, pB1, K_lds + SHM_K, qr, kb4);
  finishSM(pA0, pA1, alA, l_reg, pa0, pa1, pa2, pa3); FA_SBAR();
  pv_d0(o, vb0, pa0, pa1, pa2, pa3); partialSM(pB0, pB1, m_reg, mnB, alB, C, thr_s);
  __syncthreads(); FA_RESC(alB);
  finishSM(pB0, pB1, alB, l_reg, pa0, pa1, pa2, pa3); FA_SBAR();
  pv_d0(o, vb0 + SHM_V, pa0, pa1, pa2, pa3);
  if (hi == 0) li_l[r32] = l_reg; asm volatile("s_waitcnt lgkmcnt(0)" ::: "memory");
  float rli[16];
#pragma unroll
  for (int r = 0; r < 16; ++r) rli[r] = __builtin_amdgcn_rcpf(li_l[crow(r, hi)]);
  bf16_t* Ow = Ob + (size_t)(wid * QBLK) * LDO;
#pragma unroll
  for (int r = 0; r < 16; ++r) { const int orow = crow(r, hi);
#pragma unroll
    for (int d0 = 0; d0 < 4; ++d0) Ow[(size_t)orow * LDO + d0 * 32 + r32] = (bf16_t)f2bf(o[d0][r] * rli[r]); }
  __syncthreads();
#undef FA_SLOAD
#undef FA_SWRITE
#undef FA_SWAIT
#undef FA_RESC
}
#undef FA_SBAR
}
__device__ __forceinline__ void mla_attn_phase(unsigned char* dout, unsigned char* ws, char* lds, int bid, int nblk) {
  for (int u = bid; u < NB_ * 8 * (S_ / 256); u += nblk) {
    const int qb = u & 7, h = (u >> 3) & 7, b = u >> 6;
    const bf16_t* Q = (const bf16_t*)(dout + DO_Q) + (size_t)(b * S_ + qb * 256) * 1536 + h * 192;
    const bf16_t* K = (const bf16_t*)(dout + DO_K) + (size_t)(b * S_) * 1536 + h * 192;
    const bf16_t* V = (const bf16_t*)(dout + DO_V) + (size_t)(b * S_) * 1024 + h * 128;
    bf16_t* O = (bf16_t*)(ws + WS_YMIX) + (size_t)(b * S_ + qb * 256) * 2048 + h * 128;
    fa::attn_body<192, 1536, 1536, 1024, 2048>(Q, K, V, O, S_, 0.07216878364870322f, lds);
  }
}

__device__ __forceinline__ void mem_attn_phase(unsigned char* ws, char* lds, int bid, int nblk) {
  for (int u = bid; u < NB_ * 4 * (S_ / 256); u += nblk) {
    const int qb = u & 7, h = (u >> 3) & 3, b = u >> 5;
    const bf16_t* Q = (const bf16_t*)(ws + WS_QM) + (size_t)(b * S_ + qb * 256) * 512 + h * 128;
    const bf16_t* K = (const bf16_t*)(ws + WS_MEMKV) + (size_t)(b * 256) * 1024 + h * 128;
    const bf16_t* V = K + 512;
    bf16_t* O = (bf16_t*)(ws + WS_OM) + (size_t)(b * S_ + qb * 256) * 512 + h * 128;
    fa::attn_body<128, 512, 1024, 1024, 512>(Q, K, V, O, 256, 0.08838834764831845f, lds);
  }
}
__device__ __forceinline__ void scan_phase(unsigned char* ws, float* lds, int bid, int nblk, int tid_in) {
  int tid = tid_in; asm volatile("" : "+v"(tid));
  f32x4* sA = (f32x4*)lds; f32x4* sB = sA + 512;
  const int cq = tid & 15, ch = tid >> 4;
  for (int it = bid; it < NB_ * 2 * 16; it += nblk) {
    const int cg_ = it & 15, dir = (it >> 4) & 1, b = it >> 5;
    const char* LA = (const char*)(ws + (dir ? WS_LAB : WS_LAF)) + ((size_t)b * S_ * 1024 + cg_ * 64) * 2;
    char* BT = (char*)(ws + (dir ? WS_BTB : WS_BTF)) + ((size_t)b * S_ * 1024 + cg_ * 64) * 2;
    const int sstep = dir ? -2048 : 2048;
    const unsigned off0 = (unsigned)((dir ? (S_ - 1 - ch * 64) : ch * 64) * 2048 + cq * 8);
    f32x4 A = {1.f, 1.f, 1.f, 1.f}, Bv = {0.f, 0.f, 0.f, 0.f};
    unsigned off = off0;
#pragma unroll 8
    for (int i = 0; i < 64; ++i) { const u32x2 lw = *(const u32x2*)(LA + off), bw = *(const u32x2*)(BT + off); off += sstep;
      const f32x4 a = {__expf(bflo(lw.x)), __expf(bfhi(lw.x)), __expf(bflo(lw.y)), __expf(bfhi(lw.y))}; const f32x4 bt = {bflo(bw.x), bfhi(bw.x), bflo(bw.y), bfhi(bw.y)};
      Bv = a * Bv + bt; A = A * a; }
    __syncthreads();
    sA[ch * 16 + cq] = A; sB[ch * 16 + cq] = Bv;
    __syncthreads();
    f32x4 h = {0.f, 0.f, 0.f, 0.f};
    for (int qq = 0; qq < ch; ++qq) h = sA[qq * 16 + cq] * h + sB[qq * 16 + cq];
    off = off0;
#pragma unroll 8
    for (int i = 0; i < 64; ++i) { const u32x2 lw = *(const u32x2*)(LA + off), bw = *(const u32x2*)(BT + off);
      const f32x4 a = {__expf(bflo(lw.x)), __expf(bfhi(lw.x)), __expf(bflo(lw.y)), __expf(bfhi(lw.y))}; const f32x4 bt = {bflo(bw.x), bfhi(bw.x), bflo(bw.y), bfhi(bw.y)};
      h = a * h + bt; u32x2 w; w.x = pk2(h[0], h[1]); w.y = pk2(h[2], h[3]); *(u32x2*)(BT + off) = w; off += sstep; }
  }
  __syncthreads();
}


__device__ __forceinline__ void lru_fused_phase(const Params& p, unsigned char* lds_raw, int bid, int nblk) {
  constexpr int RS = 272;
  constexpr int AST = 65;
  unsigned char* WL = lds_raw; unsigned char* XL = lds_raw + 128 * RS;
  f32x2* AB = (f32x2*)(lds_raw + 2 * 128 * RS); float* AG = (float*)(AB + 128 * AST);
  float* CAR = AG + 2 * 8 * 64;
  int tid_ = threadIdx.x; asm volatile("" : "+v"(tid_));
  const int tid = tid_, lane = tid & 63, wave = tid >> 6, r32 = lane & 31, hi = lane >> 5;
  unsigned char* ws = p.ws;
  const bf16_t* LX = (const bf16_t*)(ws + WS_LRUX);
  for (int it = bid; it < NB_ * 8 * 2 * 2; it += nblk) {
    const int half = it & 1, dir = (it >> 1) & 1, n = (it >> 2) & 7, b = it >> 5;
    const int ch0 = n * 128 + half * 64;
    __syncthreads();
    { const bf16_t* wg = (const bf16_t*)(ws + WS_WG_T) + (size_t)(n * 512 + dir * 256 + half * 128) * 128;
      for (int i = tid; i < 128 * 16; i += NTHR) { const int r = i >> 4, c8 = (i & 15) * 8; *(u32x4*)(WL + r * RS + c8 * 2) = *(const u32x4*)(wg + r * 128 + c8); } }
    if (tid < 64) CAR[tid] = 0.f;
    float cw0[4], cw1[4]; const float cb0 = p.in[11][n * 128 + 2 * lane], cb1 = p.in[11][n * 128 + 2 * lane + 1];
#pragma unroll
    for (int k = 0; k < 4; ++k) { cw0[k] = p.in[10][k * 1024 + n * 128 + 2 * lane]; cw1[k] = p.in[10][k * 1024 + n * 128 + 2 * lane + 1]; }
    bf16_t* H = (bf16_t*)(ws + (dir ? WS_BTB : WS_BTF));
    float tb0[16], tb1[16], tb2[16];
#pragma unroll
    for (int t = 0; t < 2; ++t)
#pragma unroll
      for (int g = 0; g < 4; ++g)
#pragma unroll
        for (int u = 0; u < 2; ++u) { const int jl = (wave & 1) * 32 + 16 * t + 4 * g + 2 * hi + u; const f32x4 tb = *((const f32x4*)(ws + WS_GTAB) + dir * 1024 + ch0 + jl);
          tb0[t * 8 + g * 2 + u] = tb[0]; tb1[t * 8 + g * 2 + u] = tb[1]; tb2[t * 8 + g * 2 + u] = tb[2]; }
    unsigned xr[19];
#define LRU_LOADX(C) do { const int q0_ = (dir ? S_ - 128 * ((C) + 1) : 128 * (C)) + wave * 16; \
      _Pragma("unroll") for (int j = 0; j < 19; ++j) { const int row = q0_ + j - 2, rc = row < 0 ? 0 : (row >= S_ ? S_ - 1 : row);        \
        const unsigned v_ = *(const unsigned*)(LX + (size_t)(b * S_ + rc) * 1024 + n * 128 + 2 * lane); xr[j] = (row == rc) ? v_ : 0u; } } while (0)
    LRU_LOADX(0);
    for (int c = 0; c < 16; ++c) {
      const int p0 = dir ? S_ - 128 * (c + 1) : 128 * c;
      {
#pragma unroll
        for (int i = 0; i < 16; ++i) { float s0 = cb0, s1 = cb1;
#pragma unroll
          for (int k = 0; k < 4; ++k) { s0 += bflo(xr[i + k]) * cw0[k]; s1 += bfhi(xr[i + k]) * cw1[k]; }
          *(unsigned*)(XL + (wave * 16 + i) * RS + lane * 4) = pk2(s0, s1); } }
      if (c + 1 < 16) LRU_LOADX(c + 1);
      __syncthreads();
      f32x16 acc[2] = {};
#pragma unroll
      for (int s = 0; s < 8; ++s) { const bf16x8 xf = *(const bf16x8*)(XL + ((wave >> 1) * 32 + r32) * RS + (16 * s + 8 * hi) * 2);
#pragma unroll
        for (int t = 0; t < 2; ++t) { const bf16x8 wf = *(const bf16x8*)(WL + ((wave & 1) * 64 + 32 * t + r32) * RS + (16 * s + 8 * hi) * 2);
          acc[t] = __builtin_amdgcn_mfma_f32_32x32x16_bf16(wf, xf, acc[t], 0, 0, 0); } }
      { const int pos = (wave >> 1) * 32 + r32;
#pragma unroll
        for (int t = 0; t < 2; ++t)
#pragma unroll
          for (int g = 0; g < 4; ++g) { const int jl = (wave & 1) * 32 + 16 * t + 4 * g + 2 * hi;
            const unsigned xw = *(const unsigned*)(XL + pos * RS + (half * 64 + jl) * 2);
#pragma unroll
            for (int u = 0; u < 2; ++u) { const int ti = t * 8 + g * 2 + u;
              const float e1 = __builtin_amdgcn_exp2f(-1.4426950408889634f * (acc[t][4 * g + 2 * u] + tb1[ti])), e2 = __builtin_amdgcn_exp2f(-1.4426950408889634f * (acc[t][4 * g + 2 * u + 1] + tb2[ti]));
              const float R = __builtin_amdgcn_rcpf((1.f + e1) * (1.f + e2)), sr = (1.f + e2) * R, si = (1.f + e1) * R;
              const float la = -tb0[ti] * sr, a = __builtin_amdgcn_exp2f(la * 1.4426950408889634f), x2 = 2.f * la;
              const float ser = -x2 * (1.f + x2 * (0.5f + x2 * (1.6666667e-1f + x2 * (4.1666667e-2f + x2 * (8.3333333e-3f + x2 * 1.3888889e-3f)))));
              const float om = x2 > -0.25f ? ser : 1.f - a * a;
              AB[pos * AST + jl + u] = (f32x2){a, __builtin_amdgcn_sqrtf(om) * si * (u ? bfhi(xw) : bflo(xw))}; } } }
      __syncthreads();
      { const int jl = tid & 63, sub = tid >> 6; float av[16], bv[16]; float A = 1.f, B = 0.f;
#pragma unroll
        for (int i = 0; i < 16; ++i) { const int tau = 16 * sub + i, pos = dir ? 127 - tau : tau; const f32x2 ab = AB[pos * AST + jl]; av[i] = ab[0]; bv[i] = ab[1]; B = av[i] * B + bv[i]; A *= av[i]; }
        AG[sub * 64 + jl] = A; AG[512 + sub * 64 + jl] = B;
        __syncthreads();
        float h = CAR[jl];
        for (int s2 = 0; s2 < sub; ++s2) h = AG[s2 * 64 + jl] * h + AG[512 + s2 * 64 + jl];
#pragma unroll
        for (int i = 0; i < 16; ++i) { const int tau = 16 * sub + i, pos = dir ? 127 - tau : tau; h = av[i] * h + bv[i];
          H[(size_t)(b * S_ + p0 + pos) * 1024 + ch0 + jl] = (bf16_t)(pk2(h, 0.f) & 0xffffu); }
        __syncthreads();
        if (sub == 7) CAR[jl] = h; }
    }
#undef LRU_LOADX
  }
  __syncthreads();
}

__device__ __forceinline__ void phase3b(const Params& p, int gw, int ngw, int lane) {
  unsigned char* ws = p.ws; bf16_t* Y = (bf16_t*)(ws + WS_YMIX);
  const bf16_t* HF = (const bf16_t*)(ws + WS_BTF); const bf16_t* HB = (const bf16_t*)(ws + WS_BTB); const bf16_t* G = (const bf16_t*)(ws + WS_GATE);
  for (int r = gw; r < T_; r += ngw) {
    { bf16_t* row = Y + (size_t)r * 2048 + lane * 16; float f[16]; unpack8(*(const u32x4*)row, f); unpack8(*(const u32x4*)(row + 8), f + 8);
      float q = 0.f;
#pragma unroll
      for (int i = 0; i < 16; ++i) q += f[i] * f[i];
      const float sc = rsqrtf(dpp_sum64(q) * (1.f / 1024.f) + RMS_EPS); const float* g = p.in[17] + lane * 16;
#pragma unroll
      for (int i = 0; i < 16; ++i) f[i] = f[i] * sc * g[i];
      *(u32x4*)row = pack8(f); *(u32x4*)(row + 8) = pack8(f + 8); }
    { const size_t o = (size_t)r * 1024 + lane * 16; float a[16], b[16], gg[16];
      unpack8(*(const u32x4*)(HF + o), a); unpack8(*(const u32x4*)(HF + o + 8), a + 8);
      unpack8(*(const u32x4*)(HB + o), b); unpack8(*(const u32x4*)(HB + o + 8), b + 8);
      unpack8(*(const u32x4*)(G + o), gg); unpack8(*(const u32x4*)(G + o + 8), gg + 8);
      float q = 0.f;
#pragma unroll
      for (int i = 0; i < 16; ++i) { a[i] = (a[i] + b[i]) * gg[i]; q += a[i] * a[i]; }
      const float sc = rsqrtf(dpp_sum64(q) * (1.f / 1024.f) + RMS_EPS); const float* g = p.in[18] + lane * 16;
#pragma unroll
      for (int i = 0; i < 16; ++i) a[i] = a[i] * sc * g[i];
      bf16_t* row = Y + (size_t)r * 2048 + 1024 + lane * 16; *(u32x4*)row = pack8(a); *(u32x4*)(row + 8) = pack8(a + 8); }
  }
}
__device__ __forceinline__ void ln_pass(unsigned char* ws, const float* g, const float* b, int gw, int ngw, int lane) {
  bf16_t* X = (bf16_t*)(ws + WS_X);
  for (int r0 = gw * 2; r0 < T_; r0 += ngw * 2) { u32x4 w[2][4]; float v[32];
#pragma unroll
    for (int rr = 0; rr < 2; ++rr)
#pragma unroll
      for (int j = 0; j < 4; ++j) w[rr][j] = *(const u32x4*)(X + (size_t)(r0 + rr) * DM + j * 512 + lane * 8);
#pragma unroll
    for (int rr = 0; rr < 2; ++rr) {
#pragma unroll
      for (int j = 0; j < 4; ++j) unpack8(w[rr][j], &v[j * 8]);
      ln_row_regs(v, g, b, lane);
#pragma unroll
      for (int j = 0; j < 4; ++j) *(u32x4*)(X + (size_t)(r0 + rr) * DM + j * 512 + lane * 8) = pack8(&v[j * 8]); } }
}
__device__ __forceinline__ void cvt_pass(const float* src, bf16_t* dst, size_t n, int gw, int ngw, int lane) {
  for (size_t i = (size_t)(gw * 64 + lane) * 8; i < n; i += (size_t)ngw * 64 * 8) {
    const f32x4 a = *(const f32x4*)(src + i), b = *(const f32x4*)(src + i + 4); u32x4 o; o.x = pk2(a[0], a[1]); o.y = pk2(a[2], a[3]); o.z = pk2(b[0], b[1]); o.w = pk2(b[2], b[3]);
    *(u32x4*)(dst + i) = o; }
}

__device__ __forceinline__ unsigned key_of(float s, unsigned tag, unsigned tagmask) {
  unsigned u = __float_as_uint(s); u = (u & 0x80000000u) ? ~u : (u | 0x80000000u); return (u & ~tagmask) | (tagmask - tag);
}
__device__ __forceinline__ float val_of(unsigned k, unsigned tagmask) { unsigned u = k & ~tagmask; u = (u & 0x80000000u) ? (u & 0x7fffffffu) : ~u; return __uint_as_float(u); }
__device__ __forceinline__ void topk_phase(unsigned char* ws, const float* SC, int gw, int ngw, int lane) {
  int* IDX = (int*)(ws + WS_IDX); float* GV = (float*)(ws + WS_GV);
  int ca = -1, cb = -1; { int n = 0; for (int a = 0; a < 16; ++a) for (int b = 0; b < 16; ++b) if ((a + 1) * (b + 1) <= 16) { if (n == lane) { ca = a; cb = b; } ++n; } }
  for (int pr = gw; pr < T_ * 8; pr += ngw) {
    const float* row = SC + (size_t)pr * 256;
    unsigned k1a = key_of(row[lane], lane, 127u), k1b = key_of(row[64 + lane], 64 + lane, 127u);
    unsigned k2a = key_of(row[128 + lane], lane, 127u), k2b = key_of(row[192 + lane], 64 + lane, 127u);
    unsigned t1 = 0u, t2 = 0u;
    for (int it = 0; it < 16; ++it) {
      const unsigned m1 = dpp_max64_u32(k1a > k1b ? k1a : k1b), m2 = dpp_max64_u32(k2a > k2b ? k2a : k2b);
      if (k1a == m1) k1a = 0u; if (k1b == m1) k1b = 0u; if (k2a == m2) k2a = 0u; if (k2b == m2) k2b = 0u;
      if (lane == it) { t1 = m1; t2 = m2; }
    }
    const unsigned ka = (unsigned)__shfl((int)t1, ca < 0 ? 0 : ca), kb = (unsigned)__shfl((int)t2, cb < 0 ? 0 : cb);
    const float va = val_of(ka, 127u), vb = val_of(kb, 127u); const int ia = 127 - (int)(ka & 127u), ib = 127 - (int)(kb & 127u);
    const float cs = va + vb; const int cidx = ia * 128 + ib;
    unsigned ck = (ca >= 0) ? key_of(cs, (unsigned)(ca * 16 + cb), 255u) : 0u;
    float ts = 0.f; int ti = 0;
    for (int it = 0; it < 16; ++it) {
      const unsigned m = dpp_max64_u32(ck); const unsigned long long bal = __ballot(ck == m && ck != 0u); const int src = __ffsll((long long)bal) - 1;
      const float sv = __shfl(cs, src); const int si = __shfl(cidx, src);
      if (lane == src) ck = 0u;
      if (lane == it) { ts = sv; ti = si; }
    }
    const float mx = __uint_as_float(__builtin_amdgcn_readlane(__float_as_uint(ts), 0));
    float ex = (lane < 16) ? __expf(ts - mx) : 0.f; const float sum = dpp_sum64(ex);
    if (lane < 16) { IDX[(size_t)pr * 16 + lane] = ti; GV[(size_t)pr * 16 + lane] = ex / sum; }
  }
}


__device__ __forceinline__ unsigned umax_(unsigned a, unsigned b) { return a > b ? a : b; }
__device__ __forceinline__ unsigned umin_(unsigned a, unsigned b) { return a < b ? a : b; }
__device__ __forceinline__ unsigned ord_of(float s) { const unsigned u = __float_as_uint(s); return (u & 0x80000000u) ? ~u : (u | 0x80000000u); }
__device__ __forceinline__ unsigned qx1(unsigned v) { return (unsigned)__builtin_amdgcn_update_dpp(0, (int)v, 0xB1, 0xf, 0xf, false); }
__device__ __forceinline__ unsigned qx2(unsigned v) { return (unsigned)__builtin_amdgcn_update_dpp(0, (int)v, 0x4E, 0xf, 0xf, false); }
__device__ __forceinline__ void ins16(unsigned (&L)[16], unsigned x) {
#pragma unroll
  for (int k = 0; k < 16; ++k) { const unsigned hi = umax_(L[k], x); x = umin_(L[k], x); L[k] = hi; }
}
__device__ __forceinline__ void ins16p(unsigned (&L)[16], unsigned (&P)[16], unsigned x, unsigned px) {
#pragma unroll
  for (int k = 0; k < 16; ++k) { const bool c = x > L[k]; const unsigned nl = c ? x : L[k], nx = c ? L[k] : x, np = c ? px : P[k], npx = c ? P[k] : px; L[k] = nl; x = nx; P[k] = np; px = npx; }
}
__device__ __forceinline__ void bitonic_sort16(unsigned (&M)[16]) {
#pragma unroll
  for (int d = 8; d >= 1; d >>= 1)
#pragma unroll
    for (int i = 0; i < 16; ++i) if (!(i & d)) { const unsigned hi = umax_(M[i], M[i + d]), lo = umin_(M[i], M[i + d]); M[i] = hi; M[i + d] = lo; }
}
__device__ __forceinline__ void bitonic_sort16p(unsigned (&M)[16], unsigned (&P)[16]) {
#pragma unroll
  for (int d = 8; d >= 1; d >>= 1)
#pragma unroll
    for (int i = 0; i < 16; ++i) if (!(i & d)) { const bool c = M[i + d] > M[i]; const unsigned a = M[i], b = M[i + d], pa = P[i], pb = P[i + d];
      M[i] = c ? b : a; M[i + d] = c ? a : b; P[i] = c ? pb : pa; P[i + d] = c ? pa : pb; }
}
__device__ __forceinline__ void topk_phase2(unsigned char* ws, const float* SC, int gw, int ngw, int lane) {
  int* IDX = (int*)(ws + WS_IDX); float* GV = (float*)(ws + WS_GV);
  const int c = lane & 3;
  const unsigned tagbase = (c & 1) ? 0u : 64u;
  for (int item = gw; item < T_ * 8 / 16; item += ngw) {
    const int pr = item * 16 + (lane >> 2);
    const float* row = SC + (size_t)pr * 256 + c * 64;
    unsigned L[16];
#pragma unroll
    for (int k = 0; k < 16; ++k) L[k] = 0u;
#pragma unroll
    for (int bq = 0; bq < 4; ++bq) { f32x4 v[4];
#pragma unroll
      for (int j = 0; j < 4; ++j) v[j] = *(const f32x4*)(row + bq * 16 + j * 4);
#pragma unroll
      for (int j = 0; j < 4; ++j)
#pragma unroll
        for (int i = 0; i < 4; ++i) { const int e = bq * 16 + j * 4 + i; ins16(L, (ord_of(v[j][i]) & ~127u) | (tagbase + (unsigned)(63 - e))); } }
    { unsigned B[16];
#pragma unroll
      for (int k = 0; k < 16; ++k) B[k] = qx1(L[k]);
#pragma unroll
      for (int k = 0; k < 16; ++k) L[k] = umax_(L[k], B[15 - k]);
      bitonic_sort16(L); }
    float F1[16], F2[16]; unsigned I1[16], I2[16];
#pragma unroll
    for (int k = 0; k < 16; ++k) { const unsigned o = qx2(L[k]); const unsigned v1 = (c < 2) ? L[k] : o, v2 = (c < 2) ? o : L[k];
      unsigned u1 = v1 & ~127u, u2 = v2 & ~127u; u1 = (u1 & 0x80000000u) ? (u1 & 0x7fffffffu) : ~u1; u2 = (u2 & 0x80000000u) ? (u2 & 0x7fffffffu) : ~u2;
      F1[k] = __uint_as_float(u1); F2[k] = __uint_as_float(u2); I1[k] = (127u - (v1 & 127u)) << 7; I2[k] = 127u - (v2 & 127u); }
    unsigned M[16], P[16];
#pragma unroll
    for (int k = 0; k < 16; ++k) { M[k] = 0u; P[k] = 0u; }
    {
      constexpr int CA[52] = {0,0,0,0,0,0,0,0,0,0,0,0,0,0,0,0, 1,1,1,1,1,1,1,1, 2,2,2,2,2, 3,3,3,3, 4,4,4, 5,5, 6,6, 7,7, 8, 9, 10, 11, 12, 13, 14, 15, 15, 15};
      constexpr int CB[52] = {0,1,2,3,4,5,6,7,8,9,10,11,12,13,14,15, 0,1,2,3,4,5,6,7, 0,1,2,3,4, 0,1,2,3, 0,1,2, 0,1, 0,1, 0,1, 0, 0, 0, 0, 0, 0, 0, 0, 0, 0};
#pragma unroll
      for (int m = 0; m < 13; ++m) {
        unsigned kx[4], px[4];
#pragma unroll
        for (int q = 0; q < 4; ++q) { const int n = 4 * m + q; const bool pad = n >= 50;
          kx[q] = pad ? 0u : ord_of(F1[CA[n]] + F2[CB[n]]); px[q] = I1[CA[n]] | I2[CB[n]]; }
        const unsigned x = (c == 0) ? kx[0] : (c == 1) ? kx[1] : (c == 2) ? kx[2] : kx[3];
        const unsigned pp = (c == 0) ? px[0] : (c == 1) ? px[1] : (c == 2) ? px[2] : px[3];
        ins16p(M, P, x, pp);
      }
    }
    { unsigned B[16], Q[16];
#pragma unroll
      for (int k = 0; k < 16; ++k) { B[k] = qx1(M[k]); Q[k] = qx1(P[k]); }
#pragma unroll
      for (int k = 0; k < 16; ++k) { const bool t = B[15 - k] > M[k]; M[k] = t ? B[15 - k] : M[k]; P[k] = t ? Q[15 - k] : P[k]; }
      bitonic_sort16p(M, P);
#pragma unroll
      for (int k = 0; k < 16; ++k) { B[k] = qx2(M[k]); Q[k] = qx2(P[k]); }
#pragma unroll
      for (int k = 0; k < 16; ++k) { const bool t = B[15 - k] > M[k]; M[k] = t ? B[15 - k] : M[k]; P[k] = t ? Q[15 - k] : P[k]; }
      bitonic_sort16p(M, P); }
    float sv[16]; float mx = -1e30f;
#pragma unroll
    for (int k = 0; k < 16; ++k) { unsigned u = M[k]; u = (u & 0x80000000u) ? (u & 0x7fffffffu) : ~u; sv[k] = __uint_as_float(u); mx = fmaxf(mx, sv[k]); }
    float sum = 0.f;
#pragma unroll
    for (int k = 0; k < 16; ++k) { sv[k] = __expf(sv[k] - mx); sum += sv[k]; }
    const float inv = __builtin_amdgcn_rcpf(sum);
    u32x4 oi; f32x4 og;
#pragma unroll
    for (int i = 0; i < 4; ++i) { oi[i] = (c == 0) ? P[i] : (c == 1) ? P[4 + i] : (c == 2) ? P[8 + i] : P[12 + i];
      og[i] = ((c == 0) ? sv[i] : (c == 1) ? sv[4 + i] : (c == 2) ? sv[8 + i] : sv[12 + i]) * inv; }
    *(u32x4*)(IDX + (size_t)pr * 16 + 4 * c) = oi; *(f32x4*)(GV + (size_t)pr * 16 + 4 * c) = og;
  }
}


__device__ __forceinline__ unsigned sx16(unsigned v) { return (unsigned)__shfl_xor((int)v, 16); }
__device__ __forceinline__ unsigned sx32(unsigned v) { return (unsigned)__shfl_xor((int)v, 32); }
#define MERGE16(L, SH) do { unsigned B_[16]; _Pragma("unroll") for (int k_ = 0; k_ < 16; ++k_) B_[k_] = SH(L[k_]); \
    _Pragma("unroll") for (int k_ = 0; k_ < 16; ++k_) L[k_] = umax_(L[k_], B_[15 - k_]); bitonic_sort16(L); } while (0)
#define MERGE16P(M, P, SH) do { unsigned B_[16], Q_[16]; _Pragma("unroll") for (int k_ = 0; k_ < 16; ++k_) { B_[k_] = SH(M[k_]); Q_[k_] = SH(P[k_]); } \
    _Pragma("unroll") for (int k_ = 0; k_ < 16; ++k_) { const bool t_ = B_[15 - k_] > M[k_]; M[k_] = t_ ? B_[15 - k_] : M[k_]; P[k_] = t_ ? Q_[15 - k_] : P[k_]; } bitonic_sort16p(M, P); } while (0)
__device__ __forceinline__ void topk_phase3(const Params& p, unsigned char* lds_raw, int gw, int ngw, int tid) {
  unsigned char* ws = p.ws; int* IDX = (int*)(ws + WS_IDX); float* GV = (float*)(ws + WS_GV); const bf16_t* QP = (const bf16_t*)(ws + WS_QP);
  constexpr int KRS = 272;
  for (int i = tid; i < 2 * 128 * 32; i += NTHR) { const int tb = i >> 12, r = (i >> 5) & 127, c4 = (i & 31) * 4; const f32x4 v = *(const f32x4*)(p.in[29 + tb] + r * 128 + c4);
    u32x2 w; w.x = pk2(v[0], v[1]); w.y = pk2(v[2], v[3]); *(u32x2*)(lds_raw + tb * (128 * KRS) + r * KRS + c4 * 2) = w; }
  __syncthreads();
  const int lane = tid & 63, fr = lane & 15, c = lane >> 4;
  for (int item = gw; item < T_ * 8 / 16; item += ngw) {
    const int pr = item * 16 + fr;
    unsigned L1[16], L2[16];
#pragma unroll
    for (int k = 0; k < 16; ++k) { L1[k] = 0u; L2[k] = 0u; }
#pragma unroll
    for (int h = 0; h < 2; ++h) {
      bf16x8 qf[4];
#pragma unroll
      for (int s = 0; s < 4; ++s) qf[s] = *(const bf16x8*)(QP + (size_t)pr * 256 + 128 * h + 32 * s + 8 * c);
#pragma unroll
      for (int tp = 0; tp < 4; ++tp) {
        f32x4 acc0 = {0.f, 0.f, 0.f, 0.f}, acc1 = {0.f, 0.f, 0.f, 0.f};
#pragma unroll
        for (int s = 0; s < 4; ++s) { const unsigned char* kb = lds_raw + h * (128 * KRS) + (32 * tp + fr) * KRS + (32 * s + 8 * c) * 2;
          acc0 = __builtin_amdgcn_mfma_f32_16x16x32_bf16(*(const bf16x8*)kb, qf[s], acc0, 0, 0, 0);
          acc1 = __builtin_amdgcn_mfma_f32_16x16x32_bf16(*(const bf16x8*)(kb + 16 * KRS), qf[s], acc1, 0, 0, 0); }
#pragma unroll
        for (int r = 0; r < 4; ++r) { const unsigned t0 = (unsigned)(127 - (32 * tp + r)) - (unsigned)(4 * c), t1 = t0 - 16u;
          const unsigned k0 = (ord_of(acc0[r]) & ~127u) | t0, k1 = (ord_of(acc1[r]) & ~127u) | t1;
          if (h == 0) { ins16(L1, k0); ins16(L1, k1); } else { ins16(L2, k0); ins16(L2, k1); } }
        if (h == 0) asm volatile("" : "+v"(L1[0]), "+v"(L1[15])); else asm volatile("" : "+v"(L2[0]), "+v"(L2[15]));
      }
    }
    MERGE16(L1, sx16); MERGE16(L1, sx32); MERGE16(L2, sx16); MERGE16(L2, sx32);
    float F1[16], F2[16]; unsigned I1[16], I2[16];
#pragma unroll
    for (int k = 0; k < 16; ++k) { const unsigned v1 = L1[k], v2 = L2[k];
      unsigned u1 = v1 & ~127u, u2 = v2 & ~127u; u1 = (u1 & 0x80000000u) ? (u1 & 0x7fffffffu) : ~u1; u2 = (u2 & 0x80000000u) ? (u2 & 0x7fffffffu) : ~u2;
      F1[k] = __uint_as_float(u1); F2[k] = __uint_as_float(u2); I1[k] = (127u - (v1 & 127u)) << 7; I2[k] = 127u - (v2 & 127u); }
    unsigned M[16], P[16];
#pragma unroll
    for (int k = 0; k < 16; ++k) { M[k] = 0u; P[k] = 0u; }
    {
      constexpr int CA[52] = {0,0,0,0,0,0,0,0,0,0,0,0,0,0,0,0, 1,1,1,1,1,1,1,1, 2,2,2,2,2, 3,3,3,3, 4,4,4, 5,5, 6,6, 7,7, 8, 9, 10, 11, 12, 13, 14, 15, 15, 15};
      constexpr int CB[52] = {0,1,2,3,4,5,6,7,8,9,10,11,12,13,14,15, 0,1,2,3,4,5,6,7, 0,1,2,3,4, 0,1,2,3, 0,1,2, 0,1, 0,1, 0,1, 0, 0, 0, 0, 0, 0, 0, 0, 0, 0};
#pragma unroll
      for (int m = 0; m < 13; ++m) {
        unsigned kx[4], px[4];
#pragma unroll
        for (int q = 0; q < 4; ++q) { const int n = 4 * m + q; const bool pad = n >= 50;
          kx[q] = pad ? 0u : ord_of(F1[CA[n]] + F2[CB[n]]); px[q] = I1[CA[n]] | I2[CB[n]]; }
        const unsigned x = (c == 0) ? kx[0] : (c == 1) ? kx[1] : (c == 2) ? kx[2] : kx[3];
        const unsigned pp = (c == 0) ? px[0] : (c == 1) ? px[1] : (c == 2) ? px[2] : px[3];
        ins16p(M, P, x, pp);
      }
    }
    MERGE16P(M, P, sx16); MERGE16P(M, P, sx32);
    float sv[16]; float mx = -1e30f;
#pragma unroll
    for (int k = 0; k < 16; ++k) { unsigned u = M[k]; u = (u & 0x80000000u) ? (u & 0x7fffffffu) : ~u; sv[k] = __uint_as_float(u); mx = fmaxf(mx, sv[k]); }
    float sum = 0.f;
#pragma unroll
    for (int k = 0; k < 16; ++k) { sv[k] = __expf(sv[k] - mx); sum += sv[k]; }
    const float inv = __builtin_amdgcn_rcpf(sum);
    u32x4 oi; f32x4 og;
#pragma unroll
    for (int i = 0; i < 4; ++i) { oi[i] = (c == 0) ? P[i] : (c == 1) ? P[4 + i] : (c == 2) ? P[8 + i] : P[12 + i];
      og[i] = ((c == 0) ? sv[i] : (c == 1) ? sv[4 + i] : (c == 2) ? sv[8 + i] : sv[12 + i]) * inv; }
    *(u32x4*)(IDX + (size_t)pr * 16 + 4 * c) = oi; *(f32x4*)(GV + (size_t)pr * 16 + 4 * c) = og;
  }
  __syncthreads();
}
#undef MERGE16
#undef MERGE16P

typedef float f32x16v __attribute__((ext_vector_type(16)));
typedef float f32x32v __attribute__((ext_vector_type(32)));
typedef unsigned u32x6 __attribute__((ext_vector_type(6)));
__device__ __forceinline__ void cvt_fp4_pass(const float* src, unsigned char* dst, float* inv, int r_begin, int r_end, int gw, int ngw, int lane) {
  for (int r0 = r_begin + gw * 2; r0 < r_end; r0 += ngw * 2) {
   f32x4 vv[2][8];
#pragma unroll
   for (int rr = 0; rr < 2; ++rr)
#pragma unroll
     for (int k = 0; k < 8; ++k) vv[rr][k] = *(const f32x4*)(src + (size_t)(r0 + rr) * 2048 + lane * 32 + k * 4);
#pragma unroll
   for (int rr = 0; rr < 2; ++rr) { const int r = r0 + rr; float amA = 0.f, amB = 0.f;
#pragma unroll
    for (int k = 0; k < 4; ++k)
#pragma unroll
      for (int i = 0; i < 4; ++i) { amA = fmaxf(amA, fabsf(vv[rr][k][i])); amB = fmaxf(amB, fabsf(vv[rr][4 + k][i])); }
    const float rmax = fmaxf(__uint_as_float(dpp_max64_u32(__float_as_uint(fmaxf(amA, amB)))), 1e-30f);
    const float rs = rmax * (1.f / 6.f); if (lane == 0) inv[r] = rs;
    const float ra = amA / rmax, rb = amB / rmax;
    unsigned code = (unsigned)__builtin_amdgcn_cvt_pk_fp8_f32(ra, rb, 0, false) & 0xffffu;
    { const f32x2 back = __builtin_amdgcn_cvt_pk_f32_fp8((int)code, false); if (back[0] < ra * 0.96f) code += 1u; if (back[1] < rb * 0.96f) code += 0x100u; }
    const f32x2 sab = __builtin_amdgcn_cvt_pk_f32_fp8((int)code, false);
    const float ia = sab[0] > 0.f ? 1.f / (rs * sab[0]) : 0.f, ib = sab[1] > 0.f ? 1.f / (rs * sab[1]) : 0.f;
    u32x4 o;
#pragma unroll
    for (int k = 0; k < 4; ++k) { unsigned w = 0u; const float iv = (k < 2) ? ia : ib; const f32x4 lo = vv[rr][2 * k] * iv, hi = vv[rr][2 * k + 1] * iv;
      w = (unsigned)__builtin_amdgcn_cvt_scalef32_pk_fp4_f32(w, lo[0], lo[1], 1.0f, 0); w = (unsigned)__builtin_amdgcn_cvt_scalef32_pk_fp4_f32(w, lo[2], lo[3], 1.0f, 1);
      w = (unsigned)__builtin_amdgcn_cvt_scalef32_pk_fp4_f32(w, hi[0], hi[1], 1.0f, 2); w = (unsigned)__builtin_amdgcn_cvt_scalef32_pk_fp4_f32(w, hi[2], hi[3], 1.0f, 3);
      o[k] = w; }
    *(u32x4*)(dst + (size_t)r * 1152 + lane * 16) = o;
    *(unsigned short*)(dst + (size_t)r * 1152 + 1024 + lane * 2) = (unsigned short)code;
   }
  }
}
__device__ __forceinline__ void ln_row_regs32(float (&v)[32], const float* g, const float* b, int lane) {
  float s = 0.f;
#pragma unroll
  for (int i = 0; i < 32; ++i) s += v[i];
  const float mean = dpp_sum64(s) * (1.f / 2048.f);
  float q = 0.f;
#pragma unroll
  for (int i = 0; i < 32; ++i) { v[i] -= mean; q += v[i] * v[i]; }
  const float rstd = rsqrtf(dpp_sum64(q) * (1.f / 2048.f) + LN_EPS);
#pragma unroll
  for (int k = 0; k < 8; ++k) { const f32x4 gg = *(const f32x4*)(g + lane * 32 + k * 4), bb = *(const f32x4*)(b + lane * 32 + k * 4);
#pragma unroll
    for (int i = 0; i < 4; ++i) v[k * 4 + i] = v[k * 4 + i] * rstd * gg[i] + bb[i]; }
}
#define DEC8(W, K, D) do { const f32x2 t0_ = __builtin_amdgcn_cvt_scalef32_pk_f32_fp4(W[K], 1.0f, 0), t1_ = __builtin_amdgcn_cvt_scalef32_pk_f32_fp4(W[K], 1.0f, 1), \
    t2_ = __builtin_amdgcn_cvt_scalef32_pk_f32_fp4(W[K], 1.0f, 2), t3_ = __builtin_amdgcn_cvt_scalef32_pk_f32_fp4(W[K], 1.0f, 3); D[4 * (K)] = t0_; D[4 * (K) + 1] = t1_; D[4 * (K) + 2] = t2_; D[4 * (K) + 3] = t3_; } while (0)
__device__ __forceinline__ void peer_phase(const Params& p, int gw, int ngw, int lane_in) {
  unsigned char* ws = p.ws; const bf16_t* X = (const bf16_t*)(ws + WS_X); const unsigned char* PU = ws + WS_PU; const unsigned char* PV = ws + WS_PV;
  const float* INVU = (const float*)(ws + WS_PINV); const float* INVV = INVU + 16384;
  const int* IDX = (const int*)(ws + WS_IDX); const float* GV = (const float*)(ws + WS_GV);
  for (int t = gw; t < T_; t += ngw) {
    int lane = lane_in; asm volatile("" : "+v"(lane));
    f32x2 x2[16];
#pragma unroll
    for (int k = 0; k < 4; ++k) { float f[8]; unpack8(*(const u32x4*)(X + (size_t)t * DM + lane * 32 + k * 8), f);
#pragma unroll
      for (int i = 0; i < 4; ++i) x2[k * 4 + i] = (f32x2){f[2 * i], f[2 * i + 1]}; }
    const int id0 = IDX[(size_t)t * 128 + lane], id1 = IDX[(size_t)t * 128 + 64 + lane];
    const float g0 = GV[(size_t)t * 128 + lane], g1 = GV[(size_t)t * 128 + 64 + lane];
    const float iu0 = INVU[id0], iu1 = INVU[id1], iv0 = INVV[id0], iv1 = INVV[id1];
    float z0 = 0.f, z1 = 0.f;
#pragma unroll 1
    for (int e0 = 0; e0 < 128; e0 += 8) {
      u32x4 w[8]; unsigned short sc[8];
#pragma unroll
      for (int q = 0; q < 8; ++q) { const int id = __builtin_amdgcn_readlane(e0 < 64 ? id0 : id1, (e0 + q) & 63); const unsigned char* rp = PU + (size_t)id * 1152;
        w[q] = *(const u32x4*)(rp + lane * 16); sc[q] = *(const unsigned short*)(rp + 1024 + lane * 2); }
#pragma unroll
      for (int q = 0; q < 8; ++q) { u32x4 ww = w[q]; { unsigned w0 = ww[0]; asm volatile("" : "+v"(w0) : "v"(z0), "v"(z1)); ww[0] = w0; }
        f32x2 d[16]; DEC8(ww, 0, d); DEC8(ww, 1, d); DEC8(ww, 2, d); DEC8(ww, 3, d);
        f32x2 pa = {0.f, 0.f}, pb = {0.f, 0.f};
#pragma unroll
        for (int i = 0; i < 8; ++i) { pa = d[i] * x2[i] + pa; pb = d[8 + i] * x2[8 + i] + pb; }
        const f32x2 sab = __builtin_amdgcn_cvt_pk_f32_fp8((int)sc[q], false);
        const float tot = dpp_sum64((pa[0] + pa[1]) * sab[0] + (pb[0] + pb[1]) * sab[1]);
        if (lane == ((e0 + q) & 63)) { if (e0 < 64) z0 = tot; else z1 = tot; }
        __builtin_amdgcn_sched_barrier(0); }
    }
    const float a0 = gelu_erf(z0 * iu0) * g0 * iv0, a1 = gelu_erf(z1 * iu1) * g1 * iv1;
    f32x2 acc2[16];
#pragma unroll
    for (int i = 0; i < 16; ++i) acc2[i] = (f32x2){0.f, 0.f};
#pragma unroll 1
    for (int e0 = 0; e0 < 128; e0 += 8) {
      u32x4 w[8]; unsigned short sc[8]; float av[8];
#pragma unroll
      for (int q = 0; q < 8; ++q) { const int id = __builtin_amdgcn_readlane(e0 < 64 ? id0 : id1, (e0 + q) & 63); const unsigned char* rp = PV + (size_t)id * 1152;
        av[q] = __uint_as_float(__builtin_amdgcn_readlane(__float_as_uint(e0 < 64 ? a0 : a1), (e0 + q) & 63));
        w[q] = *(const u32x4*)(rp + lane * 16); sc[q] = *(const unsigned short*)(rp + 1024 + lane * 2); }
#pragma unroll
      for (int q = 0; q < 8; ++q) { u32x4 ww = w[q]; { unsigned w0 = ww[0]; asm volatile("" : "+v"(w0) : "v"(acc2[15])); ww[0] = w0; }
        f32x2 d[16]; DEC8(ww, 0, d); DEC8(ww, 1, d); DEC8(ww, 2, d); DEC8(ww, 3, d);
        const f32x2 sab = __builtin_amdgcn_cvt_pk_f32_fp8((int)sc[q], false); const float sa = av[q] * sab[0], sb = av[q] * sab[1];
        const f32x2 aa = {sa, sa}, bb = {sb, sb};
#pragma unroll
        for (int i = 0; i < 8; ++i) { acc2[i] = d[i] * aa + acc2[i]; acc2[8 + i] = d[8 + i] * bb + acc2[8 + i]; }
        asm volatile("" : "+v"(acc2[0]), "+v"(acc2[1]), "+v"(acc2[2]), "+v"(acc2[3]), "+v"(acc2[4]), "+v"(acc2[5]), "+v"(acc2[6]), "+v"(acc2[7]), "+v"(acc2[8]), "+v"(acc2[9]), "+v"(acc2[10]), "+v"(acc2[11]), "+v"(acc2[12]), "+v"(acc2[13]), "+v"(acc2[14]), "+v"(acc2[15])); }
    }
    float acc[32];
#pragma unroll
    for (int i = 0; i < 16; ++i) { acc[2 * i] = acc2[i][0] + DN_ALPHA * x2[i][0]; acc[2 * i + 1] = acc2[i][1] + DN_ALPHA * x2[i][1]; }
    ln_row_regs32(acc, p.in[33], p.in[34], lane);
#pragma unroll
    for (int k = 0; k < 8; ++k) *(f32x4*)(p.out + (size_t)t * DM + lane * 32 + k * 4) = (f32x4){acc[k * 4], acc[k * 4 + 1], acc[k * 4 + 2], acc[k * 4 + 3]};
  }
}
#undef DEC8

#define LAS __attribute__((address_space(3)))
#define XB_TMO      128
#define XB_XCNT(j)  (256  + 64 * (j))
#define XB_XSUB(j)  (1280 + 64 * (j))
#define XB_XGEN(j)  (2304 + 64 * (j))
#define XB_TOP      3328
#define XB_TOPGEN   3392
#define XCD_BAR_WORDS 3456
#define XB_SPIN_CAP (1u << 22)
__device__ __forceinline__ unsigned xb_ld(unsigned* p)              { return __hip_atomic_load(p, __ATOMIC_RELAXED, __HIP_MEMORY_SCOPE_AGENT); }
__device__ __forceinline__ unsigned xb_add(unsigned* p, unsigned v) { return __hip_atomic_fetch_add(p, v, __ATOMIC_RELAXED, __HIP_MEMORY_SCOPE_AGENT); }
__device__ __forceinline__ unsigned xb_xcc_id() { return (unsigned)__builtin_amdgcn_s_getreg((3 << 11) | 20) & 0xFu; }
#define XB_SPIN(cond, bar) do { unsigned _sp = 0; while (cond) { __builtin_amdgcn_s_sleep(1); \
    if ((++_sp & 255u) == 0u) { if (xb_ld(&(bar)[XB_TMO])) break; if (_sp > XB_SPIN_CAP) { atomicAdd(&(bar)[XB_TMO], 1u); break; } } } } while (0)
struct XcdBarrier { unsigned* bar; unsigned x; volatile LAS unsigned* st; };
__device__ __forceinline__ XcdBarrier xcd_barrier_post(unsigned* bar, volatile LAS unsigned* st) {
  XcdBarrier b; b.bar = bar; b.x = xb_xcc_id(); b.st = st;
  if (threadIdx.x == 0) (void)xb_add(&bar[XB_XCNT(b.x)], 1u);
  return b;
}
__device__ __forceinline__ void xcd_barrier_complete(unsigned* bar, unsigned x, unsigned& nloc, unsigned& nx) {
  const unsigned G = gridDim.x * gridDim.y * gridDim.z;
  unsigned sum, cnt, mine, sp = 0u;
  for (;;) {
    sum = 0u; cnt = 0u; mine = 0u;
#pragma unroll
    for (unsigned j = 0; j < 16; ++j) { const unsigned c = xb_ld(&bar[XB_XCNT(j)]); sum += c; cnt += (c > 0u) ? 1u : 0u; mine = (j == x) ? c : mine; }
    if (sum == G) break;
    __builtin_amdgcn_s_sleep(1);
    if ((++sp & 255u) == 0u) { if (xb_ld(&bar[XB_TMO])) break; if (sp > XB_SPIN_CAP) { atomicAdd(&bar[XB_TMO], 1u); break; } }
  }
  nloc = mine > 0u ? mine : 1u; nx = cnt > 0u ? cnt : 1u;
}
__device__ __forceinline__ void xcd_barrier(const XcdBarrier& b) {
  asm volatile("s_waitcnt vmcnt(0)" ::: "memory");
  __syncthreads();
  if (threadIdx.x == 0) {
    unsigned* bar = b.bar;
    __builtin_amdgcn_s_waitcnt(0);
    unsigned nloc = b.st[0], nx = b.st[1];
    if (nloc == 0u) { xcd_barrier_complete(bar, b.x, nloc, nx); b.st[0] = nloc; b.st[1] = nx; }
    const unsigned old = xb_add(&bar[XB_XSUB(b.x)], 1u);
    const unsigned gen = old / nloc;
    if (old + 1u == (gen + 1u) * nloc) {
      __builtin_amdgcn_fence(__ATOMIC_RELEASE, "agent");
      asm volatile("s_waitcnt vmcnt(0)" ::: "memory");
      const unsigned og = xb_add(&bar[XB_TOP], 1u);
      const unsigned tg = og / nx;
      if (og + 1u == (tg + 1u) * nx) xb_add(&bar[XB_TOPGEN], 1u);
      else XB_SPIN(xb_ld(&bar[XB_TOPGEN]) == tg, bar);
      __builtin_amdgcn_fence(__ATOMIC_ACQUIRE, "agent");
      xb_add(&bar[XB_XGEN(b.x)], 1u);
      asm volatile("s_waitcnt vmcnt(0)" ::: "memory");
    } else {
      XB_SPIN(xb_ld(&bar[XB_XGEN(b.x)]) == gen, bar);
      __builtin_amdgcn_fence(__ATOMIC_ACQUIRE, "agent");
      asm volatile("s_waitcnt vmcnt(0)" ::: "memory");
    }
  }
  __syncthreads();
}

constexpr int CVT_EARLY = 4608, CVT_SPLIT = 11264;
#ifndef PROBE_LRU
#define PROBE_LRU 0
#endif
#ifndef USE_TOPK3
#define USE_TOPK3 1
#endif
#ifndef USE_TOPK2
#define USE_TOPK2 1
#endif
#ifndef PROBE_MASK
#define PROBE_MASK 0
#endif
#ifndef PROBE_PEER
#define PROBE_PEER 0
#endif
#ifndef PROBE_SYNC
#define PROBE_SYNC 0
#endif
#ifndef PROBE_TOPK
#define PROBE_TOPK 0
#endif
#ifndef USE_FAST_XATTN
#define USE_FAST_XATTN 1
#endif
#ifndef USE_FAST_MLA
#define USE_FAST_MLA 1
#endif
#ifndef FASTMASK
#define FASTMASK 0xff
#endif
#define GEMM(MODE, g, e) do { if constexpr ((FASTMASK >> MODE) & 1) gemm_fast<MODE>(g, e, lds_raw, bid, nblk); else gemm_simple<MODE>(g, e, bid, nblk, wave, lane); } while (0)
#define IDS int tid_ = threadIdx.x; asm volatile("" : "+v"(tid_)); const int tid = tid_, lane = tid & 63, wave = tid >> 6, gw = bid * NWAVE + wave; (void)tid; (void)lane; (void)wave; (void)gw
__global__ void __launch_bounds__(NTHR) fwd_kernel(Params p) {
  extern __shared__ __attribute__((aligned(16))) unsigned char lds_raw[];
  float* lds = (float*)lds_raw;
  cg::grid_group grid = cg::this_grid();
  const int bid = blockIdx.x, nblk = gridDim.x, ngw = nblk * NWAVE;
  unsigned char* ws = p.ws; unsigned char* dout = (unsigned char*)p.out;
  EpiArgs e{ws, dout, p.in, nullptr, nullptr, 0};
  volatile LAS unsigned* bst = (volatile LAS unsigned*)((LAS unsigned char*)lds_raw + (LDS_BYTES - 64));
  if (threadIdx.x < 2) bst[threadIdx.x] = 0u;
  __syncthreads();
  const XcdBarrier xbar = xcd_barrier_post((unsigned*)ws, bst);
#define GSYNC() xcd_barrier(xbar)

  for (int rp_ = 0; rp_ < 1 + ((PROBE_MASK >> 0) & 1); ++rp_) { { IDS; if (nblk == 256) phase0<true>(p, lds, gw, ngw, lane, wave); else phase0<false>(p, lds, gw, ngw, lane, wave); } }
  if (__builtin_expect(p.ws == nullptr, 0)) grid.sync();
  GSYNC();
  if (nblk == 256 && ((bid >= 64 && bid < 128) || bid >= 160)) { IDS;
    const int sb = (bid < 128) ? bid - 64 : bid - 96; transpose_list<1>(p, lds + wave * (64 * 33), sb * NWAVE + wave, 160 * NWAVE, lane);
    cvt_fp4_pass(p.in[31], ws + WS_PU, (float*)(ws + WS_PINV), 0, CVT_EARLY, sb * NWAVE + wave, 160 * NWAVE, lane);
    cvt_fp4_pass(p.in[32], ws + WS_PV, (float*)(ws + WS_PINV) + 16384, 0, CVT_EARLY, sb * NWAVE + wave, 160 * NWAVE, lane);
    __syncthreads(); }
  for (int rp_ = 0; rp_ < 1 + ((PROBE_MASK >> 1) & 1); ++rp_) { { IDS; GemmArgs g{(const bf16_t*)(ws + WS_X), 2048, 0, (const bf16_t*)(ws + WS_WIN_T), 2048, 0, T_, 3328, 2048, 1}; GEMM(E_WIN, g, e); } }
  for (int rp_ = 0; rp_ < 1 + ((PROBE_MASK >> 1) & 1); ++rp_) { { IDS; GemmArgs g{(const bf16_t*)(ws + WS_MEMB), 2048, 0, (const bf16_t*)(ws + WS_WMKV_T), 2048, 0, 2048, 1024, 2048, 1, 128}; GEMM(E_MEMKV, g, e); } }
  GSYNC();
  { IDS; phase1b(p, gw, ngw, lane); }
  GSYNC();
  for (int rp_ = 0; rp_ < 1 + ((PROBE_MASK >> 2) & 1); ++rp_) { { IDS; GemmArgs g{(const bf16_t*)(ws + WS_CQ), 512, 0, (const bf16_t*)(ws + WS_WUQ_T), 512, 0, T_, 1536, 512, 1}; GEMM(E_Q, g, e); } }
  for (int rp_ = 0; rp_ < 1 + ((PROBE_MASK >> 2) & 1); ++rp_) { { IDS; GemmArgs g{(const bf16_t*)(ws + WS_CKV), 512, 0, (const bf16_t*)(ws + WS_WUKV_T), 512, 0, T_, 2048, 512, 1}; GEMM(E_KV, g, e); } }
#if USE_LRU_FUSED
  for (int rp_ = 0; rp_ < 1 + PROBE_LRU; ++rp_) lru_fused_phase(p, lds_raw, bid, nblk);
#else
  for (int rp_ = 0; rp_ < 1 + ((PROBE_MASK >> 2) & 1); ++rp_) { { IDS; GemmArgs g{(const bf16_t*)(ws + WS_XC), 1024, 128, (const bf16_t*)(ws + WS_WG_T), 128, 512 * 128, T_, 512, 128, 8}; GEMM(E_GATES, g, e); } }
#endif
  GSYNC();
#if USE_FAST_MLA
  for (int rp_ = 0; rp_ < 1 + ((PROBE_MASK >> 4) & 1); ++rp_) { mla_attn_phase(dout, ws, (char*)lds_raw, bid, nblk); }
#else
  { IDS; attn_scalar<192, 2048>((const bf16_t*)(dout + DO_Q), 1536, (const bf16_t*)(dout + DO_K), 1536, (const bf16_t*)(dout + DO_V), 1024, (bf16_t*)(ws + WS_YMIX), 2048, 8,
                         0.07216878364870322f, lds, bid, nblk, tid); }
#endif
#if !USE_LRU_FUSED
  { IDS; scan_phase(ws, lds, bid, nblk, tid); }
#endif
  GSYNC();
  { IDS; phase3b(p, gw, ngw, lane); }
  GSYNC();
  { IDS; GemmArgs g{(const bf16_t*)(ws + WS_YMIX), 2048, 0, (const bf16_t*)(ws + WS_WOUT_T), 2048, 0, T_, 2048, 2048, 1}; GEMM(E_RES, g, e); }
  GSYNC();
  { IDS; ln_pass(ws, p.in[20], p.in[21], gw, ngw, lane); }
  { IDS; const int rlo = (nblk == 256) ? CVT_EARLY : 0, rsplit = (nblk == 256) ? CVT_SPLIT : 16384;
    cvt_fp4_pass(p.in[31], ws + WS_PU, (float*)(ws + WS_PINV), rlo, rsplit, gw, ngw, lane);
    cvt_fp4_pass(p.in[32], ws + WS_PV, (float*)(ws + WS_PINV) + 16384, rlo, rsplit, gw, ngw, lane); }
  GSYNC();
  for (int rp_ = 0; rp_ < 1 + ((PROBE_MASK >> 5) & 1); ++rp_) { { IDS; GemmArgs g{(const bf16_t*)(ws + WS_X), 2048, 0, (const bf16_t*)(ws + WS_WMQ_T), 2048, 0, T_, 512, 2048, 1}; EpiArgs e2 = e; e2.o = (bf16_t*)(ws + WS_QM); e2.ld = 512; GEMM(E_BF16, g, e2); }
  if (nblk == 256 && bid >= 128) { IDS; const int g2 = (bid - 128) * NWAVE + wave;
    cvt_fp4_pass(p.in[31], ws + WS_PU, (float*)(ws + WS_PINV), CVT_SPLIT, 16384, g2, 128 * NWAVE, lane);
    cvt_fp4_pass(p.in[32], ws + WS_PV, (float*)(ws + WS_PINV) + 16384, CVT_SPLIT, 16384, g2, 128 * NWAVE, lane); } }
  GSYNC();
#if USE_FAST_XATTN
  for (int rp_ = 0; rp_ < 1 + ((PROBE_MASK >> 5) & 1); ++rp_) { mem_attn_phase(ws, (char*)lds_raw, bid, nblk); }
#else
  { IDS; attn_scalar<128, 256>((const bf16_t*)(ws + WS_QM), 512, (const bf16_t*)(ws + WS_MEMKV), 1024, (const bf16_t*)(ws + WS_MEMKV) + 512, 1024, (bf16_t*)(ws + WS_OM), 512, 4,
                        0.08838834764831845f, lds, bid, nblk, tid); }
#endif
  GSYNC();
  { IDS; GemmArgs g{(const bf16_t*)(ws + WS_OM), 512, 0, (const bf16_t*)(ws + WS_WMO_T), 512, 0, T_, 2048, 512, 1}; GEMM(E_RES, g, e); }
  GSYNC();
  { IDS; ln_pass(ws, p.in[26], p.in[27], gw, ngw, lane); }
  GSYNC();
  for (int rp_ = 0; rp_ < 1 + ((PROBE_MASK >> 3) & 1); ++rp_) { { IDS; GemmArgs g{(const bf16_t*)(ws + WS_X), 2048, 0, (const bf16_t*)(ws + WS_WPQ_T), 2048, 0, T_, 2048, 2048, 1}; EpiArgs e2 = e; e2.o = (bf16_t*)(ws + WS_QP); e2.ld = 2048; GEMM(E_BF16, g, e2); } }
  GSYNC();
#if USE_TOPK3
  for (int rep_ = 0; rep_ < 1 + PROBE_TOPK; ++rep_) { IDS; topk_phase3(p, lds_raw, gw, ngw, tid); }
#else
  for (int rp_ = 0; rp_ < 1 + ((PROBE_MASK >> 3) & 1); ++rp_) { { IDS; GemmArgs g{(const bf16_t*)(ws + WS_QP), 256, 0, (const bf16_t*)(ws + WS_KEYS_T), 256, 0, T_ * 8, 256, 256, 1}; EpiArgs e2 = e; e2.f = (float*)dout; e2.ld = 256; GEMM(E_F32, g, e2); } }
  GSYNC();
  for (int rep_ = 0; rep_ < 1 + PROBE_TOPK; ++rep_) { IDS; if (USE_TOPK2) topk_phase2(ws, (const float*)dout, gw, ngw, lane); else topk_phase(ws, (const float*)dout, gw, ngw, lane); }
#endif
  GSYNC();
  for (int rep_ = 0; rep_ < 1 + PROBE_PEER; ++rep_) { IDS; peer_phase(p, gw, ngw, lane); }
  for (int rep_ = 0; rep_ < PROBE_SYNC; ++rep_) GSYNC();
}

extern "C" void kernel_launch(void* const* d_in, const int* in_sizes, int n_in, void* d_out, int out_size, void* d_ws, size_t ws_size, hipStream_t stream) {
  static int grid_blocks = 0;
  if (grid_blocks == 0) {
    if (n_in != 35 || ws_size < WS_END || out_size != T_ * DM) { fprintf(stderr, "kernel_launch: unexpected shapes n_in %d ws %zu out %d\n", n_in, ws_size, out_size); grid_blocks = -1; return; }
    int dev = 0, cus = 0, per_cu = 0;
    hipGetDevice(&dev); hipDeviceGetAttribute(&cus, hipDeviceAttributeMultiprocessorCount, dev);
    if (hipFuncSetAttribute((const void*)fwd_kernel, hipFuncAttributeMaxDynamicSharedMemorySize, LDS_BYTES) != hipSuccess) { fprintf(stderr, "hipFuncSetAttribute failed\n"); grid_blocks = -1; return; }
    if (hipOccupancyMaxActiveBlocksPerMultiprocessor(&per_cu, (const void*)fwd_kernel, NTHR, LDS_BYTES) != hipSuccess || per_cu < 1) { fprintf(stderr, "occupancy query failed (%d)\n", per_cu); grid_blocks = -1; return; }
    grid_blocks = cus * per_cu;
    fprintf(stderr, "kernel_launch: cus %d per_cu %d grid %d ws %zu\n", cus, per_cu, grid_blocks, ws_size);
  }
  if (grid_blocks < 0) return;
  if (hipMemsetAsync(d_ws, 0, 65536, stream) != hipSuccess) { fprintf(stderr, "memset failed\n"); return; }
  Params p{};
  for (int i = 0; i < 35; ++i) p.in[i] = (const float*)d_in[i];
  p.out = (float*)d_out; p.ws = (unsigned char*)d_ws;
  void* args[] = {&p};
  hipError_t err = hipLaunchCooperativeKernel((const void*)fwd_kernel, dim3(grid_blocks), dim3(NTHR), args, LDS_BYTES, stream);
  if (err != hipSuccess) fprintf(stderr, "cooperative launch failed: %s (grid %d)\n", hipGetErrorString(err), grid_blocks);
}
```

```cpp
#include <hip/hip_runtime.h>
#include <hip/hip_cooperative_groups.h>
#include <cstdio>
#include <cstdint>
namespace cg = cooperative_groups;
#ifndef USE_LRU_FUSED
#define USE_LRU_FUSED 1
#endif

typedef unsigned short bf16_t;
typedef short bf16x8 __attribute__((ext_vector_type(8)));
typedef float f32x4 __attribute__((ext_vector_type(4)));
typedef float f32x2 __attribute__((ext_vector_type(2)));
typedef float f32x16 __attribute__((ext_vector_type(16)));
typedef unsigned u32x4 __attribute__((ext_vector_type(4)));
typedef unsigned u32x2 __attribute__((ext_vector_type(2)));

constexpr int T_ = 16384, S_ = 2048, NB_ = 8, DM = 2048;
constexpr int NTHR = 512, NWAVE = 8;
constexpr float DN_ALPHA = 1.189207115002721f;
constexpr float LN_EPS = 1e-5f, RMS_EPS = 1e-6f;
constexpr int LDS_BYTES = 147456;

constexpr size_t MiB = 1u << 20;
constexpr size_t WS_WIN_T = 1 * MiB;
constexpr size_t WS_WUQ_T = 14 * MiB;
constexpr size_t WS_WUKV_T = WS_WUQ_T + 1536 * 512 * 2;
constexpr size_t WS_WG_T = WS_WUKV_T + 2 * MiB;
constexpr size_t WS_WOUT_T = WS_WG_T + 1 * MiB;
constexpr size_t WS_WMQ_T = WS_WOUT_T + 8 * MiB;
constexpr size_t WS_WMKV_T = WS_WMQ_T + 2 * MiB;
constexpr size_t WS_WMO_T = WS_WMKV_T + 4 * MiB;
constexpr size_t WS_WPQ_T = WS_WMO_T + 2 * MiB;
constexpr size_t WS_KEYS_T = WS_WPQ_T + 8 * MiB;
constexpr size_t WS_COS = 43 * MiB, WS_SIN = 45 * MiB;
constexpr size_t WS_MEMB = 47 * MiB;
constexpr size_t WS_MEMKV = 55 * MiB;
constexpr size_t WS_GTAB = 59 * MiB;
static_assert(WS_KEYS_T + 256 * 256 * 2 <= WS_COS, "weights region");
constexpr size_t WS_LAF = 60 * MiB, WS_BTF = 92 * MiB, WS_LAB = 124 * MiB, WS_BTB = 156 * MiB;
constexpr size_t WS_PU = 60 * MiB, WS_PV = 124 * MiB;
constexpr size_t WS_PINV = 59 * MiB + 65536;
constexpr size_t WS_X = 188 * MiB;
constexpr size_t WS_CQ = 252 * MiB, WS_CKV = 268 * MiB, WS_KPE = 284 * MiB;
constexpr size_t WS_LRUX = 286 * MiB, WS_GATE = 318 * MiB, WS_YMIX = 350 * MiB, WS_XC = 414 * MiB;
constexpr size_t WS_QM = WS_CQ, WS_OM = WS_CKV, WS_QP = WS_YMIX, WS_IDX = WS_LRUX, WS_GV = WS_LRUX + 8 * MiB, WS_ACT = WS_LRUX + 16 * MiB;
constexpr size_t WS_END = 446 * MiB;
constexpr size_t DO_Q = 0, DO_K = 48 * MiB, DO_V = 96 * MiB;

__device__ __forceinline__ unsigned f2bf(float f) { unsigned u = __float_as_uint(f); return (u + 0x7fffu + ((u >> 16) & 1u)) >> 16; }
__device__ __forceinline__ float bf2f(unsigned h) { return __uint_as_float(h << 16); }
__device__ __forceinline__ unsigned pk2(float lo, float hi) { unsigned r; asm("v_cvt_pk_bf16_f32 %0, %1, %2" : "=v"(r) : "v"(lo), "v"(hi)); return r; }
__device__ __forceinline__ float bflo(unsigned w) { return __uint_as_float(w << 16); }
__device__ __forceinline__ float bfhi(unsigned w) { return __uint_as_float(w & 0xffff0000u); }
__device__ __forceinline__ float dpp_sum64(float v) {
#define DPPF(x, ctrl, rm, bc) __builtin_bit_cast(float, __builtin_amdgcn_update_dpp(0, __builtin_bit_cast(int, x), ctrl, rm, 0xf, bc))
  v += DPPF(v, 0x111, 0xf, true); v += DPPF(v, 0x112, 0xf, true); v += DPPF(v, 0x114, 0xf, true); v += DPPF(v, 0x118, 0xf, true);
  v += DPPF(v, 0x142, 0xa, false); v += DPPF(v, 0x143, 0xc, false);
#undef DPPF
  return __uint_as_float(__builtin_amdgcn_readlane(__float_as_uint(v), 63));
}
__device__ __forceinline__ unsigned dpp_max64_u32(unsigned v) {
#define DPPU(x, ctrl, rm, bc) (unsigned)__builtin_amdgcn_update_dpp(0, (int)(x), ctrl, rm, 0xf, bc)
  unsigned w;
  w = DPPU(v, 0x111, 0xf, true); v = v > w ? v : w; w = DPPU(v, 0x112, 0xf, true); v = v > w ? v : w;
  w = DPPU(v, 0x114, 0xf, true); v = v > w ? v : w; w = DPPU(v, 0x118, 0xf, true); v = v > w ? v : w;
  w = DPPU(v, 0x142, 0xa, false); v = v > w ? v : w; w = DPPU(v, 0x143, 0xc, false); v = v > w ? v : w;
#undef DPPU
  return (unsigned)__builtin_amdgcn_readlane((int)v, 63);
}
__device__ __forceinline__ float wave_sum(float v) {
#pragma unroll
  for (int o = 1; o < 64; o <<= 1) v += __shfl_xor(v, o);
  return v;
}
__device__ __forceinline__ float wave_max(float v) {
#pragma unroll
  for (int o = 1; o < 64; o <<= 1) v = fmaxf(v, __shfl_xor(v, o));
  return v;
}
__device__ __forceinline__ unsigned wave_max_u32(unsigned v) {
#pragma unroll
  for (int o = 1; o < 64; o <<= 1) { unsigned w = (unsigned)__shfl_xor((int)v, o); v = v > w ? v : w; }
  return v;
}
typedef __bf16 bf16x2_t __attribute__((ext_vector_type(2)));
__device__ __forceinline__ float dot2_bf16(unsigned w, unsigned x, float acc) { return __builtin_amdgcn_fdot2_f32_bf16(__builtin_bit_cast(bf16x2_t, w), __builtin_bit_cast(bf16x2_t, x), acc, false); }
__device__ __forceinline__ float sigmoidf_(float x) { return __builtin_amdgcn_rcpf(1.f + __expf(-x)); }
__device__ __forceinline__ float neg_expm1_small(float x) {
  const float s = x * (1.f + x * (0.5f + x * (1.6666667e-1f + x * (4.1666667e-2f + x * (8.3333333e-3f + x * 1.3888889e-3f)))));
  const float e = 1.f - __builtin_amdgcn_exp2f(x * 1.4426950408889634f);
  return x > -0.25f ? -s : e;
}
__device__ __forceinline__ float gelu_tanh(float x) {
  const float u = 0.7978845608028654f * (x + 0.044715f * x * x * x);
  const float t = 1.f - 2.f / (__expf(2.f * u) + 1.f);
  return 0.5f * x * (1.f + t);
}
__device__ __forceinline__ float gelu_erf(float x) { return 0.5f * x * (1.f + erff(x * 0.7071067811865476f)); }
__device__ __forceinline__ void unpack8(u32x4 w, float* f) {
  f[0] = bflo(w.x); f[1] = bfhi(w.x); f[2] = bflo(w.y); f[3] = bfhi(w.y); f[4] = bflo(w.z); f[5] = bfhi(w.z); f[6] = bflo(w.w); f[7] = bfhi(w.w);
}
__device__ __forceinline__ u32x4 pack8(const float* f) { u32x4 w; w.x = pk2(f[0], f[1]); w.y = pk2(f[2], f[3]); w.z = pk2(f[4], f[5]); w.w = pk2(f[6], f[7]); return w; }

struct Params { const float* in[35]; float* out; unsigned char* ws; };

__device__ __forceinline__ const float* wsrc(const float* const* in, int mid, int n, int& ld) {
  switch (mid) {
    case 0: { ld = 3136; int c; if (n < 1024) c = n; else if (n < 3072) c = n + 64; else if (n < 3136) { int i = (n - 3072) >> 1, g = (n - 3072) & 1; c = 1024 + g * 32 + i; } else return nullptr; return in[5] + c; }
    case 1: { ld = 1536; int h = n / 192, j = n % 192, c; if (j < 128) c = h * 192 + j; else { int i = (j - 128) >> 1, g = (j - 128) & 1; c = h * 192 + 128 + g * 32 + i; } return in[7] + c; }
    case 2: { ld = 2048; int c; if (n < 1024) c = (n >> 7) * 256 + (n & 127); else { int m = n - 1024; c = (m >> 7) * 256 + 128 + (m & 127); } return in[9] + c; }
    case 3: ld = 2048; return in[19] + n;
    case 4: ld = 512; return in[22] + n;
    case 5: ld = 512; return n < 512 ? in[23] + n : in[24] + (n - 512);
    case 6: ld = 2048; return in[25] + n;
    case 7: ld = 2048; return in[28] + n;
    default: { ld = 128; int nb = n >> 9, q = n & 511, dir = q >> 8, jj = (q & 255) >> 1, gate = q & 1; const float* m = (gate ? in[14] : in[12]) + (size_t)((dir * 8 + nb) * 128) * 128; return m + jj; }
  }
}
__device__ __forceinline__ void transpose_item(const float* const* in, int mid, int K, bf16_t* WT, float* scr, int item, int nblk, int lane) {
  const int kb = item / nblk, nb = item % nblk, k0 = 64 * kb, n0 = 32 * nb;
  int ld = 0; const float* base = wsrc(in, mid, n0 + (lane & 31), ld);
  float tv[32];
#pragma unroll
  for (int i = 0; i < 32; ++i) { const int kk = 2 * i + (lane >> 5); tv[i] = base ? base[(size_t)(k0 + kk) * ld] : 0.f; }
#pragma unroll
  for (int i = 0; i < 32; ++i) { const int kk = 2 * i + (lane >> 5); scr[kk * 33 + (lane & 31)] = tv[i]; }
  asm volatile("s_waitcnt lgkmcnt(0)" ::: "memory");
  const int c = lane & 7;
#pragma unroll
  for (int j = 0; j < 4; ++j) { const int n = (lane >> 3) + 8 * j; const float* s = scr + (8 * c) * 33 + n;
    u32x4 o; o.x = pk2(s[0 * 33], s[1 * 33]); o.y = pk2(s[2 * 33], s[3 * 33]); o.z = pk2(s[4 * 33], s[5 * 33]); o.w = pk2(s[6 * 33], s[7 * 33]);
    *(u32x4*)(WT + (size_t)(n0 + n) * K + k0 + 8 * c) = o; }
  asm volatile("s_waitcnt lgkmcnt(0)" ::: "memory");
}
__device__ __forceinline__ void ln_row_regs(float (&v)[32], const float* g, const float* b, int lane) {
  float s = 0.f;
#pragma unroll
  for (int i = 0; i < 32; ++i) s += v[i];
  const float mean = dpp_sum64(s) * (1.f / 2048.f);
  float q = 0.f;
#pragma unroll
  for (int i = 0; i < 32; ++i) { v[i] -= mean; q += v[i] * v[i]; }
  const float rstd = rsqrtf(dpp_sum64(q) * (1.f / 2048.f) + LN_EPS);
#pragma unroll
  for (int j = 0; j < 4; ++j) {
    const f32x4 g0 = *(const f32x4*)(g + j * 512 + lane * 8), g1 = *(const f32x4*)(g + j * 512 + lane * 8 + 4);
    const f32x4 b0 = *(const f32x4*)(b + j * 512 + lane * 8), b1 = *(const f32x4*)(b + j * 512 + lane * 8 + 4);
#pragma unroll
    for (int e = 0; e < 4; ++e) { v[j * 8 + e] = v[j * 8 + e] * rstd * g0[e] + b0[e]; v[j * 8 + 4 + e] = v[j * 8 + 4 + e] * rstd * g1[e] + b1[e]; }
  }
}
__device__ __forceinline__ void sincos_big(float ang, float& c, float& s) {
  const double a = (double)ang;
  const double q = __builtin_rint(a * 0.63661977236758134308);
  const float r = (float)(a - q * 1.57079632679489661923);
  const int qi = ((int)q) & 3;
  const float r2 = r * r;
  const float sn = r + r * r2 * (-1.6666667e-1f + r2 * (8.3333333e-3f + r2 * (-1.9841270e-4f + r2 * 2.7557319e-6f)));
  const float cs = 1.f + r2 * (-0.5f + r2 * (4.1666667e-2f + r2 * (-1.3888889e-3f + r2 * (2.4801587e-5f + r2 * -2.7557319e-7f))));
  const float ss = (qi & 1) ? cs : sn, cc = (qi & 1) ? sn : cs;
  s = (qi & 2) ? -ss : ss;
  c = ((qi + 1) & 2) ? -cc : cc;
}

template <int WHICH> __device__ __forceinline__ void transpose_list(const Params& p, float* scr, int gw, int ngw, int lane) {
  struct TI { int mid, ndst, K; size_t off; };
  constexpr int NT = (WHICH == 0) ? 2 : (WHICH == 1) ? 7 : 9;
  const TI all[9] = {{0, 3328, 2048, WS_WIN_T}, {5, 1024, 2048, WS_WMKV_T}, {1, 1536, 512, WS_WUQ_T}, {2, 2048, 512, WS_WUKV_T}, {3, 2048, 2048, WS_WOUT_T}, {4, 512, 2048, WS_WMQ_T},
                     {6, 2048, 512, WS_WMO_T}, {7, 2048, 2048, WS_WPQ_T}, {8, 4096, 128, WS_WG_T}};
  constexpr int T0 = (WHICH == 1) ? 2 : 0;
  int total = 0;
#pragma unroll
  for (int t = 0; t < NT; ++t) total += (all[T0 + t].ndst / 32) * (all[T0 + t].K / 64);
  for (int git = gw; git < total; git += ngw) {
    int t = 0, it = git;
#pragma unroll
    for (int u = 0; u < NT - 1; ++u) { const int nit = (all[T0 + u].ndst / 32) * (all[T0 + u].K / 64); if (t == u && it >= nit) { it -= nit; t = u + 1; } }
    int mid = 0, ndst = 0, K = 0; size_t off = 0;
#pragma unroll
    for (int u = 0; u < NT; ++u) if (t == u) { mid = all[T0 + u].mid; ndst = all[T0 + u].ndst; K = all[T0 + u].K; off = all[T0 + u].off; }
    transpose_item(p.in, mid, K, (bf16_t*)(p.ws + off), scr, it, ndst / 32, lane);
  }
}
template <bool EARLY_ONLY> __device__ __forceinline__ void phase0(const Params& p, float* lds, int gw, int ngw, int lane, int wave) {
  unsigned char* ws = p.ws;
  float* scr = lds + wave * (64 * 33);
  transpose_list<(EARLY_ONLY ? 0 : 2)>(p, scr, gw, ngw, lane);
  { bf16_t* KT = (bf16_t*)(ws + WS_KEYS_T);
    for (int i = gw * 64 + lane; i < 256 * 256; i += ngw * 64) { const int n = i >> 8, k = i & 255; float v = 0.f;
      if (n < 128) { if (k < 128) v = p.in[29][n * 128 + k]; } else { if (k >= 128) v = p.in[30][(n - 128) * 128 + (k - 128)]; }
      KT[i] = (bf16_t)f2bf(v); } }
  { f32x4* gt = (f32x4*)(ws + WS_GTAB);
    for (int i = gw * 64 + lane; i < 2048; i += ngw * 64) gt[i] = (f32x4){8.f * log1pf(__expf(-p.in[16][i])), p.in[13][i], p.in[15][i], 0.f}; }
  { float* ct = (float*)(ws + WS_COS); float* st = (float*)(ws + WS_SIN); const int* pos = (const int*)p.in[2];
    for (int i = gw * 64 + lane; i < T_ * 32; i += ngw * 64) { const int t = i >> 5, f = i & 31;
      const float inv = exp2f(-(float)(2 * f) * (13.287712379549449f / 64.f));
      const float ang = (float)pos[t] * inv; float c, s; sincos_big(ang, c, s); ct[i] = c; st[i] = s; } }
  { const float* m = p.in[1]; bf16_t* mb = (bf16_t*)(ws + WS_MEMB);
    for (size_t i = (size_t)(gw * 64 + lane) * 8; i < (size_t)2048 * 2048; i += (size_t)ngw * 64 * 8) {
      const f32x4 a = *(const f32x4*)(m + i), b = *(const f32x4*)(m + i + 4); u32x4 o; o.x = pk2(a[0], a[1]); o.y = pk2(a[2], a[3]); o.z = pk2(b[0], b[1]); o.w = pk2(b[2], b[3]);
      *(u32x4*)(mb + i) = o; } }
  { const float* x = p.in[0]; bf16_t* X = (bf16_t*)(ws + WS_X);
    for (int r0 = gw * 2; r0 < T_; r0 += ngw * 2) { float v[2][32];
#pragma unroll
      for (int rr = 0; rr < 2; ++rr)
#pragma unroll
        for (int j = 0; j < 4; ++j) { const f32x4 a = *(const f32x4*)(x + (size_t)(r0 + rr) * DM + j * 512 + lane * 8), b = *(const f32x4*)(x + (size_t)(r0 + rr) * DM + j * 512 + lane * 8 + 4);
#pragma unroll
          for (int e = 0; e < 4; ++e) { v[rr][j * 8 + e] = a[e]; v[rr][j * 8 + 4 + e] = b[e]; } }
#pragma unroll
      for (int rr = 0; rr < 2; ++rr) { ln_row_regs(v[rr], p.in[3], p.in[4], lane);
#pragma unroll
        for (int j = 0; j < 4; ++j) *(u32x4*)(X + (size_t)(r0 + rr) * DM + j * 512 + lane * 8) = pack8(&v[rr][j * 8]); } } }
}

enum { E_WIN = 0, E_MEMKV, E_Q, E_KV, E_GATES, E_RES, E_BF16, E_F32 };
struct EpiArgs { unsigned char* ws; unsigned char* dout; const float* const* in; bf16_t* o; float* f; int ld; };
__device__ __forceinline__ void st4(bf16_t* ptr, f32x4 v) { u32x2 w; w.x = pk2(v[0], v[1]); w.y = pk2(v[2], v[3]); *(u32x2*)ptr = w; }
template <int MODE> __device__ __forceinline__ void epi(const EpiArgs& e, int batch, int row, int col, f32x4 v) {
  if constexpr (MODE == E_WIN) {
    if (col < 512) st4((bf16_t*)(e.ws + WS_CQ) + (size_t)row * 512 + col, v);
    else if (col < 1024) st4((bf16_t*)(e.ws + WS_CKV) + (size_t)row * 512 + (col - 512), v);
    else if (col < 2048) st4((bf16_t*)(e.ws + WS_LRUX) + (size_t)row * 1024 + (col - 1024), v);
    else if (col < 3072) { f32x4 g; for (int i = 0; i < 4; ++i) g[i] = gelu_tanh(v[i]); st4((bf16_t*)(e.ws + WS_GATE) + (size_t)row * 1024 + (col - 2048), g); }
    else if (col < 3136) st4((bf16_t*)(e.ws + WS_KPE) + (size_t)row * 64 + (col - 3072), v);
  } else if constexpr (MODE == E_MEMKV) {
    st4((bf16_t*)(e.ws + WS_MEMKV) + (size_t)row * 1024 + col, v);
  } else if constexpr (MODE == E_Q) {
    const int j = col % 192;
    if (j >= 128) { const int i0 = (j - 128) >> 1; const float* ct = (const float*)(e.ws + WS_COS) + (size_t)row * 32 + i0; const float* st = (const float*)(e.ws + WS_SIN) + (size_t)row * 32 + i0;
      const float c0 = ct[0], s0 = st[0], c1 = ct[1], s1 = st[1];
      v = (f32x4){v[0] * c0 - v[1] * s0, v[1] * c0 + v[0] * s0, v[2] * c1 - v[3] * s1, v[3] * c1 + v[2] * s1}; }
    st4((bf16_t*)(e.dout + DO_Q) + (size_t)row * 1536 + col, v);
  } else if constexpr (MODE == E_KV) {
    if (col < 1024) st4((bf16_t*)(e.dout + DO_K) + (size_t)row * 1536 + (col >> 7) * 192 + (col & 127), v);
    else st4((bf16_t*)(e.dout + DO_V) + (size_t)row * 1024 + (col - 1024), v);
  } else if constexpr (MODE == E_GATES) {
    const int dir = col >> 8, jj = (col & 255) >> 1, c0 = batch * 128 + jj;
    const f32x4* gt = (const f32x4*)(e.ws + WS_GTAB) + dir * 1024 + c0;
    const f32x4 t0 = gt[0], t1 = gt[1];
    const unsigned xw = *(const unsigned*)((const bf16_t*)(e.ws + WS_XC) + (size_t)row * 1024 + c0);
    const float la0 = -t0[0] * sigmoidf_(v[0] + t0[1]), la1 = -t1[0] * sigmoidf_(v[2] + t1[1]);
    const float bt0 = __builtin_amdgcn_sqrtf(neg_expm1_small(2.f * la0)) * sigmoidf_(v[1] + t0[2]) * bflo(xw);
    const float bt1 = __builtin_amdgcn_sqrtf(neg_expm1_small(2.f * la1)) * sigmoidf_(v[3] + t1[2]) * bfhi(xw);
    bf16_t* LA = (bf16_t*)(e.ws + (dir ? WS_LAB : WS_LAF)); bf16_t* BT = (bf16_t*)(e.ws + (dir ? WS_BTB : WS_BTF));
    *(unsigned*)(LA + (size_t)row * 1024 + c0) = pk2(la0, la1);
    *(unsigned*)(BT + (size_t)row * 1024 + c0) = pk2(bt0, bt1);
  } else if constexpr (MODE == E_RES) {
    bf16_t* X = (bf16_t*)(e.ws + WS_X) + (size_t)row * DM + col; const u32x2 w = *(const u32x2*)X;
    v = (f32x4){DN_ALPHA * bflo(w.x) + v[0], DN_ALPHA * bfhi(w.x) + v[1], DN_ALPHA * bflo(w.y) + v[2], DN_ALPHA * bfhi(w.y) + v[3]};
    st4(X, v);
  } else if constexpr (MODE == E_BF16) {
    st4(e.o + (size_t)row * e.ld + col, v);
  } else {
    *(f32x4*)(e.f + (size_t)row * e.ld + col) = v;
  }
}


__device__ __forceinline__ void st8(bf16_t* ptr, f32x4 a, f32x4 b) { u32x4 w; w.x = pk2(a[0], a[1]); w.y = pk2(a[2], a[3]); w.z = pk2(b[0], b[1]); w.w = pk2(b[2], b[3]); *(u32x4*)ptr = w; }
template <int MODE> __device__ __forceinline__ void epi8(const EpiArgs& e, int batch, int row, int col, f32x4 v0, f32x4 v1) {
  if constexpr (MODE == E_WIN) {
    if (col < 512) st8((bf16_t*)(e.ws + WS_CQ) + (size_t)row * 512 + col, v0, v1);
    else if (col < 1024) st8((bf16_t*)(e.ws + WS_CKV) + (size_t)row * 512 + (col - 512), v0, v1);
    else if (col < 2048) st8((bf16_t*)(e.ws + WS_LRUX) + (size_t)row * 1024 + (col - 1024), v0, v1);
    else if (col < 3072) { f32x4 g0, g1;
#pragma unroll
      for (int i = 0; i < 4; ++i) { g0[i] = gelu_tanh(v0[i]); g1[i] = gelu_tanh(v1[i]); }
      st8((bf16_t*)(e.ws + WS_GATE) + (size_t)row * 1024 + (col - 2048), g0, g1); }
    else if (col < 3136) st8((bf16_t*)(e.ws + WS_KPE) + (size_t)row * 64 + (col - 3072), v0, v1);
  } else if constexpr (MODE == E_MEMKV) {
    st8((bf16_t*)(e.ws + WS_MEMKV) + (size_t)row * 1024 + col, v0, v1);
  } else if constexpr (MODE == E_Q) {
    const int j = col % 192;
    if (j >= 128) { const int i0 = (j - 128) >> 1; const f32x4 c = *(const f32x4*)((const float*)(e.ws + WS_COS) + (size_t)row * 32 + i0), s = *(const f32x4*)((const float*)(e.ws + WS_SIN) + (size_t)row * 32 + i0);
      v0 = (f32x4){v0[0] * c[0] - v0[1] * s[0], v0[1] * c[0] + v0[0] * s[0], v0[2] * c[1] - v0[3] * s[1], v0[3] * c[1] + v0[2] * s[1]};
      v1 = (f32x4){v1[0] * c[2] - v1[1] * s[2], v1[1] * c[2] + v1[0] * s[2], v1[2] * c[3] - v1[3] * s[3], v1[3] * c[3] + v1[2] * s[3]}; }
    st8((bf16_t*)(e.dout + DO_Q) + (size_t)row * 1536 + col, v0, v1);
  } else if constexpr (MODE == E_KV) {
    if (col < 1024) st8((bf16_t*)(e.dout + DO_K) + (size_t)row * 1536 + (col >> 7) * 192 + (col & 127), v0, v1);
    else st8((bf16_t*)(e.dout + DO_V) + (size_t)row * 1024 + (col - 1024), v0, v1);
  } else if constexpr (MODE == E_GATES) {
    const int dir = col >> 8, jj = (col & 255) >> 1, c0 = batch * 128 + jj;
    const f32x4* gt = (const f32x4*)(e.ws + WS_GTAB) + dir * 1024 + c0;
    const u32x2 xw = *(const u32x2*)((const bf16_t*)(e.ws + WS_XC) + (size_t)row * 1024 + c0);
    const float xc[4] = {bflo(xw.x), bfhi(xw.x), bflo(xw.y), bfhi(xw.y)}; const float vv[8] = {v0[0], v0[1], v0[2], v0[3], v1[0], v1[1], v1[2], v1[3]};
    float la[4], bt[4];
#pragma unroll
    for (int i = 0; i < 4; ++i) { const f32x4 t = gt[i]; la[i] = -t[0] * sigmoidf_(vv[2 * i] + t[1]);
      bt[i] = __builtin_amdgcn_sqrtf(neg_expm1_small(2.f * la[i])) * sigmoidf_(vv[2 * i + 1] + t[2]) * xc[i]; }
    bf16_t* LA = (bf16_t*)(e.ws + (dir ? WS_LAB : WS_LAF)); bf16_t* BT = (bf16_t*)(e.ws + (dir ? WS_BTB : WS_BTF));
    u32x2 lw, bw; lw.x = pk2(la[0], la[1]); lw.y = pk2(la[2], la[3]); bw.x = pk2(bt[0], bt[1]); bw.y = pk2(bt[2], bt[3]);
    *(u32x2*)(LA + (size_t)row * 1024 + c0) = lw; *(u32x2*)(BT + (size_t)row * 1024 + c0) = bw;
  } else if constexpr (MODE == E_BF16) {
    st8(e.o + (size_t)row * e.ld + col, v0, v1);
  } else {
    *(f32x4*)(e.f + (size_t)row * e.ld + col) = v0; *(f32x4*)(e.f + (size_t)row * e.ld + col + 4) = v1;
  }
}

struct GemmArgs { const bf16_t* A; size_t lda, a_batch; const bf16_t* Bt; size_t ldb, b_batch; int M, N, K, nbatch; int rot = 0; };
template <int MODE> __device__ __forceinline__ void gemm_simple(const GemmArgs& g, const EpiArgs& e, int bid, int nblk, int wave, int lane) {
  const int tm = g.M / 128, tn = g.N / 128, per = tm * tn, units = g.nbatch * per;
  const int r32 = lane & 31, hi = lane >> 5, wr = wave >> 1, wc = wave & 1;
  for (int u = bid; u < units; u += nblk) {
    const int bt = u / per, r = u % per, pm = r / tn, pn = r % tn;
    const bf16_t* ap = g.A + (size_t)bt * g.a_batch + (size_t)(pm * 128 + wr * 32 + r32) * g.lda + 8 * hi;
    const bf16_t* bp0 = g.Bt + (size_t)bt * g.b_batch + (size_t)(pn * 128 + wc * 64 + r32) * g.ldb + 8 * hi;
    const bf16_t* bp1 = bp0 + 32 * g.ldb;
    f32x16 acc0 = {}, acc1 = {};
#pragma unroll 4
    for (int k0 = 0; k0 < g.K; k0 += 16) {
      const bf16x8 a = *(const bf16x8*)(ap + k0), b0 = *(const bf16x8*)(bp0 + k0), b1 = *(const bf16x8*)(bp1 + k0);
      acc0 = __builtin_amdgcn_mfma_f32_32x32x16_bf16(b0, a, acc0, 0, 0, 0);
      acc1 = __builtin_amdgcn_mfma_f32_32x32x16_bf16(b1, a, acc1, 0, 0, 0);
    }
    const int row = pm * 128 + wr * 32 + r32;
#pragma unroll
    for (int gq = 0; gq < 4; ++gq) {
      const int col = pn * 128 + wc * 64 + 8 * gq + 4 * hi;
      epi<MODE>(e, bt, row, col, (f32x4){acc0[4 * gq], acc0[4 * gq + 1], acc0[4 * gq + 2], acc0[4 * gq + 3]});
      epi<MODE>(e, bt, row, col + 32, (f32x4){acc1[4 * gq], acc1[4 * gq + 1], acc1[4 * gq + 2], acc1[4 * gq + 3]});
    }
  }
}


namespace pg8 {
#define PG8_LAS __attribute__((address_space(3)))
constexpr int BM = 256, BK = 64, HALF = 128, HTB = HALF * BK * 2, STAGE_BYTES = 8 * HTB, NXCD = 8, WGM = 8;
__host__ __device__ __forceinline__ int lds_byte(int r, int c) { const int st = (r >> 4) * 2 + (c >> 5), rr = r & 15, cc = c & 31, ob = rr * 64 + cc * 2; return st * 1024 + (ob ^ (((ob >> 9) & 1) << 5)); }
__host__ __device__ __forceinline__ void stage_rc(int b, int& R, int& C) { const int st = b / 1024, sb = b % 1024, swz = sb ^ (((sb >> 9) & 1) << 5); R = (st >> 1) * 16 + swz / 64; C = (st & 1) * 32 + (swz % 64) / 2; }
__host__ __device__ __forceinline__ int perm32(int rho) { const int n = rho >> 4, i = rho & 15; return 8 * (i >> 2) + 4 * n + (i & 3); }
struct Unit { int pm, pn; };
struct Gemm { const bf16_t* A; const bf16_t* Bt; int M, N, K; int lda, ldb; int pn_per_batch; int a_batch_elems; };
struct StaticOrder {
  int nM, nN, nwg, G, c;
  __device__ void init(int M, int N, int G_, int c_) { nM = M / BM; nN = N / BM; nwg = nM * nN; G = G_; c = c_; }
  __device__ bool next(int i, Unit& u) const {
    const long L = (long)i * G + c; if (L >= nwg) return false;
    int wgid = (int)L; { const int q = nwg / NXCD, r = nwg % NXCD, xcd = wgid % NXCD, off = wgid / NXCD; wgid = (xcd < r ? xcd * (q + 1) : r * (q + 1) + (xcd - r) * q) + off; }
    const int nig = WGM * nN, gid = wgid / nig, fm = gid * WGM, gsz = (nM - fm) < WGM ? (nM - fm) : WGM;
    u.pm = fm + ((wgid % nig) % gsz); u.pn = (wgid % nig) / gsz; return true;
  }
};
template <int MODE> struct EpiAdapter {
  static constexpr bool PERM = true;
  EpiArgs e; int nb_cols;
  __device__ __forceinline__ void operator()(const f32x4 (&acc)[2][2][4][2], const Unit& u, int wr, int wc, int fr, int fq) const {
    if constexpr (MODE == E_RES) {
      bf16_t* X = (bf16_t*)(e.ws + WS_X);
#pragma unroll
      for (int ai = 0; ai < 2; ++ai) { u32x4 rw[4][2];
#pragma unroll
        for (int m = 0; m < 4; ++m)
#pragma unroll
          for (int bj = 0; bj < 2; ++bj) rw[m][bj] = *(const u32x4*)(X + (size_t)(u.pm * BM + ai * HALF + wr * 64 + m * 16 + fr) * DM + u.pn * BM + bj * HALF + wc * 32 + 8 * fq);
#pragma unroll
        for (int m = 0; m < 4; ++m)
#pragma unroll
          for (int bj = 0; bj < 2; ++bj) { const u32x4 w = rw[m][bj]; const f32x4 a0 = acc[ai][bj][m][0], a1 = acc[ai][bj][m][1];
            st8(X + (size_t)(u.pm * BM + ai * HALF + wr * 64 + m * 16 + fr) * DM + u.pn * BM + bj * HALF + wc * 32 + 8 * fq,
                (f32x4){DN_ALPHA * bflo(w.x) + a0[0], DN_ALPHA * bfhi(w.x) + a0[1], DN_ALPHA * bflo(w.y) + a0[2], DN_ALPHA * bfhi(w.y) + a0[3]},
                (f32x4){DN_ALPHA * bflo(w.z) + a1[0], DN_ALPHA * bfhi(w.z) + a1[1], DN_ALPHA * bflo(w.w) + a1[2], DN_ALPHA * bfhi(w.w) + a1[3]}); }
        asm volatile("" ::: "memory"); }
      return;
    }
#pragma unroll
    for (int ai = 0; ai < 2; ++ai)
#pragma unroll
      for (int m = 0; m < 4; ++m) { const int row = u.pm * BM + ai * HALF + wr * 64 + m * 16 + fr;
#pragma unroll
        for (int bj = 0; bj < 2; ++bj) { const int colg = u.pn * BM + bj * HALF + wc * 32 + 8 * fq; const int batch = colg / nb_cols; const int col = colg - batch * nb_cols;
          epi8<MODE>(e, batch, row, col, acc[ai][bj][m][0], acc[ai][bj][m][1]); }
        asm volatile("" ::: "memory"); }
  }
};
template <class Epi>
__device__ __forceinline__ void gemm_phase(PG8_LAS unsigned char* lds, const Gemm g, const StaticOrder& S, const Epi& E) {
  int tid_ = threadIdx.x; asm volatile("" : "+v"(tid_));
  const int tid = tid_, wid = __builtin_amdgcn_readfirstlane(tid >> 6), lane = tid & 63, wr = wid >> 2, wc = wid & 3, fr = lane & 15, fq = lane >> 4;
  const int K = g.K, nt = K / BK;
  unsigned voffA[2], voffB[2];
#pragma unroll
  for (int i = 0; i < 2; ++i) { int R, C; stage_rc(tid * 16 + i * 8192, R, C); const int Rb = Epi::PERM ? ((R & ~31) + perm32(R & 31)) : R; voffA[i] = (unsigned)(R * g.lda + C) * 2u; voffB[i] = (unsigned)(Rb * g.ldb + C) * 2u; }
  const size_t kstep = (size_t)(BK * 2);
  const size_t hstepA = (size_t)HALF * g.lda * 2, hstepB = (size_t)HALF * g.ldb * 2;
  const size_t tstepA = 2 * hstepA, tstepB = 2 * hstepB;
  const unsigned ldsw = (unsigned)wid * 1024u;
  const int aoff = lds_byte(wr * 64 + fr, fq * 8), boff = lds_byte(wc * 32 + fr, fq * 8);
#define PG8_SA(b, h) (((b) * 2 + (h)) * HTB)
#define PG8_SB(b, h) ((4 + (b) * 2 + (h)) * HTB)
#define PG8_STAGE(bufoff, gbase, voff) do { _Pragma("unroll") for (int _i = 0; _i < 2; ++_i) \
    __builtin_amdgcn_global_load_lds((const unsigned*)((const char*)(gbase) + (voff)[_i]), (PG8_LAS unsigned*)(lds + (bufoff) + ldsw + _i * 8192), 16, 0, 0); } while (0)
#define PG8_LDA(dst, b, h) do { _Pragma("unroll") for (int m = 0; m < 4; ++m) _Pragma("unroll") for (int k = 0; k < 2; ++k) dst[m][k] = *(const PG8_LAS bf16x8*)(lds + PG8_SA(b, h) + aoff + m * 2048 + k * 1024); } while (0)
#define PG8_LDB(dst, b, h) do { _Pragma("unroll") for (int n = 0; n < 2; ++n) _Pragma("unroll") for (int k = 0; k < 2; ++k) dst[n][k] = *(const PG8_LAS bf16x8*)(lds + PG8_SB(b, h) + boff + n * 2048 + k * 1024); } while (0)
#define PG8_MMA(ai, bj, At, Bt) do { __builtin_amdgcn_s_setprio(1); _Pragma("unroll") for (int m = 0; m < 4; ++m) _Pragma("unroll") for (int n = 0; n < 2; ++n) _Pragma("unroll") for (int k = 0; k < 2; ++k) \
    acc[ai][bj][m][n] = __builtin_amdgcn_mfma_f32_16x16x32_bf16(Bt[n][k], At[m][k], acc[ai][bj][m][n], 0, 0, 0); __builtin_amdgcn_s_setprio(0); } while (0)
#define PG8_WAIT_V(n) asm volatile("s_waitcnt vmcnt(" #n ")" ::: "memory")
#define PG8_WAIT_L(n) asm volatile("s_waitcnt lgkmcnt(" #n ")" ::: "memory")
#define PG8_BAR __builtin_amdgcn_s_barrier()
#define PG8_SCHED __builtin_amdgcn_sched_barrier(0)
#define PG8_APTR(u) ((const char*)g.A + (size_t)(u).pm * tstepA + (size_t)((u).pn / g.pn_per_batch) * g.a_batch_elems * 2)
#define PG8_BPTR(u) ((const char*)g.Bt + (size_t)(u).pn * tstepB)
  Unit cur, nxt; int ui = 0;
  if (!S.next(0, cur)) return;
  f32x4 acc[2][2][4][2];
#pragma unroll
  for (int a = 0; a < 2; ++a)
#pragma unroll
    for (int b = 0; b < 2; ++b)
#pragma unroll
      for (int m = 0; m < 4; ++m)
#pragma unroll
        for (int n = 0; n < 2; ++n) acc[a][b][m][n] = (f32x4){0.f, 0.f, 0.f, 0.f};
  bf16x8 At[4][2], B0[2][2], B1[2][2];
  const char* cA = PG8_APTR(cur); const char* cB = PG8_BPTR(cur);
  PG8_STAGE(PG8_SB(0, 0), cB, voffB); PG8_STAGE(PG8_SB(0, 1), cB + hstepB, voffB); PG8_STAGE(PG8_SA(0, 0), cA, voffA); PG8_STAGE(PG8_SA(0, 1), cA + hstepA, voffA);
  if (wr == 1) PG8_BAR;
  PG8_WAIT_V(2); PG8_BAR;
  PG8_STAGE(PG8_SB(1, 0), cB + kstep, voffB); PG8_STAGE(PG8_SA(1, 0), cA + kstep, voffA); PG8_STAGE(PG8_SB(1, 1), cB + hstepB + kstep, voffB);
  PG8_WAIT_V(6); PG8_BAR;
  for (;;) {
    const bool has_next = S.next(ui + 1, nxt);
    const char* nA = has_next ? PG8_APTR(nxt) : cA; const char* nB = has_next ? PG8_BPTR(nxt) : cB;
    for (int t = 0; t < nt; t += 2) {
      const bool last = (t == nt - 2);
      const char* a1 = cA + (size_t)(t + 1) * kstep;
      const char* a2 = last ? nA : cA + (size_t)(t + 2) * kstep; const char* b2 = last ? nB : cB + (size_t)(t + 2) * kstep;
      const char* a3 = a2 + kstep; const char* b3 = b2 + kstep;
      PG8_LDB(B0, 0, 0); PG8_LDB(B1, 0, 1); PG8_SCHED; PG8_LDA(At, 0, 0); PG8_STAGE(PG8_SA(1, 1), a1 + hstepA, voffA);
      PG8_WAIT_V(8); PG8_WAIT_L(0); PG8_BAR; PG8_MMA(0, 0, At, B0); PG8_MMA(0, 1, At, B1); PG8_BAR; PG8_SCHED;
      PG8_LDA(At, 0, 1); PG8_STAGE(PG8_SB(0, 0), b2, voffB); PG8_STAGE(PG8_SB(0, 1), b2 + hstepB, voffB); PG8_STAGE(PG8_SA(0, 0), a2, voffA);
      PG8_WAIT_V(8); PG8_WAIT_L(0); PG8_BAR; PG8_MMA(1, 0, At, B0); PG8_MMA(1, 1, At, B1); PG8_BAR; PG8_SCHED;
      PG8_LDB(B0, 1, 0); PG8_LDB(B1, 1, 1); PG8_SCHED; PG8_LDA(At, 1, 0); PG8_STAGE(PG8_SA(0, 1), a2 + hstepA, voffA);
      PG8_WAIT_V(8); PG8_WAIT_L(0); PG8_BAR; PG8_MMA(0, 0, At, B0); PG8_MMA(0, 1, At, B1); PG8_BAR; PG8_SCHED;
      PG8_LDA(At, 1, 1); PG8_STAGE(PG8_SB(1, 0), b3, voffB); PG8_STAGE(PG8_SB(1, 1), b3 + hstepB, voffB); PG8_STAGE(PG8_SA(1, 0), a3, voffA);
      PG8_WAIT_V(8); PG8_WAIT_L(0); PG8_BAR; PG8_MMA(1, 0, At, B0); PG8_MMA(1, 1, At, B1); PG8_BAR; PG8_SCHED;
    }
    if (wr == 0) PG8_BAR;
    E(acc, cur, wr, wc, fr, fq);
    if (!has_next) break;
#pragma unroll
    for (int a = 0; a < 2; ++a)
#pragma unroll
      for (int b = 0; b < 2; ++b)
#pragma unroll
        for (int m = 0; m < 4; ++m)
#pragma unroll
          for (int n = 0; n < 2; ++n) acc[a][b][m][n] = (f32x4){0.f, 0.f, 0.f, 0.f};
    cur = nxt; cA = nA; cB = nB; ++ui;
    if (wr == 1) PG8_BAR;
  }
  PG8_WAIT_V(0);
  PG8_BAR;
#undef PG8_SA
#undef PG8_SB
#undef PG8_STAGE
#undef PG8_LDA
#undef PG8_LDB
#undef PG8_MMA
#undef PG8_WAIT_V
#undef PG8_WAIT_L
#undef PG8_BAR
#undef PG8_SCHED
#undef PG8_APTR
#undef PG8_BPTR
}
}
template <int MODE> __device__ __forceinline__ void gemm_fast(const GemmArgs& g, const EpiArgs& e, unsigned char* lds_raw, int bid_, int nblk) {
  const int bid = (bid_ + g.rot) % nblk;
  pg8::Gemm G{g.A, g.Bt, g.M, g.N * g.nbatch, g.K, (int)g.lda, (int)g.ldb, g.nbatch > 1 ? g.N / 256 : (1 << 30), (int)g.a_batch};
  pg8::StaticOrder S; S.init(G.M, G.N, nblk, bid);
  pg8::EpiAdapter<MODE> E{e, g.N};
  pg8::gemm_phase<pg8::EpiAdapter<MODE>>((PG8_LAS unsigned char*)lds_raw, G, S, E);
}

__device__ __forceinline__ void phase1b(const Params& p, int gw, int ngw, int lane) {
  unsigned char* ws = p.ws;
  bf16_t* CQ = (bf16_t*)(ws + WS_CQ); bf16_t* CKV = (bf16_t*)(ws + WS_CKV); const bf16_t* KPE = (const bf16_t*)(ws + WS_KPE);
  bf16_t* Kd = (bf16_t*)((unsigned char*)p.out + DO_K); const bf16_t* LX = (const bf16_t*)(ws + WS_LRUX); bf16_t* XC = (bf16_t*)(ws + WS_XC);
  const float* ct = (const float*)(ws + WS_COS); const float* st = (const float*)(ws + WS_SIN);
  for (int r = gw; r < T_; r += ngw) {
#pragma unroll
    for (int which = 0; which < 2; ++which) {
      bf16_t* row = (which ? CKV : CQ) + (size_t)r * 512 + lane * 8; const float* g = p.in[which ? 8 : 6] + lane * 8;
      float f[8]; unpack8(*(const u32x4*)row, f); float q = 0.f;
#pragma unroll
      for (int i = 0; i < 8; ++i) q += f[i] * f[i];
      const float sc = rsqrtf(dpp_sum64(q) * (1.f / 512.f) + RMS_EPS);
#pragma unroll
      for (int i = 0; i < 8; ++i) f[i] = f[i] * sc * g[i];
      *(u32x4*)row = pack8(f);
    }
    {
      if (lane < 32) { const unsigned w = *(const unsigned*)(KPE + (size_t)r * 64 + 2 * lane); const float t1 = bflo(w), t2 = bfhi(w);
        const float c = ct[(size_t)r * 32 + lane], s = st[(size_t)r * 32 + lane]; const unsigned o = pk2(t1 * c - t2 * s, t2 * c + t1 * s);
#pragma unroll
        for (int h = 0; h < 8; ++h) *(unsigned*)(Kd + (size_t)r * 1536 + h * 192 + 128 + 2 * lane) = o; } }
    if (!USE_LRU_FUSED) {
      const int s = r & (S_ - 1); float acc[16];
      const float* cb = p.in[11] + lane * 16;
#pragma unroll
      for (int i = 0; i < 16; ++i) acc[i] = cb[i];
#pragma unroll
      for (int k = 0; k < 4; ++k) { const int sp = s + k - 2; if (sp < 0 || sp >= S_) continue;
        const bf16_t* src = LX + (size_t)(r + k - 2) * 1024 + lane * 16; const float* w = p.in[10] + k * 1024 + lane * 16;
        float f[16]; unpack8(*(const u32x4*)src, f); unpack8(*(const u32x4*)(src + 8), f + 8);
#pragma unroll
        for (int i = 0; i < 16; ++i) acc[i] += f[i] * w[i]; }
      *(u32x4*)(XC + (size_t)r * 1024 + lane * 16) = pack8(acc); *(u32x4*)(XC + (size_t)r * 1024 + lane * 16 + 8) = pack8(acc + 8);
    }
  }
}

template <int DQK, int NK> __device__ __forceinline__ void attn_scalar(const bf16_t* Q, int ldq, const bf16_t* K, int ldk, const bf16_t* V, int ldv, bf16_t* O, int ldo,
                                                                      int nheads, float scale, float* lds, int bid, int nblk, int tid) {
  float* sc = lds; float* qs = lds + 16 * NK; float* ls = qs + 16 * DQK;
  const int lane = tid & 63, wave = tid >> 6;
  const int units = NB_ * nheads * (S_ / 16);
  for (int u = bid; u < units; u += nblk) {
    const int qb = u % (S_ / 16), h = (u / (S_ / 16)) % nheads, b = u / ((S_ / 16) * nheads);
    __syncthreads();
    for (int i = tid; i < 16 * DQK; i += NTHR) { const int r = i / DQK, d = i % DQK; qs[i] = bf2f(Q[(size_t)(b * S_ + qb * 16 + r) * ldq + h * DQK + d]) * scale; }
    __syncthreads();
    for (int kk = tid; kk < NK; kk += NTHR) {
      const bf16_t* kp = K + (size_t)(b * NK + kk) * ldk + h * DQK; float acc[16];
#pragma unroll
      for (int r = 0; r < 16; ++r) acc[r] = 0.f;
      for (int d0 = 0; d0 < DQK; d0 += 8) { float kf[8]; unpack8(*(const u32x4*)(kp + d0), kf);
#pragma unroll
        for (int r = 0; r < 16; ++r) { const f32x4 q0 = *(const f32x4*)(qs + r * DQK + d0), q1 = *(const f32x4*)(qs + r * DQK + d0 + 4);
          acc[r] += q0[0] * kf[0] + q0[1] * kf[1] + q0[2] * kf[2] + q0[3] * kf[3] + q1[0] * kf[4] + q1[1] * kf[5] + q1[2] * kf[6] + q1[3] * kf[7]; } }
#pragma unroll
      for (int r = 0; r < 16; ++r) sc[r * NK + kk] = acc[r];
    }
    __syncthreads();
    for (int rr = 0; rr < 2; ++rr) { const int r = wave * 2 + rr; float m = -1e30f;
      for (int kk = lane; kk < NK; kk += 64) m = fmaxf(m, sc[r * NK + kk]);
      m = wave_max(m); float l = 0.f;
      for (int kk = lane; kk < NK; kk += 64) { const float pv = __expf(sc[r * NK + kk] - m); sc[r * NK + kk] = pv; l += pv; }
      l = wave_sum(l); if (lane == 0) ls[r] = l; }
    __syncthreads();
    { const int r = tid >> 5, d4 = (tid & 31) * 4; float a0 = 0.f, a1 = 0.f, a2 = 0.f, a3 = 0.f;
      const bf16_t* vp = V + (size_t)(b * NK) * ldv + h * 128 + d4;
      for (int kk = 0; kk < NK; ++kk) { const float pv = sc[r * NK + kk]; const u32x2 w = *(const u32x2*)(vp + (size_t)kk * ldv);
        a0 += pv * bflo(w.x); a1 += pv * bfhi(w.x); a2 += pv * bflo(w.y); a3 += pv * bfhi(w.y); }
      const float il = 1.f / ls[r];
      st4(O + (size_t)(b * S_ + qb * 16 + r) * ldo + h * 128 + d4, (f32x4){a0 * il, a1 * il, a2 * il, a3 * il}); }
  }
  __syncthreads();
}


namespace fa {
typedef short s16x4 __attribute__((ext_vector_type(4)));
constexpr int NW = 8, QBLK = 32, KVBLK = 64;
constexpr float THR = 8.f;
#define FA_SBAR() __builtin_amdgcn_sched_barrier(0)
__device__ __forceinline__ int crow(int r, int hi) { return (r & 3) + 8 * (r >> 2) + 4 * hi; }
__device__ __forceinline__ unsigned cvtpk(float lo, float hi) { unsigned r; asm volatile("v_cvt_pk_bf16_f32 %0, %1, %2" : "=v"(r) : "v"(lo), "v"(hi)); return r; }
__device__ __forceinline__ void partialSM(f32x16& p0, f32x16& p1, float& m_reg, float& mn, float& alpha, const float C, const float thr_s) {
  float pmax = p0[0];
#pragma unroll
  for (int r = 1; r < 16; ++r) pmax = fmaxf(pmax, p0[r]);
#pragma unroll
  for (int r = 0; r < 16; ++r) pmax = fmaxf(pmax, p1[r]);
  { auto rr = __builtin_amdgcn_permlane32_swap(__float_as_uint(pmax), __float_as_uint(pmax), false, false);
    pmax = fmaxf(__uint_as_float(rr[0]), __uint_as_float(rr[1])); }
  if (__builtin_expect(__all(pmax - m_reg <= thr_s), 1)) { mn = m_reg; alpha = 1.f; }
  else { mn = fmaxf(m_reg, pmax); alpha = __builtin_amdgcn_exp2f((m_reg - mn) * C); m_reg = mn; }
  const float mnC = -mn * C;
#pragma unroll
  for (int r = 0; r < 16; ++r) p0[r] = fmaf(p0[r], C, mnC);
#pragma unroll
  for (int r = 0; r < 16; ++r) p1[r] = fmaf(p1[r], C, mnC);
#pragma unroll
  for (int r = 0; r < 16; ++r) p0[r] = __builtin_amdgcn_exp2f(p0[r]);
}
__device__ __forceinline__ void finishSM(f32x16& p0, f32x16& p1, float alpha, float& l_reg, bf16x8& pa0, bf16x8& pa1, bf16x8& pa2, bf16x8& pa3) {
#pragma unroll
  for (int r = 0; r < 16; ++r) p1[r] = __builtin_amdgcn_exp2f(p1[r]);
  float ps = 0;
#pragma unroll
  for (int r = 0; r < 16; ++r) ps += p0[r];
#pragma unroll
  for (int r = 0; r < 16; ++r) ps += p1[r];
  { auto rr = __builtin_amdgcn_permlane32_swap(__float_as_uint(ps), __float_as_uint(ps), false, false);
    ps = __uint_as_float(rr[0]) + __uint_as_float(rr[1]); }
  l_reg = l_reg * alpha + ps;
#define FA_PK4(P, BASE, OUT) do { unsigned a0 = cvtpk(P[BASE + 0], P[BASE + 1]), a1 = cvtpk(P[BASE + 2], P[BASE + 3]);   \
    unsigned b0 = cvtpk(P[BASE + 4], P[BASE + 5]), b1 = cvtpk(P[BASE + 6], P[BASE + 7]);                              \
    auto r0 = __builtin_amdgcn_permlane32_swap(a0, b0, false, false); auto r1 = __builtin_amdgcn_permlane32_swap(a1, b1, false, false); \
    u32x4 w = {r0[0], r1[0], r0[1], r1[1]}; OUT = *reinterpret_cast<bf16x8*>(&w); } while (0)
  FA_PK4(p0, 0, pa0); FA_PK4(p0, 8, pa1); FA_PK4(p1, 0, pa2); FA_PK4(p1, 8, pa3);
#undef FA_PK4
}
template <int DQK> constexpr int krs() { return DQK == 192 ? 400 : DQK * 2; }
template <int DQK> __device__ __forceinline__ int kswz(int row, int colB) { return DQK == 192 ? row * 400 + colB : row * (DQK * 2) + (colB ^ ((row & 7) << 4)); }
template <int DQK> __device__ __forceinline__ void qkt(f32x16& p0, f32x16& p1, const char* Ks, const bf16x8* qr, const int* kb4) {
  p0 = f32x16{}; p1 = f32x16{};
#pragma unroll
  for (int d0 = 0; d0 < DQK / 16; ++d0) {
    const bf16x8 b0 = *reinterpret_cast<const bf16x8*>(Ks + kb4[d0 & 3] + (d0 >> 2) * 128);
    const bf16x8 b1 = *reinterpret_cast<const bf16x8*>(Ks + kb4[d0 & 3] + (d0 >> 2) * 128 + 32 * krs<DQK>());
    p0 = __builtin_amdgcn_mfma_f32_32x32x16_bf16(b0, qr[d0], p0, 0, 0, 0);
    p1 = __builtin_amdgcn_mfma_f32_32x32x16_bf16(b1, qr[d0], p1, 0, 0, 0); }
}
__device__ __forceinline__ int v_st(int k, int c) { const int kk = (k & ~0xC) | ((k & 4) << 1) | ((k & 8) >> 1); return ((kk >> 3) * 4 + (c >> 5)) * 512 + ((kk & 7) * 32 + (c & 31)) * 2; }
__device__ __forceinline__ int v_rd_base(int lane) { return ((lane & 3) << 3) | (((lane >> 2) & 3) << 6) | (((lane >> 4) & 1) << 5) | (((lane >> 5) & 1) << 8); }
constexpr int v_rd_off(int d0, int ks, int half) { return d0 * 512 + ks * 4096 + half * 2048; }
template <int OFF> __device__ __forceinline__ s16x4 tr_read(int vb) {
  s16x4 r; asm volatile("ds_read_b64_tr_b16 %0, %1 offset:%2" : "=&v"(r) : "v"(vb), "i"(OFF) : "memory"); return r;
}
template <int D0> __device__ __forceinline__ void pv_one(f32x16& od, int vb, bf16x8 pa0, bf16x8 pa1, bf16x8 pa2, bf16x8 pa3) {
  const s16x4 l0 = tr_read<v_rd_off(D0, 0, 0)>(vb), h0 = tr_read<v_rd_off(D0, 0, 1)>(vb), l1 = tr_read<v_rd_off(D0, 1, 0)>(vb), h1 = tr_read<v_rd_off(D0, 1, 1)>(vb);
  const s16x4 l2 = tr_read<v_rd_off(D0, 2, 0)>(vb), h2 = tr_read<v_rd_off(D0, 2, 1)>(vb), l3 = tr_read<v_rd_off(D0, 3, 0)>(vb), h3 = tr_read<v_rd_off(D0, 3, 1)>(vb);
  asm volatile("s_waitcnt lgkmcnt(0)" ::: "memory"); FA_SBAR();
#define FA_PK(L, H) (bf16x8){L[0], L[1], L[2], L[3], H[0], H[1], H[2], H[3]}
  od = __builtin_amdgcn_mfma_f32_32x32x16_bf16(pa0, FA_PK(l0, h0), od, 0, 0, 0);
  od = __builtin_amdgcn_mfma_f32_32x32x16_bf16(pa1, FA_PK(l1, h1), od, 0, 0, 0);
  od = __builtin_amdgcn_mfma_f32_32x32x16_bf16(pa2, FA_PK(l2, h2), od, 0, 0, 0);
  od = __builtin_amdgcn_mfma_f32_32x32x16_bf16(pa3, FA_PK(l3, h3), od, 0, 0, 0);
#undef FA_PK
}
__device__ __forceinline__ void pv_d0(f32x16* o, int vb, bf16x8 pa0, bf16x8 pa1, bf16x8 pa2, bf16x8 pa3) {
  pv_one<0>(o[0], vb, pa0, pa1, pa2, pa3); pv_one<1>(o[1], vb, pa0, pa1, pa2, pa3); pv_one<2>(o[2], vb, pa0, pa1, pa2, pa3); pv_one<3>(o[3], vb, pa0, pa1, pa2, pa3);
}
template <int DQK, int LDQ, int LDK, int LDV, int LDO>
__device__ __forceinline__ void attn_body(const bf16_t* __restrict__ Qb, const bf16_t* __restrict__ Kh, const bf16_t* __restrict__ Vh, bf16_t* __restrict__ Ob, int seq, float scale, char* lds) {
  constexpr int SHM_V = KVBLK * 128 * 2, SHM_K = KVBLK * krs<DQK>(), NKC = DQK / 64;
  const float C = scale * 1.4426950408889634f, thr_s = THR / scale;
  int tid_ = threadIdx.x; asm volatile("" : "+v"(tid_));
  const int tid = tid_, wid = tid >> 6, lane = tid & 63, r32 = lane & 31, hi = lane >> 5;
  char* V_lds = lds; char* K_lds = lds + 2 * SHM_V;
  float* wsf = (float*)(lds + 2 * SHM_V + 2 * SHM_K) + wid * 64; float* li_l = wsf; float* al_l = wsf + 32;
  float m_reg = -1e30f, l_reg = 0; f32x16 o[4] = {}; bf16x8 qr[DQK / 16];
  const bf16_t* Qw = Qb + (size_t)(wid * QBLK + r32) * LDQ + hi * 8;
#pragma unroll
  for (int d0 = 0; d0 < DQK / 16; ++d0) qr[d0] = *reinterpret_cast<const bf16x8*>(Qw + d0 * 16);
  const int sr = tid >> 4, sc = (tid & 15) * 8, vst0 = v_st(sr, sc), vst1 = v_st(32 + sr, sc);
  const int kgo0 = sr * LDK + sc, klo0 = kswz<DQK>(sr, sc * 2);
  const int kgo2 = (tid >> 3) * LDK + 128 + (tid & 7) * 8, klo2 = kswz<DQK>(tid >> 3, (128 + (tid & 7) * 8) * 2);
  const int vb0 = (int)(uintptr_t)V_lds + v_rd_base(lane);
  int kb4[4];
#pragma unroll
  for (int q = 0; q < 4; ++q) kb4[q] = kswz<DQK>(r32, q * 32 + hi * 16);
  bf16x8 vs0, vs1, ks[NKC];
#define FA_SLOAD(k0) do { vs0 = *reinterpret_cast<const bf16x8*>(&Vh[(size_t)((k0) + sr) * LDV + sc]); vs1 = *reinterpret_cast<const bf16x8*>(&Vh[(size_t)((k0) + 32 + sr) * LDV + sc]); \
    ks[0] = *reinterpret_cast<const bf16x8*>(&Kh[(size_t)(k0) * LDK + kgo0]); ks[1] = *reinterpret_cast<const bf16x8*>(&Kh[(size_t)((k0) + 32) * LDK + kgo0]); \
    if constexpr (NKC == 3) ks[NKC - 1] = *reinterpret_cast<const bf16x8*>(&Kh[(size_t)(k0) * LDK + kgo2]); } while (0)
#define FA_SWRITE(b) do { *(bf16x8*)(V_lds + (b) * SHM_V + vst0) = vs0; *(bf16x8*)(V_lds + (b) * SHM_V + vst1) = vs1; \
    *(bf16x8*)(K_lds + (b) * SHM_K + klo0) = ks[0]; *(bf16x8*)(K_lds + (b) * SHM_K + klo0 + 32 * krs<DQK>()) = ks[1]; \
    if constexpr (NKC == 3) *(bf16x8*)(K_lds + (b) * SHM_K + klo2) = ks[NKC - 1]; } while (0)
#define FA_SWAIT() asm volatile("s_waitcnt vmcnt(0)" ::: "memory")
#define FA_RESC(a) do { if (__any((a) < 1.f)) { if (hi == 0) al_l[r32] = (a); asm volatile("s_waitcnt lgkmcnt(0)" ::: "memory"); \
    _Pragma("unroll") for (int d = 0; d < 4; ++d) _Pragma("unroll") for (int r = 0; r < 16; ++r) o[d][r] *= al_l[crow(r, hi)]; } } while (0)
  f32x16 pA0, pA1, pB0, pB1; float mnA, mnB, alA, alB; bf16x8 pa0, pa1, pa2, pa3; const int NT = seq / KVBLK;
  FA_SLOAD(0); FA_SWAIT(); FA_SWRITE(0); __syncthreads();
  qkt<DQK>(pA0, pA1, K_lds, qr, kb4); partialSM(pA0, pA1, m_reg, mnA, alA, C, thr_s);
  FA_SLOAD(KVBLK);
  FA_SWAIT(); FA_SWRITE(1); __syncthreads();
  for (int j = 1; j + 1 < NT; j += 2) {
    FA_SBAR(); qkt<DQK>(pB0, pB1, K_lds + SHM_K, qr, kb4);
    finishSM(pA0, pA1, alA, l_reg, pa0, pa1, pa2, pa3); FA_SBAR();
    FA_SLOAD((j + 1) * KVBLK); FA_SBAR();
    pv_d0(o, vb0, pa0, pa1, pa2, pa3); partialSM(pB0, pB1, m_reg, mnB, alB, C, thr_s);
    __syncthreads(); FA_SWAIT(); FA_SWRITE(0);
    FA_RESC(alB); __syncthreads();
    FA_SBAR(); qkt<DQK>(pA0, pA1, K_lds, qr, kb4);
    finishSM(pB0, pB1, alB, l_reg, pa0, pa1, pa2, pa3); FA_SBAR();
    FA_SLOAD((j + 2) * KVBLK); FA_SBAR();
    pv_d0(o, vb0 + SHM_V, pa0, pa1, pa2, pa3); partialSM(pA0, pA1, m_reg, mnA, alA, C, thr_s);
    __syncthreads(); FA_SWAIT(); FA_SWRITE(1);
    FA_RESC(alA); __syncthreads();
  }
  FA_SBAR(); qkt<DQK>(pB0, pB1, K_lds + SHM_K, qr, kb4);
  finishSM(pA0, pA1, alA, l_reg, pa0, pa1, pa2, pa3); FA_SBAR();
  pv_d0(o, vb0, pa0, pa1, pa2, pa3); partialSM(pB0, pB1, m_reg, mnB, alB, C, thr_s);
  __syncthreads(); FA_RESC(alB);
  finishSM(pB0, pB1, alB, l_reg, pa0, pa1, pa2, pa3); FA_SBAR();
  pv_d0(o, vb0 + SHM_V, pa0, pa1, pa2, pa3);
  if (hi == 0) li_l[r32] = l_reg; asm volatile("s_waitcnt lgkmcnt(0)" ::: "memory");
  float rli[16];
#pragma unroll
  for (int r = 0; r < 16; ++r) rli[r] = __builtin_amdgcn_rcpf(li_l[crow(r, hi)]);
  bf16_t* Ow = Ob + (size_t)(wid * QBLK) * LDO;
#pragma unroll
  for (int r = 0; r < 16; ++r) { const int orow = crow(r, hi);
#pragma unroll
    for (int d0 = 0; d0 < 4; ++d0) Ow[(size_t)orow * LDO + d0 * 32 + r32] = (bf16_t)f2bf(o[d0][r] * rli[r]); }
  __syncthreads();
#undef FA_SLOAD
#undef FA_SWRITE
#undef FA_SWAIT
#undef FA_RESC
}
template <int DQK, int LDQ, int LDK, int LDV, int LDO>
__device__ __forceinline__ void attn_body3(const bf16_t* __restrict__ Qb, const bf16_t* __restrict__ Kh, const bf16_t* __restrict__ Vh, bf16_t* __restrict__ Ob, int seq, float scale, char* lds) {
  constexpr int SHM_V = KVBLK * 128 * 2, SHM_K = KVBLK * krs<DQK>(), NKC = DQK / 64;
  const float C = scale * 1.4426950408889634f, thr_s = THR / scale;
  int tid_ = threadIdx.x; asm volatile("" : "+v"(tid_));
  const int tid = tid_, wid = tid >> 6, lane = tid & 63, r32 = lane & 31, hi = lane >> 5;
  char* V_lds = lds; char* K_lds = lds + 3 * SHM_V;
  float* wsf = (float*)(lds + 3 * SHM_V + 3 * SHM_K) + wid * 64; float* li_l = wsf; float* al_l = wsf + 32;
  float m_reg = -1e30f, l_reg = 0; f32x16 o[4] = {}; bf16x8 qr[DQK / 16];
  const bf16_t* Qw = Qb + (size_t)(wid * QBLK + r32) * LDQ + hi * 8;
#pragma unroll
  for (int d0 = 0; d0 < DQK / 16; ++d0) qr[d0] = *reinterpret_cast<const bf16x8*>(Qw + d0 * 16);
  const int sr = tid >> 4, sc = (tid & 15) * 8, vst0 = v_st(sr, sc), vst1 = v_st(32 + sr, sc);
  const int kgo0 = sr * LDK + sc, klo0 = kswz<DQK>(sr, sc * 2);
  const int kgo2 = (tid >> 3) * LDK + 128 + (tid & 7) * 8, klo2 = kswz<DQK>(tid >> 3, (128 + (tid & 7) * 8) * 2);
  const int vb0 = (int)(uintptr_t)V_lds + v_rd_base(lane);
  int kb4[4];
#pragma unroll
  for (int q = 0; q < 4; ++q) kb4[q] = kswz<DQK>(r32, q * 32 + hi * 16);
  bf16x8 vs0, vs1, ks[NKC];
#define FA_SLOAD(k0) do { vs0 = *reinterpret_cast<const bf16x8*>(&Vh[(size_t)((k0) + sr) * LDV + sc]); vs1 = *reinterpret_cast<const bf16x8*>(&Vh[(size_t)((k0) + 32 + sr) * LDV + sc]); \
    ks[0] = *reinterpret_cast<const bf16x8*>(&Kh[(size_t)(k0) * LDK + kgo0]); ks[1] = *reinterpret_cast<const bf16x8*>(&Kh[(size_t)((k0) + 32) * LDK + kgo0]); \
    if constexpr (NKC == 3) ks[NKC - 1] = *reinterpret_cast<const bf16x8*>(&Kh[(size_t)(k0) * LDK + kgo2]); } while (0)
#define FA_SWRITE(b) do { *(bf16x8*)(V_lds + (b) * SHM_V + vst0) = vs0; *(bf16x8*)(V_lds + (b) * SHM_V + vst1) = vs1; \
    *(bf16x8*)(K_lds + (b) * SHM_K + klo0) = ks[0]; *(bf16x8*)(K_lds + (b) * SHM_K + klo0 + 32 * krs<DQK>()) = ks[1]; \
    if constexpr (NKC == 3) *(bf16x8*)(K_lds + (b) * SHM_K + klo2) = ks[NKC - 1]; } while (0)
#define FA_SWAIT() asm volatile("s_waitcnt vmcnt(0)" ::: "memory")
#define FA_RESC(a) do { if (__any((a) < 1.f)) { if (hi == 0) al_l[r32] = (a); asm volatile("s_waitcnt lgkmcnt(0)" ::: "memory"); \
    _Pragma("unroll") for (int d = 0; d < 4; ++d) _Pragma("unroll") for (int r = 0; r < 16; ++r) o[d][r] *= al_l[crow(r, hi)]; } } while (0)
  f32x16 pA0, pA1, pB0, pB1; float mnA, mnB, alA, alB; bf16x8 pa0, pa1, pa2, pa3; const int NT = seq / KVBLK;
  FA_SLOAD(0); FA_SWAIT(); FA_SWRITE(0); __syncthreads();
  qkt<DQK>(pA0, pA1, K_lds, qr, kb4); partialSM(pA0, pA1, m_reg, mnA, alA, C, thr_s);
  FA_SLOAD(KVBLK);
  FA_SWAIT(); FA_SWRITE(1); __syncthreads();
  int bk = 1, bv = 0, bw = 2;
#define FA_ROT() do { const int t_ = bv; bv = bk; bk = bw; bw = t_; } while (0)
  for (int j = 1; j + 1 < NT; j += 2) {
    FA_SBAR(); qkt<DQK>(pB0, pB1, K_lds + bk * SHM_K, qr, kb4);
    finishSM(pA0, pA1, alA, l_reg, pa0, pa1, pa2, pa3); FA_SBAR();
    FA_SLOAD((j + 1) * KVBLK); FA_SBAR();
    pv_d0(o, vb0 + bv * SHM_V, pa0, pa1, pa2, pa3); partialSM(pB0, pB1, m_reg, mnB, alB, C, thr_s);
    FA_SWAIT(); FA_SWRITE(bw);
    FA_RESC(alB); __syncthreads(); FA_ROT();
    FA_SBAR(); qkt<DQK>(pA0, pA1, K_lds + bk * SHM_K, qr, kb4);
    finishSM(pB0, pB1, alB, l_reg, pa0, pa1, pa2, pa3); FA_SBAR();
    FA_SLOAD((j + 2) * KVBLK); FA_SBAR();
    pv_d0(o, vb0 + bv * SHM_V, pa0, pa1, pa2, pa3); partialSM(pA0, pA1, m_reg, mnA, alA, C, thr_s);
    FA_SWAIT(); FA_SWRITE(bw);
    FA_RESC(alA); __syncthreads(); FA_ROT();
  }
  FA_SBAR(); qkt<DQK>(pB0, pB1, K_lds + bk * SHM_K, qr, kb4);
  finishSM(pA0, pA1, alA, l_reg, pa0, pa1, pa2, pa3); FA_SBAR();
  pv_d0(o, vb0 + bv * SHM_V, pa0, pa1, pa2, pa3); partialSM(pB0, pB1, m_reg, mnB, alB, C, thr_s);
  FA_RESC(alB);
  finishSM(pB0, pB1, alB, l_reg, pa0, pa1, pa2, pa3); FA_SBAR();
  pv_d0(o, vb0 + bk * SHM_V, pa0, pa1, pa2, pa3);
#undef FA_ROT
  if (hi == 0) li_l[r32] = l_reg; asm volatile("s_waitcnt lgkmcnt(0)" ::: "memory");
  float rli[16];
#pragma unroll
  for (int r = 0; r < 16; ++r) rli[r] = __builtin_amdgcn_rcpf(li_l[crow(r, hi)]);
  bf16_t* Ow = Ob + (size_t)(wid * QBLK) * LDO;
#pragma unroll
  for (int r = 0; r < 16; ++r) { const int orow = crow(r, hi);
#pragma unroll
    for (int d0 = 0; d0 < 4; ++d0) Ow[(size_t)orow * LDO + d0 * 32 + r32] = (bf16_t)f2bf(o[d0][r] * rli[r]); }
  __syncthreads();
#undef FA_SLOAD
#undef FA_SWRITE
#undef FA_SWAIT
#undef FA_RESC
}

template <int S> __device__ __forceinline__ void fin_chunk(f32x16& P0, f32x16& P1, float alpha, float& l_reg, float& ps, bf16x8& pa0, bf16x8& pa1, bf16x8& pa2, bf16x8& pa3) {
  if constexpr (S < 8) { P1[2 * S] = __builtin_amdgcn_exp2f(P1[2 * S]); P1[2 * S + 1] = __builtin_amdgcn_exp2f(P1[2 * S + 1]); }
  else if constexpr (S < 12) { constexpr int k = S - 8; ps += (P0[4 * k] + P0[4 * k + 1]) + (P0[4 * k + 2] + P0[4 * k + 3]); ps += (P1[4 * k] + P1[4 * k + 1]) + (P1[4 * k + 2] + P1[4 * k + 3]); }
  else if constexpr (S == 12) { auto rr = __builtin_amdgcn_permlane32_swap(__float_as_uint(ps), __float_as_uint(ps), false, false); l_reg = l_reg * alpha + (__uint_as_float(rr[0]) + __uint_as_float(rr[1])); }
  else if constexpr (S >= 13 && S <= 16) {
#define FA_PK4(P, BASE, OUT) do { unsigned a0 = cvtpk(P[BASE + 0], P[BASE + 1]), a1 = cvtpk(P[BASE + 2], P[BASE + 3]);   \
    unsigned b0 = cvtpk(P[BASE + 4], P[BASE + 5]), b1 = cvtpk(P[BASE + 6], P[BASE + 7]);                              \
    auto r0 = __builtin_amdgcn_permlane32_swap(a0, b0, false, false); auto r1 = __builtin_amdgcn_permlane32_swap(a1, b1, false, false); \
    u32x4 w = {r0[0], r1[0], r0[1], r1[1]}; OUT = *reinterpret_cast<bf16x8*>(&w); } while (0)
    if constexpr (S == 13) FA_PK4(P0, 0, pa0); else if constexpr (S == 14) FA_PK4(P0, 8, pa1); else if constexpr (S == 15) FA_PK4(P1, 0, pa2); else FA_PK4(P1, 8, pa3);
#undef FA_PK4
  }
}
template <int CH> __device__ __forceinline__ void par_chunk(f32x16& P0, f32x16& P1, float& m_reg, float& alpha, float& pm, float& mnC, const float C, const float thr_s) {
  if constexpr (CH < 8) { f32x16& P = (CH < 4) ? P0 : P1; constexpr int b = 4 * (CH & 3);
    if constexpr (CH == 0) pm = fmaxf(fmaxf(P[0], P[1]), fmaxf(P[2], P[3])); else pm = fmaxf(pm, fmaxf(fmaxf(P[b], P[b + 1]), fmaxf(P[b + 2], P[b + 3]))); }
  else if constexpr (CH == 8) {
    auto rr = __builtin_amdgcn_permlane32_swap(__float_as_uint(pm), __float_as_uint(pm), false, false); pm = fmaxf(__uint_as_float(rr[0]), __uint_as_float(rr[1]));
    const bool ok = __all(pm - m_reg <= thr_s);
    const float mn = ok ? m_reg : fmaxf(m_reg, pm);
    alpha = __builtin_amdgcn_exp2f((m_reg - mn) * C);
    m_reg = mn; mnC = -mn * C; }
  else if constexpr (CH < 13) { constexpr int k = CH - 9; f32x16& P = (k < 2) ? P0 : P1; constexpr int b = 8 * (k & 1);
#pragma unroll
    for (int r = 0; r < 8; ++r) { P[b + r] = fmaf(P[b + r], C, mnC); asm volatile("" : "+v"(P[b + r])); } }
  else { constexpr int lo = (CH == 13) ? 0 : (CH == 14) ? 6 : 11, hi_ = (CH == 13) ? 6 : (CH == 14) ? 11 : 16;
#pragma unroll
    for (int r = lo; r < hi_; ++r) { P0[r] = __builtin_amdgcn_exp2f(P0[r]); asm volatile("" : "+v"(P0[r])); } }
}
template <int DQK, int LDQ, int LDK, int LDV, int LDO>
__device__ __forceinline__ void attn_body4(const bf16_t* __restrict__ Qb, const bf16_t* __restrict__ Kh, const bf16_t* __restrict__ Vh, bf16_t* __restrict__ Ob, int seq, float scale, char* lds) {
  constexpr int SHM_V = KVBLK * 128 * 2, SHM_K = KVBLK * krs<DQK>(), NKC = DQK / 64, ND = DQK / 16;
  const float C = scale * 1.4426950408889634f, thr_s = THR / scale;
  int tid_ = threadIdx.x; asm volatile("" : "+v"(tid_));
  const int tid = tid_, wid = tid >> 6, lane = tid & 63, r32 = lane & 31, hi = lane >> 5;
  char* V_lds = lds; char* K_lds = lds + 3 * SHM_V;
  float* wsf = (float*)(lds + 3 * SHM_V + 3 * SHM_K) + wid * 64; float* li_l = wsf; float* al_l = wsf + 32;
  float m_reg = -1e30f, l_reg = 0; f32x16 o[4] = {}; bf16x8 qr[ND];
  const bf16_t* Qw = Qb + (size_t)(wid * QBLK + r32) * LDQ + hi * 8;
#pragma unroll
  for (int d0 = 0; d0 < ND; ++d0) qr[d0] = *reinterpret_cast<const bf16x8*>(Qw + d0 * 16);
  const int sr = tid >> 4, sc = (tid & 15) * 8, vst0 = v_st(sr, sc), vst1 = v_st(32 + sr, sc);
  const int kgo0 = sr * LDK + sc, klo0 = kswz<DQK>(sr, sc * 2);
  const int kgo2 = (tid >> 3) * LDK + 128 + (tid & 7) * 8, klo2 = kswz<DQK>(tid >> 3, (128 + (tid & 7) * 8) * 2);
  const int vb0 = (int)(uintptr_t)V_lds + v_rd_base(lane);
  int kb4[4];
#pragma unroll
  for (int q = 0; q < 4; ++q) kb4[q] = kswz<DQK>(r32, q * 32 + hi * 16);
  bf16x8 vs0, vs1, ks[NKC];
#define FA_SLOAD(k0) do { vs0 = *reinterpret_cast<const bf16x8*>(&Vh[(size_t)((k0) + sr) * LDV + sc]); vs1 = *reinterpret_cast<const bf16x8*>(&Vh[(size_t)((k0) + 32 + sr) * LDV + sc]); \
    ks[0] = *reinterpret_cast<const bf16x8*>(&Kh[(size_t)(k0) * LDK + kgo0]); ks[1] = *reinterpret_cast<const bf16x8*>(&Kh[(size_t)((k0) + 32) * LDK + kgo0]); \
    if constexpr (NKC == 3) ks[NKC - 1] = *reinterpret_cast<const bf16x8*>(&Kh[(size_t)(k0) * LDK + kgo2]); } while (0)
#define FA_SWRITE(b) do { *(bf16x8*)(V_lds + (b) * SHM_V + vst0) = vs0; *(bf16x8*)(V_lds + (b) * SHM_V + vst1) = vs1; \
    *(bf16x8*)(K_lds + (b) * SHM_K + klo0) = ks[0]; *(bf16x8*)(K_lds + (b) * SHM_K + klo0 + 32 * krs<DQK>()) = ks[1]; \
    if constexpr (NKC == 3) *(bf16x8*)(K_lds + (b) * SHM_K + klo2) = ks[NKC - 1]; } while (0)
#define FA_SWAIT() asm volatile("s_waitcnt vmcnt(0)" ::: "memory")
#define FA_RESC(a) do { if (__any((a) < 1.f)) { if (hi == 0) al_l[r32] = (a); asm volatile("s_waitcnt lgkmcnt(0)" ::: "memory"); \
    _Pragma("unroll") for (int d = 0; d < 4; ++d) _Pragma("unroll") for (int r = 0; r < 16; ++r) o[d][r] *= al_l[crow(r, hi)]; } } while (0)
#define FA_KF(KS, D0, H) (*reinterpret_cast<const bf16x8*>((KS) + kb4[(D0) & 3] + ((D0) >> 2) * 128 + (H) * 32 * krs<DQK>()))
#define FA_SEGA(PN0, PN1, KS, PO0, PO1, ALO) do { PN0 = f32x16{}; PN1 = f32x16{}; float ps_ = 0.f; bf16x8 fa_ = FA_KF(KS, 0, 0), fb_ = FA_KF(KS, 0, 1); \
    _Pragma("unroll") for (int d0 = 0; d0 < ND; ++d0) { bf16x8 na_ = fa_, nb_ = fb_; if (d0 + 1 < ND) { na_ = FA_KF(KS, d0 + 1, 0); nb_ = FA_KF(KS, d0 + 1, 1); } \
      PN0 = __builtin_amdgcn_mfma_f32_32x32x16_bf16(fa_, qr[d0], PN0, 0, 0, 0); FIN_CH(2 * d0, PO0, PO1, ALO, ps_); \
      PN1 = __builtin_amdgcn_mfma_f32_32x32x16_bf16(fb_, qr[d0], PN1, 0, 0, 0); FIN_CH(2 * d0 + 1, PO0, PO1, ALO, ps_); fa_ = na_; fb_ = nb_; FA_SBAR(); } } while (0)
#define FIN_CH(S, PO0, PO1, ALO, PS) do { switch (S) { \
    case 0: fin_chunk<0>(PO0, PO1, ALO, l_reg, PS, pa0, pa1, pa2, pa3); break; case 1: fin_chunk<1>(PO0, PO1, ALO, l_reg, PS, pa0, pa1, pa2, pa3); break; \
    case 2: fin_chunk<2>(PO0, PO1, ALO, l_reg, PS, pa0, pa1, pa2, pa3); break; case 3: fin_chunk<3>(PO0, PO1, ALO, l_reg, PS, pa0, pa1, pa2, pa3); break; \
    case 4: fin_chunk<4>(PO0, PO1, ALO, l_reg, PS, pa0, pa1, pa2, pa3); break; case 5: fin_chunk<5>(PO0, PO1, ALO, l_reg, PS, pa0, pa1, pa2, pa3); break; \
    case 6: fin_chunk<6>(PO0, PO1, ALO, l_reg, PS, pa0, pa1, pa2, pa3); break; case 7: fin_chunk<7>(PO0, PO1, ALO, l_reg, PS, pa0, pa1, pa2, pa3); break; \
    case 8: fin_chunk<8>(PO0, PO1, ALO, l_reg, PS, pa0, pa1, pa2, pa3); break; case 9: fin_chunk<9>(PO0, PO1, ALO, l_reg, PS, pa0, pa1, pa2, pa3); break; \
    case 10: fin_chunk<10>(PO0, PO1, ALO, l_reg, PS, pa0, pa1, pa2, pa3); break; case 11: fin_chunk<11>(PO0, PO1, ALO, l_reg, PS, pa0, pa1, pa2, pa3); break; \
    case 12: fin_chunk<12>(PO0, PO1, ALO, l_reg, PS, pa0, pa1, pa2, pa3); break; case 13: fin_chunk<13>(PO0, PO1, ALO, l_reg, PS, pa0, pa1, pa2, pa3); break; \
    case 14: fin_chunk<14>(PO0, PO1, ALO, l_reg, PS, pa0, pa1, pa2, pa3); break; case 15: fin_chunk<15>(PO0, PO1, ALO, l_reg, PS, pa0, pa1, pa2, pa3); break; \
    case 16: fin_chunk<16>(PO0, PO1, ALO, l_reg, PS, pa0, pa1, pa2, pa3); break; default: break; } } while (0)
#define FA_TR8(DST, D0, VB) do { DST[0] = tr_read<v_rd_off(D0, 0, 0)>(VB); DST[1] = tr_read<v_rd_off(D0, 0, 1)>(VB); DST[2] = tr_read<v_rd_off(D0, 1, 0)>(VB); DST[3] = tr_read<v_rd_off(D0, 1, 1)>(VB); \
    DST[4] = tr_read<v_rd_off(D0, 2, 0)>(VB); DST[5] = tr_read<v_rd_off(D0, 2, 1)>(VB); DST[6] = tr_read<v_rd_off(D0, 3, 0)>(VB); DST[7] = tr_read<v_rd_off(D0, 3, 1)>(VB); } while (0)
#define FA_PKV(F, i) (bf16x8){F[2 * (i)][0], F[2 * (i)][1], F[2 * (i)][2], F[2 * (i)][3], F[2 * (i) + 1][0], F[2 * (i) + 1][1], F[2 * (i) + 1][2], F[2 * (i) + 1][3]}
#define FA_PVB(D0, F, PN0, PN1, ALN) do { \
    o[D0] = __builtin_amdgcn_mfma_f32_32x32x16_bf16(pa0, FA_PKV(F, 0), o[D0], 0, 0, 0); par_chunk<4 * D0 + 0>(PN0, PN1, m_reg, ALN, pm_, mnC_, C, thr_s); \
    o[D0] = __builtin_amdgcn_mfma_f32_32x32x16_bf16(pa1, FA_PKV(F, 1), o[D0], 0, 0, 0); par_chunk<4 * D0 + 1>(PN0, PN1, m_reg, ALN, pm_, mnC_, C, thr_s); \
    o[D0] = __builtin_amdgcn_mfma_f32_32x32x16_bf16(pa2, FA_PKV(F, 2), o[D0], 0, 0, 0); par_chunk<4 * D0 + 2>(PN0, PN1, m_reg, ALN, pm_, mnC_, C, thr_s); \
    o[D0] = __builtin_amdgcn_mfma_f32_32x32x16_bf16(pa3, FA_PKV(F, 3), o[D0], 0, 0, 0); par_chunk<4 * D0 + 3>(PN0, PN1, m_reg, ALN, pm_, mnC_, C, thr_s); FA_SBAR(); } while (0)
#define FA_SEGB(VB, PN0, PN1, ALN) do { float pm_ = 0.f, mnC_ = 0.f; s16x4 fA_[8], fB_[8]; const int vb_ = (VB); \
    FA_TR8(fA_, 0, vb_); FA_TR8(fB_, 1, vb_); asm volatile("s_waitcnt lgkmcnt(8)" ::: "memory"); FA_SBAR(); FA_PVB(0, fA_, PN0, PN1, ALN); \
    FA_TR8(fA_, 2, vb_); asm volatile("s_waitcnt lgkmcnt(8)" ::: "memory"); FA_SBAR(); FA_PVB(1, fB_, PN0, PN1, ALN); \
    FA_TR8(fB_, 3, vb_); asm volatile("s_waitcnt lgkmcnt(8)" ::: "memory"); FA_SBAR(); FA_PVB(2, fA_, PN0, PN1, ALN); \
    asm volatile("s_waitcnt lgkmcnt(0)" ::: "memory"); FA_SBAR(); FA_PVB(3, fB_, PN0, PN1, ALN); } while (0)
  f32x16 pA0, pA1, pB0, pB1; float alA = 1.f, alB = 1.f; bf16x8 pa0, pa1, pa2, pa3; const int NT = seq / KVBLK;
  FA_SLOAD(0); FA_SWAIT(); FA_SWRITE(0); __syncthreads();
  { float mnA_, alA_; qkt<DQK>(pA0, pA1, K_lds, qr, kb4); partialSM(pA0, pA1, m_reg, mnA_, alA_, C, thr_s); alA = alA_; }
  FA_SLOAD(KVBLK);
  FA_SWAIT(); FA_SWRITE(1); __syncthreads();
  int bk = 1, bv = 0, bw = 2;
#define FA_ROT() do { const int t_ = bv; bv = bk; bk = bw; bw = t_; } while (0)
  for (int j = 1; j + 1 < NT; j += 2) {
    FA_SBAR(); FA_SEGA(pB0, pB1, K_lds + bk * SHM_K, pA0, pA1, alA);
    FA_SLOAD((j + 1) * KVBLK); FA_SBAR();
    FA_SEGB(vb0 + bv * SHM_V, pB0, pB1, alB);
    FA_SWAIT(); FA_SWRITE(bw);
    FA_RESC(alB); __syncthreads(); FA_ROT();
    FA_SBAR(); FA_SEGA(pA0, pA1, K_lds + bk * SHM_K, pB0, pB1, alB);
    FA_SLOAD((j + 2) * KVBLK); FA_SBAR();
    FA_SEGB(vb0 + bv * SHM_V, pA0, pA1, alA);
    FA_SWAIT(); FA_SWRITE(bw);
    FA_RESC(alA); __syncthreads(); FA_ROT();
  }
  FA_SBAR(); FA_SEGA(pB0, pB1, K_lds + bk * SHM_K, pA0, pA1, alA);
  FA_SEGB(vb0 + bv * SHM_V, pB0, pB1, alB);
  FA_RESC(alB);
  finishSM(pB0, pB1, alB, l_reg, pa0, pa1, pa2, pa3); FA_SBAR();
  pv_d0(o, vb0 + bk * SHM_V, pa0, pa1, pa2, pa3);
#undef FA_ROT
  if (hi == 0) li_l[r32] = l_reg; asm volatile("s_waitcnt lgkmcnt(0)" ::: "memory");
  float rli[16];
#pragma unroll
  for (int r = 0; r < 16; ++r) rli[r] = __builtin_amdgcn_rcpf(li_l[crow(r, hi)]);
  bf16_t* Ow = Ob + (size_t)(wid * QBLK) * LDO;
#pragma unroll
  for (int r = 0; r < 16; ++r) { const int orow = crow(r, hi);
#pragma unroll
    for (int d0 = 0; d0 < 4; ++d0) Ow[(size_t)orow * LDO + d0 * 32 + r32] = (bf16_t)f2bf(o[d0][r] * rli[r]); }
  __syncthreads();
#undef FA_SLOAD
#undef FA_SWRITE
#undef FA_SWAIT
#undef FA_RESC
#undef FA_KF
#undef FA_SEGA
#undef FIN_CH
#undef FA_TR8
#undef FA_PKV
#undef FA_PVB
#undef FA_SEGB
}
#undef FA_SBAR
}
__device__ __forceinline__ void mla_attn_phase(unsigned char* dout, unsigned char* ws, char* lds, int bid, int nblk) {
  for (int u = bid; u < NB_ * 8 * (S_ / 256); u += nblk) {
    const int qb = u & 7, h = (u >> 3) & 7, b = u >> 6;
    const bf16_t* Q = (const bf16_t*)(dout + DO_Q) + (size_t)(b * S_ + qb * 256) * 1536 + h * 192;
    const bf16_t* K = (const bf16_t*)(dout + DO_K) + (size_t)(b * S_) * 1536 + h * 192;
    const bf16_t* V = (const bf16_t*)(dout + DO_V) + (size_t)(b * S_) * 1024 + h * 128;
    bf16_t* O = (bf16_t*)(ws + WS_YMIX) + (size_t)(b * S_ + qb * 256) * 2048 + h * 128;
    fa::attn_body4<192, 1536, 1536, 1024, 2048>(Q, K, V, O, S_, 0.07216878364870322f, lds);
  }
}

__device__ __forceinline__ void mem_attn_phase(unsigned char* ws, char* lds, int bid, int nblk) {
  for (int u = bid; u < NB_ * 4 * (S_ / 256); u += nblk) {
    const int qb = u & 7, h = (u >> 3) & 3, b = u >> 5;
    const bf16_t* Q = (const bf16_t*)(ws + WS_QM) + (size_t)(b * S_ + qb * 256) * 512 + h * 128;
    const bf16_t* K = (const bf16_t*)(ws + WS_MEMKV) + (size_t)(b * 256) * 1024 + h * 128;
    const bf16_t* V = K + 512;
    bf16_t* O = (bf16_t*)(ws + WS_OM) + (size_t)(b * S_ + qb * 256) * 512 + h * 128;
    fa::attn_body<128, 512, 1024, 1024, 512>(Q, K, V, O, 256, 0.08838834764831845f, lds);
  }
}
__device__ __forceinline__ void scan_phase(unsigned char* ws, float* lds, int bid, int nblk, int tid_in) {
  int tid = tid_in; asm volatile("" : "+v"(tid));
  f32x4* sA = (f32x4*)lds; f32x4* sB = sA + 512;
  const int cq = tid & 15, ch = tid >> 4;
  for (int it = bid; it < NB_ * 2 * 16; it += nblk) {
    const int cg_ = it & 15, dir = (it >> 4) & 1, b = it >> 5;
    const char* LA = (const char*)(ws + (dir ? WS_LAB : WS_LAF)) + ((size_t)b * S_ * 1024 + cg_ * 64) * 2;
    char* BT = (char*)(ws + (dir ? WS_BTB : WS_BTF)) + ((size_t)b * S_ * 1024 + cg_ * 64) * 2;
    const int sstep = dir ? -2048 : 2048;
    const unsigned off0 = (unsigned)((dir ? (S_ - 1 - ch * 64) : ch * 64) * 2048 + cq * 8);
    f32x4 A = {1.f, 1.f, 1.f, 1.f}, Bv = {0.f, 0.f, 0.f, 0.f};
    unsigned off = off0;
#pragma unroll 8
    for (int i = 0; i < 64; ++i) { const u32x2 lw = *(const u32x2*)(LA + off), bw = *(const u32x2*)(BT + off); off += sstep;
      const f32x4 a = {__expf(bflo(lw.x)), __expf(bfhi(lw.x)), __expf(bflo(lw.y)), __expf(bfhi(lw.y))}; const f32x4 bt = {bflo(bw.x), bfhi(bw.x), bflo(bw.y), bfhi(bw.y)};
      Bv = a * Bv + bt; A = A * a; }
    __syncthreads();
    sA[ch * 16 + cq] = A; sB[ch * 16 + cq] = Bv;
    __syncthreads();
    f32x4 h = {0.f, 0.f, 0.f, 0.f};
    for (int qq = 0; qq < ch; ++qq) h = sA[qq * 16 + cq] * h + sB[qq * 16 + cq];
    off = off0;
#pragma unroll 8
    for (int i = 0; i < 64; ++i) { const u32x2 lw = *(const u32x2*)(LA + off), bw = *(const u32x2*)(BT + off);
      const f32x4 a = {__expf(bflo(lw.x)), __expf(bfhi(lw.x)), __expf(bflo(lw.y)), __expf(bfhi(lw.y))}; const f32x4 bt = {bflo(bw.x), bfhi(bw.x), bflo(bw.y), bfhi(bw.y)};
      h = a * h + bt; u32x2 w; w.x = pk2(h[0], h[1]); w.y = pk2(h[2], h[3]); *(u32x2*)(BT + off) = w; off += sstep; }
  }
  __syncthreads();
}


__device__ __forceinline__ void lru_fused_phase(const Params& p, unsigned char* lds_raw, int bid, int nblk) {
  constexpr int RS = 272;
  constexpr int AST = 65;
  unsigned char* WL = lds_raw; unsigned char* XL = lds_raw + 128 * RS;
  f32x2* AB = (f32x2*)(lds_raw + 2 * 128 * RS); float* AG = (float*)(AB + 128 * AST);
  float* CAR = AG + 2 * 8 * 64;
  int tid_ = threadIdx.x; asm volatile("" : "+v"(tid_));
  const int tid = tid_, lane = tid & 63, wave = tid >> 6, r32 = lane & 31, hi = lane >> 5;
  unsigned char* ws = p.ws;
  const bf16_t* LX = (const bf16_t*)(ws + WS_LRUX);
  for (int it = bid; it < NB_ * 8 * 2 * 2; it += nblk) {
    const int half = it & 1, dir = (it >> 1) & 1, n = (it >> 2) & 7, b = it >> 5;
    const int ch0 = n * 128 + half * 64;
    __syncthreads();
    { const bf16_t* wg = (const bf16_t*)(ws + WS_WG_T) + (size_t)(n * 512 + dir * 256 + half * 128) * 128;
      for (int i = tid; i < 128 * 16; i += NTHR) { const int r = i >> 4, c8 = (i & 15) * 8; *(u32x4*)(WL + r * RS + c8 * 2) = *(const u32x4*)(wg + r * 128 + c8); } }
    if (tid < 64) CAR[tid] = 0.f;
    float cw0[4], cw1[4]; const float cb0 = p.in[11][n * 128 + 2 * lane], cb1 = p.in[11][n * 128 + 2 * lane + 1];
#pragma unroll
    for (int k = 0; k < 4; ++k) { cw0[k] = p.in[10][k * 1024 + n * 128 + 2 * lane]; cw1[k] = p.in[10][k * 1024 + n * 128 + 2 * lane + 1]; }
    bf16_t* H = (bf16_t*)(ws + (dir ? WS_BTB : WS_BTF));
    float tb0[16], tb1[16], tb2[16];
#pragma unroll
    for (int t = 0; t < 2; ++t)
#pragma unroll
      for (int g = 0; g < 4; ++g)
#pragma unroll
        for (int u = 0; u < 2; ++u) { const int jl = (wave & 1) * 32 + 16 * t + 4 * g + 2 * hi + u; const f32x4 tb = *((const f32x4*)(ws + WS_GTAB) + dir * 1024 + ch0 + jl);
          tb0[t * 8 + g * 2 + u] = tb[0]; tb1[t * 8 + g * 2 + u] = tb[1]; tb2[t * 8 + g * 2 + u] = tb[2]; }
    unsigned xr[19];
#define LRU_LOADX(C) do { const int q0_ = (dir ? S_ - 128 * ((C) + 1) : 128 * (C)) + wave * 16; \
      _Pragma("unroll") for (int j = 0; j < 19; ++j) { const int row = q0_ + j - 2, rc = row < 0 ? 0 : (row >= S_ ? S_ - 1 : row);        \
        const unsigned v_ = *(const unsigned*)(LX + (size_t)(b * S_ + rc) * 1024 + n * 128 + 2 * lane); xr[j] = (row == rc) ? v_ : 0u; } } while (0)
    LRU_LOADX(0);
    for (int c = 0; c < 16; ++c) {
      const int p0 = dir ? S_ - 128 * (c + 1) : 128 * c;
      {
#pragma unroll
        for (int i = 0; i < 16; ++i) { float s0 = cb0, s1 = cb1;
#pragma unroll
          for (int k = 0; k < 4; ++k) { s0 += bflo(xr[i + k]) * cw0[k]; s1 += bfhi(xr[i + k]) * cw1[k]; }
          *(unsigned*)(XL + (wave * 16 + i) * RS + lane * 4) = pk2(s0, s1); } }
      if (c + 1 < 16) LRU_LOADX(c + 1);
      __syncthreads();
      f32x16 acc[2] = {};
#pragma unroll
      for (int s = 0; s < 8; ++s) { const bf16x8 xf = *(const bf16x8*)(XL + ((wave >> 1) * 32 + r32) * RS + (16 * s + 8 * hi) * 2);
#pragma unroll
        for (int t = 0; t < 2; ++t) { const bf16x8 wf = *(const bf16x8*)(WL + ((wave & 1) * 64 + 32 * t + r32) * RS + (16 * s + 8 * hi) * 2);
          acc[t] = __builtin_amdgcn_mfma_f32_32x32x16_bf16(wf, xf, acc[t], 0, 0, 0); } }
      { const int pos = (wave >> 1) * 32 + r32;
#pragma unroll
        for (int t = 0; t < 2; ++t)
#pragma unroll
          for (int g = 0; g < 4; ++g) { const int jl = (wave & 1) * 32 + 16 * t + 4 * g + 2 * hi;
            const unsigned xw = *(const unsigned*)(XL + pos * RS + (half * 64 + jl) * 2);
#pragma unroll
            for (int u = 0; u < 2; ++u) { const int ti = t * 8 + g * 2 + u;
              const float e1 = __builtin_amdgcn_exp2f(-1.4426950408889634f * (acc[t][4 * g + 2 * u] + tb1[ti])), e2 = __builtin_amdgcn_exp2f(-1.4426950408889634f * (acc[t][4 * g + 2 * u + 1] + tb2[ti]));
              const float R = __builtin_amdgcn_rcpf((1.f + e1) * (1.f + e2)), sr = (1.f + e2) * R, si = (1.f + e1) * R;
              const float la = -tb0[ti] * sr, a = __builtin_amdgcn_exp2f(la * 1.4426950408889634f), x2 = 2.f * la;
              const float ser = -x2 * (1.f + x2 * (0.5f + x2 * (1.6666667e-1f + x2 * (4.1666667e-2f + x2 * (8.3333333e-3f + x2 * 1.3888889e-3f)))));
              const float om = x2 > -0.25f ? ser : 1.f - a * a;
              AB[pos * AST + jl + u] = (f32x2){a, __builtin_amdgcn_sqrtf(om) * si * (u ? bfhi(xw) : bflo(xw))}; } } }
      __syncthreads();
      { const int jl = tid & 63, sub = tid >> 6; float av[16], bv[16]; float A = 1.f, B = 0.f;
#pragma unroll
        for (int i = 0; i < 16; ++i) { const int tau = 16 * sub + i, pos = dir ? 127 - tau : tau; const f32x2 ab = AB[pos * AST + jl]; av[i] = ab[0]; bv[i] = ab[1]; B = av[i] * B + bv[i]; A *= av[i]; }
        AG[sub * 64 + jl] = A; AG[512 + sub * 64 + jl] = B;
        __syncthreads();
        float h = CAR[jl];
        for (int s2 = 0; s2 < sub; ++s2) h = AG[s2 * 64 + jl] * h + AG[512 + s2 * 64 + jl];
#pragma unroll
        for (int i = 0; i < 16; ++i) { const int tau = 16 * sub + i, pos = dir ? 127 - tau : tau; h = av[i] * h + bv[i];
          H[(size_t)(b * S_ + p0 + pos) * 1024 + ch0 + jl] = (bf16_t)(pk2(h, 0.f) & 0xffffu); }
        __syncthreads();
        if (sub == 7) CAR[jl] = h; }
    }
#undef LRU_LOADX
  }
  __syncthreads();
}

__device__ __forceinline__ void phase3b(const Params& p, int gw, int ngw, int lane) {
  unsigned char* ws = p.ws; bf16_t* Y = (bf16_t*)(ws + WS_YMIX);
  const bf16_t* HF = (const bf16_t*)(ws + WS_BTF); const bf16_t* HB = (const bf16_t*)(ws + WS_BTB); const bf16_t* G = (const bf16_t*)(ws + WS_GATE);
  for (int r = gw; r < T_; r += ngw) {
    { bf16_t* row = Y + (size_t)r * 2048 + lane * 16; float f[16]; unpack8(*(const u32x4*)row, f); unpack8(*(const u32x4*)(row + 8), f + 8);
      float q = 0.f;
#pragma unroll
      for (int i = 0; i < 16; ++i) q += f[i] * f[i];
      const float sc = rsqrtf(dpp_sum64(q) * (1.f / 1024.f) + RMS_EPS); const float* g = p.in[17] + lane * 16;
#pragma unroll
      for (int i = 0; i < 16; ++i) f[i] = f[i] * sc * g[i];
      *(u32x4*)row = pack8(f); *(u32x4*)(row + 8) = pack8(f + 8); }
    { const size_t o = (size_t)r * 1024 + lane * 16; float a[16], b[16], gg[16];
      unpack8(*(const u32x4*)(HF + o), a); unpack8(*(const u32x4*)(HF + o + 8), a + 8);
      unpack8(*(const u32x4*)(HB + o), b); unpack8(*(const u32x4*)(HB + o + 8), b + 8);
      unpack8(*(const u32x4*)(G + o), gg); unpack8(*(const u32x4*)(G + o + 8), gg + 8);
      float q = 0.f;
#pragma unroll
      for (int i = 0; i < 16; ++i) { a[i] = (a[i] + b[i]) * gg[i]; q += a[i] * a[i]; }
      const float sc = rsqrtf(dpp_sum64(q) * (1.f / 1024.f) + RMS_EPS); const float* g = p.in[18] + lane * 16;
#pragma unroll
      for (int i = 0; i < 16; ++i) a[i] = a[i] * sc * g[i];
      bf16_t* row = Y + (size_t)r * 2048 + 1024 + lane * 16; *(u32x4*)row = pack8(a); *(u32x4*)(row + 8) = pack8(a + 8); }
  }
}
__device__ __forceinline__ void ln_pass(unsigned char* ws, const float* g, const float* b, int gw, int ngw, int lane) {
  bf16_t* X = (bf16_t*)(ws + WS_X);
  for (int r0 = gw * 2; r0 < T_; r0 += ngw * 2) { u32x4 w[2][4]; float v[32];
#pragma unroll
    for (int rr = 0; rr < 2; ++rr)
#pragma unroll
      for (int j = 0; j < 4; ++j) w[rr][j] = *(const u32x4*)(X + (size_t)(r0 + rr) * DM + j * 512 + lane * 8);
#pragma unroll
    for (int rr = 0; rr < 2; ++rr) {
#pragma unroll
      for (int j = 0; j < 4; ++j) unpack8(w[rr][j], &v[j * 8]);
      ln_row_regs(v, g, b, lane);
#pragma unroll
      for (int j = 0; j < 4; ++j) *(u32x4*)(X + (size_t)(r0 + rr) * DM + j * 512 + lane * 8) = pack8(&v[j * 8]); } }
}
__device__ __forceinline__ void cvt_pass(const float* src, bf16_t* dst, size_t n, int gw, int ngw, int lane) {
  for (size_t i = (size_t)(gw * 64 + lane) * 8; i < n; i += (size_t)ngw * 64 * 8) {
    const f32x4 a = *(const f32x4*)(src + i), b = *(const f32x4*)(src + i + 4); u32x4 o; o.x = pk2(a[0], a[1]); o.y = pk2(a[2], a[3]); o.z = pk2(b[0], b[1]); o.w = pk2(b[2], b[3]);
    *(u32x4*)(dst + i) = o; }
}

__device__ __forceinline__ unsigned key_of(float s, unsigned tag, unsigned tagmask) {
  unsigned u = __float_as_uint(s); u = (u & 0x80000000u) ? ~u : (u | 0x80000000u); return (u & ~tagmask) | (tagmask - tag);
}
__device__ __forceinline__ float val_of(unsigned k, unsigned tagmask) { unsigned u = k & ~tagmask; u = (u & 0x80000000u) ? (u & 0x7fffffffu) : ~u; return __uint_as_float(u); }
__device__ __forceinline__ void topk_phase(unsigned char* ws, const float* SC, int gw, int ngw, int lane) {
  int* IDX = (int*)(ws + WS_IDX); float* GV = (float*)(ws + WS_GV);
  int ca = -1, cb = -1; { int n = 0; for (int a = 0; a < 16; ++a) for (int b = 0; b < 16; ++b) if ((a + 1) * (b + 1) <= 16) { if (n == lane) { ca = a; cb = b; } ++n; } }
  for (int pr = gw; pr < T_ * 8; pr += ngw) {
    const float* row = SC + (size_t)pr * 256;
    unsigned k1a = key_of(row[lane], lane, 127u), k1b = key_of(row[64 + lane], 64 + lane, 127u);
    unsigned k2a = key_of(row[128 + lane], lane, 127u), k2b = key_of(row[192 + lane], 64 + lane, 127u);
    unsigned t1 = 0u, t2 = 0u;
    for (int it = 0; it < 16; ++it) {
      const unsigned m1 = dpp_max64_u32(k1a > k1b ? k1a : k1b), m2 = dpp_max64_u32(k2a > k2b ? k2a : k2b);
      if (k1a == m1) k1a = 0u; if (k1b == m1) k1b = 0u; if (k2a == m2) k2a = 0u; if (k2b == m2) k2b = 0u;
      if (lane == it) { t1 = m1; t2 = m2; }
    }
    const unsigned ka = (unsigned)__shfl((int)t1, ca < 0 ? 0 : ca), kb = (unsigned)__shfl((int)t2, cb < 0 ? 0 : cb);
    const float va = val_of(ka, 127u), vb = val_of(kb, 127u); const int ia = 127 - (int)(ka & 127u), ib = 127 - (int)(kb & 127u);
    const float cs = va + vb; const int cidx = ia * 128 + ib;
    unsigned ck = (ca >= 0) ? key_of(cs, (unsigned)(ca * 16 + cb), 255u) : 0u;
    float ts = 0.f; int ti = 0;
    for (int it = 0; it < 16; ++it) {
      const unsigned m = dpp_max64_u32(ck); const unsigned long long bal = __ballot(ck == m && ck != 0u); const int src = __ffsll((long long)bal) - 1;
      const float sv = __shfl(cs, src); const int si = __shfl(cidx, src);
      if (lane == src) ck = 0u;
      if (lane == it) { ts = sv; ti = si; }
    }
    const float mx = __uint_as_float(__builtin_amdgcn_readlane(__float_as_uint(ts), 0));
    float ex = (lane < 16) ? __expf(ts - mx) : 0.f; const float sum = dpp_sum64(ex);
    if (lane < 16) { IDX[(size_t)pr * 16 + lane] = ti; GV[(size_t)pr * 16 + lane] = ex / sum; }
  }
}


__device__ __forceinline__ unsigned umax_(unsigned a, unsigned b) { return a > b ? a : b; }
__device__ __forceinline__ unsigned umin_(unsigned a, unsigned b) { return a < b ? a : b; }
__device__ __forceinline__ unsigned ord_of(float s) { const unsigned u = __float_as_uint(s); return (u & 0x80000000u) ? ~u : (u | 0x80000000u); }
__device__ __forceinline__ unsigned qx1(unsigned v) { return (unsigned)__builtin_amdgcn_update_dpp(0, (int)v, 0xB1, 0xf, 0xf, false); }
__device__ __forceinline__ unsigned qx2(unsigned v) { return (unsigned)__builtin_amdgcn_update_dpp(0, (int)v, 0x4E, 0xf, 0xf, false); }
__device__ __forceinline__ void ins16(unsigned (&L)[16], unsigned x) {
#pragma unroll
  for (int k = 0; k < 16; ++k) { const unsigned hi = umax_(L[k], x); x = umin_(L[k], x); L[k] = hi; }
}
__device__ __forceinline__ void ins16p(unsigned (&L)[16], unsigned (&P)[16], unsigned x, unsigned px) {
#pragma unroll
  for (int k = 0; k < 16; ++k) { const bool c = x > L[k]; const unsigned nl = c ? x : L[k], nx = c ? L[k] : x, np = c ? px : P[k], npx = c ? P[k] : px; L[k] = nl; x = nx; P[k] = np; px = npx; }
}
__device__ __forceinline__ void bitonic_sort16(unsigned (&M)[16]) {
#pragma unroll
  for (int d = 8; d >= 1; d >>= 1)
#pragma unroll
    for (int i = 0; i < 16; ++i) if (!(i & d)) { const unsigned hi = umax_(M[i], M[i + d]), lo = umin_(M[i], M[i + d]); M[i] = hi; M[i + d] = lo; }
}
__device__ __forceinline__ void bitonic_sort16p(unsigned (&M)[16], unsigned (&P)[16]) {
#pragma unroll
  for (int d = 8; d >= 1; d >>= 1)
#pragma unroll
    for (int i = 0; i < 16; ++i) if (!(i & d)) { const bool c = M[i + d] > M[i]; const unsigned a = M[i], b = M[i + d], pa = P[i], pb = P[i + d];
      M[i] = c ? b : a; M[i + d] = c ? a : b; P[i] = c ? pb : pa; P[i + d] = c ? pa : pb; }
}
__device__ __forceinline__ void topk_phase2(unsigned char* ws, const float* SC, int gw, int ngw, int lane) {
  int* IDX = (int*)(ws + WS_IDX); float* GV = (float*)(ws + WS_GV);
  const int c = lane & 3;
  const unsigned tagbase = (c & 1) ? 0u : 64u;
  for (int item = gw; item < T_ * 8 / 16; item += ngw) {
    const int pr = item * 16 + (lane >> 2);
    const float* row = SC + (size_t)pr * 256 + c * 64;
    unsigned L[16];
#pragma unroll
    for (int k = 0; k < 16; ++k) L[k] = 0u;
#pragma unroll
    for (int bq = 0; bq < 4; ++bq) { f32x4 v[4];
#pragma unroll
      for (int j = 0; j < 4; ++j) v[j] = *(const f32x4*)(row + bq * 16 + j * 4);
#pragma unroll
      for (int j = 0; j < 4; ++j)
#pragma unroll
        for (int i = 0; i < 4; ++i) { const int e = bq * 16 + j * 4 + i; ins16(L, (ord_of(v[j][i]) & ~127u) | (tagbase + (unsigned)(63 - e))); } }
    { unsigned B[16];
#pragma unroll
      for (int k = 0; k < 16; ++k) B[k] = qx1(L[k]);
#pragma unroll
      for (int k = 0; k < 16; ++k) L[k] = umax_(L[k], B[15 - k]);
      bitonic_sort16(L); }
    float F1[16], F2[16]; unsigned I1[16], I2[16];
#pragma unroll
    for (int k = 0; k < 16; ++k) { const unsigned o = qx2(L[k]); const unsigned v1 = (c < 2) ? L[k] : o, v2 = (c < 2) ? o : L[k];
      unsigned u1 = v1 & ~127u, u2 = v2 & ~127u; u1 = (u1 & 0x80000000u) ? (u1 & 0x7fffffffu) : ~u1; u2 = (u2 & 0x80000000u) ? (u2 & 0x7fffffffu) : ~u2;
      F1[k] = __uint_as_float(u1); F2[k] = __uint_as_float(u2); I1[k] = (127u - (v1 & 127u)) << 7; I2[k] = 127u - (v2 & 127u); }
    unsigned M[16], P[16];
#pragma unroll
    for (int k = 0; k < 16; ++k) { M[k] = 0u; P[k] = 0u; }
    {
      constexpr int CA[52] = {0,0,0,0,0,0,0,0,0,0,0,0,0,0,0,0, 1,1,1,1,1,1,1,1, 2,2,2,2,2, 3,3,3,3, 4,4,4, 5,5, 6,6, 7,7, 8, 9, 10, 11, 12, 13, 14, 15, 15, 15};
      constexpr int CB[52] = {0,1,2,3,4,5,6,7,8,9,10,11,12,13,14,15, 0,1,2,3,4,5,6,7, 0,1,2,3,4, 0,1,2,3, 0,1,2, 0,1, 0,1, 0,1, 0, 0, 0, 0, 0, 0, 0, 0, 0, 0};
#pragma unroll
      for (int m = 0; m < 13; ++m) {
        unsigned kx[4], px[4];
#pragma unroll
        for (int q = 0; q < 4; ++q) { const int n = 4 * m + q; const bool pad = n >= 50;
          kx[q] = pad ? 0u : ord_of(F1[CA[n]] + F2[CB[n]]); px[q] = I1[CA[n]] | I2[CB[n]]; }
        const unsigned x = (c == 0) ? kx[0] : (c == 1) ? kx[1] : (c == 2) ? kx[2] : kx[3];
        const unsigned pp = (c == 0) ? px[0] : (c == 1) ? px[1] : (c == 2) ? px[2] : px[3];
        ins16p(M, P, x, pp);
      }
    }
    { unsigned B[16], Q[16];
#pragma unroll
      for (int k = 0; k < 16; ++k) { B[k] = qx1(M[k]); Q[k] = qx1(P[k]); }
#pragma unroll
      for (int k = 0; k < 16; ++k) { const bool t = B[15 - k] > M[k]; M[k] = t ? B[15 - k] : M[k]; P[k] = t ? Q[15 - k] : P[k]; }
      bitonic_sort16p(M, P);
#pragma unroll
      for (int k = 0; k < 16; ++k) { B[k] = qx2(M[k]); Q[k] = qx2(P[k]); }
#pragma unroll
      for (int k = 0; k < 16; ++k) { const bool t = B[15 - k] > M[k]; M[k] = t ? B[15 - k] : M[k]; P[k] = t ? Q[15 - k] : P[k]; }
      bitonic_sort16p(M, P); }
    float sv[16]; float mx = -1e30f;
#pragma unroll
    for (int k = 0; k < 16; ++k) { unsigned u = M[k]; u = (u & 0x80000000u) ? (u & 0x7fffffffu) : ~u; sv[k] = __uint_as_float(u); mx = fmaxf(mx, sv[k]); }
    float sum = 0.f;
#pragma unroll
    for (int k = 0; k < 16; ++k) { sv[k] = __expf(sv[k] - mx); sum += sv[k]; }
    const float inv = __builtin_amdgcn_rcpf(sum);
    u32x4 oi; f32x4 og;
#pragma unroll
    for (int i = 0; i < 4; ++i) { oi[i] = (c == 0) ? P[i] : (c == 1) ? P[4 + i] : (c == 2) ? P[8 + i] : P[12 + i];
      og[i] = ((c == 0) ? sv[i] : (c == 1) ? sv[4 + i] : (c == 2) ? sv[8 + i] : sv[12 + i]) * inv; }
    *(u32x4*)(IDX + (size_t)pr * 16 + 4 * c) = oi; *(f32x4*)(GV + (size_t)pr * 16 + 4 * c) = og;
  }
}


__device__ __forceinline__ unsigned sx16(unsigned v) { return (unsigned)__shfl_xor((int)v, 16); }
__device__ __forceinline__ unsigned sx32(unsigned v) { return (unsigned)__shfl_xor((int)v, 32); }
#define MERGE16(L, SH) do { unsigned B_[16]; _Pragma("unroll") for (int k_ = 0; k_ < 16; ++k_) B_[k_] = SH(L[k_]); \
    _Pragma("unroll") for (int k_ = 0; k_ < 16; ++k_) L[k_] = umax_(L[k_], B_[15 - k_]); bitonic_sort16(L); } while (0)
#define MERGE16P(M, P, SH) do { unsigned B_[16], Q_[16]; _Pragma("unroll") for (int k_ = 0; k_ < 16; ++k_) { B_[k_] = SH(M[k_]); Q_[k_] = SH(P[k_]); } \
    _Pragma("unroll") for (int k_ = 0; k_ < 16; ++k_) { const bool t_ = B_[15 - k_] > M[k_]; M[k_] = t_ ? B_[15 - k_] : M[k_]; P[k_] = t_ ? Q_[15 - k_] : P[k_]; } bitonic_sort16p(M, P); } while (0)
__device__ __forceinline__ void topk_phase3(const Params& p, unsigned char* lds_raw, int gw, int ngw, int tid) {
  unsigned char* ws = p.ws; int* IDX = (int*)(ws + WS_IDX); float* GV = (float*)(ws + WS_GV); const bf16_t* QP = (const bf16_t*)(ws + WS_QP);
  constexpr int KRS = 272;
  for (int i = tid; i < 2 * 128 * 32; i += NTHR) { const int tb = i >> 12, r = (i >> 5) & 127, c4 = (i & 31) * 4; const f32x4 v = *(const f32x4*)(p.in[29 + tb] + r * 128 + c4);
    u32x2 w; w.x = pk2(v[0], v[1]); w.y = pk2(v[2], v[3]); *(u32x2*)(lds_raw + tb * (128 * KRS) + r * KRS + c4 * 2) = w; }
  __syncthreads();
  const int lane = tid & 63, fr = lane & 15, c = lane >> 4;
  for (int item = gw; item < T_ * 8 / 16; item += ngw) {
    const int pr = item * 16 + fr;
    unsigned L1[16], L2[16];
#pragma unroll
    for (int k = 0; k < 16; ++k) { L1[k] = 0u; L2[k] = 0u; }
#pragma unroll
    for (int h = 0; h < 2; ++h) {
      bf16x8 qf[4];
#pragma unroll
      for (int s = 0; s < 4; ++s) qf[s] = *(const bf16x8*)(QP + (size_t)pr * 256 + 128 * h + 32 * s + 8 * c);
#pragma unroll
      for (int tp = 0; tp < 4; ++tp) {
        f32x4 acc0 = {0.f, 0.f, 0.f, 0.f}, acc1 = {0.f, 0.f, 0.f, 0.f};
#pragma unroll
        for (int s = 0; s < 4; ++s) { const unsigned char* kb = lds_raw + h * (128 * KRS) + (32 * tp + fr) * KRS + (32 * s + 8 * c) * 2;
          acc0 = __builtin_amdgcn_mfma_f32_16x16x32_bf16(*(const bf16x8*)kb, qf[s], acc0, 0, 0, 0);
          acc1 = __builtin_amdgcn_mfma_f32_16x16x32_bf16(*(const bf16x8*)(kb + 16 * KRS), qf[s], acc1, 0, 0, 0); }
#pragma unroll
        for (int r = 0; r < 4; ++r) { const unsigned t0 = (unsigned)(127 - (32 * tp + r)) - (unsigned)(4 * c), t1 = t0 - 16u;
          const unsigned k0 = (ord_of(acc0[r]) & ~127u) | t0, k1 = (ord_of(acc1[r]) & ~127u) | t1;
          if (h == 0) { ins16(L1, k0); ins16(L1, k1); } else { ins16(L2, k0); ins16(L2, k1); } }
        if (h == 0) asm volatile("" : "+v"(L1[0]), "+v"(L1[15])); else asm volatile("" : "+v"(L2[0]), "+v"(L2[15]));
      }
    }
    MERGE16(L1, sx16); MERGE16(L1, sx32); MERGE16(L2, sx16); MERGE16(L2, sx32);
    float F1[16], F2[16]; unsigned I1[16], I2[16];
#pragma unroll
    for (int k = 0; k < 16; ++k) { const unsigned v1 = L1[k], v2 = L2[k];
      unsigned u1 = v1 & ~127u, u2 = v2 & ~127u; u1 = (u1 & 0x80000000u) ? (u1 & 0x7fffffffu) : ~u1; u2 = (u2 & 0x80000000u) ? (u2 & 0x7fffffffu) : ~u2;
      F1[k] = __uint_as_float(u1); F2[k] = __uint_as_float(u2); I1[k] = (127u - (v1 & 127u)) << 7; I2[k] = 127u - (v2 & 127u); }
    unsigned M[16], P[16];
#pragma unroll
    for (int k = 0; k < 16; ++k) { M[k] = 0u; P[k] = 0u; }
    {
      constexpr int CA[52] = {0,0,0,0,0,0,0,0,0,0,0,0,0,0,0,0, 1,1,1,1,1,1,1,1, 2,2,2,2,2, 3,3,3,3, 4,4,4, 5,5, 6,6, 7,7, 8, 9, 10, 11, 12, 13, 14, 15, 15, 15};
      constexpr int CB[52] = {0,1,2,3,4,5,6,7,8,9,10,11,12,13,14,15, 0,1,2,3,4,5,6,7, 0,1,2,3,4, 0,1,2,3, 0,1,2, 0,1, 0,1, 0,1, 0, 0, 0, 0, 0, 0, 0, 0, 0, 0};
#pragma unroll
      for (int m = 0; m < 13; ++m) {
        unsigned kx[4], px[4];
#pragma unroll
        for (int q = 0; q < 4; ++q) { const int n = 4 * m + q; const bool pad = n >= 50;
          kx[q] = pad ? 0u : ord_of(F1[CA[n]] + F2[CB[n]]); px[q] = I1[CA[n]] | I2[CB[n]]; }
        const unsigned x = (c == 0) ? kx[0] : (c == 1) ? kx[1] : (c == 2) ? kx[2] : kx[3];
        const unsigned pp = (c == 0) ? px[0] : (c == 1) ? px[1] : (c == 2) ? px[2] : px[3];
        ins16p(M, P, x, pp);
      }
    }
    MERGE16P(M, P, sx16); MERGE16P(M, P, sx32);
    float sv[16]; float mx = -1e30f;
#pragma unroll
    for (int k = 0; k < 16; ++k) { unsigned u = M[k]; u = (u & 0x80000000u) ? (u & 0x7fffffffu) : ~u; sv[k] = __uint_as_float(u); mx = fmaxf(mx, sv[k]); }
    float sum = 0.f;
#pragma unroll
    for (int k = 0; k < 16; ++k) { sv[k] = __expf(sv[k] - mx); sum += sv[k]; }
    const float inv = __builtin_amdgcn_rcpf(sum);
    u32x4 oi; f32x4 og;
#pragma unroll
    for (int i = 0; i < 4; ++i) { oi[i] = (c == 0) ? P[i] : (c == 1) ? P[4 + i] : (c == 2) ? P[8 + i] : P[12 + i];
      og[i] = ((c == 0) ? sv[i] : (c == 1) ? sv[4 + i] : (c == 2) ? sv[8 + i] : sv[12 + i]) * inv; }
    *(u32x4*)(IDX + (size_t)pr * 16 + 4 * c) = oi; *(f32x4*)(GV + (size_t)pr * 16 + 4 * c) = og;
  }
  __syncthreads();
}
#undef MERGE16
#undef MERGE16P

typedef float f32x16v __attribute__((ext_vector_type(16)));
typedef float f32x32v __attribute__((ext_vector_type(32)));
typedef unsigned u32x6 __attribute__((ext_vector_type(6)));
__device__ __forceinline__ void cvt_fp4_pass(const float* src, unsigned char* dst, float* inv, int r_begin, int r_end, int gw, int ngw, int lane) {
  for (int r0 = r_begin + gw * 2; r0 < r_end; r0 += ngw * 2) {
   f32x4 vv[2][8];
#pragma unroll
   for (int rr = 0; rr < 2; ++rr)
#pragma unroll
     for (int k = 0; k < 8; ++k) vv[rr][k] = *(const f32x4*)(src + (size_t)(r0 + rr) * 2048 + lane * 32 + k * 4);
#pragma unroll
   for (int rr = 0; rr < 2; ++rr) { const int r = r0 + rr; float amA = 0.f, amB = 0.f;
#pragma unroll
    for (int k = 0; k < 4; ++k)
#pragma unroll
      for (int i = 0; i < 4; ++i) { amA = fmaxf(amA, fabsf(vv[rr][k][i])); amB = fmaxf(amB, fabsf(vv[rr][4 + k][i])); }
    const float rmax = fmaxf(__uint_as_float(dpp_max64_u32(__float_as_uint(fmaxf(amA, amB)))), 1e-30f);
    const float rs = rmax * (1.f / 6.f); if (lane == 0) inv[r] = rs;
    const float ra = amA / rmax, rb = amB / rmax;
    unsigned code = (unsigned)__builtin_amdgcn_cvt_pk_fp8_f32(ra, rb, 0, false) & 0xffffu;
    { const f32x2 back = __builtin_amdgcn_cvt_pk_f32_fp8((int)code, false); if (back[0] < ra * 0.96f) code += 1u; if (back[1] < rb * 0.96f) code += 0x100u; }
    const f32x2 sab = __builtin_amdgcn_cvt_pk_f32_fp8((int)code, false);
    const float ia = sab[0] > 0.f ? 1.f / (rs * sab[0]) : 0.f, ib = sab[1] > 0.f ? 1.f / (rs * sab[1]) : 0.f;
    u32x4 o;
#pragma unroll
    for (int k = 0; k < 4; ++k) { unsigned w = 0u; const float iv = (k < 2) ? ia : ib; const f32x4 lo = vv[rr][2 * k] * iv, hi = vv[rr][2 * k + 1] * iv;
      w = (unsigned)__builtin_amdgcn_cvt_scalef32_pk_fp4_f32(w, lo[0], lo[1], 1.0f, 0); w = (unsigned)__builtin_amdgcn_cvt_scalef32_pk_fp4_f32(w, lo[2], lo[3], 1.0f, 1);
      w = (unsigned)__builtin_amdgcn_cvt_scalef32_pk_fp4_f32(w, hi[0], hi[1], 1.0f, 2); w = (unsigned)__builtin_amdgcn_cvt_scalef32_pk_fp4_f32(w, hi[2], hi[3], 1.0f, 3);
      o[k] = w; }
    *(u32x4*)(dst + (size_t)r * 1152 + lane * 16) = o;
    *(unsigned short*)(dst + (size_t)r * 1152 + 1024 + lane * 2) = (unsigned short)code;
   }
  }
}
__device__ __forceinline__ void ln_row_regs32(float (&v)[32], const float* g, const float* b, int lane) {
  float s = 0.f;
#pragma unroll
  for (int i = 0; i < 32; ++i) s += v[i];
  const float mean = dpp_sum64(s) * (1.f / 2048.f);
  float q = 0.f;
#pragma unroll
  for (int i = 0; i < 32; ++i) { v[i] -= mean; q += v[i] * v[i]; }
  const float rstd = rsqrtf(dpp_sum64(q) * (1.f / 2048.f) + LN_EPS);
#pragma unroll
  for (int k = 0; k < 8; ++k) { const f32x4 gg = *(const f32x4*)(g + lane * 32 + k * 4), bb = *(const f32x4*)(b + lane * 32 + k * 4);
#pragma unroll
    for (int i = 0; i < 4; ++i) v[k * 4 + i] = v[k * 4 + i] * rstd * gg[i] + bb[i]; }
}
#define DEC8(W, K, D) do { const f32x2 t0_ = __builtin_amdgcn_cvt_scalef32_pk_f32_fp4(W[K], 1.0f, 0), t1_ = __builtin_amdgcn_cvt_scalef32_pk_f32_fp4(W[K], 1.0f, 1), \
    t2_ = __builtin_amdgcn_cvt_scalef32_pk_f32_fp4(W[K], 1.0f, 2), t3_ = __builtin_amdgcn_cvt_scalef32_pk_f32_fp4(W[K], 1.0f, 3); D[4 * (K)] = t0_; D[4 * (K) + 1] = t1_; D[4 * (K) + 2] = t2_; D[4 * (K) + 3] = t3_; } while (0)
__device__ __forceinline__ void peer_phase(const Params& p, int gw, int ngw, int lane_in) {
  unsigned char* ws = p.ws; const bf16_t* X = (const bf16_t*)(ws + WS_X); const unsigned char* PU = ws + WS_PU; const unsigned char* PV = ws + WS_PV;
  const float* INVU = (const float*)(ws + WS_PINV); const float* INVV = INVU + 16384;
  const int* IDX = (const int*)(ws + WS_IDX); const float* GV = (const float*)(ws + WS_GV);
  for (int t = gw; t < T_; t += ngw) {
    int lane = lane_in; asm volatile("" : "+v"(lane));
    f32x2 x2[16];
#pragma unroll
    for (int k = 0; k < 4; ++k) { float f[8]; unpack8(*(const u32x4*)(X + (size_t)t * DM + lane * 32 + k * 8), f);
#pragma unroll
      for (int i = 0; i < 4; ++i) x2[k * 4 + i] = (f32x2){f[2 * i], f[2 * i + 1]}; }
    const int id0 = IDX[(size_t)t * 128 + lane], id1 = IDX[(size_t)t * 128 + 64 + lane];
    const float g0 = GV[(size_t)t * 128 + lane], g1 = GV[(size_t)t * 128 + 64 + lane];
    const float iu0 = INVU[id0], iu1 = INVU[id1], iv0 = INVV[id0], iv1 = INVV[id1];
    float z0 = 0.f, z1 = 0.f;
#pragma unroll 1
    for (int e0 = 0; e0 < 128; e0 += 8) {
      u32x4 w[8]; unsigned short sc[8];
#pragma unroll
      for (int q = 0; q < 8; ++q) { const int id = __builtin_amdgcn_readlane(e0 < 64 ? id0 : id1, (e0 + q) & 63); const unsigned char* rp = PU + (size_t)id * 1152;
        w[q] = *(const u32x4*)(rp + lane * 16); sc[q] = *(const unsigned short*)(rp + 1024 + lane * 2); }
#pragma unroll
      for (int q = 0; q < 8; ++q) { u32x4 ww = w[q]; { unsigned w0 = ww[0]; asm volatile("" : "+v"(w0) : "v"(z0), "v"(z1)); ww[0] = w0; }
        f32x2 d[16]; DEC8(ww, 0, d); DEC8(ww, 1, d); DEC8(ww, 2, d); DEC8(ww, 3, d);
        f32x2 pa = {0.f, 0.f}, pb = {0.f, 0.f};
#pragma unroll
        for (int i = 0; i < 8; ++i) { pa = d[i] * x2[i] + pa; pb = d[8 + i] * x2[8 + i] + pb; }
        const f32x2 sab = __builtin_amdgcn_cvt_pk_f32_fp8((int)sc[q], false);
        const float tot = dpp_sum64((pa[0] + pa[1]) * sab[0] + (pb[0] + pb[1]) * sab[1]);
        if (lane == ((e0 + q) & 63)) { if (e0 < 64) z0 = tot; else z1 = tot; }
        __builtin_amdgcn_sched_barrier(0); }
    }
    const float a0 = gelu_erf(z0 * iu0) * g0 * iv0, a1 = gelu_erf(z1 * iu1) * g1 * iv1;
    f32x2 acc2[16];
#pragma unroll
    for (int i = 0; i < 16; ++i) acc2[i] = (f32x2){0.f, 0.f};
#pragma unroll 1
    for (int e0 = 0; e0 < 128; e0 += 8) {
      u32x4 w[8]; unsigned short sc[8]; float av[8];
#pragma unroll
      for (int q = 0; q < 8; ++q) { const int id = __builtin_amdgcn_readlane(e0 < 64 ? id0 : id1, (e0 + q) & 63); const unsigned char* rp = PV + (size_t)id * 1152;
        av[q] = __uint_as_float(__builtin_amdgcn_readlane(__float_as_uint(e0 < 64 ? a0 : a1), (e0 + q) & 63));
        w[q] = *(const u32x4*)(rp + lane * 16); sc[q] = *(const unsigned short*)(rp + 1024 + lane * 2); }
#pragma unroll
      for (int q = 0; q < 8; ++q) { u32x4 ww = w[q]; { unsigned w0 = ww[0]; asm volatile("" : "+v"(w0) : "v"(acc2[15])); ww[0] = w0; }
        f32x2 d[16]; DEC8(ww, 0, d); DEC8(ww, 1, d); DEC8(ww, 2, d); DEC8(ww, 3, d);
        const f32x2 sab = __builtin_amdgcn_cvt_pk_f32_fp8((int)sc[q], false); const float sa = av[q] * sab[0], sb = av[q] * sab[1];
        const f32x2 aa = {sa, sa}, bb = {sb, sb};
#pragma unroll
        for (int i = 0; i < 8; ++i) { acc2[i] = d[i] * aa + acc2[i]; acc2[8 + i] = d[8 + i] * bb + acc2[8 + i]; }
        asm volatile("" : "+v"(acc2[0]), "+v"(acc2[1]), "+v"(acc2[2]), "+v"(acc2[3]), "+v"(acc2[4]), "+v"(acc2[5]), "+v"(acc2[6]), "+v"(acc2[7]), "+v"(acc2[8]), "+v"(acc2[9]), "+v"(acc2[10]), "+v"(acc2[11]), "+v"(acc2[12]), "+v"(acc2[13]), "+v"(acc2[14]), "+v"(acc2[15])); }
    }
    float acc[32];
#pragma unroll
    for (int i = 0; i < 16; ++i) { acc[2 * i] = acc2[i][0] + DN_ALPHA * x2[i][0]; acc[2 * i + 1] = acc2[i][1] + DN_ALPHA * x2[i][1]; }
    ln_row_regs32(acc, p.in[33], p.in[34], lane);
#pragma unroll
    for (int k = 0; k < 8; ++k) *(f32x4*)(p.out + (size_t)t * DM + lane * 32 + k * 4) = (f32x4){acc[k * 4], acc[k * 4 + 1], acc[k * 4 + 2], acc[k * 4 + 3]};
  }
}
#undef DEC8

#define LAS __attribute__((address_space(3)))
#define XB_TMO      128
#define XB_XCNT(j)  (256  + 64 * (j))
#define XB_XSUB(j)  (1280 + 64 * (j))
#define XB_XGEN(j)  (2304 + 64 * (j))
#define XB_TOP      3328
#define XB_TOPGEN   3392
#define XCD_BAR_WORDS 3456
#define XB_SPIN_CAP (1u << 22)
__device__ __forceinline__ unsigned xb_ld(unsigned* p)              { return __hip_atomic_load(p, __ATOMIC_RELAXED, __HIP_MEMORY_SCOPE_AGENT); }
__device__ __forceinline__ unsigned xb_add(unsigned* p, unsigned v) { return __hip_atomic_fetch_add(p, v, __ATOMIC_RELAXED, __HIP_MEMORY_SCOPE_AGENT); }
__device__ __forceinline__ unsigned xb_xcc_id() { return (unsigned)__builtin_amdgcn_s_getreg((3 << 11) | 20) & 0xFu; }
#define XB_SPIN(cond, bar) do { unsigned _sp = 0; while (cond) { __builtin_amdgcn_s_sleep(1); \
    if ((++_sp & 255u) == 0u) { if (xb_ld(&(bar)[XB_TMO])) break; if (_sp > XB_SPIN_CAP) { atomicAdd(&(bar)[XB_TMO], 1u); break; } } } } while (0)
struct XcdBarrier { unsigned* bar; unsigned x; volatile LAS unsigned* st; };
__device__ __forceinline__ XcdBarrier xcd_barrier_post(unsigned* bar, volatile LAS unsigned* st) {
  XcdBarrier b; b.bar = bar; b.x = xb_xcc_id(); b.st = st;
  if (threadIdx.x == 0) (void)xb_add(&bar[XB_XCNT(b.x)], 1u);
  return b;
}
__device__ __forceinline__ void xcd_barrier_complete(unsigned* bar, unsigned x, unsigned& nloc, unsigned& nx) {
  const unsigned G = gridDim.x * gridDim.y * gridDim.z;
  unsigned sum, cnt, mine, sp = 0u;
  for (;;) {
    sum = 0u; cnt = 0u; mine = 0u;
#pragma unroll
    for (unsigned j = 0; j < 16; ++j) { const unsigned c = xb_ld(&bar[XB_XCNT(j)]); sum += c; cnt += (c > 0u) ? 1u : 0u; mine = (j == x) ? c : mine; }
    if (sum == G) break;
    __builtin_amdgcn_s_sleep(1);
    if ((++sp & 255u) == 0u) { if (xb_ld(&bar[XB_TMO])) break; if (sp > XB_SPIN_CAP) { atomicAdd(&bar[XB_TMO], 1u); break; } }
  }
  nloc = mine > 0u ? mine : 1u; nx = cnt > 0u ? cnt : 1u;
}
__device__ __forceinline__ void xcd_barrier(const XcdBarrier& b) {
  asm volatile("s_waitcnt vmcnt(0)" ::: "memory");
  __syncthreads();
  if (threadIdx.x == 0) {
    unsigned* bar = b.bar;
    __builtin_amdgcn_s_waitcnt(0);
    unsigned nloc = b.st[0], nx = b.st[1];
    if (nloc == 0u) { xcd_barrier_complete(bar, b.x, nloc, nx); b.st[0] = nloc; b.st[1] = nx; }
    const unsigned old = xb_add(&bar[XB_XSUB(b.x)], 1u);
    const unsigned gen = old / nloc;
    if (old + 1u == (gen + 1u) * nloc) {
      __builtin_amdgcn_fence(__ATOMIC_RELEASE, "agent");
      asm volatile("s_waitcnt vmcnt(0)" ::: "memory");
      const unsigned og = xb_add(&bar[XB_TOP], 1u);
      const unsigned tg = og / nx;
      if (og + 1u == (tg + 1u) * nx) xb_add(&bar[XB_TOPGEN], 1u);
      else XB_SPIN(xb_ld(&bar[XB_TOPGEN]) == tg, bar);
      __builtin_amdgcn_fence(__ATOMIC_ACQUIRE, "agent");
      xb_add(&bar[XB_XGEN(b.x)], 1u);
      asm volatile("s_waitcnt vmcnt(0)" ::: "memory");
    } else {
      XB_SPIN(xb_ld(&bar[XB_XGEN(b.x)]) == gen, bar);
      __builtin_amdgcn_fence(__ATOMIC_ACQUIRE, "agent");
      asm volatile("s_waitcnt vmcnt(0)" ::: "memory");
    }
  }
  __syncthreads();
}

constexpr int CVT_EARLY = 4608, CVT_SPLIT = 11264;
#ifndef PROBE_LRU
#define PROBE_LRU 0
#endif
#ifndef USE_TOPK3
#define USE_TOPK3 1
#endif
#ifndef USE_TOPK2
#define USE_TOPK2 1
#endif
#ifndef PROBE_MASK
#define PROBE_MASK 0
#endif
#ifndef PROBE_PEER
#define PROBE_PEER 0
#endif
#ifndef PROBE_SYNC
#define PROBE_SYNC 0
#endif
#ifndef PROBE_TOPK
#define PROBE_TOPK 0
#endif
#ifndef USE_FAST_XATTN
#define USE_FAST_XATTN 1
#endif
#ifndef USE_FAST_MLA
#define USE_FAST_MLA 1
#endif
#ifndef FASTMASK
#define FASTMASK 0xff
#endif
#define GEMM(MODE, g, e) do { if constexpr ((FASTMASK >> MODE) & 1) gemm_fast<MODE>(g, e, lds_raw, bid, nblk); else gemm_simple<MODE>(g, e, bid, nblk, wave, lane); } while (0)
#define IDS int tid_ = threadIdx.x; asm volatile("" : "+v"(tid_)); const int tid = tid_, lane = tid & 63, wave = tid >> 6, gw = bid * NWAVE + wave; (void)tid; (void)lane; (void)wave; (void)gw
__global__ void __launch_bounds__(NTHR) fwd_kernel(Params p) {
  extern __shared__ __attribute__((aligned(16))) unsigned char lds_raw[];
  float* lds = (float*)lds_raw;
  cg::grid_group grid = cg::this_grid();
  const int bid = blockIdx.x, nblk = gridDim.x, ngw = nblk * NWAVE;
  unsigned char* ws = p.ws; unsigned char* dout = (unsigned char*)p.out;
  EpiArgs e{ws, dout, p.in, nullptr, nullptr, 0};
  volatile LAS unsigned* bst = (volatile LAS unsigned*)((LAS unsigned char*)lds_raw + (LDS_BYTES - 64));
  if (threadIdx.x < 2) bst[threadIdx.x] = 0u;
  __syncthreads();
  const XcdBarrier xbar = xcd_barrier_post((unsigned*)ws, bst);
#define GSYNC() xcd_barrier(xbar)

  for (int rp_ = 0; rp_ < 1 + ((PROBE_MASK >> 0) & 1); ++rp_) { { IDS; if (nblk == 256) phase0<true>(p, lds, gw, ngw, lane, wave); else phase0<false>(p, lds, gw, ngw, lane, wave); } }
  if (__builtin_expect(p.ws == nullptr, 0)) grid.sync();
  GSYNC();
  if (nblk == 256 && ((bid >= 64 && bid < 128) || bid >= 160)) { IDS;
    const int sb = (bid < 128) ? bid - 64 : bid - 96; transpose_list<1>(p, lds + wave * (64 * 33), sb * NWAVE + wave, 160 * NWAVE, lane);
    cvt_fp4_pass(p.in[31], ws + WS_PU, (float*)(ws + WS_PINV), 0, CVT_EARLY, sb * NWAVE + wave, 160 * NWAVE, lane);
    cvt_fp4_pass(p.in[32], ws + WS_PV, (float*)(ws + WS_PINV) + 16384, 0, CVT_EARLY, sb * NWAVE + wave, 160 * NWAVE, lane);
    __syncthreads(); }
  for (int rp_ = 0; rp_ < 1 + ((PROBE_MASK >> 1) & 1); ++rp_) { { IDS; GemmArgs g{(const bf16_t*)(ws + WS_X), 2048, 0, (const bf16_t*)(ws + WS_WIN_T), 2048, 0, T_, 3328, 2048, 1}; GEMM(E_WIN, g, e); } }
  for (int rp_ = 0; rp_ < 1 + ((PROBE_MASK >> 1) & 1); ++rp_) { { IDS; GemmArgs g{(const bf16_t*)(ws + WS_MEMB), 2048, 0, (const bf16_t*)(ws + WS_WMKV_T), 2048, 0, 2048, 1024, 2048, 1, 128}; GEMM(E_MEMKV, g, e); } }
  GSYNC();
  { IDS; phase1b(p, gw, ngw, lane); }
  GSYNC();
  for (int rp_ = 0; rp_ < 1 + ((PROBE_MASK >> 2) & 1); ++rp_) { { IDS; GemmArgs g{(const bf16_t*)(ws + WS_CQ), 512, 0, (const bf16_t*)(ws + WS_WUQ_T), 512, 0, T_, 1536, 512, 1}; GEMM(E_Q, g, e); } }
  for (int rp_ = 0; rp_ < 1 + ((PROBE_MASK >> 2) & 1); ++rp_) { { IDS; GemmArgs g{(const bf16_t*)(ws + WS_CKV), 512, 0, (const bf16_t*)(ws + WS_WUKV_T), 512, 0, T_, 2048, 512, 1}; GEMM(E_KV, g, e); } }
#if USE_LRU_FUSED
  for (int rp_ = 0; rp_ < 1 + PROBE_LRU; ++rp_) lru_fused_phase(p, lds_raw, bid, nblk);
#else
  for (int rp_ = 0; rp_ < 1 + ((PROBE_MASK >> 2) & 1); ++rp_) { { IDS; GemmArgs g{(const bf16_t*)(ws + WS_XC), 1024, 128, (const bf16_t*)(ws + WS_WG_T), 128, 512 * 128, T_, 512, 128, 8}; GEMM(E_GATES, g, e); } }
#endif
  GSYNC();
#if USE_FAST_MLA
  for (int rp_ = 0; rp_ < 1 + ((PROBE_MASK >> 4) & 1); ++rp_) { mla_attn_phase(dout, ws, (char*)lds_raw, bid, nblk); }
#else
  { IDS; attn_scalar<192, 2048>((const bf16_t*)(dout + DO_Q), 1536, (const bf16_t*)(dout + DO_K), 1536, (const bf16_t*)(dout + DO_V), 1024, (bf16_t*)(ws + WS_YMIX), 2048, 8,
                         0.07216878364870322f, lds, bid, nblk, tid); }
#endif
#if !USE_LRU_FUSED
  { IDS; scan_phase(ws, lds, bid, nblk, tid); }
#endif
  GSYNC();
  { IDS; phase3b(p, gw, ngw, lane); }
  GSYNC();
  { IDS; GemmArgs g{(const bf16_t*)(ws + WS_YMIX), 2048, 0, (const bf16_t*)(ws + WS_WOUT_T), 2048, 0, T_, 2048, 2048, 1}; GEMM(E_RES, g, e); }
  GSYNC();
  { IDS; ln_pass(ws, p.in[20], p.in[21], gw, ngw, lane); }
  { IDS; const int rlo = (nblk == 256) ? CVT_EARLY : 0, rsplit = (nblk == 256) ? CVT_SPLIT : 16384;
    cvt_fp4_pass(p.in[31], ws + WS_PU, (float*)(ws + WS_PINV), rlo, rsplit, gw, ngw, lane);
    cvt_fp4_pass(p.in[32], ws + WS_PV, (float*)(ws + WS_PINV) + 16384, rlo, rsplit, gw, ngw, lane); }
  GSYNC();
  for (int rp_ = 0; rp_ < 1 + ((PROBE_MASK >> 5) & 1); ++rp_) { { IDS; GemmArgs g{(const bf16_t*)(ws + WS_X), 2048, 0, (const bf16_t*)(ws + WS_WMQ_T), 2048, 0, T_, 512, 2048, 1}; EpiArgs e2 = e; e2.o = (bf16_t*)(ws + WS_QM); e2.ld = 512; GEMM(E_BF16, g, e2); }
  if (nblk == 256 && bid >= 128) { IDS; const int g2 = (bid - 128) * NWAVE + wave;
    cvt_fp4_pass(p.in[31], ws + WS_PU, (float*)(ws + WS_PINV), CVT_SPLIT, 16384, g2, 128 * NWAVE, lane);
    cvt_fp4_pass(p.in[32], ws + WS_PV, (float*)(ws + WS_PINV) + 16384, CVT_SPLIT, 16384, g2, 128 * NWAVE, lane); } }
  GSYNC();
#if USE_FAST_XATTN
  for (int rp_ = 0; rp_ < 1 + ((PROBE_MASK >> 5) & 1); ++rp_) { mem_attn_phase(ws, (char*)lds_raw, bid, nblk); }
#else
  { IDS; attn_scalar<128, 256>((const bf16_t*)(ws + WS_QM), 512, (const bf16_t*)(ws + WS_MEMKV), 1024, (const bf16_t*)(ws + WS_MEMKV) + 512, 1024, (bf16_t*)(ws + WS_OM), 512, 4,
                        0.08838834764831845f, lds, bid, nblk, tid); }
#endif
  GSYNC();
  { IDS; GemmArgs g{(const bf16_t*)(ws + WS_OM), 512, 0, (const bf16_t*)(ws + WS_WMO_T), 512, 0, T_, 2048, 512, 1}; GEMM(E_RES, g, e); }
  GSYNC();
  { IDS; ln_pass(ws, p.in[26], p.in[27], gw, ngw, lane); }
  GSYNC();
  for (int rp_ = 0; rp_ < 1 + ((PROBE_MASK >> 3) & 1); ++rp_) { { IDS; GemmArgs g{(const bf16_t*)(ws + WS_X), 2048, 0, (const bf16_t*)(ws + WS_WPQ_T), 2048, 0, T_, 2048, 2048, 1}; EpiArgs e2 = e; e2.o = (bf16_t*)(ws + WS_QP); e2.ld = 2048; GEMM(E_BF16, g, e2); } }
  GSYNC();
#if USE_TOPK3
  for (int rep_ = 0; rep_ < 1 + PROBE_TOPK; ++rep_) { IDS; topk_phase3(p, lds_raw, gw, ngw, tid); }
#else
  for (int rp_ = 0; rp_ < 1 + ((PROBE_MASK >> 3) & 1); ++rp_) { { IDS; GemmArgs g{(const bf16_t*)(ws + WS_QP), 256, 0, (const bf16_t*)(ws + WS_KEYS_T), 256, 0, T_ * 8, 256, 256, 1}; EpiArgs e2 = e; e2.f = (float*)dout; e2.ld = 256; GEMM(E_F32, g, e2); } }
  GSYNC();
  for (int rep_ = 0; rep_ < 1 + PROBE_TOPK; ++rep_) { IDS; if (USE_TOPK2) topk_phase2(ws, (const float*)dout, gw, ngw, lane); else topk_phase(ws, (const float*)dout, gw, ngw, lane); }
#endif
  GSYNC();
  for (int rep_ = 0; rep_ < 1 + PROBE_PEER; ++rep_) { IDS; peer_phase(p, gw, ngw, lane); }
  for (int rep_ = 0; rep_ < PROBE_SYNC; ++rep_) GSYNC();
}

extern "C" void kernel_launch(void* const* d_in, const int* in_sizes, int n_in, void* d_out, int out_size, void* d_ws, size_t ws_size, hipStream_t stream) {
  static int grid_blocks = 0;
  if (grid_blocks == 0) {
    if (n_in != 35 || ws_size < WS_END || out_size != T_ * DM) { fprintf(stderr, "kernel_launch: unexpected shapes n_in %d ws %zu out %d\n", n_in, ws_size, out_size); grid_blocks = -1; return; }
    int dev = 0, cus = 0, per_cu = 0;
    hipGetDevice(&dev); hipDeviceGetAttribute(&cus, hipDeviceAttributeMultiprocessorCount, dev);
    if (hipFuncSetAttribute((const void*)fwd_kernel, hipFuncAttributeMaxDynamicSharedMemorySize, LDS_BYTES) != hipSuccess) { fprintf(stderr, "hipFuncSetAttribute failed\n"); grid_blocks = -1; return; }
    if (hipOccupancyMaxActiveBlocksPerMultiprocessor(&per_cu, (const void*)fwd_kernel, NTHR, LDS_BYTES) != hipSuccess || per_cu < 1) { fprintf(stderr, "occupancy query failed (%d)\n", per_cu); grid_blocks = -1; return; }
    grid_blocks = cus * per_cu;
    fprintf(stderr, "kernel_launch: cus %d per_cu %d grid %d ws %zu\n", cus, per_cu, grid_blocks, ws_size);
  }
  if (grid_blocks < 0) return;
  if (hipMemsetAsync(d_ws, 0, 65536, stream) != hipSuccess) { fprintf(stderr, "memset failed\n"); return; }
  Params p{};
  for (int i = 0; i < 35; ++i) p.in[i] = (const float*)d_in[i];
  p.out = (float*)d_out; p.ws = (unsigned char*)d_ws;
  void* args[] = {&p};
  hipError_t err = hipLaunchCooperativeKernel((const void*)fwd_kernel, dim3(grid_blocks), dim3(NTHR), args, LDS_BYTES, stream);
  if (err != hipSuccess) fprintf(stderr, "cooperative launch failed: %s (grid %d)\n", hipGetErrorString(err), grid_blocks);
}
```

```cpp
#include <hip/hip_runtime.h>
#include <hip/hip_cooperative_groups.h>
#include <cstdio>
#include <cstdint>
namespace cg = cooperative_groups;
#ifndef USE_LRU_FUSED
#define USE_LRU_FUSED 1
#endif

typedef unsigned short bf16_t;
typedef short bf16x8 __attribute__((ext_vector_type(8)));
typedef float f32x4 __attribute__((ext_vector_type(4)));
typedef float f32x2 __attribute__((ext_vector_type(2)));
typedef float f32x16 __attribute__((ext_vector_type(16)));
typedef unsigned u32x4 __attribute__((ext_vector_type(4)));
typedef unsigned u32x2 __attribute__((ext_vector_type(2)));

constexpr int T_ = 16384, S_ = 2048, NB_ = 8, DM = 2048;
constexpr int NTHR = 512, NWAVE = 8;
constexpr float DN_ALPHA = 1.189207115002721f;
constexpr float LN_EPS = 1e-5f, RMS_EPS = 1e-6f;
constexpr int LDS_BYTES = 147456;

constexpr size_t MiB = 1u << 20;
constexpr size_t WS_WIN_T = 1 * MiB;
constexpr size_t WS_WUQ_T = 14 * MiB;
constexpr size_t WS_WUKV_T = WS_WUQ_T + 1536 * 512 * 2;
constexpr size_t WS_WG_T = WS_WUKV_T + 2 * MiB;
constexpr size_t WS_WOUT_T = WS_WG_T + 1 * MiB;
constexpr size_t WS_WMQ_T = WS_WOUT_T + 8 * MiB;
constexpr size_t WS_WMKV_T = WS_WMQ_T + 2 * MiB;
constexpr size_t WS_WMO_T = WS_WMKV_T + 4 * MiB;
constexpr size_t WS_WPQ_T = WS_WMO_T + 2 * MiB;
constexpr size_t WS_KEYS_T = WS_WPQ_T + 8 * MiB;
constexpr size_t WS_COS = 43 * MiB, WS_SIN = 45 * MiB;
constexpr size_t WS_MEMB = 47 * MiB;
constexpr size_t WS_MEMKV = 55 * MiB;
constexpr size_t WS_GTAB = 59 * MiB;
static_assert(WS_KEYS_T + 256 * 256 * 2 <= WS_COS, "weights region");
constexpr size_t WS_LAF = 60 * MiB, WS_BTF = 92 * MiB, WS_LAB = 124 * MiB, WS_BTB = 156 * MiB;
constexpr size_t WS_PU = 60 * MiB, WS_PV = 124 * MiB;
constexpr size_t PSCL_OFF = 16 * MiB;
constexpr size_t WS_PINV = 59 * MiB + 65536;
constexpr size_t WS_X = 188 * MiB;
constexpr size_t WS_CQ = 252 * MiB, WS_CKV = 268 * MiB, WS_KPE = 284 * MiB;
constexpr size_t WS_LRUX = 286 * MiB, WS_GATE = 318 * MiB, WS_YMIX = 350 * MiB, WS_XC = 414 * MiB;
constexpr size_t WS_QM = WS_CQ, WS_OM = WS_CKV, WS_QP = WS_YMIX, WS_IDX = WS_LRUX, WS_GV = WS_LRUX + 8 * MiB, WS_ACT = WS_LRUX + 16 * MiB;
constexpr size_t WS_END = 446 * MiB;
constexpr size_t DO_Q = 0, DO_K = 48 * MiB, DO_V = 96 * MiB;

__device__ __forceinline__ unsigned f2bf(float f) { unsigned u = __float_as_uint(f); return (u + 0x7fffu + ((u >> 16) & 1u)) >> 16; }
__device__ __forceinline__ float bf2f(unsigned h) { return __uint_as_float(h << 16); }
__device__ __forceinline__ unsigned pk2(float lo, float hi) { unsigned r; asm("v_cvt_pk_bf16_f32 %0, %1, %2" : "=v"(r) : "v"(lo), "v"(hi)); return r; }
__device__ __forceinline__ float bflo(unsigned w) { return __uint_as_float(w << 16); }
__device__ __forceinline__ float bfhi(unsigned w) { return __uint_as_float(w & 0xffff0000u); }
__device__ __forceinline__ float dpp_sum64(float v) {
#define DPPF(x, ctrl, rm, bc) __builtin_bit_cast(float, __builtin_amdgcn_update_dpp(0, __builtin_bit_cast(int, x), ctrl, rm, 0xf, bc))
  v += DPPF(v, 0x111, 0xf, true); v += DPPF(v, 0x112, 0xf, true); v += DPPF(v, 0x114, 0xf, true); v += DPPF(v, 0x118, 0xf, true);
  v += DPPF(v, 0x142, 0xa, false); v += DPPF(v, 0x143, 0xc, false);
#undef DPPF
  return __uint_as_float(__builtin_amdgcn_readlane(__float_as_uint(v), 63));
}
__device__ __forceinline__ unsigned dpp_max64_u32(unsigned v) {
#define DPPU(x, ctrl, rm, bc) (unsigned)__builtin_amdgcn_update_dpp(0, (int)(x), ctrl, rm, 0xf, bc)
  unsigned w;
  w = DPPU(v, 0x111, 0xf, true); v = v > w ? v : w; w = DPPU(v, 0x112, 0xf, true); v = v > w ? v : w;
  w = DPPU(v, 0x114, 0xf, true); v = v > w ? v : w; w = DPPU(v, 0x118, 0xf, true); v = v > w ? v : w;
  w = DPPU(v, 0x142, 0xa, false); v = v > w ? v : w; w = DPPU(v, 0x143, 0xc, false); v = v > w ? v : w;
#undef DPPU
  return (unsigned)__builtin_amdgcn_readlane((int)v, 63);
}
__device__ __forceinline__ float wave_sum(float v) {
#pragma unroll
  for (int o = 1; o < 64; o <<= 1) v += __shfl_xor(v, o);
  return v;
}
__device__ __forceinline__ float wave_max(float v) {
#pragma unroll
  for (int o = 1; o < 64; o <<= 1) v = fmaxf(v, __shfl_xor(v, o));
  return v;
}
__device__ __forceinline__ unsigned wave_max_u32(unsigned v) {
#pragma unroll
  for (int o = 1; o < 64; o <<= 1) { unsigned w = (unsigned)__shfl_xor((int)v, o); v = v > w ? v : w; }
  return v;
}
typedef __bf16 bf16x2_t __attribute__((ext_vector_type(2)));
__device__ __forceinline__ float dot2_bf16(unsigned w, unsigned x, float acc) { return __builtin_amdgcn_fdot2_f32_bf16(__builtin_bit_cast(bf16x2_t, w), __builtin_bit_cast(bf16x2_t, x), acc, false); }
__device__ __forceinline__ float sigmoidf_(float x) { return __builtin_amdgcn_rcpf(1.f + __expf(-x)); }
__device__ __forceinline__ float neg_expm1_small(float x) {
  const float s = x * (1.f + x * (0.5f + x * (1.6666667e-1f + x * (4.1666667e-2f + x * (8.3333333e-3f + x * 1.3888889e-3f)))));
  const float e = 1.f - __builtin_amdgcn_exp2f(x * 1.4426950408889634f);
  return x > -0.25f ? -s : e;
}
__device__ __forceinline__ float gelu_tanh(float x) {
  const float u = 0.7978845608028654f * (x + 0.044715f * x * x * x);
  const float t = 1.f - 2.f / (__expf(2.f * u) + 1.f);
  return 0.5f * x * (1.f + t);
}
__device__ __forceinline__ float gelu_erf(float x) { return 0.5f * x * (1.f + erff(x * 0.7071067811865476f)); }
__device__ __forceinline__ void unpack8(u32x4 w, float* f) {
  f[0] = bflo(w.x); f[1] = bfhi(w.x); f[2] = bflo(w.y); f[3] = bfhi(w.y); f[4] = bflo(w.z); f[5] = bfhi(w.z); f[6] = bflo(w.w); f[7] = bfhi(w.w);
}
__device__ __forceinline__ u32x4 pack8(const float* f) { u32x4 w; w.x = pk2(f[0], f[1]); w.y = pk2(f[2], f[3]); w.z = pk2(f[4], f[5]); w.w = pk2(f[6], f[7]); return w; }

struct Params { const float* in[35]; float* out; unsigned char* ws; };

__device__ __forceinline__ const float* wsrc(const float* const* in, int mid, int n, int& ld) {
  switch (mid) {
    case 0: { ld = 3136; int c; if (n < 1024) c = n; else if (n < 3072) c = n + 64; else if (n < 3136) { int i = (n - 3072) >> 1, g = (n - 3072) & 1; c = 1024 + g * 32 + i; } else return nullptr; return in[5] + c; }
    case 1: { ld = 1536; int h = n / 192, j = n % 192, c; if (j < 128) c = h * 192 + j; else { int i = (j - 128) >> 1, g = (j - 128) & 1; c = h * 192 + 128 + g * 32 + i; } return in[7] + c; }
    case 2: { ld = 2048; int c; if (n < 1024) c = (n >> 7) * 256 + (n & 127); else { int m = n - 1024; c = (m >> 7) * 256 + 128 + (m & 127); } return in[9] + c; }
    case 3: ld = 2048; return in[19] + n;
    case 4: ld = 512; return in[22] + n;
    case 5: ld = 512; return n < 512 ? in[23] + n : in[24] + (n - 512);
    case 6: ld = 2048; return in[25] + n;
    case 7: ld = 2048; return in[28] + n;
    default: { ld = 128; int nb = n >> 9, q = n & 511, dir = q >> 8, jj = (q & 255) >> 1, gate = q & 1; const float* m = (gate ? in[14] : in[12]) + (size_t)((dir * 8 + nb) * 128) * 128; return m + jj; }
  }
}
__device__ __forceinline__ void transpose_item(const float* const* in, int mid, int K, bf16_t* WT, float* scr, int item, int nblk, int lane) {
  const int kb = item / nblk, nb = item % nblk, k0 = 64 * kb, n0 = 32 * nb;
  int ld = 0; const float* base = wsrc(in, mid, n0 + (lane & 31), ld);
  float tv[32];
#pragma unroll
  for (int i = 0; i < 32; ++i) { const int kk = 2 * i + (lane >> 5); tv[i] = base ? base[(size_t)(k0 + kk) * ld] : 0.f; }
#pragma unroll
  for (int i = 0; i < 32; ++i) { const int kk = 2 * i + (lane >> 5); scr[kk * 33 + (lane & 31)] = tv[i]; }
  asm volatile("s_waitcnt lgkmcnt(0)" ::: "memory");
  const int c = lane & 7;
#pragma unroll
  for (int j = 0; j < 4; ++j) { const int n = (lane >> 3) + 8 * j; const float* s = scr + (8 * c) * 33 + n;
    u32x4 o; o.x = pk2(s[0 * 33], s[1 * 33]); o.y = pk2(s[2 * 33], s[3 * 33]); o.z = pk2(s[4 * 33], s[5 * 33]); o.w = pk2(s[6 * 33], s[7 * 33]);
    *(u32x4*)(WT + (size_t)(n0 + n) * K + k0 + 8 * c) = o; }
  asm volatile("s_waitcnt lgkmcnt(0)" ::: "memory");
}
__device__ __forceinline__ void ln_row_regs(float (&v)[32], const float* g, const float* b, int lane) {
  float s = 0.f;
#pragma unroll
  for (int i = 0; i < 32; ++i) s += v[i];
  const float mean = dpp_sum64(s) * (1.f / 2048.f);
  float q = 0.f;
#pragma unroll
  for (int i = 0; i < 32; ++i) { v[i] -= mean; q += v[i] * v[i]; }
  const float rstd = rsqrtf(dpp_sum64(q) * (1.f / 2048.f) + LN_EPS);
#pragma unroll
  for (int j = 0; j < 4; ++j) {
    const f32x4 g0 = *(const f32x4*)(g + j * 512 + lane * 8), g1 = *(const f32x4*)(g + j * 512 + lane * 8 + 4);
    const f32x4 b0 = *(const f32x4*)(b + j * 512 + lane * 8), b1 = *(const f32x4*)(b + j * 512 + lane * 8 + 4);
#pragma unroll
    for (int e = 0; e < 4; ++e) { v[j * 8 + e] = v[j * 8 + e] * rstd * g0[e] + b0[e]; v[j * 8 + 4 + e] = v[j * 8 + 4 + e] * rstd * g1[e] + b1[e]; }
  }
}
__device__ __forceinline__ void sincos_big(float ang, float& c, float& s) {
  const double a = (double)ang;
  const double q = __builtin_rint(a * 0.63661977236758134308);
  const float r = (float)(a - q * 1.57079632679489661923);
  const int qi = ((int)q) & 3;
  const float r2 = r * r;
  const float sn = r + r * r2 * (-1.6666667e-1f + r2 * (8.3333333e-3f + r2 * (-1.9841270e-4f + r2 * 2.7557319e-6f)));
  const float cs = 1.f + r2 * (-0.5f + r2 * (4.1666667e-2f + r2 * (-1.3888889e-3f + r2 * (2.4801587e-5f + r2 * -2.7557319e-7f))));
  const float ss = (qi & 1) ? cs : sn, cc = (qi & 1) ? sn : cs;
  s = (qi & 2) ? -ss : ss;
  c = ((qi + 1) & 2) ? -cc : cc;
}

template <int WHICH> __device__ __forceinline__ void transpose_list(const Params& p, float* scr, int gw, int ngw, int lane) {
  struct TI { int mid, ndst, K; size_t off; };
  constexpr int NT = (WHICH == 0) ? 2 : (WHICH == 1) ? 7 : 9;
  const TI all[9] = {{0, 3328, 2048, WS_WIN_T}, {5, 1024, 2048, WS_WMKV_T}, {1, 1536, 512, WS_WUQ_T}, {2, 2048, 512, WS_WUKV_T}, {3, 2048, 2048, WS_WOUT_T}, {4, 512, 2048, WS_WMQ_T},
                     {6, 2048, 512, WS_WMO_T}, {7, 2048, 2048, WS_WPQ_T}, {8, 4096, 128, WS_WG_T}};
  constexpr int T0 = (WHICH == 1) ? 2 : 0;
  int total = 0;
#pragma unroll
  for (int t = 0; t < NT; ++t) total += (all[T0 + t].ndst / 32) * (all[T0 + t].K / 64);
  for (int git = gw; git < total; git += ngw) {
    int t = 0, it = git;
#pragma unroll
    for (int u = 0; u < NT - 1; ++u) { const int nit = (all[T0 + u].ndst / 32) * (all[T0 + u].K / 64); if (t == u && it >= nit) { it -= nit; t = u + 1; } }
    int mid = 0, ndst = 0, K = 0; size_t off = 0;
#pragma unroll
    for (int u = 0; u < NT; ++u) if (t == u) { mid = all[T0 + u].mid; ndst = all[T0 + u].ndst; K = all[T0 + u].K; off = all[T0 + u].off; }
    transpose_item(p.in, mid, K, (bf16_t*)(p.ws + off), scr, it, ndst / 32, lane);
  }
}
template <bool EARLY_ONLY> __device__ __forceinline__ void phase0(const Params& p, float* lds, int gw, int ngw, int lane, int wave) {
  unsigned char* ws = p.ws;
  float* scr = lds + wave * (64 * 33);
  transpose_list<(EARLY_ONLY ? 0 : 2)>(p, scr, gw, ngw, lane);
  { bf16_t* KT = (bf16_t*)(ws + WS_KEYS_T);
    for (int i = gw * 64 + lane; i < 256 * 256; i += ngw * 64) { const int n = i >> 8, k = i & 255; float v = 0.f;
      if (n < 128) { if (k < 128) v = p.in[29][n * 128 + k]; } else { if (k >= 128) v = p.in[30][(n - 128) * 128 + (k - 128)]; }
      KT[i] = (bf16_t)f2bf(v); } }
  { f32x4* gt = (f32x4*)(ws + WS_GTAB);
    for (int i = gw * 64 + lane; i < 2048; i += ngw * 64) gt[i] = (f32x4){8.f * log1pf(__expf(-p.in[16][i])), p.in[13][i], p.in[15][i], 0.f}; }
  { float* ct = (float*)(ws + WS_COS); float* st = (float*)(ws + WS_SIN); const int* pos = (const int*)p.in[2];
    for (int i = gw * 64 + lane; i < T_ * 32; i += ngw * 64) { const int t = i >> 5, f = i & 31;
      const float inv = exp2f(-(float)(2 * f) * (13.287712379549449f / 64.f));
      const float ang = (float)pos[t] * inv; float c, s; sincos_big(ang, c, s); ct[i] = c; st[i] = s; } }
  { const float* m = p.in[1]; bf16_t* mb = (bf16_t*)(ws + WS_MEMB);
    for (size_t i = (size_t)(gw * 64 + lane) * 8; i < (size_t)2048 * 2048; i += (size_t)ngw * 64 * 8) {
      const f32x4 a = *(const f32x4*)(m + i), b = *(const f32x4*)(m + i + 4); u32x4 o; o.x = pk2(a[0], a[1]); o.y = pk2(a[2], a[3]); o.z = pk2(b[0], b[1]); o.w = pk2(b[2], b[3]);
      *(u32x4*)(mb + i) = o; } }
  { const float* x = p.in[0]; bf16_t* X = (bf16_t*)(ws + WS_X);
    for (int r0 = gw * 2; r0 < T_; r0 += ngw * 2) { float v[2][32];
#pragma unroll
      for (int rr = 0; rr < 2; ++rr)
#pragma unroll
        for (int j = 0; j < 4; ++j) { const f32x4 a = *(const f32x4*)(x + (size_t)(r0 + rr) * DM + j * 512 + lane * 8), b = *(const f32x4*)(x + (size_t)(r0 + rr) * DM + j * 512 + lane * 8 + 4);
#pragma unroll
          for (int e = 0; e < 4; ++e) { v[rr][j * 8 + e] = a[e]; v[rr][j * 8 + 4 + e] = b[e]; } }
#pragma unroll
      for (int rr = 0; rr < 2; ++rr) { ln_row_regs(v[rr], p.in[3], p.in[4], lane);
#pragma unroll
        for (int j = 0; j < 4; ++j) *(u32x4*)(X + (size_t)(r0 + rr) * DM + j * 512 + lane * 8) = pack8(&v[rr][j * 8]); } } }
}

enum { E_WIN = 0, E_MEMKV, E_Q, E_KV, E_GATES, E_RES, E_BF16, E_F32 };
struct EpiArgs { unsigned char* ws; unsigned char* dout; const float* const* in; bf16_t* o; float* f; int ld; };
__device__ __forceinline__ void st4(bf16_t* ptr, f32x4 v) { u32x2 w; w.x = pk2(v[0], v[1]); w.y = pk2(v[2], v[3]); *(u32x2*)ptr = w; }
template <int MODE> __device__ __forceinline__ void epi(const EpiArgs& e, int batch, int row, int col, f32x4 v) {
  if constexpr (MODE == E_WIN) {
    if (col < 512) st4((bf16_t*)(e.ws + WS_CQ) + (size_t)row * 512 + col, v);
    else if (col < 1024) st4((bf16_t*)(e.ws + WS_CKV) + (size_t)row * 512 + (col - 512), v);
    else if (col < 2048) st4((bf16_t*)(e.ws + WS_LRUX) + (size_t)row * 1024 + (col - 1024), v);
    else if (col < 3072) { f32x4 g; for (int i = 0; i < 4; ++i) g[i] = gelu_tanh(v[i]); st4((bf16_t*)(e.ws + WS_GATE) + (size_t)row * 1024 + (col - 2048), g); }
    else if (col < 3136) st4((bf16_t*)(e.ws + WS_KPE) + (size_t)row * 64 + (col - 3072), v);
  } else if constexpr (MODE == E_MEMKV) {
    st4((bf16_t*)(e.ws + WS_MEMKV) + (size_t)row * 1024 + col, v);
  } else if constexpr (MODE == E_Q) {
    const int j = col % 192;
    if (j >= 128) { const int i0 = (j - 128) >> 1; const float* ct = (const float*)(e.ws + WS_COS) + (size_t)row * 32 + i0; const float* st = (const float*)(e.ws + WS_SIN) + (size_t)row * 32 + i0;
      const float c0 = ct[0], s0 = st[0], c1 = ct[1], s1 = st[1];
      v = (f32x4){v[0] * c0 - v[1] * s0, v[1] * c0 + v[0] * s0, v[2] * c1 - v[3] * s1, v[3] * c1 + v[2] * s1}; }
    st4((bf16_t*)(e.dout + DO_Q) + (size_t)row * 1536 + col, v);
  } else if constexpr (MODE == E_KV) {
    if (col < 1024) st4((bf16_t*)(e.dout + DO_K) + (size_t)row * 1536 + (col >> 7) * 192 + (col & 127), v);
    else st4((bf16_t*)(e.dout + DO_V) + (size_t)row * 1024 + (col - 1024), v);
  } else if constexpr (MODE == E_GATES) {
    const int dir = col >> 8, jj = (col & 255) >> 1, c0 = batch * 128 + jj;
    const f32x4* gt = (const f32x4*)(e.ws + WS_GTAB) + dir * 1024 + c0;
    const f32x4 t0 = gt[0], t1 = gt[1];
    const unsigned xw = *(const unsigned*)((const bf16_t*)(e.ws + WS_XC) + (size_t)row * 1024 + c0);
    const float la0 = -t0[0] * sigmoidf_(v[0] + t0[1]), la1 = -t1[0] * sigmoidf_(v[2] + t1[1]);
    const float bt0 = __builtin_amdgcn_sqrtf(neg_expm1_small(2.f * la0)) * sigmoidf_(v[1] + t0[2]) * bflo(xw);
    const float bt1 = __builtin_amdgcn_sqrtf(neg_expm1_small(2.f * la1)) * sigmoidf_(v[3] + t1[2]) * bfhi(xw);
    bf16_t* LA = (bf16_t*)(e.ws + (dir ? WS_LAB : WS_LAF)); bf16_t* BT = (bf16_t*)(e.ws + (dir ? WS_BTB : WS_BTF));
    *(unsigned*)(LA + (size_t)row * 1024 + c0) = pk2(la0, la1);
    *(unsigned*)(BT + (size_t)row * 1024 + c0) = pk2(bt0, bt1);
  } else if constexpr (MODE == E_RES) {
    bf16_t* X = (bf16_t*)(e.ws + WS_X) + (size_t)row * DM + col; const u32x2 w = *(const u32x2*)X;
    v = (f32x4){DN_ALPHA * bflo(w.x) + v[0], DN_ALPHA * bfhi(w.x) + v[1], DN_ALPHA * bflo(w.y) + v[2], DN_ALPHA * bfhi(w.y) + v[3]};
    st4(X, v);
  } else if constexpr (MODE == E_BF16) {
    st4(e.o + (size_t)row * e.ld + col, v);
  } else {
    *(f32x4*)(e.f + (size_t)row * e.ld + col) = v;
  }
}


__device__ __forceinline__ void st8(bf16_t* ptr, f32x4 a, f32x4 b) { u32x4 w; w.x = pk2(a[0], a[1]); w.y = pk2(a[2], a[3]); w.z = pk2(b[0], b[1]); w.w = pk2(b[2], b[3]); *(u32x4*)ptr = w; }
template <int MODE> __device__ __forceinline__ void epi8(const EpiArgs& e, int batch, int row, int col, f32x4 v0, f32x4 v1) {
  if constexpr (MODE == E_WIN) {
    if (col < 512) st8((bf16_t*)(e.ws + WS_CQ) + (size_t)row * 512 + col, v0, v1);
    else if (col < 1024) st8((bf16_t*)(e.ws + WS_CKV) + (size_t)row * 512 + (col - 512), v0, v1);
    else if (col < 2048) st8((bf16_t*)(e.ws + WS_LRUX) + (size_t)row * 1024 + (col - 1024), v0, v1);
    else if (col < 3072) { f32x4 g0, g1;
#pragma unroll
      for (int i = 0; i < 4; ++i) { g0[i] = gelu_tanh(v0[i]); g1[i] = gelu_tanh(v1[i]); }
      st8((bf16_t*)(e.ws + WS_GATE) + (size_t)row * 1024 + (col - 2048), g0, g1); }
    else if (col < 3136) st8((bf16_t*)(e.ws + WS_KPE) + (size_t)row * 64 + (col - 3072), v0, v1);
  } else if constexpr (MODE == E_MEMKV) {
    st8((bf16_t*)(e.ws + WS_MEMKV) + (size_t)row * 1024 + col, v0, v1);
  } else if constexpr (MODE == E_Q) {
    const int j = col % 192;
    if (j >= 128) { const int i0 = (j - 128) >> 1; const f32x4 c = *(const f32x4*)((const float*)(e.ws + WS_COS) + (size_t)row * 32 + i0), s = *(const f32x4*)((const float*)(e.ws + WS_SIN) + (size_t)row * 32 + i0);
      v0 = (f32x4){v0[0] * c[0] - v0[1] * s[0], v0[1] * c[0] + v0[0] * s[0], v0[2] * c[1] - v0[3] * s[1], v0[3] * c[1] + v0[2] * s[1]};
      v1 = (f32x4){v1[0] * c[2] - v1[1] * s[2], v1[1] * c[2] + v1[0] * s[2], v1[2] * c[3] - v1[3] * s[3], v1[3] * c[3] + v1[2] * s[3]}; }
    st8((bf16_t*)(e.dout + DO_Q) + (size_t)row * 1536 + col, v0, v1);
  } else if constexpr (MODE == E_KV) {
    if (col < 1024) st8((bf16_t*)(e.dout + DO_K) + (size_t)row * 1536 + (col >> 7) * 192 + (col & 127), v0, v1);
    else st8((bf16_t*)(e.dout + DO_V) + (size_t)row * 1024 + (col - 1024), v0, v1);
  } else if constexpr (MODE == E_GATES) {
    const int dir = col >> 8, jj = (col & 255) >> 1, c0 = batch * 128 + jj;
    const f32x4* gt = (const f32x4*)(e.ws + WS_GTAB) + dir * 1024 + c0;
    const u32x2 xw = *(const u32x2*)((const bf16_t*)(e.ws + WS_XC) + (size_t)row * 1024 + c0);
    const float xc[4] = {bflo(xw.x), bfhi(xw.x), bflo(xw.y), bfhi(xw.y)}; const float vv[8] = {v0[0], v0[1], v0[2], v0[3], v1[0], v1[1], v1[2], v1[3]};
    float la[4], bt[4];
#pragma unroll
    for (int i = 0; i < 4; ++i) { const f32x4 t = gt[i]; la[i] = -t[0] * sigmoidf_(vv[2 * i] + t[1]);
      bt[i] = __builtin_amdgcn_sqrtf(neg_expm1_small(2.f * la[i])) * sigmoidf_(vv[2 * i + 1] + t[2]) * xc[i]; }
    bf16_t* LA = (bf16_t*)(e.ws + (dir ? WS_LAB : WS_LAF)); bf16_t* BT = (bf16_t*)(e.ws + (dir ? WS_BTB : WS_BTF));
    u32x2 lw, bw; lw.x = pk2(la[0], la[1]); lw.y = pk2(la[2], la[3]); bw.x = pk2(bt[0], bt[1]); bw.y = pk2(bt[2], bt[3]);
    *(u32x2*)(LA + (size_t)row * 1024 + c0) = lw; *(u32x2*)(BT + (size_t)row * 1024 + c0) = bw;
  } else if constexpr (MODE == E_BF16) {
    st8(e.o + (size_t)row * e.ld + col, v0, v1);
  } else {
    *(f32x4*)(e.f + (size_t)row * e.ld + col) = v0; *(f32x4*)(e.f + (size_t)row * e.ld + col + 4) = v1;
  }
}

struct GemmArgs { const bf16_t* A; size_t lda, a_batch; const bf16_t* Bt; size_t ldb, b_batch; int M, N, K, nbatch; int rot = 0; };
template <int MODE> __device__ __forceinline__ void gemm_simple(const GemmArgs& g, const EpiArgs& e, int bid, int nblk, int wave, int lane) {
  const int tm = g.M / 128, tn = g.N / 128, per = tm * tn, units = g.nbatch * per;
  const int r32 = lane & 31, hi = lane >> 5, wr = wave >> 1, wc = wave & 1;
  for (int u = bid; u < units; u += nblk) {
    const int bt = u / per, r = u % per, pm = r / tn, pn = r % tn;
    const bf16_t* ap = g.A + (size_t)bt * g.a_batch + (size_t)(pm * 128 + wr * 32 + r32) * g.lda + 8 * hi;
    const bf16_t* bp0 = g.Bt + (size_t)bt * g.b_batch + (size_t)(pn * 128 + wc * 64 + r32) * g.ldb + 8 * hi;
    const bf16_t* bp1 = bp0 + 32 * g.ldb;
    f32x16 acc0 = {}, acc1 = {};
#pragma unroll 4
    for (int k0 = 0; k0 < g.K; k0 += 16) {
      const bf16x8 a = *(const bf16x8*)(ap + k0), b0 = *(const bf16x8*)(bp0 + k0), b1 = *(const bf16x8*)(bp1 + k0);
      acc0 = __builtin_amdgcn_mfma_f32_32x32x16_bf16(b0, a, acc0, 0, 0, 0);
      acc1 = __builtin_amdgcn_mfma_f32_32x32x16_bf16(b1, a, acc1, 0, 0, 0);
    }
    const int row = pm * 128 + wr * 32 + r32;
#pragma unroll
    for (int gq = 0; gq < 4; ++gq) {
      const int col = pn * 128 + wc * 64 + 8 * gq + 4 * hi;
      epi<MODE>(e, bt, row, col, (f32x4){acc0[4 * gq], acc0[4 * gq + 1], acc0[4 * gq + 2], acc0[4 * gq + 3]});
      epi<MODE>(e, bt, row, col + 32, (f32x4){acc1[4 * gq], acc1[4 * gq + 1], acc1[4 * gq + 2], acc1[4 * gq + 3]});
    }
  }
}


namespace pg8 {
#define PG8_LAS __attribute__((address_space(3)))
constexpr int BM = 256, BK = 64, HALF = 128, HTB = HALF * BK * 2, STAGE_BYTES = 8 * HTB, NXCD = 8, WGM = 8;
__host__ __device__ __forceinline__ int lds_byte(int r, int c) { const int st = (r >> 4) * 2 + (c >> 5), rr = r & 15, cc = c & 31, ob = rr * 64 + cc * 2; return st * 1024 + (ob ^ (((ob >> 9) & 1) << 5)); }
__host__ __device__ __forceinline__ void stage_rc(int b, int& R, int& C) { const int st = b / 1024, sb = b % 1024, swz = sb ^ (((sb >> 9) & 1) << 5); R = (st >> 1) * 16 + swz / 64; C = (st & 1) * 32 + (swz % 64) / 2; }
__host__ __device__ __forceinline__ int perm32(int rho) { const int n = rho >> 4, i = rho & 15; return 8 * (i >> 2) + 4 * n + (i & 3); }
struct Unit { int pm, pn; };
struct Gemm { const bf16_t* A; const bf16_t* Bt; int M, N, K; int lda, ldb; int pn_per_batch; int a_batch_elems; };
struct StaticOrder {
  int nM, nN, nwg, G, c;
  __device__ void init(int M, int N, int G_, int c_) { nM = M / BM; nN = N / BM; nwg = nM * nN; G = G_; c = c_; }
  __device__ bool next(int i, Unit& u) const {
    const long L = (long)i * G + c; if (L >= nwg) return false;
    int wgid = (int)L; { const int q = nwg / NXCD, r = nwg % NXCD, xcd = wgid % NXCD, off = wgid / NXCD; wgid = (xcd < r ? xcd * (q + 1) : r * (q + 1) + (xcd - r) * q) + off; }
    const int nig = WGM * nN, gid = wgid / nig, fm = gid * WGM, gsz = (nM - fm) < WGM ? (nM - fm) : WGM;
    u.pm = fm + ((wgid % nig) % gsz); u.pn = (wgid % nig) / gsz; return true;
  }
};
template <int MODE> struct EpiAdapter {
  static constexpr bool PERM = true;
  EpiArgs e; int nb_cols;
  __device__ __forceinline__ void operator()(const f32x4 (&acc)[2][2][4][2], const Unit& u, int wr, int wc, int fr, int fq) const {
    if constexpr (MODE == E_RES) {
      bf16_t* X = (bf16_t*)(e.ws + WS_X);
#pragma unroll
      for (int ai = 0; ai < 2; ++ai) { u32x4 rw[4][2];
#pragma unroll
        for (int m = 0; m < 4; ++m)
#pragma unroll
          for (int bj = 0; bj < 2; ++bj) rw[m][bj] = *(const u32x4*)(X + (size_t)(u.pm * BM + ai * HALF + wr * 64 + m * 16 + fr) * DM + u.pn * BM + bj * HALF + wc * 32 + 8 * fq);
#pragma unroll
        for (int m = 0; m < 4; ++m)
#pragma unroll
          for (int bj = 0; bj < 2; ++bj) { const u32x4 w = rw[m][bj]; const f32x4 a0 = acc[ai][bj][m][0], a1 = acc[ai][bj][m][1];
            st8(X + (size_t)(u.pm * BM + ai * HALF + wr * 64 + m * 16 + fr) * DM + u.pn * BM + bj * HALF + wc * 32 + 8 * fq,
                (f32x4){DN_ALPHA * bflo(w.x) + a0[0], DN_ALPHA * bfhi(w.x) + a0[1], DN_ALPHA * bflo(w.y) + a0[2], DN_ALPHA * bfhi(w.y) + a0[3]},
                (f32x4){DN_ALPHA * bflo(w.z) + a1[0], DN_ALPHA * bfhi(w.z) + a1[1], DN_ALPHA * bflo(w.w) + a1[2], DN_ALPHA * bfhi(w.w) + a1[3]}); }
        asm volatile("" ::: "memory"); }
      return;
    }
#pragma unroll
    for (int ai = 0; ai < 2; ++ai)
#pragma unroll
      for (int m = 0; m < 4; ++m) { const int row = u.pm * BM + ai * HALF + wr * 64 + m * 16 + fr;
#pragma unroll
        for (int bj = 0; bj < 2; ++bj) { const int colg = u.pn * BM + bj * HALF + wc * 32 + 8 * fq; const int batch = colg / nb_cols; const int col = colg - batch * nb_cols;
          epi8<MODE>(e, batch, row, col, acc[ai][bj][m][0], acc[ai][bj][m][1]); }
        asm volatile("" ::: "memory"); }
  }
};
template <class Epi>
__device__ __forceinline__ void gemm_phase(PG8_LAS unsigned char* lds, const Gemm g, const StaticOrder& S, const Epi& E) {
  int tid_ = threadIdx.x; asm volatile("" : "+v"(tid_));
  const int tid = tid_, wid = __builtin_amdgcn_readfirstlane(tid >> 6), lane = tid & 63, wr = wid >> 2, wc = wid & 3, fr = lane & 15, fq = lane >> 4;
  const int K = g.K, nt = K / BK;
  unsigned voffA[2], voffB[2];
#pragma unroll
  for (int i = 0; i < 2; ++i) { int R, C; stage_rc(tid * 16 + i * 8192, R, C); const int Rb = Epi::PERM ? ((R & ~31) + perm32(R & 31)) : R; voffA[i] = (unsigned)(R * g.lda + C) * 2u; voffB[i] = (unsigned)(Rb * g.ldb + C) * 2u; }
  const size_t kstep = (size_t)(BK * 2);
  const size_t hstepA = (size_t)HALF * g.lda * 2, hstepB = (size_t)HALF * g.ldb * 2;
  const size_t tstepA = 2 * hstepA, tstepB = 2 * hstepB;
  const unsigned ldsw = (unsigned)wid * 1024u;
  const int aoff = lds_byte(wr * 64 + fr, fq * 8), boff = lds_byte(wc * 32 + fr, fq * 8);
#define PG8_SA(b, h) (((b) * 2 + (h)) * HTB)
#define PG8_SB(b, h) ((4 + (b) * 2 + (h)) * HTB)
#define PG8_STAGE(bufoff, gbase, voff) do { _Pragma("unroll") for (int _i = 0; _i < 2; ++_i) \
    __builtin_amdgcn_global_load_lds((const unsigned*)((const char*)(gbase) + (voff)[_i]), (PG8_LAS unsigned*)(lds + (bufoff) + ldsw + _i * 8192), 16, 0, 0); } while (0)
#define PG8_LDA(dst, b, h) do { _Pragma("unroll") for (int m = 0; m < 4; ++m) _Pragma("unroll") for (int k = 0; k < 2; ++k) dst[m][k] = *(const PG8_LAS bf16x8*)(lds + PG8_SA(b, h) + aoff + m * 2048 + k * 1024); } while (0)
#define PG8_LDB(dst, b, h) do { _Pragma("unroll") for (int n = 0; n < 2; ++n) _Pragma("unroll") for (int k = 0; k < 2; ++k) dst[n][k] = *(const PG8_LAS bf16x8*)(lds + PG8_SB(b, h) + boff + n * 2048 + k * 1024); } while (0)
#define PG8_MMA(ai, bj, At, Bt) do { __builtin_amdgcn_s_setprio(1); _Pragma("unroll") for (int m = 0; m < 4; ++m) _Pragma("unroll") for (int n = 0; n < 2; ++n) _Pragma("unroll") for (int k = 0; k < 2; ++k) \
    acc[ai][bj][m][n] = __builtin_amdgcn_mfma_f32_16x16x32_bf16(Bt[n][k], At[m][k], acc[ai][bj][m][n], 0, 0, 0); __builtin_amdgcn_s_setprio(0); } while (0)
#define PG8_WAIT_V(n) asm volatile("s_waitcnt vmcnt(" #n ")" ::: "memory")
#define PG8_WAIT_L(n) asm volatile("s_waitcnt lgkmcnt(" #n ")" ::: "memory")
#define PG8_BAR __builtin_amdgcn_s_barrier()
#define PG8_SCHED __builtin_amdgcn_sched_barrier(0)
#define PG8_APTR(u) ((const char*)g.A + (size_t)(u).pm * tstepA + (size_t)((u).pn / g.pn_per_batch) * g.a_batch_elems * 2)
#define PG8_BPTR(u) ((const char*)g.Bt + (size_t)(u).pn * tstepB)
  Unit cur, nxt; int ui = 0;
  if (!S.next(0, cur)) return;
  f32x4 acc[2][2][4][2];
#pragma unroll
  for (int a = 0; a < 2; ++a)
#pragma unroll
    for (int b = 0; b < 2; ++b)
#pragma unroll
      for (int m = 0; m < 4; ++m)
#pragma unroll
        for (int n = 0; n < 2; ++n) acc[a][b][m][n] = (f32x4){0.f, 0.f, 0.f, 0.f};
  bf16x8 At[4][2], B0[2][2], B1[2][2];
  const char* cA = PG8_APTR(cur); const char* cB = PG8_BPTR(cur);
  PG8_STAGE(PG8_SB(0, 0), cB, voffB); PG8_STAGE(PG8_SB(0, 1), cB + hstepB, voffB); PG8_STAGE(PG8_SA(0, 0), cA, voffA); PG8_STAGE(PG8_SA(0, 1), cA + hstepA, voffA);
  if (wr == 1) PG8_BAR;
  PG8_WAIT_V(2); PG8_BAR;
  PG8_STAGE(PG8_SB(1, 0), cB + kstep, voffB); PG8_STAGE(PG8_SA(1, 0), cA + kstep, voffA); PG8_STAGE(PG8_SB(1, 1), cB + hstepB + kstep, voffB);
  PG8_WAIT_V(6); PG8_BAR;
  for (;;) {
    const bool has_next = S.next(ui + 1, nxt);
    const char* nA = has_next ? PG8_APTR(nxt) : cA; const char* nB = has_next ? PG8_BPTR(nxt) : cB;
    for (int t = 0; t < nt; t += 2) {
      const bool last = (t == nt - 2);
      const char* a1 = cA + (size_t)(t + 1) * kstep;
      const char* a2 = last ? nA : cA + (size_t)(t + 2) * kstep; const char* b2 = last ? nB : cB + (size_t)(t + 2) * kstep;
      const char* a3 = a2 + kstep; const char* b3 = b2 + kstep;
      PG8_LDB(B0, 0, 0); PG8_LDB(B1, 0, 1); PG8_SCHED; PG8_LDA(At, 0, 0); PG8_STAGE(PG8_SA(1, 1), a1 + hstepA, voffA);
      PG8_WAIT_V(8); PG8_WAIT_L(0); PG8_BAR; PG8_MMA(0, 0, At, B0); PG8_MMA(0, 1, At, B1); PG8_BAR; PG8_SCHED;
      PG8_LDA(At, 0, 1); PG8_STAGE(PG8_SB(0, 0), b2, voffB); PG8_STAGE(PG8_SB(0, 1), b2 + hstepB, voffB); PG8_STAGE(PG8_SA(0, 0), a2, voffA);
      PG8_WAIT_V(8); PG8_WAIT_L(0); PG8_BAR; PG8_MMA(1, 0, At, B0); PG8_MMA(1, 1, At, B1); PG8_BAR; PG8_SCHED;
      PG8_LDB(B0, 1, 0); PG8_LDB(B1, 1, 1); PG8_SCHED; PG8_LDA(At, 1, 0); PG8_STAGE(PG8_SA(0, 1), a2 + hstepA, voffA);
      PG8_WAIT_V(8); PG8_WAIT_L(0); PG8_BAR; PG8_MMA(0, 0, At, B0); PG8_MMA(0, 1, At, B1); PG8_BAR; PG8_SCHED;
      PG8_LDA(At, 1, 1); PG8_STAGE(PG8_SB(1, 0), b3, voffB); PG8_STAGE(PG8_SB(1, 1), b3 + hstepB, voffB); PG8_STAGE(PG8_SA(1, 0), a3, voffA);
      PG8_WAIT_V(8); PG8_WAIT_L(0); PG8_BAR; PG8_MMA(1, 0, At, B0); PG8_MMA(1, 1, At, B1); PG8_BAR; PG8_SCHED;
    }
    if (wr == 0) PG8_BAR;
    E(acc, cur, wr, wc, fr, fq);
    if (!has_next) break;
#pragma unroll
    for (int a = 0; a < 2; ++a)
#pragma unroll
      for (int b = 0; b < 2; ++b)
#pragma unroll
        for (int m = 0; m < 4; ++m)
#pragma unroll
          for (int n = 0; n < 2; ++n) acc[a][b][m][n] = (f32x4){0.f, 0.f, 0.f, 0.f};
    cur = nxt; cA = nA; cB = nB; ++ui;
    if (wr == 1) PG8_BAR;
  }
  PG8_WAIT_V(0);
  PG8_BAR;
#undef PG8_SA
#undef PG8_SB
#undef PG8_STAGE
#undef PG8_LDA
#undef PG8_LDB
#undef PG8_MMA
#undef PG8_WAIT_V
#undef PG8_WAIT_L
#undef PG8_BAR
#undef PG8_SCHED
#undef PG8_APTR
#undef PG8_BPTR
}
}
template <int MODE> __device__ __forceinline__ void gemm_fast(const GemmArgs& g, const EpiArgs& e, unsigned char* lds_raw, int bid_, int nblk) {
  const int bid = (bid_ + g.rot) % nblk;
  pg8::Gemm G{g.A, g.Bt, g.M, g.N * g.nbatch, g.K, (int)g.lda, (int)g.ldb, g.nbatch > 1 ? g.N / 256 : (1 << 30), (int)g.a_batch};
  pg8::StaticOrder S; S.init(G.M, G.N, nblk, bid);
  pg8::EpiAdapter<MODE> E{e, g.N};
  pg8::gemm_phase<pg8::EpiAdapter<MODE>>((PG8_LAS unsigned char*)lds_raw, G, S, E);
}

__device__ __forceinline__ void phase1b(const Params& p, int gw, int ngw, int lane) {
  unsigned char* ws = p.ws;
  bf16_t* CQ = (bf16_t*)(ws + WS_CQ); bf16_t* CKV = (bf16_t*)(ws + WS_CKV); const bf16_t* KPE = (const bf16_t*)(ws + WS_KPE);
  bf16_t* Kd = (bf16_t*)((unsigned char*)p.out + DO_K); const bf16_t* LX = (const bf16_t*)(ws + WS_LRUX); bf16_t* XC = (bf16_t*)(ws + WS_XC);
  const float* ct = (const float*)(ws + WS_COS); const float* st = (const float*)(ws + WS_SIN);
  for (int r = gw; r < T_; r += ngw) {
#pragma unroll
    for (int which = 0; which < 2; ++which) {
      bf16_t* row = (which ? CKV : CQ) + (size_t)r * 512 + lane * 8; const float* g = p.in[which ? 8 : 6] + lane * 8;
      float f[8]; unpack8(*(const u32x4*)row, f); float q = 0.f;
#pragma unroll
      for (int i = 0; i < 8; ++i) q += f[i] * f[i];
      const float sc = rsqrtf(dpp_sum64(q) * (1.f / 512.f) + RMS_EPS);
#pragma unroll
      for (int i = 0; i < 8; ++i) f[i] = f[i] * sc * g[i];
      *(u32x4*)row = pack8(f);
    }
    {
      if (lane < 32) { const unsigned w = *(const unsigned*)(KPE + (size_t)r * 64 + 2 * lane); const float t1 = bflo(w), t2 = bfhi(w);
        const float c = ct[(size_t)r * 32 + lane], s = st[(size_t)r * 32 + lane]; const unsigned o = pk2(t1 * c - t2 * s, t2 * c + t1 * s);
#pragma unroll
        for (int h = 0; h < 8; ++h) *(unsigned*)(Kd + (size_t)r * 1536 + h * 192 + 128 + 2 * lane) = o; } }
    if (!USE_LRU_FUSED) {
      const int s = r & (S_ - 1); float acc[16];
      const float* cb = p.in[11] + lane * 16;
#pragma unroll
      for (int i = 0; i < 16; ++i) acc[i] = cb[i];
#pragma unroll
      for (int k = 0; k < 4; ++k) { const int sp = s + k - 2; if (sp < 0 || sp >= S_) continue;
        const bf16_t* src = LX + (size_t)(r + k - 2) * 1024 + lane * 16; const float* w = p.in[10] + k * 1024 + lane * 16;
        float f[16]; unpack8(*(const u32x4*)src, f); unpack8(*(const u32x4*)(src + 8), f + 8);
#pragma unroll
        for (int i = 0; i < 16; ++i) acc[i] += f[i] * w[i]; }
      *(u32x4*)(XC + (size_t)r * 1024 + lane * 16) = pack8(acc); *(u32x4*)(XC + (size_t)r * 1024 + lane * 16 + 8) = pack8(acc + 8);
    }
  }
}

template <int DQK, int NK> __device__ __forceinline__ void attn_scalar(const bf16_t* Q, int ldq, const bf16_t* K, int ldk, const bf16_t* V, int ldv, bf16_t* O, int ldo,
                                                                      int nheads, float scale, float* lds, int bid, int nblk, int tid) {
  float* sc = lds; float* qs = lds + 16 * NK; float* ls = qs + 16 * DQK;
  const int lane = tid & 63, wave = tid >> 6;
  const int units = NB_ * nheads * (S_ / 16);
  for (int u = bid; u < units; u += nblk) {
    const int qb = u % (S_ / 16), h = (u / (S_ / 16)) % nheads, b = u / ((S_ / 16) * nheads);
    __syncthreads();
    for (int i = tid; i < 16 * DQK; i += NTHR) { const int r = i / DQK, d = i % DQK; qs[i] = bf2f(Q[(size_t)(b * S_ + qb * 16 + r) * ldq + h * DQK + d]) * scale; }
    __syncthreads();
    for (int kk = tid; kk < NK; kk += NTHR) {
      const bf16_t* kp = K + (size_t)(b * NK + kk) * ldk + h * DQK; float acc[16];
#pragma unroll
      for (int r = 0; r < 16; ++r) acc[r] = 0.f;
      for (int d0 = 0; d0 < DQK; d0 += 8) { float kf[8]; unpack8(*(const u32x4*)(kp + d0), kf);
#pragma unroll
        for (int r = 0; r < 16; ++r) { const f32x4 q0 = *(const f32x4*)(qs + r * DQK + d0), q1 = *(const f32x4*)(qs + r * DQK + d0 + 4);
          acc[r] += q0[0] * kf[0] + q0[1] * kf[1] + q0[2] * kf[2] + q0[3] * kf[3] + q1[0] * kf[4] + q1[1] * kf[5] + q1[2] * kf[6] + q1[3] * kf[7]; } }
#pragma unroll
      for (int r = 0; r < 16; ++r) sc[r * NK + kk] = acc[r];
    }
    __syncthreads();
    for (int rr = 0; rr < 2; ++rr) { const int r = wave * 2 + rr; float m = -1e30f;
      for (int kk = lane; kk < NK; kk += 64) m = fmaxf(m, sc[r * NK + kk]);
      m = wave_max(m); float l = 0.f;
      for (int kk = lane; kk < NK; kk += 64) { const float pv = __expf(sc[r * NK + kk] - m); sc[r * NK + kk] = pv; l += pv; }
      l = wave_sum(l); if (lane == 0) ls[r] = l; }
    __syncthreads();
    { const int r = tid >> 5, d4 = (tid & 31) * 4; float a0 = 0.f, a1 = 0.f, a2 = 0.f, a3 = 0.f;
      const bf16_t* vp = V + (size_t)(b * NK) * ldv + h * 128 + d4;
      for (int kk = 0; kk < NK; ++kk) { const float pv = sc[r * NK + kk]; const u32x2 w = *(const u32x2*)(vp + (size_t)kk * ldv);
        a0 += pv * bflo(w.x); a1 += pv * bfhi(w.x); a2 += pv * bflo(w.y); a3 += pv * bfhi(w.y); }
      const float il = 1.f / ls[r];
      st4(O + (size_t)(b * S_ + qb * 16 + r) * ldo + h * 128 + d4, (f32x4){a0 * il, a1 * il, a2 * il, a3 * il}); }
  }
  __syncthreads();
}


namespace fa {
typedef short s16x4 __attribute__((ext_vector_type(4)));
constexpr int NW = 8, QBLK = 32, KVBLK = 64;
constexpr float THR = 8.f;
#define FA_SBAR() __builtin_amdgcn_sched_barrier(0)
__device__ __forceinline__ int crow(int r, int hi) { return (r & 3) + 8 * (r >> 2) + 4 * hi; }
__device__ __forceinline__ unsigned cvtpk(float lo, float hi) { unsigned r; asm volatile("v_cvt_pk_bf16_f32 %0, %1, %2" : "=v"(r) : "v"(lo), "v"(hi)); return r; }
__device__ __forceinline__ void partialSM(f32x16& p0, f32x16& p1, float& m_reg, float& mn, float& alpha, const float C, const float thr_s) {
  float pmax = p0[0];
#pragma unroll
  for (int r = 1; r < 16; ++r) pmax = fmaxf(pmax, p0[r]);
#pragma unroll
  for (int r = 0; r < 16; ++r) pmax = fmaxf(pmax, p1[r]);
  { auto rr = __builtin_amdgcn_permlane32_swap(__float_as_uint(pmax), __float_as_uint(pmax), false, false);
    pmax = fmaxf(__uint_as_float(rr[0]), __uint_as_float(rr[1])); }
  if (__builtin_expect(__all(pmax - m_reg <= thr_s), 1)) { mn = m_reg; alpha = 1.f; }
  else { mn = fmaxf(m_reg, pmax); alpha = __builtin_amdgcn_exp2f((m_reg - mn) * C); m_reg = mn; }
  const float mnC = -mn * C;
#pragma unroll
  for (int r = 0; r < 16; ++r) p0[r] = fmaf(p0[r], C, mnC);
#pragma unroll
  for (int r = 0; r < 16; ++r) p1[r] = fmaf(p1[r], C, mnC);
#pragma unroll
  for (int r = 0; r < 16; ++r) p0[r] = __builtin_amdgcn_exp2f(p0[r]);
}
__device__ __forceinline__ void finishSM(f32x16& p0, f32x16& p1, float alpha, float& l_reg, bf16x8& pa0, bf16x8& pa1, bf16x8& pa2, bf16x8& pa3) {
#pragma unroll
  for (int r = 0; r < 16; ++r) p1[r] = __builtin_amdgcn_exp2f(p1[r]);
  float ps = 0;
#pragma unroll
  for (int r = 0; r < 16; ++r) ps += p0[r];
#pragma unroll
  for (int r = 0; r < 16; ++r) ps += p1[r];
  { auto rr = __builtin_amdgcn_permlane32_swap(__float_as_uint(ps), __float_as_uint(ps), false, false);
    ps = __uint_as_float(rr[0]) + __uint_as_float(rr[1]); }
  l_reg = l_reg * alpha + ps;
#define FA_PK4(P, BASE, OUT) do { unsigned a0 = cvtpk(P[BASE + 0], P[BASE + 1]), a1 = cvtpk(P[BASE + 2], P[BASE + 3]);   \
    unsigned b0 = cvtpk(P[BASE + 4], P[BASE + 5]), b1 = cvtpk(P[BASE + 6], P[BASE + 7]);                              \
    auto r0 = __builtin_amdgcn_permlane32_swap(a0, b0, false, false); auto r1 = __builtin_amdgcn_permlane32_swap(a1, b1, false, false); \
    u32x4 w = {r0[0], r1[0], r0[1], r1[1]}; OUT = *reinterpret_cast<bf16x8*>(&w); } while (0)
  FA_PK4(p0, 0, pa0); FA_PK4(p0, 8, pa1); FA_PK4(p1, 0, pa2); FA_PK4(p1, 8, pa3);
#undef FA_PK4
}
template <int DQK> constexpr int krs() { return DQK == 192 ? 400 : DQK * 2; }
template <int DQK> __device__ __forceinline__ int kswz(int row, int colB) { return DQK == 192 ? row * 400 + colB : row * (DQK * 2) + (colB ^ ((row & 7) << 4)); }
template <int DQK> __device__ __forceinline__ void qkt(f32x16& p0, f32x16& p1, const char* Ks, const bf16x8* qr, const int* kb4) {
  p0 = f32x16{}; p1 = f32x16{};
#pragma unroll
  for (int d0 = 0; d0 < DQK / 16; ++d0) {
    const bf16x8 b0 = *reinterpret_cast<const bf16x8*>(Ks + kb4[d0 & 3] + (d0 >> 2) * 128);
    const bf16x8 b1 = *reinterpret_cast<const bf16x8*>(Ks + kb4[d0 & 3] + (d0 >> 2) * 128 + 32 * krs<DQK>());
    p0 = __builtin_amdgcn_mfma_f32_32x32x16_bf16(b0, qr[d0], p0, 0, 0, 0);
    p1 = __builtin_amdgcn_mfma_f32_32x32x16_bf16(b1, qr[d0], p1, 0, 0, 0); }
}
__device__ __forceinline__ int v_st(int k, int c) { const int kk = (k & ~0xC) | ((k & 4) << 1) | ((k & 8) >> 1); return ((kk >> 3) * 4 + (c >> 5)) * 512 + ((kk & 7) * 32 + (c & 31)) * 2; }
__device__ __forceinline__ int v_rd_base(int lane) { return ((lane & 3) << 3) | (((lane >> 2) & 3) << 6) | (((lane >> 4) & 1) << 5) | (((lane >> 5) & 1) << 8); }
constexpr int v_rd_off(int d0, int ks, int half) { return d0 * 512 + ks * 4096 + half * 2048; }
template <int OFF> __device__ __forceinline__ s16x4 tr_read(int vb) {
  s16x4 r; asm volatile("ds_read_b64_tr_b16 %0, %1 offset:%2" : "=&v"(r) : "v"(vb), "i"(OFF) : "memory"); return r;
}
template <int D0> __device__ __forceinline__ void pv_one(f32x16& od, int vb, bf16x8 pa0, bf16x8 pa1, bf16x8 pa2, bf16x8 pa3) {
  const s16x4 l0 = tr_read<v_rd_off(D0, 0, 0)>(vb), h0 = tr_read<v_rd_off(D0, 0, 1)>(vb), l1 = tr_read<v_rd_off(D0, 1, 0)>(vb), h1 = tr_read<v_rd_off(D0, 1, 1)>(vb);
  const s16x4 l2 = tr_read<v_rd_off(D0, 2, 0)>(vb), h2 = tr_read<v_rd_off(D0, 2, 1)>(vb), l3 = tr_read<v_rd_off(D0, 3, 0)>(vb), h3 = tr_read<v_rd_off(D0, 3, 1)>(vb);
  asm volatile("s_waitcnt lgkmcnt(0)" ::: "memory"); FA_SBAR();
#define FA_PK(L, H) (bf16x8){L[0], L[1], L[2], L[3], H[0], H[1], H[2], H[3]}
  od = __builtin_amdgcn_mfma_f32_32x32x16_bf16(pa0, FA_PK(l0, h0), od, 0, 0, 0);
  od = __builtin_amdgcn_mfma_f32_32x32x16_bf16(pa1, FA_PK(l1, h1), od, 0, 0, 0);
  od = __builtin_amdgcn_mfma_f32_32x32x16_bf16(pa2, FA_PK(l2, h2), od, 0, 0, 0);
  od = __builtin_amdgcn_mfma_f32_32x32x16_bf16(pa3, FA_PK(l3, h3), od, 0, 0, 0);
#undef FA_PK
}
__device__ __forceinline__ void pv_d0(f32x16* o, int vb, bf16x8 pa0, bf16x8 pa1, bf16x8 pa2, bf16x8 pa3) {
  pv_one<0>(o[0], vb, pa0, pa1, pa2, pa3); pv_one<1>(o[1], vb, pa0, pa1, pa2, pa3); pv_one<2>(o[2], vb, pa0, pa1, pa2, pa3); pv_one<3>(o[3], vb, pa0, pa1, pa2, pa3);
}
template <int DQK, int LDQ, int LDK, int LDV, int LDO>
__device__ __forceinline__ void attn_body(const bf16_t* __restrict__ Qb, const bf16_t* __restrict__ Kh, const bf16_t* __restrict__ Vh, bf16_t* __restrict__ Ob, int seq, float scale, char* lds) {
  constexpr int SHM_V = KVBLK * 128 * 2, SHM_K = KVBLK * krs<DQK>(), NKC = DQK / 64;
  const float C = scale * 1.4426950408889634f, thr_s = THR / scale;
  int tid_ = threadIdx.x; asm volatile("" : "+v"(tid_));
  const int tid = tid_, wid = tid >> 6, lane = tid & 63, r32 = lane & 31, hi = lane >> 5;
  char* V_lds = lds; char* K_lds = lds + 2 * SHM_V;
  float* wsf = (float*)(lds + 2 * SHM_V + 2 * SHM_K) + wid * 64; float* li_l = wsf; float* al_l = wsf + 32;
  float m_reg = -1e30f, l_reg = 0; f32x16 o[4] = {}; bf16x8 qr[DQK / 16];
  const bf16_t* Qw = Qb + (size_t)(wid * QBLK + r32) * LDQ + hi * 8;
#pragma unroll
  for (int d0 = 0; d0 < DQK / 16; ++d0) qr[d0] = *reinterpret_cast<const bf16x8*>(Qw + d0 * 16);
  const int sr = tid >> 4, sc = (tid & 15) * 8, vst0 = v_st(sr, sc), vst1 = v_st(32 + sr, sc);
  const int kgo0 = sr * LDK + sc, klo0 = kswz<DQK>(sr, sc * 2);
  const int kgo2 = (tid >> 3) * LDK + 128 + (tid & 7) * 8, klo2 = kswz<DQK>(tid >> 3, (128 + (tid & 7) * 8) * 2);
  const int vb0 = (int)(uintptr_t)V_lds + v_rd_base(lane);
  int kb4[4];
#pragma unroll
  for (int q = 0; q < 4; ++q) kb4[q] = kswz<DQK>(r32, q * 32 + hi * 16);
  bf16x8 vs0, vs1, ks[NKC];
#define FA_SLOAD(k0) do { vs0 = *reinterpret_cast<const bf16x8*>(&Vh[(size_t)((k0) + sr) * LDV + sc]); vs1 = *reinterpret_cast<const bf16x8*>(&Vh[(size_t)((k0) + 32 + sr) * LDV + sc]); \
    ks[0] = *reinterpret_cast<const bf16x8*>(&Kh[(size_t)(k0) * LDK + kgo0]); ks[1] = *reinterpret_cast<const bf16x8*>(&Kh[(size_t)((k0) + 32) * LDK + kgo0]); \
    if constexpr (NKC == 3) ks[NKC - 1] = *reinterpret_cast<const bf16x8*>(&Kh[(size_t)(k0) * LDK + kgo2]); } while (0)
#define FA_SWRITE(b) do { *(bf16x8*)(V_lds + (b) * SHM_V + vst0) = vs0; *(bf16x8*)(V_lds + (b) * SHM_V + vst1) = vs1; \
    *(bf16x8*)(K_lds + (b) * SHM_K + klo0) = ks[0]; *(bf16x8*)(K_lds + (b) * SHM_K + klo0 + 32 * krs<DQK>()) = ks[1]; \
    if constexpr (NKC == 3) *(bf16x8*)(K_lds + (b) * SHM_K + klo2) = ks[NKC - 1]; } while (0)
#define FA_SWAIT() asm volatile("s_waitcnt vmcnt(0)" ::: "memory")
#define FA_RESC(a) do { if (__any((a) < 1.f)) { if (hi == 0) al_l[r32] = (a); asm volatile("s_waitcnt lgkmcnt(0)" ::: "memory"); \
    _Pragma("unroll") for (int d = 0; d < 4; ++d) _Pragma("unroll") for (int r = 0; r < 16; ++r) o[d][r] *= al_l[crow(r, hi)]; } } while (0)
  f32x16 pA0, pA1, pB0, pB1; float mnA, mnB, alA, alB; bf16x8 pa0, pa1, pa2, pa3; const int NT = seq / KVBLK;
  FA_SLOAD(0); FA_SWAIT(); FA_SWRITE(0); __syncthreads();
  qkt<DQK>(pA0, pA1, K_lds, qr, kb4); partialSM(pA0, pA1, m_reg, mnA, alA, C, thr_s);
  FA_SLOAD(KVBLK);
  FA_SWAIT(); FA_SWRITE(1); __syncthreads();
  for (int j = 1; j + 1 < NT; j += 2) {
    FA_SBAR(); qkt<DQK>(pB0, pB1, K_lds + SHM_K, qr, kb4);
    finishSM(pA0, pA1, alA, l_reg, pa0, pa1, pa2, pa3); FA_SBAR();
    FA_SLOAD((j + 1) * KVBLK); FA_SBAR();
    pv_d0(o, vb0, pa0, pa1, pa2, pa3); partialSM(pB0, pB1, m_reg, mnB, alB, C, thr_s);
    __syncthreads(); FA_SWAIT(); FA_SWRITE(0);
    FA_RESC(alB); __syncthreads();
    FA_SBAR(); qkt<DQK>(pA0, pA1, K_lds, qr, kb4);
    finishSM(pB0, pB1, alB, l_reg, pa0, pa1, pa2, pa3); FA_SBAR();
    FA_SLOAD((j + 2) * KVBLK); FA_SBAR();
    pv_d0(o, vb0 + SHM_V, pa0, pa1, pa2, pa3); partialSM(pA0, pA1, m_reg, mnA, alA, C, thr_s);
    __syncthreads(); FA_SWAIT(); FA_SWRITE(1);
    FA_RESC(alA); __syncthreads();
  }
  FA_SBAR(); qkt<DQK>(pB0, pB1, K_lds + SHM_K, qr, kb4);
  finishSM(pA0, pA1, alA, l_reg, pa0, pa1, pa2, pa3); FA_SBAR();
  pv_d0(o, vb0, pa0, pa1, pa2, pa3); partialSM(pB0, pB1, m_reg, mnB, alB, C, thr_s);
  __syncthreads(); FA_RESC(alB);
  finishSM(pB0, pB1, alB, l_reg, pa0, pa1, pa2, pa3); FA_SBAR();
  pv_d0(o, vb0 + SHM_V, pa0, pa1, pa2, pa3);
  if (hi == 0) li_l[r32] = l_reg; asm volatile("s_waitcnt lgkmcnt(0)" ::: "memory");
  float rli[16];
#pragma unroll
  for (int r = 0; r < 16; ++r) rli[r] = __builtin_amdgcn_rcpf(li_l[crow(r, hi)]);
  bf16_t* Ow = Ob + (size_t)(wid * QBLK) * LDO;
#pragma unroll
  for (int r = 0; r < 16; ++r) { const int orow = crow(r, hi);
#pragma unroll
    for (int d0 = 0; d0 < 4; ++d0) Ow[(size_t)orow * LDO + d0 * 32 + r32] = (bf16_t)f2bf(o[d0][r] * rli[r]); }
  __syncthreads();
#undef FA_SLOAD
#undef FA_SWRITE
#undef FA_SWAIT
#undef FA_RESC
}
#undef FA_SBAR
}
__device__ __forceinline__ void mla_attn_phase(unsigned char* dout, unsigned char* ws, char* lds, int bid, int nblk) {
  for (int u = bid; u < NB_ * 8 * (S_ / 256); u += nblk) {
    const int qb = u & 7, h = (u >> 3) & 7, b = u >> 6;
    const bf16_t* Q = (const bf16_t*)(dout + DO_Q) + (size_t)(b * S_ + qb * 256) * 1536 + h * 192;
    const bf16_t* K = (const bf16_t*)(dout + DO_K) + (size_t)(b * S_) * 1536 + h * 192;
    const bf16_t* V = (const bf16_t*)(dout + DO_V) + (size_t)(b * S_) * 1024 + h * 128;
    bf16_t* O = (bf16_t*)(ws + WS_YMIX) + (size_t)(b * S_ + qb * 256) * 2048 + h * 128;
    fa::attn_body<192, 1536, 1536, 1024, 2048>(Q, K, V, O, S_, 0.07216878364870322f, lds);
  }
}

__device__ __forceinline__ void mem_attn_phase(unsigned char* ws, char* lds, int bid, int nblk) {
  for (int u = bid; u < NB_ * 4 * (S_ / 256); u += nblk) {
    const int qb = u & 7, h = (u >> 3) & 3, b = u >> 5;
    const bf16_t* Q = (const bf16_t*)(ws + WS_QM) + (size_t)(b * S_ + qb * 256) * 512 + h * 128;
    const bf16_t* K = (const bf16_t*)(ws + WS_MEMKV) + (size_t)(b * 256) * 1024 + h * 128;
    const bf16_t* V = K + 512;
    bf16_t* O = (bf16_t*)(ws + WS_OM) + (size_t)(b * S_ + qb * 256) * 512 + h * 128;
    fa::attn_body<128, 512, 1024, 1024, 512>(Q, K, V, O, 256, 0.08838834764831845f, lds);
  }
}
__device__ __forceinline__ void scan_phase(unsigned char* ws, float* lds, int bid, int nblk, int tid_in) {
  int tid = tid_in; asm volatile("" : "+v"(tid));
  f32x4* sA = (f32x4*)lds; f32x4* sB = sA + 512;
  const int cq = tid & 15, ch = tid >> 4;
  for (int it = bid; it < NB_ * 2 * 16; it += nblk) {
    const int cg_ = it & 15, dir = (it >> 4) & 1, b = it >> 5;
    const char* LA = (const char*)(ws + (dir ? WS_LAB : WS_LAF)) + ((size_t)b * S_ * 1024 + cg_ * 64) * 2;
    char* BT = (char*)(ws + (dir ? WS_BTB : WS_BTF)) + ((size_t)b * S_ * 1024 + cg_ * 64) * 2;
    const int sstep = dir ? -2048 : 2048;
    const unsigned off0 = (unsigned)((dir ? (S_ - 1 - ch * 64) : ch * 64) * 2048 + cq * 8);
    f32x4 A = {1.f, 1.f, 1.f, 1.f}, Bv = {0.f, 0.f, 0.f, 0.f};
    unsigned off = off0;
#pragma unroll 8
    for (int i = 0; i < 64; ++i) { const u32x2 lw = *(const u32x2*)(LA + off), bw = *(const u32x2*)(BT + off); off += sstep;
      const f32x4 a = {__expf(bflo(lw.x)), __expf(bfhi(lw.x)), __expf(bflo(lw.y)), __expf(bfhi(lw.y))}; const f32x4 bt = {bflo(bw.x), bfhi(bw.x), bflo(bw.y), bfhi(bw.y)};
      Bv = a * Bv + bt; A = A * a; }
    __syncthreads();
    sA[ch * 16 + cq] = A; sB[ch * 16 + cq] = Bv;
    __syncthreads();
    f32x4 h = {0.f, 0.f, 0.f, 0.f};
    for (int qq = 0; qq < ch; ++qq) h = sA[qq * 16 + cq] * h + sB[qq * 16 + cq];
    off = off0;
#pragma unroll 8
    for (int i = 0; i < 64; ++i) { const u32x2 lw = *(const u32x2*)(LA + off), bw = *(const u32x2*)(BT + off);
      const f32x4 a = {__expf(bflo(lw.x)), __expf(bfhi(lw.x)), __expf(bflo(lw.y)), __expf(bfhi(lw.y))}; const f32x4 bt = {bflo(bw.x), bfhi(bw.x), bflo(bw.y), bfhi(bw.y)};
      h = a * h + bt; u32x2 w; w.x = pk2(h[0], h[1]); w.y = pk2(h[2], h[3]); *(u32x2*)(BT + off) = w; off += sstep; }
  }
  __syncthreads();
}


__device__ __forceinline__ void lru_fused_phase(const Params& p, unsigned char* lds_raw, int bid, int nblk) {
  constexpr int RS = 272;
  constexpr int AST = 65;
  unsigned char* WL = lds_raw; unsigned char* XL = lds_raw + 128 * RS;
  f32x2* AB = (f32x2*)(lds_raw + 2 * 128 * RS); float* AG = (float*)(AB + 128 * AST);
  float* CAR = AG + 2 * 8 * 64;
  int tid_ = threadIdx.x; asm volatile("" : "+v"(tid_));
  const int tid = tid_, lane = tid & 63, wave = tid >> 6, r32 = lane & 31, hi = lane >> 5;
  unsigned char* ws = p.ws;
  const bf16_t* LX = (const bf16_t*)(ws + WS_LRUX);
  for (int it = bid; it < NB_ * 8 * 2 * 2; it += nblk) {
    const int half = it & 1, dir = (it >> 1) & 1, n = (it >> 2) & 7, b = it >> 5;
    const int ch0 = n * 128 + half * 64;
    __syncthreads();
    { const bf16_t* wg = (const bf16_t*)(ws + WS_WG_T) + (size_t)(n * 512 + dir * 256 + half * 128) * 128;
      for (int i = tid; i < 128 * 16; i += NTHR) { const int r = i >> 4, c8 = (i & 15) * 8; *(u32x4*)(WL + r * RS + c8 * 2) = *(const u32x4*)(wg + r * 128 + c8); } }
    if (tid < 64) CAR[tid] = 0.f;
    float cw0[4], cw1[4]; const float cb0 = p.in[11][n * 128 + 2 * lane], cb1 = p.in[11][n * 128 + 2 * lane + 1];
#pragma unroll
    for (int k = 0; k < 4; ++k) { cw0[k] = p.in[10][k * 1024 + n * 128 + 2 * lane]; cw1[k] = p.in[10][k * 1024 + n * 128 + 2 * lane + 1]; }
    bf16_t* H = (bf16_t*)(ws + (dir ? WS_BTB : WS_BTF));
    float tb0[16], tb1[16], tb2[16];
#pragma unroll
    for (int t = 0; t < 2; ++t)
#pragma unroll
      for (int g = 0; g < 4; ++g)
#pragma unroll
        for (int u = 0; u < 2; ++u) { const int jl = (wave & 1) * 32 + 16 * t + 4 * g + 2 * hi + u; const f32x4 tb = *((const f32x4*)(ws + WS_GTAB) + dir * 1024 + ch0 + jl);
          tb0[t * 8 + g * 2 + u] = tb[0]; tb1[t * 8 + g * 2 + u] = tb[1]; tb2[t * 8 + g * 2 + u] = tb[2]; }
    unsigned xr[19];
#define LRU_LOADX(C) do { const int q0_ = (dir ? S_ - 128 * ((C) + 1) : 128 * (C)) + wave * 16; \
      _Pragma("unroll") for (int j = 0; j < 19; ++j) { const int row = q0_ + j - 2, rc = row < 0 ? 0 : (row >= S_ ? S_ - 1 : row);        \
        const unsigned v_ = *(const unsigned*)(LX + (size_t)(b * S_ + rc) * 1024 + n * 128 + 2 * lane); xr[j] = (row == rc) ? v_ : 0u; } } while (0)
    LRU_LOADX(0);
    for (int c = 0; c < 16; ++c) {
      const int p0 = dir ? S_ - 128 * (c + 1) : 128 * c;
      {
#pragma unroll
        for (int i = 0; i < 16; ++i) { float s0 = cb0, s1 = cb1;
#pragma unroll
          for (int k = 0; k < 4; ++k) { s0 += bflo(xr[i + k]) * cw0[k]; s1 += bfhi(xr[i + k]) * cw1[k]; }
          *(unsigned*)(XL + (wave * 16 + i) * RS + lane * 4) = pk2(s0, s1); } }
      if (c + 1 < 16) LRU_LOADX(c + 1);
      __syncthreads();
      f32x16 acc[2] = {};
#pragma unroll
      for (int s = 0; s < 8; ++s) { const bf16x8 xf = *(const bf16x8*)(XL + ((wave >> 1) * 32 + r32) * RS + (16 * s + 8 * hi) * 2);
#pragma unroll
        for (int t = 0; t < 2; ++t) { const bf16x8 wf = *(const bf16x8*)(WL + ((wave & 1) * 64 + 32 * t + r32) * RS + (16 * s + 8 * hi) * 2);
          acc[t] = __builtin_amdgcn_mfma_f32_32x32x16_bf16(wf, xf, acc[t], 0, 0, 0); } }
      { const int pos = (wave >> 1) * 32 + r32;
#pragma unroll
        for (int t = 0; t < 2; ++t)
#pragma unroll
          for (int g = 0; g < 4; ++g) { const int jl = (wave & 1) * 32 + 16 * t + 4 * g + 2 * hi;
            const unsigned xw = *(const unsigned*)(XL + pos * RS + (half * 64 + jl) * 2);
#pragma unroll
            for (int u = 0; u < 2; ++u) { const int ti = t * 8 + g * 2 + u;
              const float e1 = __builtin_amdgcn_exp2f(-1.4426950408889634f * (acc[t][4 * g + 2 * u] + tb1[ti])), e2 = __builtin_amdgcn_exp2f(-1.4426950408889634f * (acc[t][4 * g + 2 * u + 1] + tb2[ti]));
              const float R = __builtin_amdgcn_rcpf((1.f + e1) * (1.f + e2)), sr = (1.f + e2) * R, si = (1.f + e1) * R;
              const float la = -tb0[ti] * sr, a = __builtin_amdgcn_exp2f(la * 1.4426950408889634f), x2 = 2.f * la;
              const float ser = -x2 * (1.f + x2 * (0.5f + x2 * (1.6666667e-1f + x2 * (4.1666667e-2f + x2 * (8.3333333e-3f + x2 * 1.3888889e-3f)))));
              const float om = x2 > -0.25f ? ser : 1.f - a * a;
              AB[pos * AST + jl + u] = (f32x2){a, __builtin_amdgcn_sqrtf(om) * si * (u ? bfhi(xw) : bflo(xw))}; } } }
      __syncthreads();
      { const int jl = tid & 63, sub = tid >> 6; float av[16], bv[16]; float A = 1.f, B = 0.f;
#pragma unroll
        for (int i = 0; i < 16; ++i) { const int tau = 16 * sub + i, pos = dir ? 127 - tau : tau; const f32x2 ab = AB[pos * AST + jl]; av[i] = ab[0]; bv[i] = ab[1]; B = av[i] * B + bv[i]; A *= av[i]; }
        AG[sub * 64 + jl] = A; AG[512 + sub * 64 + jl] = B;
        __syncthreads();
        float h = CAR[jl];
        for (int s2 = 0; s2 < sub; ++s2) h = AG[s2 * 64 + jl] * h + AG[512 + s2 * 64 + jl];
#pragma unroll
        for (int i = 0; i < 16; ++i) { const int tau = 16 * sub + i, pos = dir ? 127 - tau : tau; h = av[i] * h + bv[i];
          H[(size_t)(b * S_ + p0 + pos) * 1024 + ch0 + jl] = (bf16_t)(pk2(h, 0.f) & 0xffffu); }
        __syncthreads();
        if (sub == 7) CAR[jl] = h; }
    }
#undef LRU_LOADX
  }
  __syncthreads();
}

__device__ __forceinline__ void phase3b(const Params& p, int gw, int ngw, int lane) {
  unsigned char* ws = p.ws; bf16_t* Y = (bf16_t*)(ws + WS_YMIX);
  const bf16_t* HF = (const bf16_t*)(ws + WS_BTF); const bf16_t* HB = (const bf16_t*)(ws + WS_BTB); const bf16_t* G = (const bf16_t*)(ws + WS_GATE);
  for (int r = gw; r < T_; r += ngw) {
    { bf16_t* row = Y + (size_t)r * 2048 + lane * 16; float f[16]; unpack8(*(const u32x4*)row, f); unpack8(*(const u32x4*)(row + 8), f + 8);
      float q = 0.f;
#pragma unroll
      for (int i = 0; i < 16; ++i) q += f[i] * f[i];
      const float sc = rsqrtf(dpp_sum64(q) * (1.f / 1024.f) + RMS_EPS); const float* g = p.in[17] + lane * 16;
#pragma unroll
      for (int i = 0; i < 16; ++i) f[i] = f[i] * sc * g[i];
      *(u32x4*)row = pack8(f); *(u32x4*)(row + 8) = pack8(f + 8); }
    { const size_t o = (size_t)r * 1024 + lane * 16; float a[16], b[16], gg[16];
      unpack8(*(const u32x4*)(HF + o), a); unpack8(*(const u32x4*)(HF + o + 8), a + 8);
      unpack8(*(const u32x4*)(HB + o), b); unpack8(*(const u32x4*)(HB + o + 8), b + 8);
      unpack8(*(const u32x4*)(G + o), gg); unpack8(*(const u32x4*)(G + o + 8), gg + 8);
      float q = 0.f;
#pragma unroll
      for (int i = 0; i < 16; ++i) { a[i] = (a[i] + b[i]) * gg[i]; q += a[i] * a[i]; }
      const float sc = rsqrtf(dpp_sum64(q) * (1.f / 1024.f) + RMS_EPS); const float* g = p.in[18] + lane * 16;
#pragma unroll
      for (int i = 0; i < 16; ++i) a[i] = a[i] * sc * g[i];
      bf16_t* row = Y + (size_t)r * 2048 + 1024 + lane * 16; *(u32x4*)row = pack8(a); *(u32x4*)(row + 8) = pack8(a + 8); }
  }
}
__device__ __forceinline__ void ln_pass(unsigned char* ws, const float* g, const float* b, int gw, int ngw, int lane) {
  bf16_t* X = (bf16_t*)(ws + WS_X);
  for (int r0 = gw * 2; r0 < T_; r0 += ngw * 2) { u32x4 w[2][4]; float v[32];
#pragma unroll
    for (int rr = 0; rr < 2; ++rr)
#pragma unroll
      for (int j = 0; j < 4; ++j) w[rr][j] = *(const u32x4*)(X + (size_t)(r0 + rr) * DM + j * 512 + lane * 8);
#pragma unroll
    for (int rr = 0; rr < 2; ++rr) {
#pragma unroll
      for (int j = 0; j < 4; ++j) unpack8(w[rr][j], &v[j * 8]);
      ln_row_regs(v, g, b, lane);
#pragma unroll
      for (int j = 0; j < 4; ++j) *(u32x4*)(X + (size_t)(r0 + rr) * DM + j * 512 + lane * 8) = pack8(&v[j * 8]); } }
}
__device__ __forceinline__ void cvt_pass(const float* src, bf16_t* dst, size_t n, int gw, int ngw, int lane) {
  for (size_t i = (size_t)(gw * 64 + lane) * 8; i < n; i += (size_t)ngw * 64 * 8) {
    const f32x4 a = *(const f32x4*)(src + i), b = *(const f32x4*)(src + i + 4); u32x4 o; o.x = pk2(a[0], a[1]); o.y = pk2(a[2], a[3]); o.z = pk2(b[0], b[1]); o.w = pk2(b[2], b[3]);
    *(u32x4*)(dst + i) = o; }
}

__device__ __forceinline__ unsigned key_of(float s, unsigned tag, unsigned tagmask) {
  unsigned u = __float_as_uint(s); u = (u & 0x80000000u) ? ~u : (u | 0x80000000u); return (u & ~tagmask) | (tagmask - tag);
}
__device__ __forceinline__ float val_of(unsigned k, unsigned tagmask) { unsigned u = k & ~tagmask; u = (u & 0x80000000u) ? (u & 0x7fffffffu) : ~u; return __uint_as_float(u); }
__device__ __forceinline__ void topk_phase(unsigned char* ws, const float* SC, int gw, int ngw, int lane) {
  int* IDX = (int*)(ws + WS_IDX); float* GV = (float*)(ws + WS_GV);
  int ca = -1, cb = -1; { int n = 0; for (int a = 0; a < 16; ++a) for (int b = 0; b < 16; ++b) if ((a + 1) * (b + 1) <= 16) { if (n == lane) { ca = a; cb = b; } ++n; } }
  for (int pr = gw; pr < T_ * 8; pr += ngw) {
    const float* row = SC + (size_t)pr * 256;
    unsigned k1a = key_of(row[lane], lane, 127u), k1b = key_of(row[64 + lane], 64 + lane, 127u);
    unsigned k2a = key_of(row[128 + lane], lane, 127u), k2b = key_of(row[192 + lane], 64 + lane, 127u);
    unsigned t1 = 0u, t2 = 0u;
    for (int it = 0; it < 16; ++it) {
      const unsigned m1 = dpp_max64_u32(k1a > k1b ? k1a : k1b), m2 = dpp_max64_u32(k2a > k2b ? k2a : k2b);
      if (k1a == m1) k1a = 0u; if (k1b == m1) k1b = 0u; if (k2a == m2) k2a = 0u; if (k2b == m2) k2b = 0u;
      if (lane == it) { t1 = m1; t2 = m2; }
    }
    const unsigned ka = (unsigned)__shfl((int)t1, ca < 0 ? 0 : ca), kb = (unsigned)__shfl((int)t2, cb < 0 ? 0 : cb);
    const float va = val_of(ka, 127u), vb = val_of(kb, 127u); const int ia = 127 - (int)(ka & 127u), ib = 127 - (int)(kb & 127u);
    const float cs = va + vb; const int cidx = ia * 128 + ib;
    unsigned ck = (ca >= 0) ? key_of(cs, (unsigned)(ca * 16 + cb), 255u) : 0u;
    float ts = 0.f; int ti = 0;
    for (int it = 0; it < 16; ++it) {
      const unsigned m = dpp_max64_u32(ck); const unsigned long long bal = __ballot(ck == m && ck != 0u); const int src = __ffsll((long long)bal) - 1;
      const float sv = __shfl(cs, src); const int si = __shfl(cidx, src);
      if (lane == src) ck = 0u;
      if (lane == it) { ts = sv; ti = si; }
    }
    const float mx = __uint_as_float(__builtin_amdgcn_readlane(__float_as_uint(ts), 0));
    float ex = (lane < 16) ? __expf(ts - mx) : 0.f; const float sum = dpp_sum64(ex);
    if (lane < 16) { IDX[(size_t)pr * 16 + lane] = ti; GV[(size_t)pr * 16 + lane] = ex / sum; }
  }
}


__device__ __forceinline__ unsigned umax_(unsigned a, unsigned b) { return a > b ? a : b; }
__device__ __forceinline__ unsigned umin_(unsigned a, unsigned b) { return a < b ? a : b; }
__device__ __forceinline__ unsigned ord_of(float s) { const unsigned u = __float_as_uint(s); return (u & 0x80000000u) ? ~u : (u | 0x80000000u); }
__device__ __forceinline__ unsigned qx1(unsigned v) { return (unsigned)__builtin_amdgcn_update_dpp(0, (int)v, 0xB1, 0xf, 0xf, false); }
__device__ __forceinline__ unsigned qx2(unsigned v) { return (unsigned)__builtin_amdgcn_update_dpp(0, (int)v, 0x4E, 0xf, 0xf, false); }
__device__ __forceinline__ void ins16(unsigned (&L)[16], unsigned x) {
#pragma unroll
  for (int k = 0; k < 16; ++k) { const unsigned hi = umax_(L[k], x); x = umin_(L[k], x); L[k] = hi; }
}
__device__ __forceinline__ void ins16p(unsigned (&L)[16], unsigned (&P)[16], unsigned x, unsigned px) {
#pragma unroll
  for (int k = 0; k < 16; ++k) { const bool c = x > L[k]; const unsigned nl = c ? x : L[k], nx = c ? L[k] : x, np = c ? px : P[k], npx = c ? P[k] : px; L[k] = nl; x = nx; P[k] = np; px = npx; }
}
__device__ __forceinline__ void bitonic_sort16(unsigned (&M)[16]) {
#pragma unroll
  for (int d = 8; d >= 1; d >>= 1)
#pragma unroll
    for (int i = 0; i < 16; ++i) if (!(i & d)) { const unsigned hi = umax_(M[i], M[i + d]), lo = umin_(M[i], M[i + d]); M[i] = hi; M[i + d] = lo; }
}
__device__ __forceinline__ void bitonic_sort16p(unsigned (&M)[16], unsigned (&P)[16]) {
#pragma unroll
  for (int d = 8; d >= 1; d >>= 1)
#pragma unroll
    for (int i = 0; i < 16; ++i) if (!(i & d)) { const bool c = M[i + d] > M[i]; const unsigned a = M[i], b = M[i + d], pa = P[i], pb = P[i + d];
      M[i] = c ? b : a; M[i + d] = c ? a : b; P[i] = c ? pb : pa; P[i + d] = c ? pa : pb; }
}
__device__ __forceinline__ void topk_phase2(unsigned char* ws, const float* SC, int gw, int ngw, int lane) {
  int* IDX = (int*)(ws + WS_IDX); float* GV = (float*)(ws + WS_GV);
  const int c = lane & 3;
  const unsigned tagbase = (c & 1) ? 0u : 64u;
  for (int item = gw; item < T_ * 8 / 16; item += ngw) {
    const int pr = item * 16 + (lane >> 2);
    const float* row = SC + (size_t)pr * 256 + c * 64;
    unsigned L[16];
#pragma unroll
    for (int k = 0; k < 16; ++k) L[k] = 0u;
#pragma unroll
    for (int bq = 0; bq < 4; ++bq) { f32x4 v[4];
#pragma unroll
      for (int j = 0; j < 4; ++j) v[j] = *(const f32x4*)(row + bq * 16 + j * 4);
#pragma unroll
      for (int j = 0; j < 4; ++j)
#pragma unroll
        for (int i = 0; i < 4; ++i) { const int e = bq * 16 + j * 4 + i; ins16(L, (ord_of(v[j][i]) & ~127u) | (tagbase + (unsigned)(63 - e))); } }
    { unsigned B[16];
#pragma unroll
      for (int k = 0; k < 16; ++k) B[k] = qx1(L[k]);
#pragma unroll
      for (int k = 0; k < 16; ++k) L[k] = umax_(L[k], B[15 - k]);
      bitonic_sort16(L); }
    float F1[16], F2[16]; unsigned I1[16], I2[16];
#pragma unroll
    for (int k = 0; k < 16; ++k) { const unsigned o = qx2(L[k]); const unsigned v1 = (c < 2) ? L[k] : o, v2 = (c < 2) ? o : L[k];
      unsigned u1 = v1 & ~127u, u2 = v2 & ~127u; u1 = (u1 & 0x80000000u) ? (u1 & 0x7fffffffu) : ~u1; u2 = (u2 & 0x80000000u) ? (u2 & 0x7fffffffu) : ~u2;
      F1[k] = __uint_as_float(u1); F2[k] = __uint_as_float(u2); I1[k] = (127u - (v1 & 127u)) << 7; I2[k] = 127u - (v2 & 127u); }
    unsigned M[16], P[16];
#pragma unroll
    for (int k = 0; k < 16; ++k) { M[k] = 0u; P[k] = 0u; }
    {
      constexpr int CA[52] = {0,0,0,0,0,0,0,0,0,0,0,0,0,0,0,0, 1,1,1,1,1,1,1,1, 2,2,2,2,2, 3,3,3,3, 4,4,4, 5,5, 6,6, 7,7, 8, 9, 10, 11, 12, 13, 14, 15, 15, 15};
      constexpr int CB[52] = {0,1,2,3,4,5,6,7,8,9,10,11,12,13,14,15, 0,1,2,3,4,5,6,7, 0,1,2,3,4, 0,1,2,3, 0,1,2, 0,1, 0,1, 0,1, 0, 0, 0, 0, 0, 0, 0, 0, 0, 0};
#pragma unroll
      for (int m = 0; m < 13; ++m) {
        unsigned kx[4], px[4];
#pragma unroll
        for (int q = 0; q < 4; ++q) { const int n = 4 * m + q; const bool pad = n >= 50;
          kx[q] = pad ? 0u : ord_of(F1[CA[n]] + F2[CB[n]]); px[q] = I1[CA[n]] | I2[CB[n]]; }
        const unsigned x = (c == 0) ? kx[0] : (c == 1) ? kx[1] : (c == 2) ? kx[2] : kx[3];
        const unsigned pp = (c == 0) ? px[0] : (c == 1) ? px[1] : (c == 2) ? px[2] : px[3];
        ins16p(M, P, x, pp);
      }
    }
    { unsigned B[16], Q[16];
#pragma unroll
      for (int k = 0; k < 16; ++k) { B[k] = qx1(M[k]); Q[k] = qx1(P[k]); }
#pragma unroll
      for (int k = 0; k < 16; ++k) { const bool t = B[15 - k] > M[k]; M[k] = t ? B[15 - k] : M[k]; P[k] = t ? Q[15 - k] : P[k]; }
      bitonic_sort16p(M, P);
#pragma unroll
      for (int k = 0; k < 16; ++k) { B[k] = qx2(M[k]); Q[k] = qx2(P[k]); }
#pragma unroll
      for (int k = 0; k < 16; ++k) { const bool t = B[15 - k] > M[k]; M[k] = t ? B[15 - k] : M[k]; P[k] = t ? Q[15 - k] : P[k]; }
      bitonic_sort16p(M, P); }
    float sv[16]; float mx = -1e30f;
#pragma unroll
    for (int k = 0; k < 16; ++k) { unsigned u = M[k]; u = (u & 0x80000000u) ? (u & 0x7fffffffu) : ~u; sv[k] = __uint_as_float(u); mx = fmaxf(mx, sv[k]); }
    float sum = 0.f;
#pragma unroll
    for (int k = 0; k < 16; ++k) { sv[k] = __expf(sv[k] - mx); sum += sv[k]; }
    const float inv = __builtin_amdgcn_rcpf(sum);
    u32x4 oi; f32x4 og;
#pragma unroll
    for (int i = 0; i < 4; ++i) { oi[i] = (c == 0) ? P[i] : (c == 1) ? P[4 + i] : (c == 2) ? P[8 + i] : P[12 + i];
      og[i] = ((c == 0) ? sv[i] : (c == 1) ? sv[4 + i] : (c == 2) ? sv[8 + i] : sv[12 + i]) * inv; }
    *(u32x4*)(IDX + (size_t)pr * 16 + 4 * c) = oi; *(f32x4*)(GV + (size_t)pr * 16 + 4 * c) = og;
  }
}


__device__ __forceinline__ unsigned sx16(unsigned v) { return (unsigned)__shfl_xor((int)v, 16); }
__device__ __forceinline__ unsigned sx32(unsigned v) { return (unsigned)__shfl_xor((int)v, 32); }
#define MERGE16(L, SH) do { unsigned B_[16]; _Pragma("unroll") for (int k_ = 0; k_ < 16; ++k_) B_[k_] = SH(L[k_]); \
    _Pragma("unroll") for (int k_ = 0; k_ < 16; ++k_) L[k_] = umax_(L[k_], B_[15 - k_]); bitonic_sort16(L); } while (0)
#define MERGE16P(M, P, SH) do { unsigned B_[16], Q_[16]; _Pragma("unroll") for (int k_ = 0; k_ < 16; ++k_) { B_[k_] = SH(M[k_]); Q_[k_] = SH(P[k_]); } \
    _Pragma("unroll") for (int k_ = 0; k_ < 16; ++k_) { const bool t_ = B_[15 - k_] > M[k_]; M[k_] = t_ ? B_[15 - k_] : M[k_]; P[k_] = t_ ? Q_[15 - k_] : P[k_]; } bitonic_sort16p(M, P); } while (0)
__device__ __forceinline__ void topk_phase3(const Params& p, unsigned char* lds_raw, int gw, int ngw, int tid) {
  unsigned char* ws = p.ws; int* IDX = (int*)(ws + WS_IDX); float* GV = (float*)(ws + WS_GV); const bf16_t* QP = (const bf16_t*)(ws + WS_QP);
  constexpr int KRS = 272;
  for (int i = tid; i < 2 * 128 * 32; i += NTHR) { const int tb = i >> 12, r = (i >> 5) & 127, c4 = (i & 31) * 4; const f32x4 v = *(const f32x4*)(p.in[29 + tb] + r * 128 + c4);
    u32x2 w; w.x = pk2(v[0], v[1]); w.y = pk2(v[2], v[3]); *(u32x2*)(lds_raw + tb * (128 * KRS) + r * KRS + c4 * 2) = w; }
  __syncthreads();
  const int lane = tid & 63, fr = lane & 15, c = lane >> 4;
  for (int item = gw; item < T_ * 8 / 16; item += ngw) {
    const int pr = item * 16 + fr;
    unsigned L1[16], L2[16];
#pragma unroll
    for (int k = 0; k < 16; ++k) { L1[k] = 0u; L2[k] = 0u; }
#pragma unroll
    for (int h = 0; h < 2; ++h) {
      bf16x8 qf[4];
#pragma unroll
      for (int s = 0; s < 4; ++s) qf[s] = *(const bf16x8*)(QP + (size_t)pr * 256 + 128 * h + 32 * s + 8 * c);
#pragma unroll
      for (int tp = 0; tp < 4; ++tp) {
        f32x4 acc0 = {0.f, 0.f, 0.f, 0.f}, acc1 = {0.f, 0.f, 0.f, 0.f};
#pragma unroll
        for (int s = 0; s < 4; ++s) { const unsigned char* kb = lds_raw + h * (128 * KRS) + (32 * tp + fr) * KRS + (32 * s + 8 * c) * 2;
          acc0 = __builtin_amdgcn_mfma_f32_16x16x32_bf16(*(const bf16x8*)kb, qf[s], acc0, 0, 0, 0);
          acc1 = __builtin_amdgcn_mfma_f32_16x16x32_bf16(*(const bf16x8*)(kb + 16 * KRS), qf[s], acc1, 0, 0, 0); }
#pragma unroll
        for (int r = 0; r < 4; ++r) { const unsigned t0 = (unsigned)(127 - (32 * tp + r)) - (unsigned)(4 * c), t1 = t0 - 16u;
          const unsigned k0 = (ord_of(acc0[r]) & ~127u) | t0, k1 = (ord_of(acc1[r]) & ~127u) | t1;
          if (h == 0) { ins16(L1, k0); ins16(L1, k1); } else { ins16(L2, k0); ins16(L2, k1); } }
        if (h == 0) asm volatile("" : "+v"(L1[0]), "+v"(L1[15])); else asm volatile("" : "+v"(L2[0]), "+v"(L2[15]));
      }
    }
    MERGE16(L1, sx16); MERGE16(L1, sx32); MERGE16(L2, sx16); MERGE16(L2, sx32);
    float F1[16], F2[16]; unsigned I1[16], I2[16];
#pragma unroll
    for (int k = 0; k < 16; ++k) { const unsigned v1 = L1[k], v2 = L2[k];
      unsigned u1 = v1 & ~127u, u2 = v2 & ~127u; u1 = (u1 & 0x80000000u) ? (u1 & 0x7fffffffu) : ~u1; u2 = (u2 & 0x80000000u) ? (u2 & 0x7fffffffu) : ~u2;
      F1[k] = __uint_as_float(u1); F2[k] = __uint_as_float(u2); I1[k] = (127u - (v1 & 127u)) << 7; I2[k] = 127u - (v2 & 127u); }
    unsigned M[16], P[16];
#pragma unroll
    for (int k = 0; k < 16; ++k) { M[k] = 0u; P[k] = 0u; }
    {
      constexpr int CA[52] = {0,0,0,0,0,0,0,0,0,0,0,0,0,0,0,0, 1,1,1,1,1,1,1,1, 2,2,2,2,2, 3,3,3,3, 4,4,4, 5,5, 6,6, 7,7, 8, 9, 10, 11, 12, 13, 14, 15, 15, 15};
      constexpr int CB[52] = {0,1,2,3,4,5,6,7,8,9,10,11,12,13,14,15, 0,1,2,3,4,5,6,7, 0,1,2,3,4, 0,1,2,3, 0,1,2, 0,1, 0,1, 0,1, 0, 0, 0, 0, 0, 0, 0, 0, 0, 0};
#pragma unroll
      for (int m = 0; m < 13; ++m) {
        unsigned kx[4], px[4];
#pragma unroll
        for (int q = 0; q < 4; ++q) { const int n = 4 * m + q; const bool pad = n >= 50;
          kx[q] = pad ? 0u : ord_of(F1[CA[n]] + F2[CB[n]]); px[q] = I1[CA[n]] | I2[CB[n]]; }
        const unsigned x = (c == 0) ? kx[0] : (c == 1) ? kx[1] : (c == 2) ? kx[2] : kx[3];
        const unsigned pp = (c == 0) ? px[0] : (c == 1) ? px[1] : (c == 2) ? px[2] : px[3];
        ins16p(M, P, x, pp);
      }
    }
    MERGE16P(M, P, sx16); MERGE16P(M, P, sx32);
    float sv[16]; float mx = -1e30f;
#pragma unroll
    for (int k = 0; k < 16; ++k) { unsigned u = M[k]; u = (u & 0x80000000u) ? (u & 0x7fffffffu) : ~u; sv[k] = __uint_as_float(u); mx = fmaxf(mx, sv[k]); }
    float sum = 0.f;
#pragma unroll
    for (int k = 0; k < 16; ++k) { sv[k] = __expf(sv[k] - mx); sum += sv[k]; }
    const float inv = __builtin_amdgcn_rcpf(sum);
    u32x4 oi; f32x4 og;
#pragma unroll
    for (int i = 0; i < 4; ++i) { oi[i] = (c == 0) ? P[i] : (c == 1) ? P[4 + i] : (c == 2) ? P[8 + i] : P[12 + i];
      og[i] = ((c == 0) ? sv[i] : (c == 1) ? sv[4 + i] : (c == 2) ? sv[8 + i] : sv[12 + i]) * inv; }
    *(u32x4*)(IDX + (size_t)pr * 16 + 4 * c) = oi; *(f32x4*)(GV + (size_t)pr * 16 + 4 * c) = og;
  }
  __syncthreads();
}
#undef MERGE16
#undef MERGE16P

typedef float f32x16v __attribute__((ext_vector_type(16)));
typedef float f32x32v __attribute__((ext_vector_type(32)));
typedef unsigned u32x6 __attribute__((ext_vector_type(6)));
typedef int i32x8 __attribute__((ext_vector_type(8)));
__device__ __forceinline__ void cvt_fp4_pass(const float* src, unsigned char* dst, float* inv, int r_begin, int r_end, int gw, int ngw, int lane) {
  for (int r0 = r_begin + gw * 2; r0 < r_end; r0 += ngw * 2) {
   f32x4 vv[2][8];
#pragma unroll
   for (int rr = 0; rr < 2; ++rr)
#pragma unroll
     for (int k = 0; k < 8; ++k) vv[rr][k] = *(const f32x4*)(src + (size_t)(r0 + rr) * 2048 + lane * 32 + k * 4);
#pragma unroll
   for (int rr = 0; rr < 2; ++rr) { const int r = r0 + rr; float amA = 0.f, amB = 0.f;
#pragma unroll
    for (int k = 0; k < 4; ++k)
#pragma unroll
      for (int i = 0; i < 4; ++i) { amA = fmaxf(amA, fabsf(vv[rr][k][i])); amB = fmaxf(amB, fabsf(vv[rr][4 + k][i])); }
    const float rmax = fmaxf(__uint_as_float(dpp_max64_u32(__float_as_uint(fmaxf(amA, amB)))), 1e-30f);
    const float rs = rmax * (1.f / 6.f); if (lane == 0) inv[r] = rs;
    const float ra = amA / rmax, rb = amB / rmax;
    unsigned code = (unsigned)__builtin_amdgcn_cvt_pk_fp8_f32(ra, rb, 0, false) & 0xffffu;
    { const f32x2 back = __builtin_amdgcn_cvt_pk_f32_fp8((int)code, false); if (back[0] < ra * 0.96f) code += 1u; if (back[1] < rb * 0.96f) code += 0x100u; }
    const f32x2 sab = __builtin_amdgcn_cvt_pk_f32_fp8((int)code, false);
    const float ia = sab[0] > 0.f ? 1.f / (rs * sab[0]) : 0.f, ib = sab[1] > 0.f ? 1.f / (rs * sab[1]) : 0.f;
    u32x4 o;
#pragma unroll
    for (int k = 0; k < 4; ++k) { unsigned w = 0u; const float iv = (k < 2) ? ia : ib; const f32x4 lo = vv[rr][2 * k] * iv, hi = vv[rr][2 * k + 1] * iv;
      w = (unsigned)__builtin_amdgcn_cvt_scalef32_pk_fp4_f32(w, lo[0], lo[1], 1.0f, 0); w = (unsigned)__builtin_amdgcn_cvt_scalef32_pk_fp4_f32(w, lo[2], lo[3], 1.0f, 1);
      w = (unsigned)__builtin_amdgcn_cvt_scalef32_pk_fp4_f32(w, hi[0], hi[1], 1.0f, 2); w = (unsigned)__builtin_amdgcn_cvt_scalef32_pk_fp4_f32(w, hi[2], hi[3], 1.0f, 3);
      o[k] = w; }
    *(u32x4*)(dst + (size_t)r * 1152 + lane * 16) = o;
    *(unsigned short*)(dst + (size_t)r * 1152 + 1024 + lane * 2) = (unsigned short)code;
   }
  }
}
__device__ __forceinline__ void cvt_mx4_pass(const float* src, unsigned char* dst, float* inv, int r_begin, int r_end, int gw, int ngw, int lane) {
  for (int r0 = r_begin + gw * 2; r0 < r_end; r0 += ngw * 2) {
   f32x4 vv[2][8];
#pragma unroll
   for (int rr = 0; rr < 2; ++rr)
#pragma unroll
     for (int k = 0; k < 8; ++k) vv[rr][k] = *(const f32x4*)(src + (size_t)(r0 + rr) * 2048 + lane * 32 + k * 4);
#pragma unroll
   for (int rr = 0; rr < 2; ++rr) { const int r = r0 + rr; float bm = 0.f;
#pragma unroll
    for (int k = 0; k < 8; ++k)
#pragma unroll
      for (int i = 0; i < 4; ++i) bm = fmaxf(bm, fabsf(vv[rr][k][i]));
    const float rmax = fmaxf(__uint_as_float(dpp_max64_u32(__float_as_uint(bm))), 1e-30f);
    const float rs = rmax * (1.f / 6.f); if (lane == 0) inv[r] = rs;
    const unsigned yb = __float_as_uint(bm / rmax * (1.f / 1.04f));
    int ex = (int)(yb >> 23) - 127 + ((yb & 0x7fffffu) ? 1 : 0); ex = ex < -60 ? -60 : (ex > 0 ? 0 : ex);
    const float isc = (1.f / rs) * __uint_as_float((unsigned)(127 - ex) << 23);
    u32x4 o;
#pragma unroll
    for (int k = 0; k < 4; ++k) { unsigned w = 0u; const f32x4 lo = vv[rr][2 * k] * isc, hi = vv[rr][2 * k + 1] * isc;
      w = (unsigned)__builtin_amdgcn_cvt_scalef32_pk_fp4_f32(w, lo[0], lo[1], 1.0f, 0); w = (unsigned)__builtin_amdgcn_cvt_scalef32_pk_fp4_f32(w, lo[2], lo[3], 1.0f, 1);
      w = (unsigned)__builtin_amdgcn_cvt_scalef32_pk_fp4_f32(w, hi[0], hi[1], 1.0f, 2); w = (unsigned)__builtin_amdgcn_cvt_scalef32_pk_fp4_f32(w, hi[2], hi[3], 1.0f, 3);
      o[k] = w; }
    *(u32x4*)(dst + (size_t)r * 1024 + lane * 16) = o;
    dst[PSCL_OFF + (size_t)r * 64 + (lane & 3) * 16 + (lane >> 2)] = (unsigned char)(127 + ex);
   }
  }
}
__device__ __forceinline__ void ln_row_regs32(float (&v)[32], const float* g, const float* b, int lane) {
  float s = 0.f;
#pragma unroll
  for (int i = 0; i < 32; ++i) s += v[i];
  const float mean = dpp_sum64(s) * (1.f / 2048.f);
  float q = 0.f;
#pragma unroll
  for (int i = 0; i < 32; ++i) { v[i] -= mean; q += v[i] * v[i]; }
  const float rstd = rsqrtf(dpp_sum64(q) * (1.f / 2048.f) + LN_EPS);
#pragma unroll
  for (int k = 0; k < 8; ++k) { const f32x4 gg = *(const f32x4*)(g + lane * 32 + k * 4), bb = *(const f32x4*)(b + lane * 32 + k * 4);
#pragma unroll
    for (int i = 0; i < 4; ++i) v[k * 4 + i] = v[k * 4 + i] * rstd * gg[i] + bb[i]; }
}
#define DEC8(W, K, D) do { const f32x2 t0_ = __builtin_amdgcn_cvt_scalef32_pk_f32_fp4(W[K], 1.0f, 0), t1_ = __builtin_amdgcn_cvt_scalef32_pk_f32_fp4(W[K], 1.0f, 1), \
    t2_ = __builtin_amdgcn_cvt_scalef32_pk_f32_fp4(W[K], 1.0f, 2), t3_ = __builtin_amdgcn_cvt_scalef32_pk_f32_fp4(W[K], 1.0f, 3); D[4 * (K)] = t0_; D[4 * (K) + 1] = t1_; D[4 * (K) + 2] = t2_; D[4 * (K) + 3] = t3_; } while (0)
__device__ __forceinline__ void peer_phase(const Params& p, char* lds_raw, int wave, int gw, int ngw, int lane_in) {
  unsigned char* ws = p.ws; const bf16_t* X = (const bf16_t*)(ws + WS_X); const unsigned char* PU = ws + WS_PU; const unsigned char* PV = ws + WS_PV;
  const float* INVU = (const float*)(ws + WS_PINV); const float* INVV = INVU + 16384;
  const int* IDX = (const int*)(ws + WS_IDX); const float* GV = (const float*)(ws + WS_GV);
  for (int t = gw; t < T_; t += ngw) {
    int lane = lane_in; asm volatile("" : "+v"(lane));
    char* XQ = lds_raw + wave * 2560; float* ZL = (float*)(XQ + 2048);
    const int r16 = lane & 15, kb = lane >> 4;
    { unsigned q[8];
#pragma unroll
      for (int k = 0; k < 4; ++k) { float f[8]; unpack8(*(const u32x4*)(X + (size_t)t * DM + lane * 32 + k * 8), f);
        int a = __builtin_amdgcn_cvt_pk_fp8_f32(f[0], f[1], 0, false); a = __builtin_amdgcn_cvt_pk_fp8_f32(f[2], f[3], a, true);
        int b = __builtin_amdgcn_cvt_pk_fp8_f32(f[4], f[5], 0, false); b = __builtin_amdgcn_cvt_pk_fp8_f32(f[6], f[7], b, true);
        q[2 * k] = (unsigned)a; q[2 * k + 1] = (unsigned)b; }
      *(u32x4*)(XQ + lane * 32) = (u32x4){q[0], q[1], q[2], q[3]}; *(u32x4*)(XQ + lane * 32 + 16) = (u32x4){q[4], q[5], q[6], q[7]}; }
    const int id0 = IDX[(size_t)t * 128 + lane], id1 = IDX[(size_t)t * 128 + 64 + lane];
    const float g0 = GV[(size_t)t * 128 + lane], g1 = GV[(size_t)t * 128 + 64 + lane];
    const float iu0 = INVU[id0], iu1 = INVU[id1], iv0 = INVV[id0], iv1 = INVV[id1];
    unsigned roff[8], soff[8]; u32x4 scl[8]; f32x4 accz[8];
#pragma unroll
    for (int g = 0; g < 8; ++g) { const int idg = IDX[(size_t)t * 128 + g * 16 + r16]; roff[g] = (unsigned)(idg * 1024 + kb * 16); soff[g] = (unsigned)(PSCL_OFF + idg * 64 + kb * 16); accz[g] = (f32x4){0.f, 0.f, 0.f, 0.f}; }
#pragma unroll
    for (int g = 0; g < 8; ++g) scl[g] = *(const u32x4*)(PU + soff[g]);
    u32x4 wq[3][8];
#define PU_LOAD(BUF, M) do { _Pragma("unroll") for (int g = 0; g < 8; ++g) wq[BUF][g] = *(const u32x4*)(PU + roff[g] + 64 * (M)); } while (0)
#define PU_STEP(M) do { if ((M) + 2 < 16) { _Pragma("unroll") for (int g = 0; g < 8; ++g) asm volatile("" : "+v"(roff[g]) : "v"(accz[g])); PU_LOAD(((M) + 2) % 3, (M) + 2); } \
      __builtin_amdgcn_sched_barrier(0); \
      const u32x4 b0_ = *(const u32x4*)(XQ + 128 * (M) + 16 * kb), b1_ = *(const u32x4*)(XQ + 128 * (M) + 64 + 16 * kb);     \
      const i32x8 bq_ = {(int)b0_[0], (int)b0_[1], (int)b0_[2], (int)b0_[3], (int)b1_[0], (int)b1_[1], (int)b1_[2], (int)b1_[3]}; \
      _Pragma("unroll") for (int g = 0; g < 8; ++g) { const u32x4 a_ = wq[(M) % 3][g]; const i32x8 a8_ = {(int)a_[0], (int)a_[1], (int)a_[2], (int)a_[3], 0, 0, 0, 0}; \
        accz[g] = __builtin_amdgcn_mfma_scale_f32_16x16x128_f8f6f4(a8_, bq_, accz[g], 4, 0, (M) & 3, (int)scl[g][(M) >> 2], 0, 0x7f7f7f7f); } \
      __builtin_amdgcn_sched_barrier(0); } while (0)
    PU_LOAD(0, 0); PU_LOAD(1, 1);
    PU_STEP(0); PU_STEP(1); PU_STEP(2); PU_STEP(3); PU_STEP(4); PU_STEP(5); PU_STEP(6); PU_STEP(7);
    PU_STEP(8); PU_STEP(9); PU_STEP(10); PU_STEP(11); PU_STEP(12); PU_STEP(13); PU_STEP(14); PU_STEP(15);
#undef PU_LOAD
#undef PU_STEP
    if (r16 == 0) {
#pragma unroll
      for (int g = 0; g < 8; ++g) *(f32x4*)(ZL + g * 16 + kb * 4) = accz[g]; }
    const float z0 = ZL[lane], z1 = ZL[64 + lane];
    const float a0 = gelu_erf(z0 * iu0) * g0 * iv0, a1 = gelu_erf(z1 * iu1) * g1 * iv1;
    f32x2 acc2[16];
#pragma unroll
    for (int i = 0; i < 16; ++i) acc2[i] = (f32x2){0.f, 0.f};
#pragma unroll 1
    for (int e0 = 0; e0 < 128; e0 += 8) {
      u32x4 w[8]; unsigned short sc[8]; float av[8];
#pragma unroll
      for (int q = 0; q < 8; ++q) { const int id = __builtin_amdgcn_readlane(e0 < 64 ? id0 : id1, (e0 + q) & 63); const unsigned char* rp = PV + (size_t)id * 1024;
        av[q] = __uint_as_float(__builtin_amdgcn_readlane(__float_as_uint(e0 < 64 ? a0 : a1), (e0 + q) & 63));
        w[q] = *(const u32x4*)(rp + lane * 16); sc[q] = *(PV + PSCL_OFF + (size_t)id * 64 + (lane & 3) * 16 + (lane >> 2)); }
#pragma unroll
      for (int q = 0; q < 8; ++q) { u32x4 ww = w[q]; { unsigned w0 = ww[0]; asm volatile("" : "+v"(w0) : "v"(acc2[15])); ww[0] = w0; }
        f32x2 d[16]; DEC8(ww, 0, d); DEC8(ww, 1, d); DEC8(ww, 2, d); DEC8(ww, 3, d);
        const float sa = av[q] * __uint_as_float((unsigned)sc[q] << 23), sb = sa;
        const f32x2 aa = {sa, sa}, bb = {sb, sb};
#pragma unroll
        for (int i = 0; i < 8; ++i) { acc2[i] = d[i] * aa + acc2[i]; acc2[8 + i] = d[8 + i] * bb + acc2[8 + i]; }
        asm volatile("" : "+v"(acc2[0]), "+v"(acc2[1]), "+v"(acc2[2]), "+v"(acc2[3]), "+v"(acc2[4]), "+v"(acc2[5]), "+v"(acc2[6]), "+v"(acc2[7]), "+v"(acc2[8]), "+v"(acc2[9]), "+v"(acc2[10]), "+v"(acc2[11]), "+v"(acc2[12]), "+v"(acc2[13]), "+v"(acc2[14]), "+v"(acc2[15])); }
    }
    float acc[32];
#pragma unroll
    for (int k = 0; k < 4; ++k) { float f[8]; unpack8(*(const u32x4*)(X + (size_t)t * DM + lane * 32 + k * 8), f);
#pragma unroll
      for (int i = 0; i < 4; ++i) { acc[k * 8 + 2 * i] = acc2[k * 4 + i][0] + DN_ALPHA * f[2 * i]; acc[k * 8 + 2 * i + 1] = acc2[k * 4 + i][1] + DN_ALPHA * f[2 * i + 1]; } }
    ln_row_regs32(acc, p.in[33], p.in[34], lane);
#pragma unroll
    for (int k = 0; k < 8; ++k) *(f32x4*)(p.out + (size_t)t * DM + lane * 32 + k * 4) = (f32x4){acc[k * 4], acc[k * 4 + 1], acc[k * 4 + 2], acc[k * 4 + 3]};
  }
}
#undef DEC8

#define LAS __attribute__((address_space(3)))
#define XB_TMO      128
#define XB_XCNT(j)  (256  + 64 * (j))
#define XB_XSUB(j)  (1280 + 64 * (j))
#define XB_XGEN(j)  (2304 + 64 * (j))
#define XB_TOP      3328
#define XB_TOPGEN   3392
#define XCD_BAR_WORDS 3456
#define XB_SPIN_CAP (1u << 22)
__device__ __forceinline__ unsigned xb_ld(unsigned* p)              { return __hip_atomic_load(p, __ATOMIC_RELAXED, __HIP_MEMORY_SCOPE_AGENT); }
__device__ __forceinline__ unsigned xb_add(unsigned* p, unsigned v) { return __hip_atomic_fetch_add(p, v, __ATOMIC_RELAXED, __HIP_MEMORY_SCOPE_AGENT); }
__device__ __forceinline__ unsigned xb_xcc_id() { return (unsigned)__builtin_amdgcn_s_getreg((3 << 11) | 20) & 0xFu; }
#define XB_SPIN(cond, bar) do { unsigned _sp = 0; while (cond) { __builtin_amdgcn_s_sleep(1); \
    if ((++_sp & 255u) == 0u) { if (xb_ld(&(bar)[XB_TMO])) break; if (_sp > XB_SPIN_CAP) { atomicAdd(&(bar)[XB_TMO], 1u); break; } } } } while (0)
struct XcdBarrier { unsigned* bar; unsigned x; volatile LAS unsigned* st; };
__device__ __forceinline__ XcdBarrier xcd_barrier_post(unsigned* bar, volatile LAS unsigned* st) {
  XcdBarrier b; b.bar = bar; b.x = xb_xcc_id(); b.st = st;
  if (threadIdx.x == 0) (void)xb_add(&bar[XB_XCNT(b.x)], 1u);
  return b;
}
__device__ __forceinline__ void xcd_barrier_complete(unsigned* bar, unsigned x, unsigned& nloc, unsigned& nx) {
  const unsigned G = gridDim.x * gridDim.y * gridDim.z;
  unsigned sum, cnt, mine, sp = 0u;
  for (;;) {
    sum = 0u; cnt = 0u; mine = 0u;
#pragma unroll
    for (unsigned j = 0; j < 16; ++j) { const unsigned c = xb_ld(&bar[XB_XCNT(j)]); sum += c; cnt += (c > 0u) ? 1u : 0u; mine = (j == x) ? c : mine; }
    if (sum == G) break;
    __builtin_amdgcn_s_sleep(1);
    if ((++sp & 255u) == 0u) { if (xb_ld(&bar[XB_TMO])) break; if (sp > XB_SPIN_CAP) { atomicAdd(&bar[XB_TMO], 1u); break; } }
  }
  nloc = mine > 0u ? mine : 1u; nx = cnt > 0u ? cnt : 1u;
}
__device__ __forceinline__ void xcd_barrier(const XcdBarrier& b) {
  asm volatile("s_waitcnt vmcnt(0)" ::: "memory");
  __syncthreads();
  if (threadIdx.x == 0) {
    unsigned* bar = b.bar;
    __builtin_amdgcn_s_waitcnt(0);
    unsigned nloc = b.st[0], nx = b.st[1];
    if (nloc == 0u) { xcd_barrier_complete(bar, b.x, nloc, nx); b.st[0] = nloc; b.st[1] = nx; }
    const unsigned old = xb_add(&bar[XB_XSUB(b.x)], 1u);
    const unsigned gen = old / nloc;
    if (old + 1u == (gen + 1u) * nloc) {
      __builtin_amdgcn_fence(__ATOMIC_RELEASE, "agent");
      asm volatile("s_waitcnt vmcnt(0)" ::: "memory");
      const unsigned og = xb_add(&bar[XB_TOP], 1u);
      const unsigned tg = og / nx;
      if (og + 1u == (tg + 1u) * nx) xb_add(&bar[XB_TOPGEN], 1u);
      else XB_SPIN(xb_ld(&bar[XB_TOPGEN]) == tg, bar);
      __builtin_amdgcn_fence(__ATOMIC_ACQUIRE, "agent");
      xb_add(&bar[XB_XGEN(b.x)], 1u);
      asm volatile("s_waitcnt vmcnt(0)" ::: "memory");
    } else {
      XB_SPIN(xb_ld(&bar[XB_XGEN(b.x)]) == gen, bar);
      __builtin_amdgcn_fence(__ATOMIC_ACQUIRE, "agent");
      asm volatile("s_waitcnt vmcnt(0)" ::: "memory");
    }
  }
  __syncthreads();
}

constexpr int CVT_EARLY = 4608, CVT_SPLIT = 11264;
#ifndef PROBE_LRU
#define PROBE_LRU 0
#endif
#ifndef USE_TOPK3
#define USE_TOPK3 1
#endif
#ifndef USE_TOPK2
#define USE_TOPK2 1
#endif
#ifndef PROBE_MASK
#define PROBE_MASK 0
#endif
#ifndef PROBE_PEER
#define PROBE_PEER 0
#endif
#ifndef PROBE_SYNC
#define PROBE_SYNC 0
#endif
#ifndef PROBE_TOPK
#define PROBE_TOPK 0
#endif
#ifndef USE_FAST_XATTN
#define USE_FAST_XATTN 1
#endif
#ifndef USE_FAST_MLA
#define USE_FAST_MLA 1
#endif
#ifndef FASTMASK
#define FASTMASK 0xff
#endif
#define GEMM(MODE, g, e) do { if constexpr ((FASTMASK >> MODE) & 1) gemm_fast<MODE>(g, e, lds_raw, bid, nblk); else gemm_simple<MODE>(g, e, bid, nblk, wave, lane); } while (0)
#define IDS int tid_ = threadIdx.x; asm volatile("" : "+v"(tid_)); const int tid = tid_, lane = tid & 63, wave = tid >> 6, gw = bid * NWAVE + wave; (void)tid; (void)lane; (void)wave; (void)gw
__global__ void __launch_bounds__(NTHR) fwd_kernel(Params p) {
  extern __shared__ __attribute__((aligned(16))) unsigned char lds_raw[];
  float* lds = (float*)lds_raw;
  cg::grid_group grid = cg::this_grid();
  const int bid = blockIdx.x, nblk = gridDim.x, ngw = nblk * NWAVE;
  unsigned char* ws = p.ws; unsigned char* dout = (unsigned char*)p.out;
  EpiArgs e{ws, dout, p.in, nullptr, nullptr, 0};
  volatile LAS unsigned* bst = (volatile LAS unsigned*)((LAS unsigned char*)lds_raw + (LDS_BYTES - 64));
  if (threadIdx.x < 2) bst[threadIdx.x] = 0u;
  __syncthreads();
  const XcdBarrier xbar = xcd_barrier_post((unsigned*)ws, bst);
#define GSYNC() xcd_barrier(xbar)

  for (int rp_ = 0; rp_ < 1 + ((PROBE_MASK >> 0) & 1); ++rp_) { { IDS; if (nblk == 256) phase0<true>(p, lds, gw, ngw, lane, wave); else phase0<false>(p, lds, gw, ngw, lane, wave); } }
  if (__builtin_expect(p.ws == nullptr, 0)) grid.sync();
  GSYNC();
  if (nblk == 256 && ((bid >= 64 && bid < 128) || bid >= 160)) { IDS;
    const int sb = (bid < 128) ? bid - 64 : bid - 96; transpose_list<1>(p, lds + wave * (64 * 33), sb * NWAVE + wave, 160 * NWAVE, lane);
    cvt_mx4_pass(p.in[31], ws + WS_PU, (float*)(ws + WS_PINV), 0, CVT_EARLY, sb * NWAVE + wave, 160 * NWAVE, lane);
    cvt_mx4_pass(p.in[32], ws + WS_PV, (float*)(ws + WS_PINV) + 16384, 0, CVT_EARLY, sb * NWAVE + wave, 160 * NWAVE, lane);
    __syncthreads(); }
  for (int rp_ = 0; rp_ < 1 + ((PROBE_MASK >> 1) & 1); ++rp_) { { IDS; GemmArgs g{(const bf16_t*)(ws + WS_X), 2048, 0, (const bf16_t*)(ws + WS_WIN_T), 2048, 0, T_, 3328, 2048, 1}; GEMM(E_WIN, g, e); } }
  for (int rp_ = 0; rp_ < 1 + ((PROBE_MASK >> 1) & 1); ++rp_) { { IDS; GemmArgs g{(const bf16_t*)(ws + WS_MEMB), 2048, 0, (const bf16_t*)(ws + WS_WMKV_T), 2048, 0, 2048, 1024, 2048, 1, 128}; GEMM(E_MEMKV, g, e); } }
  GSYNC();
  { IDS; phase1b(p, gw, ngw, lane); }
  GSYNC();
  for (int rp_ = 0; rp_ < 1 + ((PROBE_MASK >> 2) & 1); ++rp_) { { IDS; GemmArgs g{(const bf16_t*)(ws + WS_CQ), 512, 0, (const bf16_t*)(ws + WS_WUQ_T), 512, 0, T_, 1536, 512, 1}; GEMM(E_Q, g, e); } }
  for (int rp_ = 0; rp_ < 1 + ((PROBE_MASK >> 2) & 1); ++rp_) { { IDS; GemmArgs g{(const bf16_t*)(ws + WS_CKV), 512, 0, (const bf16_t*)(ws + WS_WUKV_T), 512, 0, T_, 2048, 512, 1}; GEMM(E_KV, g, e); } }
#if USE_LRU_FUSED
  for (int rp_ = 0; rp_ < 1 + PROBE_LRU; ++rp_) lru_fused_phase(p, lds_raw, bid, nblk);
#else
  for (int rp_ = 0; rp_ < 1 + ((PROBE_MASK >> 2) & 1); ++rp_) { { IDS; GemmArgs g{(const bf16_t*)(ws + WS_XC), 1024, 128, (const bf16_t*)(ws + WS_WG_T), 128, 512 * 128, T_, 512, 128, 8}; GEMM(E_GATES, g, e); } }
#endif
  GSYNC();
#if USE_FAST_MLA
  for (int rp_ = 0; rp_ < 1 + ((PROBE_MASK >> 4) & 1); ++rp_) { mla_attn_phase(dout, ws, (char*)lds_raw, bid, nblk); }
#else
  { IDS; attn_scalar<192, 2048>((const bf16_t*)(dout + DO_Q), 1536, (const bf16_t*)(dout + DO_K), 1536, (const bf16_t*)(dout + DO_V), 1024, (bf16_t*)(ws + WS_YMIX), 2048, 8,
                         0.07216878364870322f, lds, bid, nblk, tid); }
#endif
#if !USE_LRU_FUSED
  { IDS; scan_phase(ws, lds, bid, nblk, tid); }
#endif
  GSYNC();
  { IDS; phase3b(p, gw, ngw, lane); }
  GSYNC();
  { IDS; GemmArgs g{(const bf16_t*)(ws + WS_YMIX), 2048, 0, (const bf16_t*)(ws + WS_WOUT_T), 2048, 0, T_, 2048, 2048, 1}; GEMM(E_RES, g, e); }
  GSYNC();
  { IDS; ln_pass(ws, p.in[20], p.in[21], gw, ngw, lane); }
  { IDS; const int rlo = (nblk == 256) ? CVT_EARLY : 0, rsplit = (nblk == 256) ? CVT_SPLIT : 16384;
    cvt_mx4_pass(p.in[31], ws + WS_PU, (float*)(ws + WS_PINV), rlo, rsplit, gw, ngw, lane);
    cvt_mx4_pass(p.in[32], ws + WS_PV, (float*)(ws + WS_PINV) + 16384, rlo, rsplit, gw, ngw, lane); }
  GSYNC();
  for (int rp_ = 0; rp_ < 1 + ((PROBE_MASK >> 5) & 1); ++rp_) { { IDS; GemmArgs g{(const bf16_t*)(ws + WS_X), 2048, 0, (const bf16_t*)(ws + WS_WMQ_T), 2048, 0, T_, 512, 2048, 1}; EpiArgs e2 = e; e2.o = (bf16_t*)(ws + WS_QM); e2.ld = 512; GEMM(E_BF16, g, e2); }
  if (nblk == 256 && bid >= 128) { IDS; const int g2 = (bid - 128) * NWAVE + wave;
    cvt_mx4_pass(p.in[31], ws + WS_PU, (float*)(ws + WS_PINV), CVT_SPLIT, 16384, g2, 128 * NWAVE, lane);
    cvt_mx4_pass(p.in[32], ws + WS_PV, (float*)(ws + WS_PINV) + 16384, CVT_SPLIT, 16384, g2, 128 * NWAVE, lane); } }
  GSYNC();
#if USE_FAST_XATTN
  for (int rp_ = 0; rp_ < 1 + ((PROBE_MASK >> 5) & 1); ++rp_) { mem_attn_phase(ws, (char*)lds_raw, bid, nblk); }
#else
  { IDS; attn_scalar<128, 256>((const bf16_t*)(ws + WS_QM), 512, (const bf16_t*)(ws + WS_MEMKV), 1024, (const bf16_t*)(ws + WS_MEMKV) + 512, 1024, (bf16_t*)(ws + WS_OM), 512, 4,
                        0.08838834764831845f, lds, bid, nblk, tid); }
#endif
  GSYNC();
  { IDS; GemmArgs g{(const bf16_t*)(ws + WS_OM), 512, 0, (const bf16_t*)(ws + WS_WMO_T), 512, 0, T_, 2048, 512, 1}; GEMM(E_RES, g, e); }
  GSYNC();
  { IDS; ln_pass(ws, p.in[26], p.in[27], gw, ngw, lane); }
  GSYNC();
  for (int rp_ = 0; rp_ < 1 + ((PROBE_MASK >> 3) & 1); ++rp_) { { IDS; GemmArgs g{(const bf16_t*)(ws + WS_X), 2048, 0, (const bf16_t*)(ws + WS_WPQ_T), 2048, 0, T_, 2048, 2048, 1}; EpiArgs e2 = e; e2.o = (bf16_t*)(ws + WS_QP); e2.ld = 2048; GEMM(E_BF16, g, e2); } }
  GSYNC();
#if USE_TOPK3
  for (int rep_ = 0; rep_ < 1 + PROBE_TOPK; ++rep_) { IDS; topk_phase3(p, lds_raw, gw, ngw, tid); }
#else
  for (int rp_ = 0; rp_ < 1 + ((PROBE_MASK >> 3) & 1); ++rp_) { { IDS; GemmArgs g{(const bf16_t*)(ws + WS_QP), 256, 0, (const bf16_t*)(ws + WS_KEYS_T), 256, 0, T_ * 8, 256, 256, 1}; EpiArgs e2 = e; e2.f = (float*)dout; e2.ld = 256; GEMM(E_F32, g, e2); } }
  GSYNC();
  for (int rep_ = 0; rep_ < 1 + PROBE_TOPK; ++rep_) { IDS; if (USE_TOPK2) topk_phase2(ws, (const float*)dout, gw, ngw, lane); else topk_phase(ws, (const float*)dout, gw, ngw, lane); }
#endif
  GSYNC();
  for (int rep_ = 0; rep_ < 1 + PROBE_PEER; ++rep_) { IDS; peer_phase(p, (char*)lds_raw, wave, gw, ngw, lane); }
  for (int rep_ = 0; rep_ < PROBE_SYNC; ++rep_) GSYNC();
}

extern "C" void kernel_launch(void* const* d_in, const int* in_sizes, int n_in, void* d_out, int out_size, void* d_ws, size_t ws_size, hipStream_t stream) {
  static int grid_blocks = 0;
  if (grid_blocks == 0) {
    if (n_in != 35 || ws_size < WS_END || out_size != T_ * DM) { fprintf(stderr, "kernel_launch: unexpected shapes n_in %d ws %zu out %d\n", n_in, ws_size, out_size); grid_blocks = -1; return; }
    int dev = 0, cus = 0, per_cu = 0;
    hipGetDevice(&dev); hipDeviceGetAttribute(&cus, hipDeviceAttributeMultiprocessorCount, dev);
    if (hipFuncSetAttribute((const void*)fwd_kernel, hipFuncAttributeMaxDynamicSharedMemorySize, LDS_BYTES) != hipSuccess) { fprintf(stderr, "hipFuncSetAttribute failed\n"); grid_blocks = -1; return; }
    if (hipOccupancyMaxActiveBlocksPerMultiprocessor(&per_cu, (const void*)fwd_kernel, NTHR, LDS_BYTES) != hipSuccess || per_cu < 1) { fprintf(stderr, "occupancy query failed (%d)\n", per_cu); grid_blocks = -1; return; }
    grid_blocks = cus * per_cu;
    fprintf(stderr, "kernel_launch: cus %d per_cu %d grid %d ws %zu\n", cus, per_cu, grid_blocks, ws_size);
  }
  if (grid_blocks < 0) return;
  if (hipMemsetAsync(d_ws, 0, 65536, stream) != hipSuccess) { fprintf(stderr, "memset failed\n"); return; }
  Params p{};
  for (int i = 0; i < 35; ++i) p.in[i] = (const float*)d_in[i];
  p.out = (float*)d_out; p.ws = (unsigned char*)d_ws;
  void* args[] = {&p};
  hipError_t err = hipLaunchCooperativeKernel((const void*)fwd_kernel, dim3(grid_blocks), dim3(NTHR), args, LDS_BYTES, stream);
  if (err != hipSuccess) fprintf(stderr, "cooperative launch failed: %s (grid %d)\n", hipGetErrorString(err), grid_blocks);
}
```

```cpp
#include <hip/hip_runtime.h>
#include <hip/hip_cooperative_groups.h>
#include <cstdio>
#include <cstdint>
namespace cg = cooperative_groups;
#ifndef USE_LRU_FUSED
#define USE_LRU_FUSED 1
#endif

typedef unsigned short bf16_t;
typedef short bf16x8 __attribute__((ext_vector_type(8)));
typedef float f32x4 __attribute__((ext_vector_type(4)));
typedef float f32x2 __attribute__((ext_vector_type(2)));
typedef float f32x16 __attribute__((ext_vector_type(16)));
typedef unsigned u32x4 __attribute__((ext_vector_type(4)));
typedef unsigned u32x2 __attribute__((ext_vector_type(2)));

constexpr int T_ = 16384, S_ = 2048, NB_ = 8, DM = 2048;
constexpr int NTHR = 512, NWAVE = 8;
constexpr float DN_ALPHA = 1.189207115002721f;
constexpr float LN_EPS = 1e-5f, RMS_EPS = 1e-6f;
constexpr int LDS_BYTES = 147456;

constexpr size_t MiB = 1u << 20;
constexpr size_t WS_WIN_T = 1 * MiB;
constexpr size_t WS_WUQ_T = 14 * MiB;
constexpr size_t WS_WUKV_T = WS_WUQ_T + 1536 * 512 * 2;
constexpr size_t WS_WG_T = WS_WUKV_T + 2 * MiB;
constexpr size_t WS_WOUT_T = WS_WG_T + 1 * MiB;
constexpr size_t WS_WMQ_T = WS_WOUT_T + 8 * MiB;
constexpr size_t WS_WMKV_T = WS_WMQ_T + 2 * MiB;
constexpr size_t WS_WMO_T = WS_WMKV_T + 4 * MiB;
constexpr size_t WS_WPQ_T = WS_WMO_T + 2 * MiB;
constexpr size_t WS_KEYS_T = WS_WPQ_T + 8 * MiB;
constexpr size_t WS_COS = 43 * MiB, WS_SIN = 45 * MiB;
constexpr size_t WS_MEMB = 47 * MiB;
constexpr size_t WS_MEMKV = 55 * MiB;
constexpr size_t WS_GTAB = 59 * MiB;
static_assert(WS_KEYS_T + 256 * 256 * 2 <= WS_COS, "weights region");
constexpr size_t WS_LAF = 60 * MiB, WS_BTF = 92 * MiB, WS_LAB = 124 * MiB, WS_BTB = 156 * MiB;
constexpr size_t WS_PU = 60 * MiB, WS_PV = 124 * MiB;
constexpr size_t WS_PINV = 59 * MiB + 65536;
constexpr size_t WS_X = 188 * MiB;
constexpr size_t WS_CQ = 252 * MiB, WS_CKV = 268 * MiB, WS_KPE = 284 * MiB;
constexpr size_t WS_LRUX = 286 * MiB, WS_GATE = 318 * MiB, WS_YMIX = 350 * MiB, WS_XC = 414 * MiB;
constexpr size_t WS_QM = WS_CQ, WS_OM = WS_CKV, WS_QP = WS_YMIX, WS_IDX = WS_LRUX, WS_GV = WS_LRUX + 8 * MiB, WS_ACT = WS_LRUX + 16 * MiB;
constexpr size_t WS_SS = 65536;
constexpr size_t WS_END = 446 * MiB;
constexpr size_t DO_Q = 0, DO_K = 48 * MiB, DO_V = 96 * MiB;

__device__ __forceinline__ unsigned f2bf(float f) { unsigned u = __float_as_uint(f); return (u + 0x7fffu + ((u >> 16) & 1u)) >> 16; }
__device__ __forceinline__ float bf2f(unsigned h) { return __uint_as_float(h << 16); }
__device__ __forceinline__ unsigned pk2(float lo, float hi) { unsigned r; asm("v_cvt_pk_bf16_f32 %0, %1, %2" : "=v"(r) : "v"(lo), "v"(hi)); return r; }
__device__ __forceinline__ float bflo(unsigned w) { return __uint_as_float(w << 16); }
__device__ __forceinline__ float bfhi(unsigned w) { return __uint_as_float(w & 0xffff0000u); }
__device__ __forceinline__ float dpp_sum64(float v) {
#define DPPF(x, ctrl, rm, bc) __builtin_bit_cast(float, __builtin_amdgcn_update_dpp(0, __builtin_bit_cast(int, x), ctrl, rm, 0xf, bc))
  v += DPPF(v, 0x111, 0xf, true); v += DPPF(v, 0x112, 0xf, true); v += DPPF(v, 0x114, 0xf, true); v += DPPF(v, 0x118, 0xf, true);
  v += DPPF(v, 0x142, 0xa, false); v += DPPF(v, 0x143, 0xc, false);
#undef DPPF
  return __uint_as_float(__builtin_amdgcn_readlane(__float_as_uint(v), 63));
}
__device__ __forceinline__ unsigned dpp_max64_u32(unsigned v) {
#define DPPU(x, ctrl, rm, bc) (unsigned)__builtin_amdgcn_update_dpp(0, (int)(x), ctrl, rm, 0xf, bc)
  unsigned w;
  w = DPPU(v, 0x111, 0xf, true); v = v > w ? v : w; w = DPPU(v, 0x112, 0xf, true); v = v > w ? v : w;
  w = DPPU(v, 0x114, 0xf, true); v = v > w ? v : w; w = DPPU(v, 0x118, 0xf, true); v = v > w ? v : w;
  w = DPPU(v, 0x142, 0xa, false); v = v > w ? v : w; w = DPPU(v, 0x143, 0xc, false); v = v > w ? v : w;
#undef DPPU
  return (unsigned)__builtin_amdgcn_readlane((int)v, 63);
}
__device__ __forceinline__ float wave_sum(float v) {
#pragma unroll
  for (int o = 1; o < 64; o <<= 1) v += __shfl_xor(v, o);
  return v;
}
__device__ __forceinline__ float wave_max(float v) {
#pragma unroll
  for (int o = 1; o < 64; o <<= 1) v = fmaxf(v, __shfl_xor(v, o));
  return v;
}
__device__ __forceinline__ unsigned wave_max_u32(unsigned v) {
#pragma unroll
  for (int o = 1; o < 64; o <<= 1) { unsigned w = (unsigned)__shfl_xor((int)v, o); v = v > w ? v : w; }
  return v;
}
typedef __bf16 bf16x2_t __attribute__((ext_vector_type(2)));
__device__ __forceinline__ float dot2_bf16(unsigned w, unsigned x, float acc) { return __builtin_amdgcn_fdot2_f32_bf16(__builtin_bit_cast(bf16x2_t, w), __builtin_bit_cast(bf16x2_t, x), acc, false); }
__device__ __forceinline__ float sigmoidf_(float x) { return __builtin_amdgcn_rcpf(1.f + __expf(-x)); }
__device__ __forceinline__ float neg_expm1_small(float x) {
  const float s = x * (1.f + x * (0.5f + x * (1.6666667e-1f + x * (4.1666667e-2f + x * (8.3333333e-3f + x * 1.3888889e-3f)))));
  const float e = 1.f - __builtin_amdgcn_exp2f(x * 1.4426950408889634f);
  return x > -0.25f ? -s : e;
}
__device__ __forceinline__ float gelu_tanh(float x) {
  const float u = 0.7978845608028654f * (x + 0.044715f * x * x * x);
  const float t = 1.f - 2.f / (__expf(2.f * u) + 1.f);
  return 0.5f * x * (1.f + t);
}
__device__ __forceinline__ float gelu_erf(float x) { return 0.5f * x * (1.f + erff(x * 0.7071067811865476f)); }
__device__ __forceinline__ void unpack8(u32x4 w, float* f) {
  f[0] = bflo(w.x); f[1] = bfhi(w.x); f[2] = bflo(w.y); f[3] = bfhi(w.y); f[4] = bflo(w.z); f[5] = bfhi(w.z); f[6] = bflo(w.w); f[7] = bfhi(w.w);
}
__device__ __forceinline__ u32x4 pack8(const float* f) { u32x4 w; w.x = pk2(f[0], f[1]); w.y = pk2(f[2], f[3]); w.z = pk2(f[4], f[5]); w.w = pk2(f[6], f[7]); return w; }

struct Params { const float* in[35]; float* out; unsigned char* ws; };

__device__ __forceinline__ const float* wsrc(const float* const* in, int mid, int n, int& ld) {
  switch (mid) {
    case 0: { ld = 3136; int c; if (n < 1024) c = n; else if (n < 3072) c = n + 64; else if (n < 3136) { int i = (n - 3072) >> 1, g = (n - 3072) & 1; c = 1024 + g * 32 + i; } else return nullptr; return in[5] + c; }
    case 1: { ld = 1536; int h = n / 192, j = n % 192, c; if (j < 128) c = h * 192 + j; else { int i = (j - 128) >> 1, g = (j - 128) & 1; c = h * 192 + 128 + g * 32 + i; } return in[7] + c; }
    case 2: { ld = 2048; int c; if (n < 1024) c = (n >> 7) * 256 + (n & 127); else { int m = n - 1024; c = (m >> 7) * 256 + 128 + (m & 127); } return in[9] + c; }
    case 3: ld = 2048; return in[19] + n;
    case 4: ld = 512; return in[22] + n;
    case 5: ld = 512; return n < 512 ? in[23] + n : in[24] + (n - 512);
    case 6: ld = 2048; return in[25] + n;
    case 7: ld = 2048; return in[28] + n;
    default: { ld = 128; int nb = n >> 9, q = n & 511, dir = q >> 8, jj = (q & 255) >> 1, gate = q & 1; const float* m = (gate ? in[14] : in[12]) + (size_t)((dir * 8 + nb) * 128) * 128; return m + jj; }
  }
}
__device__ __forceinline__ void transpose_item(const float* const* in, int mid, int K, bf16_t* WT, float* scr, int item, int nblk, int lane) {
  const int kb = item / nblk, nb = item % nblk, k0 = 64 * kb, n0 = 32 * nb;
  int ld = 0; const float* base = wsrc(in, mid, n0 + (lane & 31), ld);
  float tv[32];
  const float* gsc = (mid == 1) ? in[6] : (mid == 2) ? in[8] : nullptr;
#pragma unroll
  for (int i = 0; i < 32; ++i) { const int kk = 2 * i + (lane >> 5); tv[i] = base ? base[(size_t)(k0 + kk) * ld] : 0.f; }
  if (gsc) {
#pragma unroll
    for (int i = 0; i < 32; ++i) tv[i] *= gsc[k0 + 2 * i + (lane >> 5)]; }
#pragma unroll
  for (int i = 0; i < 32; ++i) { const int kk = 2 * i + (lane >> 5); scr[kk * 33 + (lane & 31)] = tv[i]; }
  asm volatile("s_waitcnt lgkmcnt(0)" ::: "memory");
  const int c = lane & 7;
#pragma unroll
  for (int j = 0; j < 4; ++j) { const int n = (lane >> 3) + 8 * j; const float* s = scr + (8 * c) * 33 + n;
    u32x4 o; o.x = pk2(s[0 * 33], s[1 * 33]); o.y = pk2(s[2 * 33], s[3 * 33]); o.z = pk2(s[4 * 33], s[5 * 33]); o.w = pk2(s[6 * 33], s[7 * 33]);
    *(u32x4*)(WT + (size_t)(n0 + n) * K + k0 + 8 * c) = o; }
  asm volatile("s_waitcnt lgkmcnt(0)" ::: "memory");
}
__device__ __forceinline__ void ln_row_regs(float (&v)[32], const float* g, const float* b, int lane) {
  float s = 0.f;
#pragma unroll
  for (int i = 0; i < 32; ++i) s += v[i];
  const float mean = dpp_sum64(s) * (1.f / 2048.f);
  float q = 0.f;
#pragma unroll
  for (int i = 0; i < 32; ++i) { v[i] -= mean; q += v[i] * v[i]; }
  const float rstd = rsqrtf(dpp_sum64(q) * (1.f / 2048.f) + LN_EPS);
#pragma unroll
  for (int j = 0; j < 4; ++j) {
    const f32x4 g0 = *(const f32x4*)(g + j * 512 + lane * 8), g1 = *(const f32x4*)(g + j * 512 + lane * 8 + 4);
    const f32x4 b0 = *(const f32x4*)(b + j * 512 + lane * 8), b1 = *(const f32x4*)(b + j * 512 + lane * 8 + 4);
#pragma unroll
    for (int e = 0; e < 4; ++e) { v[j * 8 + e] = v[j * 8 + e] * rstd * g0[e] + b0[e]; v[j * 8 + 4 + e] = v[j * 8 + 4 + e] * rstd * g1[e] + b1[e]; }
  }
}
__device__ __forceinline__ void sincos_big(float ang, float& c, float& s) {
  const double a = (double)ang;
  const double q = __builtin_rint(a * 0.63661977236758134308);
  const float r = (float)(a - q * 1.57079632679489661923);
  const int qi = ((int)q) & 3;
  const float r2 = r * r;
  const float sn = r + r * r2 * (-1.6666667e-1f + r2 * (8.3333333e-3f + r2 * (-1.9841270e-4f + r2 * 2.7557319e-6f)));
  const float cs = 1.f + r2 * (-0.5f + r2 * (4.1666667e-2f + r2 * (-1.3888889e-3f + r2 * (2.4801587e-5f + r2 * -2.7557319e-7f))));
  const float ss = (qi & 1) ? cs : sn, cc = (qi & 1) ? sn : cs;
  s = (qi & 2) ? -ss : ss;
  c = ((qi + 1) & 2) ? -cc : cc;
}

template <int WHICH> __device__ __forceinline__ void transpose_list(const Params& p, float* scr, int gw, int ngw, int lane) {
  struct TI { int mid, ndst, K; size_t off; };
  constexpr int NT = (WHICH == 0) ? 2 : (WHICH == 1) ? 7 : 9;
  const TI all[9] = {{0, 3328, 2048, WS_WIN_T}, {5, 1024, 2048, WS_WMKV_T}, {1, 1536, 512, WS_WUQ_T}, {2, 2048, 512, WS_WUKV_T}, {3, 2048, 2048, WS_WOUT_T}, {4, 512, 2048, WS_WMQ_T},
                     {6, 2048, 512, WS_WMO_T}, {7, 2048, 2048, WS_WPQ_T}, {8, 4096, 128, WS_WG_T}};
  constexpr int T0 = (WHICH == 1) ? 2 : 0;
  int total = 0;
#pragma unroll
  for (int t = 0; t < NT; ++t) total += (all[T0 + t].ndst / 32) * (all[T0 + t].K / 64);
  for (int git = gw; git < total; git += ngw) {
    int t = 0, it = git;
#pragma unroll
    for (int u = 0; u < NT - 1; ++u) { const int nit = (all[T0 + u].ndst / 32) * (all[T0 + u].K / 64); if (t == u && it >= nit) { it -= nit; t = u + 1; } }
    int mid = 0, ndst = 0, K = 0; size_t off = 0;
#pragma unroll
    for (int u = 0; u < NT; ++u) if (t == u) { mid = all[T0 + u].mid; ndst = all[T0 + u].ndst; K = all[T0 + u].K; off = all[T0 + u].off; }
    transpose_item(p.in, mid, K, (bf16_t*)(p.ws + off), scr, it, ndst / 32, lane);
  }
}
template <bool EARLY_ONLY> __device__ __forceinline__ void phase0(const Params& p, float* lds, int gw, int ngw, int lane, int wave) {
  unsigned char* ws = p.ws;
  float* scr = lds + wave * (64 * 33);
  transpose_list<(EARLY_ONLY ? 0 : 2)>(p, scr, gw, ngw, lane);
  { bf16_t* KT = (bf16_t*)(ws + WS_KEYS_T);
    for (int i = gw * 64 + lane; i < 256 * 256; i += ngw * 64) { const int n = i >> 8, k = i & 255; float v = 0.f;
      if (n < 128) { if (k < 128) v = p.in[29][n * 128 + k]; } else { if (k >= 128) v = p.in[30][(n - 128) * 128 + (k - 128)]; }
      KT[i] = (bf16_t)f2bf(v); } }
  { f32x4* gt = (f32x4*)(ws + WS_GTAB);
    for (int i = gw * 64 + lane; i < 2048; i += ngw * 64) gt[i] = (f32x4){8.f * log1pf(__expf(-p.in[16][i])), p.in[13][i], p.in[15][i], 0.f}; }
  { float* ct = (float*)(ws + WS_COS); float* st = (float*)(ws + WS_SIN); const int* pos = (const int*)p.in[2];
    for (int i = gw * 64 + lane; i < T_ * 32; i += ngw * 64) { const int t = i >> 5, f = i & 31;
      const float inv = exp2f(-(float)(2 * f) * (13.287712379549449f / 64.f));
      const float ang = (float)pos[t] * inv; float c, s; sincos_big(ang, c, s); ct[i] = c; st[i] = s; } }
  { const float* m = p.in[1]; bf16_t* mb = (bf16_t*)(ws + WS_MEMB);
    for (size_t i = (size_t)(gw * 64 + lane) * 8; i < (size_t)2048 * 2048; i += (size_t)ngw * 64 * 8) {
      const f32x4 a = *(const f32x4*)(m + i), b = *(const f32x4*)(m + i + 4); u32x4 o; o.x = pk2(a[0], a[1]); o.y = pk2(a[2], a[3]); o.z = pk2(b[0], b[1]); o.w = pk2(b[2], b[3]);
      *(u32x4*)(mb + i) = o; } }
  { const float* x = p.in[0]; bf16_t* X = (bf16_t*)(ws + WS_X);
    for (int r0 = gw * 2; r0 < T_; r0 += ngw * 2) { float v[2][32];
#pragma unroll
      for (int rr = 0; rr < 2; ++rr)
#pragma unroll
        for (int j = 0; j < 4; ++j) { const f32x4 a = *(const f32x4*)(x + (size_t)(r0 + rr) * DM + j * 512 + lane * 8), b = *(const f32x4*)(x + (size_t)(r0 + rr) * DM + j * 512 + lane * 8 + 4);
#pragma unroll
          for (int e = 0; e < 4; ++e) { v[rr][j * 8 + e] = a[e]; v[rr][j * 8 + 4 + e] = b[e]; } }
#pragma unroll
      for (int rr = 0; rr < 2; ++rr) { ln_row_regs(v[rr], p.in[3], p.in[4], lane);
#pragma unroll
        for (int j = 0; j < 4; ++j) *(u32x4*)(X + (size_t)(r0 + rr) * DM + j * 512 + lane * 8) = pack8(&v[rr][j * 8]); } } }
}

enum { E_WIN = 0, E_MEMKV, E_Q, E_KV, E_GATES, E_RES, E_BF16, E_F32 };
struct EpiArgs { unsigned char* ws; unsigned char* dout; const float* const* in; bf16_t* o; float* f; int ld; };
__device__ __forceinline__ void st4(bf16_t* ptr, f32x4 v) { u32x2 w; w.x = pk2(v[0], v[1]); w.y = pk2(v[2], v[3]); *(u32x2*)ptr = w; }
template <int MODE> __device__ __forceinline__ void epi(const EpiArgs& e, int batch, int row, int col, f32x4 v) {
  if constexpr (MODE == E_WIN) {
    if (col < 512) st4((bf16_t*)(e.ws + WS_CQ) + (size_t)row * 512 + col, v);
    else if (col < 1024) st4((bf16_t*)(e.ws + WS_CKV) + (size_t)row * 512 + (col - 512), v);
    else if (col < 2048) st4((bf16_t*)(e.ws + WS_LRUX) + (size_t)row * 1024 + (col - 1024), v);
    else if (col < 3072) { f32x4 g; for (int i = 0; i < 4; ++i) g[i] = gelu_tanh(v[i]); st4((bf16_t*)(e.ws + WS_GATE) + (size_t)row * 1024 + (col - 2048), g); }
    else if (col < 3136) st4((bf16_t*)(e.ws + WS_KPE) + (size_t)row * 64 + (col - 3072), v);
  } else if constexpr (MODE == E_MEMKV) {
    st4((bf16_t*)(e.ws + WS_MEMKV) + (size_t)row * 1024 + col, v);
  } else if constexpr (MODE == E_Q) {
    const int j = col % 192;
    if (j >= 128) { const int i0 = (j - 128) >> 1; const float* ct = (const float*)(e.ws + WS_COS) + (size_t)row * 32 + i0; const float* st = (const float*)(e.ws + WS_SIN) + (size_t)row * 32 + i0;
      const float c0 = ct[0], s0 = st[0], c1 = ct[1], s1 = st[1];
      v = (f32x4){v[0] * c0 - v[1] * s0, v[1] * c0 + v[0] * s0, v[2] * c1 - v[3] * s1, v[3] * c1 + v[2] * s1}; }
    st4((bf16_t*)(e.dout + DO_Q) + (size_t)row * 1536 + col, v);
  } else if constexpr (MODE == E_KV) {
    if (col < 1024) st4((bf16_t*)(e.dout + DO_K) + (size_t)row * 1536 + (col >> 7) * 192 + (col & 127), v);
    else st4((bf16_t*)(e.dout + DO_V) + (size_t)row * 1024 + (col - 1024), v);
  } else if constexpr (MODE == E_GATES) {
    const int dir = col >> 8, jj = (col & 255) >> 1, c0 = batch * 128 + jj;
    const f32x4* gt = (const f32x4*)(e.ws + WS_GTAB) + dir * 1024 + c0;
    const f32x4 t0 = gt[0], t1 = gt[1];
    const unsigned xw = *(const unsigned*)((const bf16_t*)(e.ws + WS_XC) + (size_t)row * 1024 + c0);
    const float la0 = -t0[0] * sigmoidf_(v[0] + t0[1]), la1 = -t1[0] * sigmoidf_(v[2] + t1[1]);
    const float bt0 = __builtin_amdgcn_sqrtf(neg_expm1_small(2.f * la0)) * sigmoidf_(v[1] + t0[2]) * bflo(xw);
    const float bt1 = __builtin_amdgcn_sqrtf(neg_expm1_small(2.f * la1)) * sigmoidf_(v[3] + t1[2]) * bfhi(xw);
    bf16_t* LA = (bf16_t*)(e.ws + (dir ? WS_LAB : WS_LAF)); bf16_t* BT = (bf16_t*)(e.ws + (dir ? WS_BTB : WS_BTF));
    *(unsigned*)(LA + (size_t)row * 1024 + c0) = pk2(la0, la1);
    *(unsigned*)(BT + (size_t)row * 1024 + c0) = pk2(bt0, bt1);
  } else if constexpr (MODE == E_RES) {
    bf16_t* X = (bf16_t*)(e.ws + WS_X) + (size_t)row * DM + col; const u32x2 w = *(const u32x2*)X;
    v = (f32x4){DN_ALPHA * bflo(w.x) + v[0], DN_ALPHA * bfhi(w.x) + v[1], DN_ALPHA * bflo(w.y) + v[2], DN_ALPHA * bfhi(w.y) + v[3]};
    st4(X, v);
  } else if constexpr (MODE == E_BF16) {
    st4(e.o + (size_t)row * e.ld + col, v);
  } else {
    *(f32x4*)(e.f + (size_t)row * e.ld + col) = v;
  }
}


__device__ __forceinline__ void st8(bf16_t* ptr, f32x4 a, f32x4 b) { u32x4 w; w.x = pk2(a[0], a[1]); w.y = pk2(a[2], a[3]); w.z = pk2(b[0], b[1]); w.w = pk2(b[2], b[3]); *(u32x4*)ptr = w; }
template <int MODE> __device__ __forceinline__ void epi8(const EpiArgs& e, int batch, int row, int col, f32x4 v0, f32x4 v1) {
  if constexpr (MODE == E_WIN) {
    if (col < 512) st8((bf16_t*)(e.ws + WS_CQ) + (size_t)row * 512 + col, v0, v1);
    else if (col < 1024) st8((bf16_t*)(e.ws + WS_CKV) + (size_t)row * 512 + (col - 512), v0, v1);
    else if (col < 2048) st8((bf16_t*)(e.ws + WS_LRUX) + (size_t)row * 1024 + (col - 1024), v0, v1);
    else if (col < 3072) { f32x4 g0, g1;
#pragma unroll
      for (int i = 0; i < 4; ++i) { g0[i] = gelu_tanh(v0[i]); g1[i] = gelu_tanh(v1[i]); }
      st8((bf16_t*)(e.ws + WS_GATE) + (size_t)row * 1024 + (col - 2048), g0, g1); }
    else if (col < 3136) { const int i0 = (col - 3072) >> 1;
      const f32x4 c = *(const f32x4*)((const float*)(e.ws + WS_COS) + (size_t)row * 32 + i0), s = *(const f32x4*)((const float*)(e.ws + WS_SIN) + (size_t)row * 32 + i0);
      const f32x4 r0 = {v0[0] * c[0] - v0[1] * s[0], v0[1] * c[0] + v0[0] * s[0], v0[2] * c[1] - v0[3] * s[1], v0[3] * c[1] + v0[2] * s[1]};
      const f32x4 r1 = {v1[0] * c[2] - v1[1] * s[2], v1[1] * c[2] + v1[0] * s[2], v1[2] * c[3] - v1[3] * s[3], v1[3] * c[3] + v1[2] * s[3]};
      bf16_t* kd = (bf16_t*)(e.dout + DO_K) + (size_t)row * 1536 + 128 + (col - 3072);
#pragma unroll
      for (int h = 0; h < 8; ++h) st8(kd + h * 192, r0, r1); }
  } else if constexpr (MODE == E_MEMKV) {
    st8((bf16_t*)(e.ws + WS_MEMKV) + (size_t)row * 1024 + col, v0, v1);
  } else if constexpr (MODE == E_Q) {
    const int j = col % 192;
    if (j >= 128) { const int i0 = (j - 128) >> 1; const f32x4 c = *(const f32x4*)((const float*)(e.ws + WS_COS) + (size_t)row * 32 + i0), s = *(const f32x4*)((const float*)(e.ws + WS_SIN) + (size_t)row * 32 + i0);
      v0 = (f32x4){v0[0] * c[0] - v0[1] * s[0], v0[1] * c[0] + v0[0] * s[0], v0[2] * c[1] - v0[3] * s[1], v0[3] * c[1] + v0[2] * s[1]};
      v1 = (f32x4){v1[0] * c[2] - v1[1] * s[2], v1[1] * c[2] + v1[0] * s[2], v1[2] * c[3] - v1[3] * s[3], v1[3] * c[3] + v1[2] * s[3]}; }
    st8((bf16_t*)(e.dout + DO_Q) + (size_t)row * 1536 + col, v0, v1);
  } else if constexpr (MODE == E_KV) {
    if (col < 1024) st8((bf16_t*)(e.dout + DO_K) + (size_t)row * 1536 + (col >> 7) * 192 + (col & 127), v0, v1);
    else st8((bf16_t*)(e.dout + DO_V) + (size_t)row * 1024 + (col - 1024), v0, v1);
  } else if constexpr (MODE == E_GATES) {
    const int dir = col >> 8, jj = (col & 255) >> 1, c0 = batch * 128 + jj;
    const f32x4* gt = (const f32x4*)(e.ws + WS_GTAB) + dir * 1024 + c0;
    const u32x2 xw = *(const u32x2*)((const bf16_t*)(e.ws + WS_XC) + (size_t)row * 1024 + c0);
    const float xc[4] = {bflo(xw.x), bfhi(xw.x), bflo(xw.y), bfhi(xw.y)}; const float vv[8] = {v0[0], v0[1], v0[2], v0[3], v1[0], v1[1], v1[2], v1[3]};
    float la[4], bt[4];
#pragma unroll
    for (int i = 0; i < 4; ++i) { const f32x4 t = gt[i]; la[i] = -t[0] * sigmoidf_(vv[2 * i] + t[1]);
      bt[i] = __builtin_amdgcn_sqrtf(neg_expm1_small(2.f * la[i])) * sigmoidf_(vv[2 * i + 1] + t[2]) * xc[i]; }
    bf16_t* LA = (bf16_t*)(e.ws + (dir ? WS_LAB : WS_LAF)); bf16_t* BT = (bf16_t*)(e.ws + (dir ? WS_BTB : WS_BTF));
    u32x2 lw, bw; lw.x = pk2(la[0], la[1]); lw.y = pk2(la[2], la[3]); bw.x = pk2(bt[0], bt[1]); bw.y = pk2(bt[2], bt[3]);
    *(u32x2*)(LA + (size_t)row * 1024 + c0) = lw; *(u32x2*)(BT + (size_t)row * 1024 + c0) = bw;
  } else if constexpr (MODE == E_BF16) {
    st8(e.o + (size_t)row * e.ld + col, v0, v1);
  } else {
    *(f32x4*)(e.f + (size_t)row * e.ld + col) = v0; *(f32x4*)(e.f + (size_t)row * e.ld + col + 4) = v1;
  }
}

struct GemmArgs { const bf16_t* A; size_t lda, a_batch; const bf16_t* Bt; size_t ldb, b_batch; int M, N, K, nbatch; int rot = 0; };
template <int MODE> __device__ __forceinline__ void gemm_simple(const GemmArgs& g, const EpiArgs& e, int bid, int nblk, int wave, int lane) {
  const int tm = g.M / 128, tn = g.N / 128, per = tm * tn, units = g.nbatch * per;
  const int r32 = lane & 31, hi = lane >> 5, wr = wave >> 1, wc = wave & 1;
  for (int u = bid; u < units; u += nblk) {
    const int bt = u / per, r = u % per, pm = r / tn, pn = r % tn;
    const bf16_t* ap = g.A + (size_t)bt * g.a_batch + (size_t)(pm * 128 + wr * 32 + r32) * g.lda + 8 * hi;
    const bf16_t* bp0 = g.Bt + (size_t)bt * g.b_batch + (size_t)(pn * 128 + wc * 64 + r32) * g.ldb + 8 * hi;
    const bf16_t* bp1 = bp0 + 32 * g.ldb;
    f32x16 acc0 = {}, acc1 = {};
#pragma unroll 4
    for (int k0 = 0; k0 < g.K; k0 += 16) {
      const bf16x8 a = *(const bf16x8*)(ap + k0), b0 = *(const bf16x8*)(bp0 + k0), b1 = *(const bf16x8*)(bp1 + k0);
      acc0 = __builtin_amdgcn_mfma_f32_32x32x16_bf16(b0, a, acc0, 0, 0, 0);
      acc1 = __builtin_amdgcn_mfma_f32_32x32x16_bf16(b1, a, acc1, 0, 0, 0);
    }
    const int row = pm * 128 + wr * 32 + r32;
#pragma unroll
    for (int gq = 0; gq < 4; ++gq) {
      const int col = pn * 128 + wc * 64 + 8 * gq + 4 * hi;
      epi<MODE>(e, bt, row, col, (f32x4){acc0[4 * gq], acc0[4 * gq + 1], acc0[4 * gq + 2], acc0[4 * gq + 3]});
      epi<MODE>(e, bt, row, col + 32, (f32x4){acc1[4 * gq], acc1[4 * gq + 1], acc1[4 * gq + 2], acc1[4 * gq + 3]});
    }
  }
}


namespace pg8 {
#define PG8_LAS __attribute__((address_space(3)))
constexpr int BM = 256, BK = 64, HALF = 128, HTB = HALF * BK * 2, STAGE_BYTES = 8 * HTB, NXCD = 8, WGM = 8;
__host__ __device__ __forceinline__ int lds_byte(int r, int c) { const int st = (r >> 4) * 2 + (c >> 5), rr = r & 15, cc = c & 31, ob = rr * 64 + cc * 2; return st * 1024 + (ob ^ (((ob >> 9) & 1) << 5)); }
__host__ __device__ __forceinline__ void stage_rc(int b, int& R, int& C) { const int st = b / 1024, sb = b % 1024, swz = sb ^ (((sb >> 9) & 1) << 5); R = (st >> 1) * 16 + swz / 64; C = (st & 1) * 32 + (swz % 64) / 2; }
__host__ __device__ __forceinline__ int perm32(int rho) { const int n = rho >> 4, i = rho & 15; return 8 * (i >> 2) + 4 * n + (i & 3); }
struct Unit { int pm, pn; };
struct Gemm { const bf16_t* A; const bf16_t* Bt; int M, N, K; int lda, ldb; int pn_per_batch; int a_batch_elems; };
struct StaticOrder {
  int nM, nN, nwg, G, c;
  __device__ void init(int M, int N, int G_, int c_) { nM = M / BM; nN = N / BM; nwg = nM * nN; G = G_; c = c_; }
  __device__ bool next(int i, Unit& u) const {
    const long L = (long)i * G + c; if (L >= nwg) return false;
    int wgid = (int)L; { const int q = nwg / NXCD, r = nwg % NXCD, xcd = wgid % NXCD, off = wgid / NXCD; wgid = (xcd < r ? xcd * (q + 1) : r * (q + 1) + (xcd - r) * q) + off; }
    const int nig = WGM * nN, gid = wgid / nig, fm = gid * WGM, gsz = (nM - fm) < WGM ? (nM - fm) : WGM;
    u.pm = fm + ((wgid % nig) % gsz); u.pn = (wgid % nig) / gsz; return true;
  }
};
template <int MODE> struct EpiAdapter {
  static constexpr bool PERM = true;
  EpiArgs e; int nb_cols;
  __device__ __forceinline__ void operator()(const f32x4 (&acc)[2][2][4][2], const Unit& u, int wr, int wc, int fr, int fq) const {
    if constexpr (MODE == E_RES) {
      bf16_t* X = (bf16_t*)(e.ws + WS_X);
#pragma unroll
      for (int ai = 0; ai < 2; ++ai) { u32x4 rw[4][2];
#pragma unroll
        for (int m = 0; m < 4; ++m)
#pragma unroll
          for (int bj = 0; bj < 2; ++bj) rw[m][bj] = *(const u32x4*)(X + (size_t)(u.pm * BM + ai * HALF + wr * 64 + m * 16 + fr) * DM + u.pn * BM + bj * HALF + wc * 32 + 8 * fq);
#pragma unroll
        for (int m = 0; m < 4; ++m)
#pragma unroll
          for (int bj = 0; bj < 2; ++bj) { const u32x4 w = rw[m][bj]; const f32x4 a0 = acc[ai][bj][m][0], a1 = acc[ai][bj][m][1];
            st8(X + (size_t)(u.pm * BM + ai * HALF + wr * 64 + m * 16 + fr) * DM + u.pn * BM + bj * HALF + wc * 32 + 8 * fq,
                (f32x4){DN_ALPHA * bflo(w.x) + a0[0], DN_ALPHA * bfhi(w.x) + a0[1], DN_ALPHA * bflo(w.y) + a0[2], DN_ALPHA * bfhi(w.y) + a0[3]},
                (f32x4){DN_ALPHA * bflo(w.z) + a1[0], DN_ALPHA * bfhi(w.z) + a1[1], DN_ALPHA * bflo(w.w) + a1[2], DN_ALPHA * bfhi(w.w) + a1[3]}); }
        asm volatile("" ::: "memory"); }
      return;
    }
#pragma unroll
    for (int ai = 0; ai < 2; ++ai)
#pragma unroll
      for (int m = 0; m < 4; ++m) { const int row = u.pm * BM + ai * HALF + wr * 64 + m * 16 + fr;
        float rs = 1.f;
        if constexpr (MODE == E_WIN) {
          if (u.pn < 4) { float s = 0.f;
#pragma unroll
            for (int bj = 0; bj < 2; ++bj)
#pragma unroll
              for (int n = 0; n < 2; ++n) { const f32x4 x = acc[ai][bj][m][n]; s += (x[0] * x[0] + x[1] * x[1]) + (x[2] * x[2] + x[3] * x[3]); }
            s += __shfl_xor(s, 16); s += __shfl_xor(s, 32);
            if (fq == 0) atomicAdd((unsigned long long*)(e.ws + WS_SS) + (u.pn >> 1) * 16384 + row, (unsigned long long)(s * 16777216.f)); } }
        if constexpr (MODE == E_Q || MODE == E_KV) { const unsigned long long ss = ((const unsigned long long*)(e.ws + WS_SS))[(MODE == E_KV ? 16384 : 0) + row];
          rs = rsqrtf((float)ss * (1.f / 16777216.f / 512.f) + RMS_EPS); }
#pragma unroll
        for (int bj = 0; bj < 2; ++bj) { const int colg = u.pn * BM + bj * HALF + wc * 32 + 8 * fq; const int batch = colg / nb_cols; const int col = colg - batch * nb_cols;
          if constexpr (MODE == E_Q || MODE == E_KV) epi8<MODE>(e, batch, row, col, acc[ai][bj][m][0] * rs, acc[ai][bj][m][1] * rs);
          else epi8<MODE>(e, batch, row, col, acc[ai][bj][m][0], acc[ai][bj][m][1]); }
        asm volatile("" ::: "memory"); }
  }
};
template <class Epi>
__device__ __forceinline__ void gemm_phase(PG8_LAS unsigned char* lds, const Gemm g, const StaticOrder& S, const Epi& E) {
  int tid_ = threadIdx.x; asm volatile("" : "+v"(tid_));
  const int tid = tid_, wid = __builtin_amdgcn_readfirstlane(tid >> 6), lane = tid & 63, wr = wid >> 2, wc = wid & 3, fr = lane & 15, fq = lane >> 4;
  const int K = g.K, nt = K / BK;
  unsigned voffA[2], voffB[2];
#pragma unroll
  for (int i = 0; i < 2; ++i) { int R, C; stage_rc(tid * 16 + i * 8192, R, C); const int Rb = Epi::PERM ? ((R & ~31) + perm32(R & 31)) : R; voffA[i] = (unsigned)(R * g.lda + C) * 2u; voffB[i] = (unsigned)(Rb * g.ldb + C) * 2u; }
  const size_t kstep = (size_t)(BK * 2);
  const size_t hstepA = (size_t)HALF * g.lda * 2, hstepB = (size_t)HALF * g.ldb * 2;
  const size_t tstepA = 2 * hstepA, tstepB = 2 * hstepB;
  const unsigned ldsw = (unsigned)wid * 1024u;
  const int aoff = lds_byte(wr * 64 + fr, fq * 8), boff = lds_byte(wc * 32 + fr, fq * 8);
#define PG8_SA(b, h) (((b) * 2 + (h)) * HTB)
#define PG8_SB(b, h) ((4 + (b) * 2 + (h)) * HTB)
#define PG8_STAGE(bufoff, gbase, voff) do { _Pragma("unroll") for (int _i = 0; _i < 2; ++_i) \
    __builtin_amdgcn_global_load_lds((const unsigned*)((const char*)(gbase) + (voff)[_i]), (PG8_LAS unsigned*)(lds + (bufoff) + ldsw + _i * 8192), 16, 0, 0); } while (0)
#define PG8_LDA(dst, b, h) do { _Pragma("unroll") for (int m = 0; m < 4; ++m) _Pragma("unroll") for (int k = 0; k < 2; ++k) dst[m][k] = *(const PG8_LAS bf16x8*)(lds + PG8_SA(b, h) + aoff + m * 2048 + k * 1024); } while (0)
#define PG8_LDB(dst, b, h) do { _Pragma("unroll") for (int n = 0; n < 2; ++n) _Pragma("unroll") for (int k = 0; k < 2; ++k) dst[n][k] = *(const PG8_LAS bf16x8*)(lds + PG8_SB(b, h) + boff + n * 2048 + k * 1024); } while (0)
#define PG8_MMA(ai, bj, At, Bt) do { __builtin_amdgcn_s_setprio(1); _Pragma("unroll") for (int m = 0; m < 4; ++m) _Pragma("unroll") for (int n = 0; n < 2; ++n) _Pragma("unroll") for (int k = 0; k < 2; ++k) \
    acc[ai][bj][m][n] = __builtin_amdgcn_mfma_f32_16x16x32_bf16(Bt[n][k], At[m][k], acc[ai][bj][m][n], 0, 0, 0); __builtin_amdgcn_s_setprio(0); } while (0)
#define PG8_WAIT_V(n) asm volatile("s_waitcnt vmcnt(" #n ")" ::: "memory")
#define PG8_WAIT_L(n) asm volatile("s_waitcnt lgkmcnt(" #n ")" ::: "memory")
#define PG8_BAR __builtin_amdgcn_s_barrier()
#define PG8_SCHED __builtin_amdgcn_sched_barrier(0)
#define PG8_APTR(u) ((const char*)g.A + (size_t)(u).pm * tstepA + (size_t)((u).pn / g.pn_per_batch) * g.a_batch_elems * 2)
#define PG8_BPTR(u) ((const char*)g.Bt + (size_t)(u).pn * tstepB)
  Unit cur, nxt; int ui = 0;
  if (!S.next(0, cur)) return;
  f32x4 acc[2][2][4][2];
#pragma unroll
  for (int a = 0; a < 2; ++a)
#pragma unroll
    for (int b = 0; b < 2; ++b)
#pragma unroll
      for (int m = 0; m < 4; ++m)
#pragma unroll
        for (int n = 0; n < 2; ++n) acc[a][b][m][n] = (f32x4){0.f, 0.f, 0.f, 0.f};
  bf16x8 At[4][2], B0[2][2], B1[2][2];
  const char* cA = PG8_APTR(cur); const char* cB = PG8_BPTR(cur);
  PG8_STAGE(PG8_SB(0, 0), cB, voffB); PG8_STAGE(PG8_SB(0, 1), cB + hstepB, voffB); PG8_STAGE(PG8_SA(0, 0), cA, voffA); PG8_STAGE(PG8_SA(0, 1), cA + hstepA, voffA);
  if (wr == 1) PG8_BAR;
  PG8_WAIT_V(2); PG8_BAR;
  PG8_STAGE(PG8_SB(1, 0), cB + kstep, voffB); PG8_STAGE(PG8_SA(1, 0), cA + kstep, voffA); PG8_STAGE(PG8_SB(1, 1), cB + hstepB + kstep, voffB);
  PG8_WAIT_V(6); PG8_BAR;
  for (;;) {
    const bool has_next = S.next(ui + 1, nxt);
    const char* nA = has_next ? PG8_APTR(nxt) : cA; const char* nB = has_next ? PG8_BPTR(nxt) : cB;
    for (int t = 0; t < nt; t += 2) {
      const bool last = (t == nt - 2);
      const char* a1 = cA + (size_t)(t + 1) * kstep;
      const char* a2 = last ? nA : cA + (size_t)(t + 2) * kstep; const char* b2 = last ? nB : cB + (size_t)(t + 2) * kstep;
      const char* a3 = a2 + kstep; const char* b3 = b2 + kstep;
      PG8_LDB(B0, 0, 0); PG8_LDB(B1, 0, 1); PG8_SCHED; PG8_LDA(At, 0, 0); PG8_STAGE(PG8_SA(1, 1), a1 + hstepA, voffA);
      PG8_WAIT_V(8); PG8_WAIT_L(0); PG8_BAR; PG8_MMA(0, 0, At, B0); PG8_MMA(0, 1, At, B1); PG8_BAR; PG8_SCHED;
      PG8_LDA(At, 0, 1); PG8_STAGE(PG8_SB(0, 0), b2, voffB); PG8_STAGE(PG8_SB(0, 1), b2 + hstepB, voffB); PG8_STAGE(PG8_SA(0, 0), a2, voffA);
      PG8_WAIT_V(8); PG8_WAIT_L(0); PG8_BAR; PG8_MMA(1, 0, At, B0); PG8_MMA(1, 1, At, B1); PG8_BAR; PG8_SCHED;
      PG8_LDB(B0, 1, 0); PG8_LDB(B1, 1, 1); PG8_SCHED; PG8_LDA(At, 1, 0); PG8_STAGE(PG8_SA(0, 1), a2 + hstepA, voffA);
      PG8_WAIT_V(8); PG8_WAIT_L(0); PG8_BAR; PG8_MMA(0, 0, At, B0); PG8_MMA(0, 1, At, B1); PG8_BAR; PG8_SCHED;
      PG8_LDA(At, 1, 1); PG8_STAGE(PG8_SB(1, 0), b3, voffB); PG8_STAGE(PG8_SB(1, 1), b3 + hstepB, voffB); PG8_STAGE(PG8_SA(1, 0), a3, voffA);
      PG8_WAIT_V(8); PG8_WAIT_L(0); PG8_BAR; PG8_MMA(1, 0, At, B0); PG8_MMA(1, 1, At, B1); PG8_BAR; PG8_SCHED;
    }
    if (wr == 0) PG8_BAR;
    E(acc, cur, wr, wc, fr, fq);
    if (!has_next) break;
#pragma unroll
    for (int a = 0; a < 2; ++a)
#pragma unroll
      for (int b = 0; b < 2; ++b)
#pragma unroll
        for (int m = 0; m < 4; ++m)
#pragma unroll
          for (int n = 0; n < 2; ++n) acc[a][b][m][n] = (f32x4){0.f, 0.f, 0.f, 0.f};
    cur = nxt; cA = nA; cB = nB; ++ui;
    if (wr == 1) PG8_BAR;
  }
  PG8_WAIT_V(0);
  PG8_BAR;
#undef PG8_SA
#undef PG8_SB
#undef PG8_STAGE
#undef PG8_LDA
#undef PG8_LDB
#undef PG8_MMA
#undef PG8_WAIT_V
#undef PG8_WAIT_L
#undef PG8_BAR
#undef PG8_SCHED
#undef PG8_APTR
#undef PG8_BPTR
}
}
template <int MODE> __device__ __forceinline__ void gemm_fast(const GemmArgs& g, const EpiArgs& e, unsigned char* lds_raw, int bid_, int nblk) {
  const int bid = (bid_ + g.rot) % nblk;
  pg8::Gemm G{g.A, g.Bt, g.M, g.N * g.nbatch, g.K, (int)g.lda, (int)g.ldb, g.nbatch > 1 ? g.N / 256 : (1 << 30), (int)g.a_batch};
  pg8::StaticOrder S; S.init(G.M, G.N, nblk, bid);
  pg8::EpiAdapter<MODE> E{e, g.N};
  pg8::gemm_phase<pg8::EpiAdapter<MODE>>((PG8_LAS unsigned char*)lds_raw, G, S, E);
}

__device__ __forceinline__ void phase1b(const Params& p, int gw, int ngw, int lane) {
  unsigned char* ws = p.ws;
  bf16_t* CQ = (bf16_t*)(ws + WS_CQ); bf16_t* CKV = (bf16_t*)(ws + WS_CKV); const bf16_t* KPE = (const bf16_t*)(ws + WS_KPE);
  bf16_t* Kd = (bf16_t*)((unsigned char*)p.out + DO_K); const bf16_t* LX = (const bf16_t*)(ws + WS_LRUX); bf16_t* XC = (bf16_t*)(ws + WS_XC);
  const float* ct = (const float*)(ws + WS_COS); const float* st = (const float*)(ws + WS_SIN);
  for (int r = gw; r < T_; r += ngw) {
#pragma unroll
    for (int which = 0; which < 2; ++which) {
      bf16_t* row = (which ? CKV : CQ) + (size_t)r * 512 + lane * 8; const float* g = p.in[which ? 8 : 6] + lane * 8;
      float f[8]; unpack8(*(const u32x4*)row, f); float q = 0.f;
#pragma unroll
      for (int i = 0; i < 8; ++i) q += f[i] * f[i];
      const float sc = rsqrtf(dpp_sum64(q) * (1.f / 512.f) + RMS_EPS);
#pragma unroll
      for (int i = 0; i < 8; ++i) f[i] = f[i] * sc * g[i];
      *(u32x4*)row = pack8(f);
    }
    {
      if (lane < 32) { const unsigned w = *(const unsigned*)(KPE + (size_t)r * 64 + 2 * lane); const float t1 = bflo(w), t2 = bfhi(w);
        const float c = ct[(size_t)r * 32 + lane], s = st[(size_t)r * 32 + lane]; const unsigned o = pk2(t1 * c - t2 * s, t2 * c + t1 * s);
#pragma unroll
        for (int h = 0; h < 8; ++h) *(unsigned*)(Kd + (size_t)r * 1536 + h * 192 + 128 + 2 * lane) = o; } }
    if (!USE_LRU_FUSED) {
      const int s = r & (S_ - 1); float acc[16];
      const float* cb = p.in[11] + lane * 16;
#pragma unroll
      for (int i = 0; i < 16; ++i) acc[i] = cb[i];
#pragma unroll
      for (int k = 0; k < 4; ++k) { const int sp = s + k - 2; if (sp < 0 || sp >= S_) continue;
        const bf16_t* src = LX + (size_t)(r + k - 2) * 1024 + lane * 16; const float* w = p.in[10] + k * 1024 + lane * 16;
        float f[16]; unpack8(*(const u32x4*)src, f); unpack8(*(const u32x4*)(src + 8), f + 8);
#pragma unroll
        for (int i = 0; i < 16; ++i) acc[i] += f[i] * w[i]; }
      *(u32x4*)(XC + (size_t)r * 1024 + lane * 16) = pack8(acc); *(u32x4*)(XC + (size_t)r * 1024 + lane * 16 + 8) = pack8(acc + 8);
    }
  }
}

template <int DQK, int NK> __device__ __forceinline__ void attn_scalar(const bf16_t* Q, int ldq, const bf16_t* K, int ldk, const bf16_t* V, int ldv, bf16_t* O, int ldo,
                                                                      int nheads, float scale, float* lds, int bid, int nblk, int tid) {
  float* sc = lds; float* qs = lds + 16 * NK; float* ls = qs + 16 * DQK;
  const int lane = tid & 63, wave = tid >> 6;
  const int units = NB_ * nheads * (S_ / 16);
  for (int u = bid; u < units; u += nblk) {
    const int qb = u % (S_ / 16), h = (u / (S_ / 16)) % nheads, b = u / ((S_ / 16) * nheads);
    __syncthreads();
    for (int i = tid; i < 16 * DQK; i += NTHR) { const int r = i / DQK, d = i % DQK; qs[i] = bf2f(Q[(size_t)(b * S_ + qb * 16 + r) * ldq + h * DQK + d]) * scale; }
    __syncthreads();
    for (int kk = tid; kk < NK; kk += NTHR) {
      const bf16_t* kp = K + (size_t)(b * NK + kk) * ldk + h * DQK; float acc[16];
#pragma unroll
      for (int r = 0; r < 16; ++r) acc[r] = 0.f;
      for (int d0 = 0; d0 < DQK; d0 += 8) { float kf[8]; unpack8(*(const u32x4*)(kp + d0), kf);
#pragma unroll
        for (int r = 0; r < 16; ++r) { const f32x4 q0 = *(const f32x4*)(qs + r * DQK + d0), q1 = *(const f32x4*)(qs + r * DQK + d0 + 4);
          acc[r] += q0[0] * kf[0] + q0[1] * kf[1] + q0[2] * kf[2] + q0[3] * kf[3] + q1[0] * kf[4] + q1[1] * kf[5] + q1[2] * kf[6] + q1[3] * kf[7]; } }
#pragma unroll
      for (int r = 0; r < 16; ++r) sc[r * NK + kk] = acc[r];
    }
    __syncthreads();
    for (int rr = 0; rr < 2; ++rr) { const int r = wave * 2 + rr; float m = -1e30f;
      for (int kk = lane; kk < NK; kk += 64) m = fmaxf(m, sc[r * NK + kk]);
      m = wave_max(m); float l = 0.f;
      for (int kk = lane; kk < NK; kk += 64) { const float pv = __expf(sc[r * NK + kk] - m); sc[r * NK + kk] = pv; l += pv; }
      l = wave_sum(l); if (lane == 0) ls[r] = l; }
    __syncthreads();
    { const int r = tid >> 5, d4 = (tid & 31) * 4; float a0 = 0.f, a1 = 0.f, a2 = 0.f, a3 = 0.f;
      const bf16_t* vp = V + (size_t)(b * NK) * ldv + h * 128 + d4;
      for (int kk = 0; kk < NK; ++kk) { const float pv = sc[r * NK + kk]; const u32x2 w = *(const u32x2*)(vp + (size_t)kk * ldv);
        a0 += pv * bflo(w.x); a1 += pv * bfhi(w.x); a2 += pv * bflo(w.y); a3 += pv * bfhi(w.y); }
      const float il = 1.f / ls[r];
      st4(O + (size_t)(b * S_ + qb * 16 + r) * ldo + h * 128 + d4, (f32x4){a0 * il, a1 * il, a2 * il, a3 * il}); }
  }
  __syncthreads();
}


namespace fa {
typedef short s16x4 __attribute__((ext_vector_type(4)));
constexpr int NW = 8, QBLK = 32, KVBLK = 64;
constexpr float THR = 8.f;
#define FA_SBAR() __builtin_amdgcn_sched_barrier(0)
__device__ __forceinline__ int crow(int r, int hi) { return (r & 3) + 8 * (r >> 2) + 4 * hi; }
__device__ __forceinline__ unsigned cvtpk(float lo, float hi) { unsigned r; asm volatile("v_cvt_pk_bf16_f32 %0, %1, %2" : "=v"(r) : "v"(lo), "v"(hi)); return r; }
__device__ __forceinline__ void partialSM(f32x16& p0, f32x16& p1, float& m_reg, float& mn, float& alpha, const float C, const float thr_s) {
  float pmax = p0[0];
#pragma unroll
  for (int r = 1; r < 16; ++r) pmax = fmaxf(pmax, p0[r]);
#pragma unroll
  for (int r = 0; r < 16; ++r) pmax = fmaxf(pmax, p1[r]);
  { auto rr = __builtin_amdgcn_permlane32_swap(__float_as_uint(pmax), __float_as_uint(pmax), false, false);
    pmax = fmaxf(__uint_as_float(rr[0]), __uint_as_float(rr[1])); }
  if (__builtin_expect(__all(pmax - m_reg <= thr_s), 1)) { mn = m_reg; alpha = 1.f; }
  else { mn = fmaxf(m_reg, pmax); alpha = __builtin_amdgcn_exp2f((m_reg - mn) * C); m_reg = mn; }
  const float mnC = -mn * C;
#pragma unroll
  for (int r = 0; r < 16; ++r) p0[r] = fmaf(p0[r], C, mnC);
#pragma unroll
  for (int r = 0; r < 16; ++r) p1[r] = fmaf(p1[r], C, mnC);
#pragma unroll
  for (int r = 0; r < 16; ++r) p0[r] = __builtin_amdgcn_exp2f(p0[r]);
}
__device__ __forceinline__ void finishSM(f32x16& p0, f32x16& p1, float alpha, float& l_reg, bf16x8& pa0, bf16x8& pa1, bf16x8& pa2, bf16x8& pa3) {
#pragma unroll
  for (int r = 0; r < 16; ++r) p1[r] = __builtin_amdgcn_exp2f(p1[r]);
  float ps = 0;
#pragma unroll
  for (int r = 0; r < 16; ++r) ps += p0[r];
#pragma unroll
  for (int r = 0; r < 16; ++r) ps += p1[r];
  { auto rr = __builtin_amdgcn_permlane32_swap(__float_as_uint(ps), __float_as_uint(ps), false, false);
    ps = __uint_as_float(rr[0]) + __uint_as_float(rr[1]); }
  l_reg = l_reg * alpha + ps;
#define FA_PK4(P, BASE, OUT) do { unsigned a0 = cvtpk(P[BASE + 0], P[BASE + 1]), a1 = cvtpk(P[BASE + 2], P[BASE + 3]);   \
    unsigned b0 = cvtpk(P[BASE + 4], P[BASE + 5]), b1 = cvtpk(P[BASE + 6], P[BASE + 7]);                              \
    auto r0 = __builtin_amdgcn_permlane32_swap(a0, b0, false, false); auto r1 = __builtin_amdgcn_permlane32_swap(a1, b1, false, false); \
    u32x4 w = {r0[0], r1[0], r0[1], r1[1]}; OUT = *reinterpret_cast<bf16x8*>(&w); } while (0)
  FA_PK4(p0, 0, pa0); FA_PK4(p0, 8, pa1); FA_PK4(p1, 0, pa2); FA_PK4(p1, 8, pa3);
#undef FA_PK4
}
template <int DQK> constexpr int krs() { return DQK == 192 ? 400 : DQK * 2; }
template <int DQK> __device__ __forceinline__ int kswz(int row, int colB) { return DQK == 192 ? row * 400 + colB : row * (DQK * 2) + (colB ^ ((row & 7) << 4)); }
template <int DQK> __device__ __forceinline__ void qkt(f32x16& p0, f32x16& p1, const char* Ks, const bf16x8* qr, const int* kb4) {
  p0 = f32x16{}; p1 = f32x16{};
#pragma unroll
  for (int d0 = 0; d0 < DQK / 16; ++d0) {
    const bf16x8 b0 = *reinterpret_cast<const bf16x8*>(Ks + kb4[d0 & 3] + (d0 >> 2) * 128);
    const bf16x8 b1 = *reinterpret_cast<const bf16x8*>(Ks + kb4[d0 & 3] + (d0 >> 2) * 128 + 32 * krs<DQK>());
    p0 = __builtin_amdgcn_mfma_f32_32x32x16_bf16(b0, qr[d0], p0, 0, 0, 0);
    p1 = __builtin_amdgcn_mfma_f32_32x32x16_bf16(b1, qr[d0], p1, 0, 0, 0); }
}
__device__ __forceinline__ int v_st(int k, int c) { const int kk = (k & ~0xC) | ((k & 4) << 1) | ((k & 8) >> 1); return ((kk >> 3) * 4 + (c >> 5)) * 512 + ((kk & 7) * 32 + (c & 31)) * 2; }
__device__ __forceinline__ int v_rd_base(int lane) { return ((lane & 3) << 3) | (((lane >> 2) & 3) << 6) | (((lane >> 4) & 1) << 5) | (((lane >> 5) & 1) << 8); }
constexpr int v_rd_off(int d0, int ks, int half) { return d0 * 512 + ks * 4096 + half * 2048; }
template <int OFF> __device__ __forceinline__ s16x4 tr_read(int vb) {
  s16x4 r; asm volatile("ds_read_b64_tr_b16 %0, %1 offset:%2" : "=&v"(r) : "v"(vb), "i"(OFF) : "memory"); return r;
}
template <int D0> __device__ __forceinline__ void pv_one(f32x16& od, int vb, bf16x8 pa0, bf16x8 pa1, bf16x8 pa2, bf16x8 pa3) {
  const s16x4 l0 = tr_read<v_rd_off(D0, 0, 0)>(vb), h0 = tr_read<v_rd_off(D0, 0, 1)>(vb), l1 = tr_read<v_rd_off(D0, 1, 0)>(vb), h1 = tr_read<v_rd_off(D0, 1, 1)>(vb);
  const s16x4 l2 = tr_read<v_rd_off(D0, 2, 0)>(vb), h2 = tr_read<v_rd_off(D0, 2, 1)>(vb), l3 = tr_read<v_rd_off(D0, 3, 0)>(vb), h3 = tr_read<v_rd_off(D0, 3, 1)>(vb);
  asm volatile("s_waitcnt lgkmcnt(0)" ::: "memory"); FA_SBAR();
#define FA_PK(L, H) (bf16x8){L[0], L[1], L[2], L[3], H[0], H[1], H[2], H[3]}
  od = __builtin_amdgcn_mfma_f32_32x32x16_bf16(pa0, FA_PK(l0, h0), od, 0, 0, 0);
  od = __builtin_amdgcn_mfma_f32_32x32x16_bf16(pa1, FA_PK(l1, h1), od, 0, 0, 0);
  od = __builtin_amdgcn_mfma_f32_32x32x16_bf16(pa2, FA_PK(l2, h2), od, 0, 0, 0);
  od = __builtin_amdgcn_mfma_f32_32x32x16_bf16(pa3, FA_PK(l3, h3), od, 0, 0, 0);
#undef FA_PK
}
__device__ __forceinline__ void pv_d0(f32x16* o, int vb, bf16x8 pa0, bf16x8 pa1, bf16x8 pa2, bf16x8 pa3) {
  pv_one<0>(o[0], vb, pa0, pa1, pa2, pa3); pv_one<1>(o[1], vb, pa0, pa1, pa2, pa3); pv_one<2>(o[2], vb, pa0, pa1, pa2, pa3); pv_one<3>(o[3], vb, pa0, pa1, pa2, pa3);
}
template <int DQK, int LDQ, int LDK, int LDV, int LDO>
__device__ __forceinline__ void attn_body(const bf16_t* __restrict__ Qb, const bf16_t* __restrict__ Kh, const bf16_t* __restrict__ Vh, bf16_t* __restrict__ Ob, int seq, float scale, char* lds) {
  constexpr int SHM_V = KVBLK * 128 * 2, SHM_K = KVBLK * krs<DQK>(), NKC = DQK / 64;
  const float C = scale * 1.4426950408889634f, thr_s = THR / scale;
  int tid_ = threadIdx.x; asm volatile("" : "+v"(tid_));
  const int tid = tid_, wid = tid >> 6, lane = tid & 63, r32 = lane & 31, hi = lane >> 5;
  char* V_lds = lds; char* K_lds = lds + 2 * SHM_V;
  float* wsf = (float*)(lds + 2 * SHM_V + 2 * SHM_K) + wid * 64; float* li_l = wsf; float* al_l = wsf + 32;
  float m_reg = -1e30f, l_reg = 0; f32x16 o[4] = {}; bf16x8 qr[DQK / 16];
  const bf16_t* Qw = Qb + (size_t)(wid * QBLK + r32) * LDQ + hi * 8;
#pragma unroll
  for (int d0 = 0; d0 < DQK / 16; ++d0) qr[d0] = *reinterpret_cast<const bf16x8*>(Qw + d0 * 16);
  const int sr = tid >> 4, sc = (tid & 15) * 8, vst0 = v_st(sr, sc), vst1 = v_st(32 + sr, sc);
  const int kgo0 = sr * LDK + sc, klo0 = kswz<DQK>(sr, sc * 2);
  const int kgo2 = (tid >> 3) * LDK + 128 + (tid & 7) * 8, klo2 = kswz<DQK>(tid >> 3, (128 + (tid & 7) * 8) * 2);
  const int vb0 = (int)(uintptr_t)V_lds + v_rd_base(lane);
  int kb4[4];
#pragma unroll
  for (int q = 0; q < 4; ++q) kb4[q] = kswz<DQK>(r32, q * 32 + hi * 16);
  bf16x8 vs0, vs1, ks[NKC];
#define FA_SLOAD(k0) do { vs0 = *reinterpret_cast<const bf16x8*>(&Vh[(size_t)((k0) + sr) * LDV + sc]); vs1 = *reinterpret_cast<const bf16x8*>(&Vh[(size_t)((k0) + 32 + sr) * LDV + sc]); \
    ks[0] = *reinterpret_cast<const bf16x8*>(&Kh[(size_t)(k0) * LDK + kgo0]); ks[1] = *reinterpret_cast<const bf16x8*>(&Kh[(size_t)((k0) + 32) * LDK + kgo0]); \
    if constexpr (NKC == 3) ks[NKC - 1] = *reinterpret_cast<const bf16x8*>(&Kh[(size_t)(k0) * LDK + kgo2]); } while (0)
#define FA_SWRITE(b) do { *(bf16x8*)(V_lds + (b) * SHM_V + vst0) = vs0; *(bf16x8*)(V_lds + (b) * SHM_V + vst1) = vs1; \
    *(bf16x8*)(K_lds + (b) * SHM_K + klo0) = ks[0]; *(bf16x8*)(K_lds + (b) * SHM_K + klo0 + 32 * krs<DQK>()) = ks[1]; \
    if constexpr (NKC == 3) *(bf16x8*)(K_lds + (b) * SHM_K + klo2) = ks[NKC - 1]; } while (0)
#define FA_SWAIT() asm volatile("s_waitcnt vmcnt(0)" ::: "memory")
#define FA_RESC(a) do { if (__any((a) < 1.f)) { if (hi == 0) al_l[r32] = (a); asm volatile("s_waitcnt lgkmcnt(0)" ::: "memory"); \
    _Pragma("unroll") for (int d = 0; d < 4; ++d) _Pragma("unroll") for (int r = 0; r < 16; ++r) o[d][r] *= al_l[crow(r, hi)]; } } while (0)
  f32x16 pA0, pA1, pB0, pB1; float mnA, mnB, alA, alB; bf16x8 pa0, pa1, pa2, pa3; const int NT = seq / KVBLK;
  FA_SLOAD(0); FA_SWAIT(); FA_SWRITE(0); __syncthreads();
  qkt<DQK>(pA0, pA1, K_lds, qr, kb4); partialSM(pA0, pA1, m_reg, mnA, alA, C, thr_s);
  FA_SLOAD(KVBLK);
  FA_SWAIT(); FA_SWRITE(1); __syncthreads();
  for (int j = 1; j + 1 < NT; j += 2) {
    FA_SBAR(); qkt<DQK>(pB0, pB1, K_lds + SHM_K, qr, kb4);
    finishSM(pA0, pA1, alA, l_reg, pa0, pa1, pa2, pa3); FA_SBAR();
    FA_SLOAD((j + 1) * KVBLK); FA_SBAR();
    pv_d0(o, vb0, pa0, pa1, pa2, pa3); partialSM(pB0, pB1, m_reg, mnB, alB, C, thr_s);
    __syncthreads(); FA_SWAIT(); FA_SWRITE(0);
    FA_RESC(alB); __syncthreads();
    FA_SBAR(); qkt<DQK>(pA0, pA1, K_lds, qr, kb4);
    finishSM(pB0, pB1, alB, l_reg, pa0, pa1, pa2, pa3); FA_SBAR();
    FA_SLOAD((j + 2) * KVBLK); FA_SBAR();
    pv_d0(o, vb0 + SHM_V, pa0, pa1, pa2, pa3); partialSM(pA0, pA1, m_reg, mnA, alA, C, thr_s);
    __syncthreads(); FA_SWAIT(); FA_SWRITE(1);
    FA_RESC(alA); __syncthreads();
  }
  FA_SBAR(); qkt<DQK>(pB0, pB1, K_lds + SHM_K, qr, kb4);
  finishSM(pA0, pA1, alA, l_reg, pa0, pa1, pa2, pa3); FA_SBAR();
  pv_d0(o, vb0, pa0, pa1, pa2, pa3); partialSM(pB0, pB1, m_reg, mnB, alB, C, thr_s);
  __syncthreads(); FA_RESC(alB);
  finishSM(pB0, pB1, alB, l_reg, pa0, pa1, pa2, pa3); FA_SBAR();
  pv_d0(o, vb0 + SHM_V, pa0, pa1, pa2, pa3);
  if (hi == 0) li_l[r32] = l_reg; asm volatile("s_waitcnt lgkmcnt(0)" ::: "memory");
  float rli[16];
#pragma unroll
  for (int r = 0; r < 16; ++r) rli[r] = __builtin_amdgcn_rcpf(li_l[crow(r, hi)]);
  bf16_t* Ow = Ob + (size_t)(wid * QBLK) * LDO;
#pragma unroll
  for (int r = 0; r < 16; ++r) { const int orow = crow(r, hi);
#pragma unroll
    for (int d0 = 0; d0 < 4; ++d0) Ow[(size_t)orow * LDO + d0 * 32 + r32] = (bf16_t)f2bf(o[d0][r] * rli[r]); }
  __syncthreads();
#undef FA_SLOAD
#undef FA_SWRITE
#undef FA_SWAIT
#undef FA_RESC
}
template <int DQK, int LDQ, int LDK, int LDV, int LDO>
__device__ __forceinline__ void attn_body3(const bf16_t* __restrict__ Qb, const bf16_t* __restrict__ Kh, const bf16_t* __restrict__ Vh, bf16_t* __restrict__ Ob, int seq, float scale, char* lds) {
  constexpr int SHM_V = KVBLK * 128 * 2, SHM_K = KVBLK * krs<DQK>(), NKC = DQK / 64;
  const float C = scale * 1.4426950408889634f, thr_s = THR / scale;
  int tid_ = threadIdx.x; asm volatile("" : "+v"(tid_));
  const int tid = tid_, wid = tid >> 6, lane = tid & 63, r32 = lane & 31, hi = lane >> 5;
  char* V_lds = lds; char* K_lds = lds + 3 * SHM_V;
  float* wsf = (float*)(lds + 3 * SHM_V + 3 * SHM_K) + wid * 64; float* li_l = wsf; float* al_l = wsf + 32;
  float m_reg = -1e30f, l_reg = 0; f32x16 o[4] = {}; bf16x8 qr[DQK / 16];
  const bf16_t* Qw = Qb + (size_t)(wid * QBLK + r32) * LDQ + hi * 8;
#pragma unroll
  for (int d0 = 0; d0 < DQK / 16; ++d0) qr[d0] = *reinterpret_cast<const bf16x8*>(Qw + d0 * 16);
  const int sr = tid >> 4, sc = (tid & 15) * 8, vst0 = v_st(sr, sc), vst1 = v_st(32 + sr, sc);
  const int kgo0 = sr * LDK + sc, klo0 = kswz<DQK>(sr, sc * 2);
  const int kgo2 = (tid >> 3) * LDK + 128 + (tid & 7) * 8, klo2 = kswz<DQK>(tid >> 3, (128 + (tid & 7) * 8) * 2);
  const int vb0 = (int)(uintptr_t)V_lds + v_rd_base(lane);
  int kb4[4];
#pragma unroll
  for (int q = 0; q < 4; ++q) kb4[q] = kswz<DQK>(r32, q * 32 + hi * 16);
  bf16x8 vs0, vs1, ks[NKC];
#define FA_SLOAD(k0) do { vs0 = *reinterpret_cast<const bf16x8*>(&Vh[(size_t)((k0) + sr) * LDV + sc]); vs1 = *reinterpret_cast<const bf16x8*>(&Vh[(size_t)((k0) + 32 + sr) * LDV + sc]); \
    ks[0] = *reinterpret_cast<const bf16x8*>(&Kh[(size_t)(k0) * LDK + kgo0]); ks[1] = *reinterpret_cast<const bf16x8*>(&Kh[(size_t)((k0) + 32) * LDK + kgo0]); \
    if constexpr (NKC == 3) ks[NKC - 1] = *reinterpret_cast<const bf16x8*>(&Kh[(size_t)(k0) * LDK + kgo2]); } while (0)
#define FA_SWRITE(b) do { *(bf16x8*)(V_lds + (b) * SHM_V + vst0) = vs0; *(bf16x8*)(V_lds + (b) * SHM_V + vst1) = vs1; \
    *(bf16x8*)(K_lds + (b) * SHM_K + klo0) = ks[0]; *(bf16x8*)(K_lds + (b) * SHM_K + klo0 + 32 * krs<DQK>()) = ks[1]; \
    if constexpr (NKC == 3) *(bf16x8*)(K_lds + (b) * SHM_K + klo2) = ks[NKC - 1]; } while (0)
#define FA_SWAIT() asm volatile("s_waitcnt vmcnt(0)" ::: "memory")
#define FA_RESC(a) do { if (__any((a) < 1.f)) { if (hi == 0) al_l[r32] = (a); asm volatile("s_waitcnt lgkmcnt(0)" ::: "memory"); \
    _Pragma("unroll") for (int d = 0; d < 4; ++d) _Pragma("unroll") for (int r = 0; r < 16; ++r) o[d][r] *= al_l[crow(r, hi)]; } } while (0)
  f32x16 pA0, pA1, pB0, pB1; float mnA, mnB, alA, alB; bf16x8 pa0, pa1, pa2, pa3; const int NT = seq / KVBLK;
  FA_SLOAD(0); FA_SWAIT(); FA_SWRITE(0); __syncthreads();
  qkt<DQK>(pA0, pA1, K_lds, qr, kb4); partialSM(pA0, pA1, m_reg, mnA, alA, C, thr_s);
  FA_SLOAD(KVBLK);
  FA_SWAIT(); FA_SWRITE(1); __syncthreads();
  int bk = 1, bv = 0, bw = 2;
#define FA_ROT() do { const int t_ = bv; bv = bk; bk = bw; bw = t_; } while (0)
  for (int j = 1; j + 1 < NT; j += 2) {
    FA_SBAR(); qkt<DQK>(pB0, pB1, K_lds + bk * SHM_K, qr, kb4);
    finishSM(pA0, pA1, alA, l_reg, pa0, pa1, pa2, pa3); FA_SBAR();
    FA_SLOAD((j + 1) * KVBLK); FA_SBAR();
    pv_d0(o, vb0 + bv * SHM_V, pa0, pa1, pa2, pa3); partialSM(pB0, pB1, m_reg, mnB, alB, C, thr_s);
    FA_SWAIT(); FA_SWRITE(bw);
    FA_RESC(alB); __syncthreads(); FA_ROT();
    FA_SBAR(); qkt<DQK>(pA0, pA1, K_lds + bk * SHM_K, qr, kb4);
    finishSM(pB0, pB1, alB, l_reg, pa0, pa1, pa2, pa3); FA_SBAR();
    FA_SLOAD((j + 2) * KVBLK); FA_SBAR();
    pv_d0(o, vb0 + bv * SHM_V, pa0, pa1, pa2, pa3); partialSM(pA0, pA1, m_reg, mnA, alA, C, thr_s);
    FA_SWAIT(); FA_SWRITE(bw);
    FA_RESC(alA); __syncthreads(); FA_ROT();
  }
  FA_SBAR(); qkt<DQK>(pB0, pB1, K_lds + bk * SHM_K, qr, kb4);
  finishSM(pA0, pA1, alA, l_reg, pa0, pa1, pa2, pa3); FA_SBAR();
  pv_d0(o, vb0 + bv * SHM_V, pa0, pa1, pa2, pa3); partialSM(pB0, pB1, m_reg, mnB, alB, C, thr_s);
  FA_RESC(alB);
  finishSM(pB0, pB1, alB, l_reg, pa0, pa1, pa2, pa3); FA_SBAR();
  pv_d0(o, vb0 + bk * SHM_V, pa0, pa1, pa2, pa3);
#undef FA_ROT
  if (hi == 0) li_l[r32] = l_reg; asm volatile("s_waitcnt lgkmcnt(0)" ::: "memory");
  float rli[16];
#pragma unroll
  for (int r = 0; r < 16; ++r) rli[r] = __builtin_amdgcn_rcpf(li_l[crow(r, hi)]);
  bf16_t* Ow = Ob + (size_t)(wid * QBLK) * LDO;
#pragma unroll
  for (int r = 0; r < 16; ++r) { const int orow = crow(r, hi);
#pragma unroll
    for (int d0 = 0; d0 < 4; ++d0) Ow[(size_t)orow * LDO + d0 * 32 + r32] = (bf16_t)f2bf(o[d0][r] * rli[r]); }
  __syncthreads();
#undef FA_SLOAD
#undef FA_SWRITE
#undef FA_SWAIT
#undef FA_RESC
}

template <int S> __device__ __forceinline__ void fin_chunk(f32x16& P0, f32x16& P1, float alpha, float& l_reg, float& ps, bf16x8& pa0, bf16x8& pa1, bf16x8& pa2, bf16x8& pa3) {
  if constexpr (S < 8) { P1[2 * S] = __builtin_amdgcn_exp2f(P1[2 * S]); P1[2 * S + 1] = __builtin_amdgcn_exp2f(P1[2 * S + 1]); }
  else if constexpr (S < 12) { constexpr int k = S - 8; ps += (P0[4 * k] + P0[4 * k + 1]) + (P0[4 * k + 2] + P0[4 * k + 3]); ps += (P1[4 * k] + P1[4 * k + 1]) + (P1[4 * k + 2] + P1[4 * k + 3]); }
  else if constexpr (S == 12) { auto rr = __builtin_amdgcn_permlane32_swap(__float_as_uint(ps), __float_as_uint(ps), false, false); l_reg = l_reg * alpha + (__uint_as_float(rr[0]) + __uint_as_float(rr[1])); }
  else if constexpr (S >= 13 && S <= 16) {
#define FA_PK4(P, BASE, OUT) do { unsigned a0 = cvtpk(P[BASE + 0], P[BASE + 1]), a1 = cvtpk(P[BASE + 2], P[BASE + 3]);   \
    unsigned b0 = cvtpk(P[BASE + 4], P[BASE + 5]), b1 = cvtpk(P[BASE + 6], P[BASE + 7]);                              \
    auto r0 = __builtin_amdgcn_permlane32_swap(a0, b0, false, false); auto r1 = __builtin_amdgcn_permlane32_swap(a1, b1, false, false); \
    u32x4 w = {r0[0], r1[0], r0[1], r1[1]}; OUT = *reinterpret_cast<bf16x8*>(&w); } while (0)
    if constexpr (S == 13) FA_PK4(P0, 0, pa0); else if constexpr (S == 14) FA_PK4(P0, 8, pa1); else if constexpr (S == 15) FA_PK4(P1, 0, pa2); else FA_PK4(P1, 8, pa3);
#undef FA_PK4
  }
}
template <int CH> __device__ __forceinline__ void par_chunk(f32x16& P0, f32x16& P1, float& m_reg, float& alpha, float& pm, float& mnC, const float C, const float thr_s) {
  if constexpr (CH < 8) { f32x16& P = (CH < 4) ? P0 : P1; constexpr int b = 4 * (CH & 3);
    if constexpr (CH == 0) pm = fmaxf(fmaxf(P[0], P[1]), fmaxf(P[2], P[3])); else pm = fmaxf(pm, fmaxf(fmaxf(P[b], P[b + 1]), fmaxf(P[b + 2], P[b + 3]))); }
  else if constexpr (CH == 8) {
    auto rr = __builtin_amdgcn_permlane32_swap(__float_as_uint(pm), __float_as_uint(pm), false, false); pm = fmaxf(__uint_as_float(rr[0]), __uint_as_float(rr[1]));
    const bool ok = __all(pm - m_reg <= thr_s);
    const float mn = ok ? m_reg : fmaxf(m_reg, pm);
    alpha = __builtin_amdgcn_exp2f((m_reg - mn) * C);
    m_reg = mn; mnC = -mn * C; }
  else if constexpr (CH < 13) { constexpr int k = CH - 9; f32x16& P = (k < 2) ? P0 : P1; constexpr int b = 8 * (k & 1);
#pragma unroll
    for (int r = 0; r < 8; ++r) { P[b + r] = fmaf(P[b + r], C, mnC); asm volatile("" : "+v"(P[b + r])); } }
  else { constexpr int lo = (CH == 13) ? 0 : (CH == 14) ? 6 : 11, hi_ = (CH == 13) ? 6 : (CH == 14) ? 11 : 16;
#pragma unroll
    for (int r = lo; r < hi_; ++r) { P0[r] = __builtin_amdgcn_exp2f(P0[r]); asm volatile("" : "+v"(P0[r])); } }
}
template <int DQK, int LDQ, int LDK, int LDV, int LDO>
__device__ __forceinline__ void attn_body4(const bf16_t* __restrict__ Qb, const bf16_t* __restrict__ Kh, const bf16_t* __restrict__ Vh, bf16_t* __restrict__ Ob, int seq, float scale, char* lds) {
  constexpr int SHM_V = KVBLK * 128 * 2, SHM_K = KVBLK * krs<DQK>(), NKC = DQK / 64, ND = DQK / 16;
  const float C = scale * 1.4426950408889634f, thr_s = THR / scale;
  int tid_ = threadIdx.x; asm volatile("" : "+v"(tid_));
  const int tid = tid_, wid = tid >> 6, lane = tid & 63, r32 = lane & 31, hi = lane >> 5;
  char* V_lds = lds; char* K_lds = lds + 3 * SHM_V;
  float* wsf = (float*)(lds + 3 * SHM_V + 3 * SHM_K) + wid * 64; float* li_l = wsf; float* al_l = wsf + 32;
  float m_reg = -1e30f, l_reg = 0; f32x16 o[4] = {}; bf16x8 qr[ND];
  const bf16_t* Qw = Qb + (size_t)(wid * QBLK + r32) * LDQ + hi * 8;
#pragma unroll
  for (int d0 = 0; d0 < ND; ++d0) qr[d0] = *reinterpret_cast<const bf16x8*>(Qw + d0 * 16);
  const int sr = tid >> 4, sc = (tid & 15) * 8, vst0 = v_st(sr, sc), vst1 = v_st(32 + sr, sc);
  const int kgo0 = sr * LDK + sc, klo0 = kswz<DQK>(sr, sc * 2);
  const int kgo2 = (tid >> 3) * LDK + 128 + (tid & 7) * 8, klo2 = kswz<DQK>(tid >> 3, (128 + (tid & 7) * 8) * 2);
  const int vb0 = (int)(uintptr_t)V_lds + v_rd_base(lane);
  int kb4[4];
#pragma unroll
  for (int q = 0; q < 4; ++q) kb4[q] = kswz<DQK>(r32, q * 32 + hi * 16);
  bf16x8 vs0, vs1, ks[NKC];
#define FA_SLOAD(k0) do { vs0 = *reinterpret_cast<const bf16x8*>(&Vh[(size_t)((k0) + sr) * LDV + sc]); vs1 = *reinterpret_cast<const bf16x8*>(&Vh[(size_t)((k0) + 32 + sr) * LDV + sc]); \
    ks[0] = *reinterpret_cast<const bf16x8*>(&Kh[(size_t)(k0) * LDK + kgo0]); ks[1] = *reinterpret_cast<const bf16x8*>(&Kh[(size_t)((k0) + 32) * LDK + kgo0]); \
    if constexpr (NKC == 3) ks[NKC - 1] = *reinterpret_cast<const bf16x8*>(&Kh[(size_t)(k0) * LDK + kgo2]); } while (0)
#define FA_SWRITE(b) do { *(bf16x8*)(V_lds + (b) * SHM_V + vst0) = vs0; *(bf16x8*)(V_lds + (b) * SHM_V + vst1) = vs1; \
    *(bf16x8*)(K_lds + (b) * SHM_K + klo0) = ks[0]; *(bf16x8*)(K_lds + (b) * SHM_K + klo0 + 32 * krs<DQK>()) = ks[1]; \
    if constexpr (NKC == 3) *(bf16x8*)(K_lds + (b) * SHM_K + klo2) = ks[NKC - 1]; } while (0)
#define FA_SWAIT() asm volatile("s_waitcnt vmcnt(0)" ::: "memory")
#define FA_RESC(a) do { if (__any((a) < 1.f)) { if (hi == 0) al_l[r32] = (a); asm volatile("s_waitcnt lgkmcnt(0)" ::: "memory"); \
    _Pragma("unroll") for (int d = 0; d < 4; ++d) _Pragma("unroll") for (int r = 0; r < 16; ++r) o[d][r] *= al_l[crow(r, hi)]; } } while (0)
#define FA_KF(KS, D0, H) (*reinterpret_cast<const bf16x8*>((KS) + kb4[(D0) & 3] + ((D0) >> 2) * 128 + (H) * 32 * krs<DQK>()))
#define FA_SEGA(PN0, PN1, KS, PO0, PO1, ALO) do { PN0 = f32x16{}; PN1 = f32x16{}; float ps_ = 0.f; bf16x8 fa_ = FA_KF(KS, 0, 0), fb_ = FA_KF(KS, 0, 1); \
    _Pragma("unroll") for (int d0 = 0; d0 < ND; ++d0) { bf16x8 na_ = fa_, nb_ = fb_; if (d0 + 1 < ND) { na_ = FA_KF(KS, d0 + 1, 0); nb_ = FA_KF(KS, d0 + 1, 1); } \
      PN0 = __builtin_amdgcn_mfma_f32_32x32x16_bf16(fa_, qr[d0], PN0, 0, 0, 0); FIN_CH(2 * d0, PO0, PO1, ALO, ps_); \
      PN1 = __builtin_amdgcn_mfma_f32_32x32x16_bf16(fb_, qr[d0], PN1, 0, 0, 0); FIN_CH(2 * d0 + 1, PO0, PO1, ALO, ps_); fa_ = na_; fb_ = nb_; FA_SBAR(); } } while (0)
#define FIN_CH(S, PO0, PO1, ALO, PS) do { switch (S) { \
    case 0: fin_chunk<0>(PO0, PO1, ALO, l_reg, PS, pa0, pa1, pa2, pa3); break; case 1: fin_chunk<1>(PO0, PO1, ALO, l_reg, PS, pa0, pa1, pa2, pa3); break; \
    case 2: fin_chunk<2>(PO0, PO1, ALO, l_reg, PS, pa0, pa1, pa2, pa3); break; case 3: fin_chunk<3>(PO0, PO1, ALO, l_reg, PS, pa0, pa1, pa2, pa3); break; \
    case 4: fin_chunk<4>(PO0, PO1, ALO, l_reg, PS, pa0, pa1, pa2, pa3); break; case 5: fin_chunk<5>(PO0, PO1, ALO, l_reg, PS, pa0, pa1, pa2, pa3); break; \
    case 6: fin_chunk<6>(PO0, PO1, ALO, l_reg, PS, pa0, pa1, pa2, pa3); break; case 7: fin_chunk<7>(PO0, PO1, ALO, l_reg, PS, pa0, pa1, pa2, pa3); break; \
    case 8: fin_chunk<8>(PO0, PO1, ALO, l_reg, PS, pa0, pa1, pa2, pa3); break; case 9: fin_chunk<9>(PO0, PO1, ALO, l_reg, PS, pa0, pa1, pa2, pa3); break; \
    case 10: fin_chunk<10>(PO0, PO1, ALO, l_reg, PS, pa0, pa1, pa2, pa3); break; case 11: fin_chunk<11>(PO0, PO1, ALO, l_reg, PS, pa0, pa1, pa2, pa3); break; \
    case 12: fin_chunk<12>(PO0, PO1, ALO, l_reg, PS, pa0, pa1, pa2, pa3); break; case 13: fin_chunk<13>(PO0, PO1, ALO, l_reg, PS, pa0, pa1, pa2, pa3); break; \
    case 14: fin_chunk<14>(PO0, PO1, ALO, l_reg, PS, pa0, pa1, pa2, pa3); break; case 15: fin_chunk<15>(PO0, PO1, ALO, l_reg, PS, pa0, pa1, pa2, pa3); break; \
    case 16: fin_chunk<16>(PO0, PO1, ALO, l_reg, PS, pa0, pa1, pa2, pa3); break; default: break; } } while (0)
#define FA_TR8(DST, D0, VB) do { DST[0] = tr_read<v_rd_off(D0, 0, 0)>(VB); DST[1] = tr_read<v_rd_off(D0, 0, 1)>(VB); DST[2] = tr_read<v_rd_off(D0, 1, 0)>(VB); DST[3] = tr_read<v_rd_off(D0, 1, 1)>(VB); \
    DST[4] = tr_read<v_rd_off(D0, 2, 0)>(VB); DST[5] = tr_read<v_rd_off(D0, 2, 1)>(VB); DST[6] = tr_read<v_rd_off(D0, 3, 0)>(VB); DST[7] = tr_read<v_rd_off(D0, 3, 1)>(VB); } while (0)
#define FA_PKV(F, i) (bf16x8){F[2 * (i)][0], F[2 * (i)][1], F[2 * (i)][2], F[2 * (i)][3], F[2 * (i) + 1][0], F[2 * (i) + 1][1], F[2 * (i) + 1][2], F[2 * (i) + 1][3]}
#define FA_PVB(D0, F, PN0, PN1, ALN) do { \
    o[D0] = __builtin_amdgcn_mfma_f32_32x32x16_bf16(pa0, FA_PKV(F, 0), o[D0], 0, 0, 0); par_chunk<4 * D0 + 0>(PN0, PN1, m_reg, ALN, pm_, mnC_, C, thr_s); \
    o[D0] = __builtin_amdgcn_mfma_f32_32x32x16_bf16(pa1, FA_PKV(F, 1), o[D0], 0, 0, 0); par_chunk<4 * D0 + 1>(PN0, PN1, m_reg, ALN, pm_, mnC_, C, thr_s); \
    o[D0] = __builtin_amdgcn_mfma_f32_32x32x16_bf16(pa2, FA_PKV(F, 2), o[D0], 0, 0, 0); par_chunk<4 * D0 + 2>(PN0, PN1, m_reg, ALN, pm_, mnC_, C, thr_s); \
    o[D0] = __builtin_amdgcn_mfma_f32_32x32x16_bf16(pa3, FA_PKV(F, 3), o[D0], 0, 0, 0); par_chunk<4 * D0 + 3>(PN0, PN1, m_reg, ALN, pm_, mnC_, C, thr_s); FA_SBAR(); } while (0)
#define FA_SEGB(VB, PN0, PN1, ALN) do { float pm_ = 0.f, mnC_ = 0.f; s16x4 fA_[8], fB_[8]; const int vb_ = (VB); \
    FA_TR8(fA_, 0, vb_); FA_TR8(fB_, 1, vb_); asm volatile("s_waitcnt lgkmcnt(8)" ::: "memory"); FA_SBAR(); FA_PVB(0, fA_, PN0, PN1, ALN); \
    FA_TR8(fA_, 2, vb_); asm volatile("s_waitcnt lgkmcnt(8)" ::: "memory"); FA_SBAR(); FA_PVB(1, fB_, PN0, PN1, ALN); \
    FA_TR8(fB_, 3, vb_); asm volatile("s_waitcnt lgkmcnt(8)" ::: "memory"); FA_SBAR(); FA_PVB(2, fA_, PN0, PN1, ALN); \
    asm volatile("s_waitcnt lgkmcnt(0)" ::: "memory"); FA_SBAR(); FA_PVB(3, fB_, PN0, PN1, ALN); } while (0)
  f32x16 pA0, pA1, pB0, pB1; float alA = 1.f, alB = 1.f; bf16x8 pa0, pa1, pa2, pa3; const int NT = seq / KVBLK;
  FA_SLOAD(0); FA_SWAIT(); FA_SWRITE(0); __syncthreads();
  { float mnA_, alA_; qkt<DQK>(pA0, pA1, K_lds, qr, kb4); partialSM(pA0, pA1, m_reg, mnA_, alA_, C, thr_s); alA = alA_; }
  FA_SLOAD(KVBLK);
  FA_SWAIT(); FA_SWRITE(1); __syncthreads();
  int bk = 1, bv = 0, bw = 2;
#define FA_ROT() do { const int t_ = bv; bv = bk; bk = bw; bw = t_; } while (0)
  for (int j = 1; j + 1 < NT; j += 2) {
    FA_SBAR(); FA_SEGA(pB0, pB1, K_lds + bk * SHM_K, pA0, pA1, alA);
    FA_SLOAD((j + 1) * KVBLK); FA_SBAR();
    FA_SEGB(vb0 + bv * SHM_V, pB0, pB1, alB);
    FA_SWAIT(); FA_SWRITE(bw);
    FA_RESC(alB); __syncthreads(); FA_ROT();
    FA_SBAR(); FA_SEGA(pA0, pA1, K_lds + bk * SHM_K, pB0, pB1, alB);
    FA_SLOAD((j + 2) * KVBLK); FA_SBAR();
    FA_SEGB(vb0 + bv * SHM_V, pA0, pA1, alA);
    FA_SWAIT(); FA_SWRITE(bw);
    FA_RESC(alA); __syncthreads(); FA_ROT();
  }
  FA_SBAR(); FA_SEGA(pB0, pB1, K_lds + bk * SHM_K, pA0, pA1, alA);
  FA_SEGB(vb0 + bv * SHM_V, pB0, pB1, alB);
  FA_RESC(alB);
  finishSM(pB0, pB1, alB, l_reg, pa0, pa1, pa2, pa3); FA_SBAR();
  pv_d0(o, vb0 + bk * SHM_V, pa0, pa1, pa2, pa3);
#undef FA_ROT
  if (hi == 0) li_l[r32] = l_reg; asm volatile("s_waitcnt lgkmcnt(0)" ::: "memory");
  float rli[16];
#pragma unroll
  for (int r = 0; r < 16; ++r) rli[r] = __builtin_amdgcn_rcpf(li_l[crow(r, hi)]);
  bf16_t* Ow = Ob + (size_t)(wid * QBLK) * LDO;
#pragma unroll
  for (int r = 0; r < 16; ++r) { const int orow = crow(r, hi);
#pragma unroll
    for (int d0 = 0; d0 < 4; ++d0) Ow[(size_t)orow * LDO + d0 * 32 + r32] = (bf16_t)f2bf(o[d0][r] * rli[r]); }
  __syncthreads();
#undef FA_SLOAD
#undef FA_SWRITE
#undef FA_SWAIT
#undef FA_RESC
#undef FA_KF
#undef FA_SEGA
#undef FIN_CH
#undef FA_TR8
#undef FA_PKV
#undef FA_PVB
#undef FA_SEGB
}
#undef FA_SBAR
}
__device__ __forceinline__ void mla_attn_phase(unsigned char* dout, unsigned char* ws, char* lds, int bid, int nblk) {
  for (int u = bid; u < NB_ * 8 * (S_ / 256); u += nblk) {
    const int qb = u & 7, h = (u >> 3) & 7, b = u >> 6;
    const bf16_t* Q = (const bf16_t*)(dout + DO_Q) + (size_t)(b * S_ + qb * 256) * 1536 + h * 192;
    const bf16_t* K = (const bf16_t*)(dout + DO_K) + (size_t)(b * S_) * 1536 + h * 192;
    const bf16_t* V = (const bf16_t*)(dout + DO_V) + (size_t)(b * S_) * 1024 + h * 128;
    bf16_t* O = (bf16_t*)(ws + WS_YMIX) + (size_t)(b * S_ + qb * 256) * 2048 + h * 128;
    fa::attn_body4<192, 1536, 1536, 1024, 2048>(Q, K, V, O, S_, 0.07216878364870322f, lds);
  }
}

__device__ __forceinline__ void mem_attn_phase(unsigned char* ws, char* lds, int bid, int nblk) {
  for (int u = bid; u < NB_ * 4 * (S_ / 256); u += nblk) {
    const int qb = u & 7, h = (u >> 3) & 3, b = u >> 5;
    const bf16_t* Q = (const bf16_t*)(ws + WS_QM) + (size_t)(b * S_ + qb * 256) * 512 + h * 128;
    const bf16_t* K = (const bf16_t*)(ws + WS_MEMKV) + (size_t)(b * 256) * 1024 + h * 128;
    const bf16_t* V = K + 512;
    bf16_t* O = (bf16_t*)(ws + WS_OM) + (size_t)(b * S_ + qb * 256) * 512 + h * 128;
    fa::attn_body<128, 512, 1024, 1024, 512>(Q, K, V, O, 256, 0.08838834764831845f, lds);
  }
}
__device__ __forceinline__ void scan_phase(unsigned char* ws, float* lds, int bid, int nblk, int tid_in) {
  int tid = tid_in; asm volatile("" : "+v"(tid));
  f32x4* sA = (f32x4*)lds; f32x4* sB = sA + 512;
  const int cq = tid & 15, ch = tid >> 4;
  for (int it = bid; it < NB_ * 2 * 16; it += nblk) {
    const int cg_ = it & 15, dir = (it >> 4) & 1, b = it >> 5;
    const char* LA = (const char*)(ws + (dir ? WS_LAB : WS_LAF)) + ((size_t)b * S_ * 1024 + cg_ * 64) * 2;
    char* BT = (char*)(ws + (dir ? WS_BTB : WS_BTF)) + ((size_t)b * S_ * 1024 + cg_ * 64) * 2;
    const int sstep = dir ? -2048 : 2048;
    const unsigned off0 = (unsigned)((dir ? (S_ - 1 - ch * 64) : ch * 64) * 2048 + cq * 8);
    f32x4 A = {1.f, 1.f, 1.f, 1.f}, Bv = {0.f, 0.f, 0.f, 0.f};
    unsigned off = off0;
#pragma unroll 8
    for (int i = 0; i < 64; ++i) { const u32x2 lw = *(const u32x2*)(LA + off), bw = *(const u32x2*)(BT + off); off += sstep;
      const f32x4 a = {__expf(bflo(lw.x)), __expf(bfhi(lw.x)), __expf(bflo(lw.y)), __expf(bfhi(lw.y))}; const f32x4 bt = {bflo(bw.x), bfhi(bw.x), bflo(bw.y), bfhi(bw.y)};
      Bv = a * Bv + bt; A = A * a; }
    __syncthreads();
    sA[ch * 16 + cq] = A; sB[ch * 16 + cq] = Bv;
    __syncthreads();
    f32x4 h = {0.f, 0.f, 0.f, 0.f};
    for (int qq = 0; qq < ch; ++qq) h = sA[qq * 16 + cq] * h + sB[qq * 16 + cq];
    off = off0;
#pragma unroll 8
    for (int i = 0; i < 64; ++i) { const u32x2 lw = *(const u32x2*)(LA + off), bw = *(const u32x2*)(BT + off);
      const f32x4 a = {__expf(bflo(lw.x)), __expf(bfhi(lw.x)), __expf(bflo(lw.y)), __expf(bfhi(lw.y))}; const f32x4 bt = {bflo(bw.x), bfhi(bw.x), bflo(bw.y), bfhi(bw.y)};
      h = a * h + bt; u32x2 w; w.x = pk2(h[0], h[1]); w.y = pk2(h[2], h[3]); *(u32x2*)(BT + off) = w; off += sstep; }
  }
  __syncthreads();
}


__device__ __forceinline__ void lru_fused_phase(const Params& p, unsigned char* lds_raw, int bid, int nblk) {
  constexpr int RS = 272;
  constexpr int AST = 65;
  unsigned char* WL = lds_raw; unsigned char* XL = lds_raw + 128 * RS;
  f32x2* AB = (f32x2*)(lds_raw + 2 * 128 * RS); float* AG = (float*)(AB + 128 * AST);
  float* CAR = AG + 2 * 8 * 64;
  int tid_ = threadIdx.x; asm volatile("" : "+v"(tid_));
  const int tid = tid_, lane = tid & 63, wave = tid >> 6, r32 = lane & 31, hi = lane >> 5;
  unsigned char* ws = p.ws;
  const bf16_t* LX = (const bf16_t*)(ws + WS_LRUX);
  for (int it = bid; it < NB_ * 8 * 2 * 2; it += nblk) {
    const int half = it & 1, dir = (it >> 1) & 1, n = (it >> 2) & 7, b = it >> 5;
    const int ch0 = n * 128 + half * 64;
    __syncthreads();
    { const bf16_t* wg = (const bf16_t*)(ws + WS_WG_T) + (size_t)(n * 512 + dir * 256 + half * 128) * 128;
      for (int i = tid; i < 128 * 16; i += NTHR) { const int r = i >> 4, c8 = (i & 15) * 8; *(u32x4*)(WL + r * RS + c8 * 2) = *(const u32x4*)(wg + r * 128 + c8); } }
    if (tid < 64) CAR[tid] = 0.f;
    float cw0[4], cw1[4]; const float cb0 = p.in[11][n * 128 + 2 * lane], cb1 = p.in[11][n * 128 + 2 * lane + 1];
#pragma unroll
    for (int k = 0; k < 4; ++k) { cw0[k] = p.in[10][k * 1024 + n * 128 + 2 * lane]; cw1[k] = p.in[10][k * 1024 + n * 128 + 2 * lane + 1]; }
    bf16_t* H = (bf16_t*)(ws + (dir ? WS_BTB : WS_BTF));
    float tb0[16], tb1[16], tb2[16];
#pragma unroll
    for (int t = 0; t < 2; ++t)
#pragma unroll
      for (int g = 0; g < 4; ++g)
#pragma unroll
        for (int u = 0; u < 2; ++u) { const int jl = (wave & 1) * 32 + 16 * t + 4 * g + 2 * hi + u; const f32x4 tb = *((const f32x4*)(ws + WS_GTAB) + dir * 1024 + ch0 + jl);
          tb0[t * 8 + g * 2 + u] = tb[0]; tb1[t * 8 + g * 2 + u] = tb[1]; tb2[t * 8 + g * 2 + u] = tb[2]; }
    unsigned xr[19];
#define LRU_LOADX(C) do { const int q0_ = (dir ? S_ - 128 * ((C) + 1) : 128 * (C)) + wave * 16; \
      _Pragma("unroll") for (int j = 0; j < 19; ++j) { const int row = q0_ + j - 2, rc = row < 0 ? 0 : (row >= S_ ? S_ - 1 : row);        \
        const unsigned v_ = *(const unsigned*)(LX + (size_t)(b * S_ + rc) * 1024 + n * 128 + 2 * lane); xr[j] = (row == rc) ? v_ : 0u; } } while (0)
    LRU_LOADX(0);
    for (int c = 0; c < 16; ++c) {
      const int p0 = dir ? S_ - 128 * (c + 1) : 128 * c;
      {
#pragma unroll
        for (int i = 0; i < 16; ++i) { float s0 = cb0, s1 = cb1;
#pragma unroll
          for (int k = 0; k < 4; ++k) { s0 += bflo(xr[i + k]) * cw0[k]; s1 += bfhi(xr[i + k]) * cw1[k]; }
          *(unsigned*)(XL + (wave * 16 + i) * RS + lane * 4) = pk2(s0, s1); } }
      if (c + 1 < 16) LRU_LOADX(c + 1);
      __syncthreads();
      f32x16 acc[2] = {};
#pragma unroll
      for (int s = 0; s < 8; ++s) { const bf16x8 xf = *(const bf16x8*)(XL + ((wave >> 1) * 32 + r32) * RS + (16 * s + 8 * hi) * 2);
#pragma unroll
        for (int t = 0; t < 2; ++t) { const bf16x8 wf = *(const bf16x8*)(WL + ((wave & 1) * 64 + 32 * t + r32) * RS + (16 * s + 8 * hi) * 2);
          acc[t] = __builtin_amdgcn_mfma_f32_32x32x16_bf16(wf, xf, acc[t], 0, 0, 0); } }
      { const int pos = (wave >> 1) * 32 + r32;
#pragma unroll
        for (int t = 0; t < 2; ++t)
#pragma unroll
          for (int g = 0; g < 4; ++g) { const int jl = (wave & 1) * 32 + 16 * t + 4 * g + 2 * hi;
            const unsigned xw = *(const unsigned*)(XL + pos * RS + (half * 64 + jl) * 2);
#pragma unroll
            for (int u = 0; u < 2; ++u) { const int ti = t * 8 + g * 2 + u;
              const float e1 = __builtin_amdgcn_exp2f(-1.4426950408889634f * (acc[t][4 * g + 2 * u] + tb1[ti])), e2 = __builtin_amdgcn_exp2f(-1.4426950408889634f * (acc[t][4 * g + 2 * u + 1] + tb2[ti]));
              const float R = __builtin_amdgcn_rcpf((1.f + e1) * (1.f + e2)), sr = (1.f + e2) * R, si = (1.f + e1) * R;
              const float la = -tb0[ti] * sr, a = __builtin_amdgcn_exp2f(la * 1.4426950408889634f), x2 = 2.f * la;
              const float ser = -x2 * (1.f + x2 * (0.5f + x2 * (1.6666667e-1f + x2 * (4.1666667e-2f + x2 * (8.3333333e-3f + x2 * 1.3888889e-3f)))));
              const float om = x2 > -0.25f ? ser : 1.f - a * a;
              AB[pos * AST + jl + u] = (f32x2){a, __builtin_amdgcn_sqrtf(om) * si * (u ? bfhi(xw) : bflo(xw))}; } } }
      __syncthreads();
      { const int jl = tid & 63, sub = tid >> 6; float av[16], bv[16]; float A = 1.f, B = 0.f;
#pragma unroll
        for (int i = 0; i < 16; ++i) { const int tau = 16 * sub + i, pos = dir ? 127 - tau : tau; const f32x2 ab = AB[pos * AST + jl]; av[i] = ab[0]; bv[i] = ab[1]; B = av[i] * B + bv[i]; A *= av[i]; }
        AG[sub * 64 + jl] = A; AG[512 + sub * 64 + jl] = B;
        __syncthreads();
        float h = CAR[jl];
        for (int s2 = 0; s2 < sub; ++s2) h = AG[s2 * 64 + jl] * h + AG[512 + s2 * 64 + jl];
#pragma unroll
        for (int i = 0; i < 16; ++i) { const int tau = 16 * sub + i, pos = dir ? 127 - tau : tau; h = av[i] * h + bv[i];
          H[(size_t)(b * S_ + p0 + pos) * 1024 + ch0 + jl] = (bf16_t)(pk2(h, 0.f) & 0xffffu); }
        __syncthreads();
        if (sub == 7) CAR[jl] = h; }
    }
#undef LRU_LOADX
  }
  __syncthreads();
}

__device__ __forceinline__ void phase3b(const Params& p, int gw, int ngw, int lane) {
  unsigned char* ws = p.ws; bf16_t* Y = (bf16_t*)(ws + WS_YMIX);
  const bf16_t* HF = (const bf16_t*)(ws + WS_BTF); const bf16_t* HB = (const bf16_t*)(ws + WS_BTB); const bf16_t* G = (const bf16_t*)(ws + WS_GATE);
  for (int r = gw; r < T_; r += ngw) {
    { bf16_t* row = Y + (size_t)r * 2048 + lane * 16; float f[16]; unpack8(*(const u32x4*)row, f); unpack8(*(const u32x4*)(row + 8), f + 8);
      float q = 0.f;
#pragma unroll
      for (int i = 0; i < 16; ++i) q += f[i] * f[i];
      const float sc = rsqrtf(dpp_sum64(q) * (1.f / 1024.f) + RMS_EPS); const float* g = p.in[17] + lane * 16;
#pragma unroll
      for (int i = 0; i < 16; ++i) f[i] = f[i] * sc * g[i];
      *(u32x4*)row = pack8(f); *(u32x4*)(row + 8) = pack8(f + 8); }
    { const size_t o = (size_t)r * 1024 + lane * 16; float a[16], b[16], gg[16];
      unpack8(*(const u32x4*)(HF + o), a); unpack8(*(const u32x4*)(HF + o + 8), a + 8);
      unpack8(*(const u32x4*)(HB + o), b); unpack8(*(const u32x4*)(HB + o + 8), b + 8);
      unpack8(*(const u32x4*)(G + o), gg); unpack8(*(const u32x4*)(G + o + 8), gg + 8);
      float q = 0.f;
#pragma unroll
      for (int i = 0; i < 16; ++i) { a[i] = (a[i] + b[i]) * gg[i]; q += a[i] * a[i]; }
      const float sc = rsqrtf(dpp_sum64(q) * (1.f / 1024.f) + RMS_EPS); const float* g = p.in[18] + lane * 16;
#pragma unroll
      for (int i = 0; i < 16; ++i) a[i] = a[i] * sc * g[i];
      bf16_t* row = Y + (size_t)r * 2048 + 1024 + lane * 16; *(u32x4*)row = pack8(a); *(u32x4*)(row + 8) = pack8(a + 8); }
  }
}
__device__ __forceinline__ void ln_pass(unsigned char* ws, const float* g, const float* b, int gw, int ngw, int lane) {
  bf16_t* X = (bf16_t*)(ws + WS_X);
  for (int r0 = gw * 2; r0 < T_; r0 += ngw * 2) { u32x4 w[2][4]; float v[32];
#pragma unroll
    for (int rr = 0; rr < 2; ++rr)
#pragma unroll
      for (int j = 0; j < 4; ++j) w[rr][j] = *(const u32x4*)(X + (size_t)(r0 + rr) * DM + j * 512 + lane * 8);
#pragma unroll
    for (int rr = 0; rr < 2; ++rr) {
#pragma unroll
      for (int j = 0; j < 4; ++j) unpack8(w[rr][j], &v[j * 8]);
      ln_row_regs(v, g, b, lane);
#pragma unroll
      for (int j = 0; j < 4; ++j) *(u32x4*)(X + (size_t)(r0 + rr) * DM + j * 512 + lane * 8) = pack8(&v[j * 8]); } }
}
__device__ __forceinline__ void cvt_pass(const float* src, bf16_t* dst, size_t n, int gw, int ngw, int lane) {
  for (size_t i = (size_t)(gw * 64 + lane) * 8; i < n; i += (size_t)ngw * 64 * 8) {
    const f32x4 a = *(const f32x4*)(src + i), b = *(const f32x4*)(src + i + 4); u32x4 o; o.x = pk2(a[0], a[1]); o.y = pk2(a[2], a[3]); o.z = pk2(b[0], b[1]); o.w = pk2(b[2], b[3]);
    *(u32x4*)(dst + i) = o; }
}

__device__ __forceinline__ unsigned key_of(float s, unsigned tag, unsigned tagmask) {
  unsigned u = __float_as_uint(s); u = (u & 0x80000000u) ? ~u : (u | 0x80000000u); return (u & ~tagmask) | (tagmask - tag);
}
__device__ __forceinline__ float val_of(unsigned k, unsigned tagmask) { unsigned u = k & ~tagmask; u = (u & 0x80000000u) ? (u & 0x7fffffffu) : ~u; return __uint_as_float(u); }
__device__ __forceinline__ void topk_phase(unsigned char* ws, const float* SC, int gw, int ngw, int lane) {
  int* IDX = (int*)(ws + WS_IDX); float* GV = (float*)(ws + WS_GV);
  int ca = -1, cb = -1; { int n = 0; for (int a = 0; a < 16; ++a) for (int b = 0; b < 16; ++b) if ((a + 1) * (b + 1) <= 16) { if (n == lane) { ca = a; cb = b; } ++n; } }
  for (int pr = gw; pr < T_ * 8; pr += ngw) {
    const float* row = SC + (size_t)pr * 256;
    unsigned k1a = key_of(row[lane], lane, 127u), k1b = key_of(row[64 + lane], 64 + lane, 127u);
    unsigned k2a = key_of(row[128 + lane], lane, 127u), k2b = key_of(row[192 + lane], 64 + lane, 127u);
    unsigned t1 = 0u, t2 = 0u;
    for (int it = 0; it < 16; ++it) {
      const unsigned m1 = dpp_max64_u32(k1a > k1b ? k1a : k1b), m2 = dpp_max64_u32(k2a > k2b ? k2a : k2b);
      if (k1a == m1) k1a = 0u; if (k1b == m1) k1b = 0u; if (k2a == m2) k2a = 0u; if (k2b == m2) k2b = 0u;
      if (lane == it) { t1 = m1; t2 = m2; }
    }
    const unsigned ka = (unsigned)__shfl((int)t1, ca < 0 ? 0 : ca), kb = (unsigned)__shfl((int)t2, cb < 0 ? 0 : cb);
    const float va = val_of(ka, 127u), vb = val_of(kb, 127u); const int ia = 127 - (int)(ka & 127u), ib = 127 - (int)(kb & 127u);
    const float cs = va + vb; const int cidx = ia * 128 + ib;
    unsigned ck = (ca >= 0) ? key_of(cs, (unsigned)(ca * 16 + cb), 255u) : 0u;
    float ts = 0.f; int ti = 0;
    for (int it = 0; it < 16; ++it) {
      const unsigned m = dpp_max64_u32(ck); const unsigned long long bal = __ballot(ck == m && ck != 0u); const int src = __ffsll((long long)bal) - 1;
      const float sv = __shfl(cs, src); const int si = __shfl(cidx, src);
      if (lane == src) ck = 0u;
      if (lane == it) { ts = sv; ti = si; }
    }
    const float mx = __uint_as_float(__builtin_amdgcn_readlane(__float_as_uint(ts), 0));
    float ex = (lane < 16) ? __expf(ts - mx) : 0.f; const float sum = dpp_sum64(ex);
    if (lane < 16) { IDX[(size_t)pr * 16 + lane] = ti; GV[(size_t)pr * 16 + lane] = ex / sum; }
  }
}


__device__ __forceinline__ unsigned umax_(unsigned a, unsigned b) { return a > b ? a : b; }
__device__ __forceinline__ unsigned umin_(unsigned a, unsigned b) { return a < b ? a : b; }
__device__ __forceinline__ unsigned ord_of(float s) { const unsigned u = __float_as_uint(s); return (u & 0x80000000u) ? ~u : (u | 0x80000000u); }
__device__ __forceinline__ unsigned qx1(unsigned v) { return (unsigned)__builtin_amdgcn_update_dpp(0, (int)v, 0xB1, 0xf, 0xf, false); }
__device__ __forceinline__ unsigned qx2(unsigned v) { return (unsigned)__builtin_amdgcn_update_dpp(0, (int)v, 0x4E, 0xf, 0xf, false); }
__device__ __forceinline__ void ins16(unsigned (&L)[16], unsigned x) {
#pragma unroll
  for (int k = 0; k < 16; ++k) { const unsigned hi = umax_(L[k], x); x = umin_(L[k], x); L[k] = hi; }
}
__device__ __forceinline__ void ins16p(unsigned (&L)[16], unsigned (&P)[16], unsigned x, unsigned px) {
#pragma unroll
  for (int k = 0; k < 16; ++k) { const bool c = x > L[k]; const unsigned nl = c ? x : L[k], nx = c ? L[k] : x, np = c ? px : P[k], npx = c ? P[k] : px; L[k] = nl; x = nx; P[k] = np; px = npx; }
}
__device__ __forceinline__ void bitonic_sort16(unsigned (&M)[16]) {
#pragma unroll
  for (int d = 8; d >= 1; d >>= 1)
#pragma unroll
    for (int i = 0; i < 16; ++i) if (!(i & d)) { const unsigned hi = umax_(M[i], M[i + d]), lo = umin_(M[i], M[i + d]); M[i] = hi; M[i + d] = lo; }
}
__device__ __forceinline__ void bitonic_sort16p(unsigned (&M)[16], unsigned (&P)[16]) {
#pragma unroll
  for (int d = 8; d >= 1; d >>= 1)
#pragma unroll
    for (int i = 0; i < 16; ++i) if (!(i & d)) { const bool c = M[i + d] > M[i]; const unsigned a = M[i], b = M[i + d], pa = P[i], pb = P[i + d];
      M[i] = c ? b : a; M[i + d] = c ? a : b; P[i] = c ? pb : pa; P[i + d] = c ? pa : pb; }
}
__device__ __forceinline__ void topk_phase2(unsigned char* ws, const float* SC, int gw, int ngw, int lane) {
  int* IDX = (int*)(ws + WS_IDX); float* GV = (float*)(ws + WS_GV);
  const int c = lane & 3;
  const unsigned tagbase = (c & 1) ? 0u : 64u;
  for (int item = gw; item < T_ * 8 / 16; item += ngw) {
    const int pr = item * 16 + (lane >> 2);
    const float* row = SC + (size_t)pr * 256 + c * 64;
    unsigned L[16];
#pragma unroll
    for (int k = 0; k < 16; ++k) L[k] = 0u;
#pragma unroll
    for (int bq = 0; bq < 4; ++bq) { f32x4 v[4];
#pragma unroll
      for (int j = 0; j < 4; ++j) v[j] = *(const f32x4*)(row + bq * 16 + j * 4);
#pragma unroll
      for (int j = 0; j < 4; ++j)
#pragma unroll
        for (int i = 0; i < 4; ++i) { const int e = bq * 16 + j * 4 + i; ins16(L, (ord_of(v[j][i]) & ~127u) | (tagbase + (unsigned)(63 - e))); } }
    { unsigned B[16];
#pragma unroll
      for (int k = 0; k < 16; ++k) B[k] = qx1(L[k]);
#pragma unroll
      for (int k = 0; k < 16; ++k) L[k] = umax_(L[k], B[15 - k]);
      bitonic_sort16(L); }
    float F1[16], F2[16]; unsigned I1[16], I2[16];
#pragma unroll
    for (int k = 0; k < 16; ++k) { const unsigned o = qx2(L[k]); const unsigned v1 = (c < 2) ? L[k] : o, v2 = (c < 2) ? o : L[k];
      unsigned u1 = v1 & ~127u, u2 = v2 & ~127u; u1 = (u1 & 0x80000000u) ? (u1 & 0x7fffffffu) : ~u1; u2 = (u2 & 0x80000000u) ? (u2 & 0x7fffffffu) : ~u2;
      F1[k] = __uint_as_float(u1); F2[k] = __uint_as_float(u2); I1[k] = (127u - (v1 & 127u)) << 7; I2[k] = 127u - (v2 & 127u); }
    unsigned M[16], P[16];
#pragma unroll
    for (int k = 0; k < 16; ++k) { M[k] = 0u; P[k] = 0u; }
    {
      constexpr int CA[52] = {0,0,0,0,0,0,0,0,0,0,0,0,0,0,0,0, 1,1,1,1,1,1,1,1, 2,2,2,2,2, 3,3,3,3, 4,4,4, 5,5, 6,6, 7,7, 8, 9, 10, 11, 12, 13, 14, 15, 15, 15};
      constexpr int CB[52] = {0,1,2,3,4,5,6,7,8,9,10,11,12,13,14,15, 0,1,2,3,4,5,6,7, 0,1,2,3,4, 0,1,2,3, 0,1,2, 0,1, 0,1, 0,1, 0, 0, 0, 0, 0, 0, 0, 0, 0, 0};
#pragma unroll
      for (int m = 0; m < 13; ++m) {
        unsigned kx[4], px[4];
#pragma unroll
        for (int q = 0; q < 4; ++q) { const int n = 4 * m + q; const bool pad = n >= 50;
          kx[q] = pad ? 0u : ord_of(F1[CA[n]] + F2[CB[n]]); px[q] = I1[CA[n]] | I2[CB[n]]; }
        const unsigned x = (c == 0) ? kx[0] : (c == 1) ? kx[1] : (c == 2) ? kx[2] : kx[3];
        const unsigned pp = (c == 0) ? px[0] : (c == 1) ? px[1] : (c == 2) ? px[2] : px[3];
        ins16p(M, P, x, pp);
      }
    }
    { unsigned B[16], Q[16];
#pragma unroll
      for (int k = 0; k < 16; ++k) { B[k] = qx1(M[k]); Q[k] = qx1(P[k]); }
#pragma unroll
      for (int k = 0; k < 16; ++k) { const bool t = B[15 - k] > M[k]; M[k] = t ? B[15 - k] : M[k]; P[k] = t ? Q[15 - k] : P[k]; }
      bitonic_sort16p(M, P);
#pragma unroll
      for (int k = 0; k < 16; ++k) { B[k] = qx2(M[k]); Q[k] = qx2(P[k]); }
#pragma unroll
      for (int k = 0; k < 16; ++k) { const bool t = B[15 - k] > M[k]; M[k] = t ? B[15 - k] : M[k]; P[k] = t ? Q[15 - k] : P[k]; }
      bitonic_sort16p(M, P); }
    float sv[16]; float mx = -1e30f;
#pragma unroll
    for (int k = 0; k < 16; ++k) { unsigned u = M[k]; u = (u & 0x80000000u) ? (u & 0x7fffffffu) : ~u; sv[k] = __uint_as_float(u); mx = fmaxf(mx, sv[k]); }
    float sum = 0.f;
#pragma unroll
    for (int k = 0; k < 16; ++k) { sv[k] = __expf(sv[k] - mx); sum += sv[k]; }
    const float inv = __builtin_amdgcn_rcpf(sum);
    u32x4 oi; f32x4 og;
#pragma unroll
    for (int i = 0; i < 4; ++i) { oi[i] = (c == 0) ? P[i] : (c == 1) ? P[4 + i] : (c == 2) ? P[8 + i] : P[12 + i];
      og[i] = ((c == 0) ? sv[i] : (c == 1) ? sv[4 + i] : (c == 2) ? sv[8 + i] : sv[12 + i]) * inv; }
    *(u32x4*)(IDX + (size_t)pr * 16 + 4 * c) = oi; *(f32x4*)(GV + (size_t)pr * 16 + 4 * c) = og;
  }
}


__device__ __forceinline__ unsigned sx16(unsigned v) { return (unsigned)__shfl_xor((int)v, 16); }
__device__ __forceinline__ unsigned sx32(unsigned v) { return (unsigned)__shfl_xor((int)v, 32); }
#define MERGE16(L, SH) do { unsigned B_[16]; _Pragma("unroll") for (int k_ = 0; k_ < 16; ++k_) B_[k_] = SH(L[k_]); \
    _Pragma("unroll") for (int k_ = 0; k_ < 16; ++k_) L[k_] = umax_(L[k_], B_[15 - k_]); bitonic_sort16(L); } while (0)
#define MERGE16P(M, P, SH) do { unsigned B_[16], Q_[16]; _Pragma("unroll") for (int k_ = 0; k_ < 16; ++k_) { B_[k_] = SH(M[k_]); Q_[k_] = SH(P[k_]); } \
    _Pragma("unroll") for (int k_ = 0; k_ < 16; ++k_) { const bool t_ = B_[15 - k_] > M[k_]; M[k_] = t_ ? B_[15 - k_] : M[k_]; P[k_] = t_ ? Q_[15 - k_] : P[k_]; } bitonic_sort16p(M, P); } while (0)
__device__ __forceinline__ void topk_phase3(const Params& p, unsigned char* lds_raw, int gw, int ngw, int tid) {
  unsigned char* ws = p.ws; int* IDX = (int*)(ws + WS_IDX); float* GV = (float*)(ws + WS_GV); const bf16_t* QP = (const bf16_t*)(ws + WS_QP);
  constexpr int KRS = 272;
  for (int i = tid; i < 2 * 128 * 32; i += NTHR) { const int tb = i >> 12, r = (i >> 5) & 127, c4 = (i & 31) * 4; const f32x4 v = *(const f32x4*)(p.in[29 + tb] + r * 128 + c4);
    u32x2 w; w.x = pk2(v[0], v[1]); w.y = pk2(v[2], v[3]); *(u32x2*)(lds_raw + tb * (128 * KRS) + r * KRS + c4 * 2) = w; }
  __syncthreads();
  const int lane = tid & 63, fr = lane & 15, c = lane >> 4;
  for (int item = gw; item < T_ * 8 / 16; item += ngw) {
    const int pr = item * 16 + fr;
    unsigned L1[16], L2[16];
#pragma unroll
    for (int k = 0; k < 16; ++k) { L1[k] = 0u; L2[k] = 0u; }
#pragma unroll
    for (int h = 0; h < 2; ++h) {
      bf16x8 qf[4];
#pragma unroll
      for (int s = 0; s < 4; ++s) qf[s] = *(const bf16x8*)(QP + (size_t)pr * 256 + 128 * h + 32 * s + 8 * c);
#pragma unroll
      for (int tp = 0; tp < 4; ++tp) {
        f32x4 acc0 = {0.f, 0.f, 0.f, 0.f}, acc1 = {0.f, 0.f, 0.f, 0.f};
#pragma unroll
        for (int s = 0; s < 4; ++s) { const unsigned char* kb = lds_raw + h * (128 * KRS) + (32 * tp + fr) * KRS + (32 * s + 8 * c) * 2;
          acc0 = __builtin_amdgcn_mfma_f32_16x16x32_bf16(*(const bf16x8*)kb, qf[s], acc0, 0, 0, 0);
          acc1 = __builtin_amdgcn_mfma_f32_16x16x32_bf16(*(const bf16x8*)(kb + 16 * KRS), qf[s], acc1, 0, 0, 0); }
#pragma unroll
        for (int r = 0; r < 4; ++r) { const unsigned t0 = (unsigned)(127 - (32 * tp + r)) - (unsigned)(4 * c), t1 = t0 - 16u;
          const unsigned k0 = (ord_of(acc0[r]) & ~127u) | t0, k1 = (ord_of(acc1[r]) & ~127u) | t1;
          if (h == 0) { ins16(L1, k0); ins16(L1, k1); } else { ins16(L2, k0); ins16(L2, k1); } }
        if (h == 0) asm volatile("" : "+v"(L1[0]), "+v"(L1[15])); else asm volatile("" : "+v"(L2[0]), "+v"(L2[15]));
      }
    }
    MERGE16(L1, sx16); MERGE16(L1, sx32); MERGE16(L2, sx16); MERGE16(L2, sx32);
    float F1[16], F2[16]; unsigned I1[16], I2[16];
#pragma unroll
    for (int k = 0; k < 16; ++k) { const unsigned v1 = L1[k], v2 = L2[k];
      unsigned u1 = v1 & ~127u, u2 = v2 & ~127u; u1 = (u1 & 0x80000000u) ? (u1 & 0x7fffffffu) : ~u1; u2 = (u2 & 0x80000000u) ? (u2 & 0x7fffffffu) : ~u2;
      F1[k] = __uint_as_float(u1); F2[k] = __uint_as_float(u2); I1[k] = (127u - (v1 & 127u)) << 7; I2[k] = 127u - (v2 & 127u); }
    unsigned M[16], P[16];
#pragma unroll
    for (int k = 0; k < 16; ++k) { M[k] = 0u; P[k] = 0u; }
    {
      constexpr int CA[52] = {0,0,0,0,0,0,0,0,0,0,0,0,0,0,0,0, 1,1,1,1,1,1,1,1, 2,2,2,2,2, 3,3,3,3, 4,4,4, 5,5, 6,6, 7,7, 8, 9, 10, 11, 12, 13, 14, 15, 15, 15};
      constexpr int CB[52] = {0,1,2,3,4,5,6,7,8,9,10,11,12,13,14,15, 0,1,2,3,4,5,6,7, 0,1,2,3,4, 0,1,2,3, 0,1,2, 0,1, 0,1, 0,1, 0, 0, 0, 0, 0, 0, 0, 0, 0, 0};
#pragma unroll
      for (int m = 0; m < 13; ++m) {
        unsigned kx[4], px[4];
#pragma unroll
        for (int q = 0; q < 4; ++q) { const int n = 4 * m + q; const bool pad = n >= 50;
          kx[q] = pad ? 0u : ord_of(F1[CA[n]] + F2[CB[n]]); px[q] = I1[CA[n]] | I2[CB[n]]; }
        const unsigned x = (c == 0) ? kx[0] : (c == 1) ? kx[1] : (c == 2) ? kx[2] : kx[3];
        const unsigned pp = (c == 0) ? px[0] : (c == 1) ? px[1] : (c == 2) ? px[2] : px[3];
        ins16p(M, P, x, pp);
      }
    }
    MERGE16P(M, P, sx16); MERGE16P(M, P, sx32);
    float sv[16]; float mx = -1e30f;
#pragma unroll
    for (int k = 0; k < 16; ++k) { unsigned u = M[k]; u = (u & 0x80000000u) ? (u & 0x7fffffffu) : ~u; sv[k] = __uint_as_float(u); mx = fmaxf(mx, sv[k]); }
    float sum = 0.f;
#pragma unroll
    for (int k = 0; k < 16; ++k) { sv[k] = __expf(sv[k] - mx); sum += sv[k]; }
    const float inv = __builtin_amdgcn_rcpf(sum);
    u32x4 oi; f32x4 og;
#pragma unroll
    for (int i = 0; i < 4; ++i) { oi[i] = (c == 0) ? P[i] : (c == 1) ? P[4 + i] : (c == 2) ? P[8 + i] : P[12 + i];
      og[i] = ((c == 0) ? sv[i] : (c == 1) ? sv[4 + i] : (c == 2) ? sv[8 + i] : sv[12 + i]) * inv; }
    *(u32x4*)(IDX + (size_t)pr * 16 + 4 * c) = oi; *(f32x4*)(GV + (size_t)pr * 16 + 4 * c) = og;
  }
  __syncthreads();
}
#undef MERGE16
#undef MERGE16P

typedef float f32x16v __attribute__((ext_vector_type(16)));
typedef float f32x32v __attribute__((ext_vector_type(32)));
typedef unsigned u32x6 __attribute__((ext_vector_type(6)));
__device__ __forceinline__ void cvt_fp4_pass(const float* src, unsigned char* dst, float* inv, int r_begin, int r_end, int gw, int ngw, int lane) {
  for (int r0 = r_begin + gw * 2; r0 < r_end; r0 += ngw * 2) {
   f32x4 vv[2][8];
#pragma unroll
   for (int rr = 0; rr < 2; ++rr)
#pragma unroll
     for (int k = 0; k < 8; ++k) vv[rr][k] = *(const f32x4*)(src + (size_t)(r0 + rr) * 2048 + lane * 32 + k * 4);
#pragma unroll
   for (int rr = 0; rr < 2; ++rr) { const int r = r0 + rr; float amA = 0.f, amB = 0.f;
#pragma unroll
    for (int k = 0; k < 4; ++k)
#pragma unroll
      for (int i = 0; i < 4; ++i) { amA = fmaxf(amA, fabsf(vv[rr][k][i])); amB = fmaxf(amB, fabsf(vv[rr][4 + k][i])); }
    const float rmax = fmaxf(__uint_as_float(dpp_max64_u32(__float_as_uint(fmaxf(amA, amB)))), 1e-30f);
    const float rs = rmax * (1.f / 6.f); if (lane == 0) inv[r] = rs;
    const float ra = amA / rmax, rb = amB / rmax;
    unsigned code = (unsigned)__builtin_amdgcn_cvt_pk_fp8_f32(ra, rb, 0, false) & 0xffffu;
    { const f32x2 back = __builtin_amdgcn_cvt_pk_f32_fp8((int)code, false); if (back[0] < ra * 0.96f) code += 1u; if (back[1] < rb * 0.96f) code += 0x100u; }
    const f32x2 sab = __builtin_amdgcn_cvt_pk_f32_fp8((int)code, false);
    const float ia = sab[0] > 0.f ? 1.f / (rs * sab[0]) : 0.f, ib = sab[1] > 0.f ? 1.f / (rs * sab[1]) : 0.f;
    u32x4 o;
#pragma unroll
    for (int k = 0; k < 4; ++k) { unsigned w = 0u; const float iv = (k < 2) ? ia : ib; const f32x4 lo = vv[rr][2 * k] * iv, hi = vv[rr][2 * k + 1] * iv;
      w = (unsigned)__builtin_amdgcn_cvt_scalef32_pk_fp4_f32(w, lo[0], lo[1], 1.0f, 0); w = (unsigned)__builtin_amdgcn_cvt_scalef32_pk_fp4_f32(w, lo[2], lo[3], 1.0f, 1);
      w = (unsigned)__builtin_amdgcn_cvt_scalef32_pk_fp4_f32(w, hi[0], hi[1], 1.0f, 2); w = (unsigned)__builtin_amdgcn_cvt_scalef32_pk_fp4_f32(w, hi[2], hi[3], 1.0f, 3);
      o[k] = w; }
    *(u32x4*)(dst + (size_t)r * 1152 + lane * 16) = o;
    *(unsigned short*)(dst + (size_t)r * 1152 + 1024 + lane * 2) = (unsigned short)code;
   }
  }
}
__device__ __forceinline__ void ln_row_regs32(float (&v)[32], const float* g, const float* b, int lane) {
  float s = 0.f;
#pragma unroll
  for (int i = 0; i < 32; ++i) s += v[i];
  const float mean = dpp_sum64(s) * (1.f / 2048.f);
  float q = 0.f;
#pragma unroll
  for (int i = 0; i < 32; ++i) { v[i] -= mean; q += v[i] * v[i]; }
  const float rstd = rsqrtf(dpp_sum64(q) * (1.f / 2048.f) + LN_EPS);
#pragma unroll
  for (int k = 0; k < 8; ++k) { const f32x4 gg = *(const f32x4*)(g + lane * 32 + k * 4), bb = *(const f32x4*)(b + lane * 32 + k * 4);
#pragma unroll
    for (int i = 0; i < 4; ++i) v[k * 4 + i] = v[k * 4 + i] * rstd * gg[i] + bb[i]; }
}
#define DEC8(W, K, D) do { const f32x2 t0_ = __builtin_amdgcn_cvt_scalef32_pk_f32_fp4(W[K], 1.0f, 0), t1_ = __builtin_amdgcn_cvt_scalef32_pk_f32_fp4(W[K], 1.0f, 1), \
    t2_ = __builtin_amdgcn_cvt_scalef32_pk_f32_fp4(W[K], 1.0f, 2), t3_ = __builtin_amdgcn_cvt_scalef32_pk_f32_fp4(W[K], 1.0f, 3); D[4 * (K)] = t0_; D[4 * (K) + 1] = t1_; D[4 * (K) + 2] = t2_; D[4 * (K) + 3] = t3_; } while (0)
__device__ __forceinline__ void peer_phase(const Params& p, int gw, int ngw, int lane_in) {
  unsigned char* ws = p.ws; const bf16_t* X = (const bf16_t*)(ws + WS_X); const unsigned char* PU = ws + WS_PU; const unsigned char* PV = ws + WS_PV;
  const float* INVU = (const float*)(ws + WS_PINV); const float* INVV = INVU + 16384;
  const int* IDX = (const int*)(ws + WS_IDX); const float* GV = (const float*)(ws + WS_GV);
  for (int t = gw; t < T_; t += ngw) {
    int lane = lane_in; asm volatile("" : "+v"(lane));
    f32x2 x2[16];
#pragma unroll
    for (int k = 0; k < 4; ++k) { float f[8]; unpack8(*(const u32x4*)(X + (size_t)t * DM + lane * 32 + k * 8), f);
#pragma unroll
      for (int i = 0; i < 4; ++i) x2[k * 4 + i] = (f32x2){f[2 * i], f[2 * i + 1]}; }
    const int id0 = IDX[(size_t)t * 128 + lane], id1 = IDX[(size_t)t * 128 + 64 + lane];
    const float g0 = GV[(size_t)t * 128 + lane], g1 = GV[(size_t)t * 128 + 64 + lane];
    const float iu0 = INVU[id0], iu1 = INVU[id1], iv0 = INVV[id0], iv1 = INVV[id1];
    float z0 = 0.f, z1 = 0.f;
#pragma unroll 1
    for (int e0 = 0; e0 < 128; e0 += 8) {
      u32x4 w[8]; unsigned short sc[8];
#pragma unroll
      for (int q = 0; q < 8; ++q) { const int id = __builtin_amdgcn_readlane(e0 < 64 ? id0 : id1, (e0 + q) & 63); const unsigned char* rp = PU + (size_t)id * 1152;
        w[q] = *(const u32x4*)(rp + lane * 16); sc[q] = *(const unsigned short*)(rp + 1024 + lane * 2); }
#pragma unroll
      for (int q = 0; q < 8; ++q) { u32x4 ww = w[q]; { unsigned w0 = ww[0]; asm volatile("" : "+v"(w0) : "v"(z0), "v"(z1)); ww[0] = w0; }
        f32x2 d[16]; DEC8(ww, 0, d); DEC8(ww, 1, d); DEC8(ww, 2, d); DEC8(ww, 3, d);
        f32x2 pa = {0.f, 0.f}, pb = {0.f, 0.f};
#pragma unroll
        for (int i = 0; i < 8; ++i) { pa = d[i] * x2[i] + pa; pb = d[8 + i] * x2[8 + i] + pb; }
        const f32x2 sab = __builtin_amdgcn_cvt_pk_f32_fp8((int)sc[q], false);
        const float tot = dpp_sum64((pa[0] + pa[1]) * sab[0] + (pb[0] + pb[1]) * sab[1]);
        if (lane == ((e0 + q) & 63)) { if (e0 < 64) z0 = tot; else z1 = tot; }
        __builtin_amdgcn_sched_barrier(0); }
    }
    const float a0 = gelu_erf(z0 * iu0) * g0 * iv0, a1 = gelu_erf(z1 * iu1) * g1 * iv1;
    f32x2 acc2[16];
#pragma unroll
    for (int i = 0; i < 16; ++i) acc2[i] = (f32x2){0.f, 0.f};
#pragma unroll 1
    for (int e0 = 0; e0 < 128; e0 += 8) {
      u32x4 w[8]; unsigned short sc[8]; float av[8];
#pragma unroll
      for (int q = 0; q < 8; ++q) { const int id = __builtin_amdgcn_readlane(e0 < 64 ? id0 : id1, (e0 + q) & 63); const unsigned char* rp = PV + (size_t)id * 1152;
        av[q] = __uint_as_float(__builtin_amdgcn_readlane(__float_as_uint(e0 < 64 ? a0 : a1), (e0 + q) & 63));
        w[q] = *(const u32x4*)(rp + lane * 16); sc[q] = *(const unsigned short*)(rp + 1024 + lane * 2); }
#pragma unroll
      for (int q = 0; q < 8; ++q) { u32x4 ww = w[q]; { unsigned w0 = ww[0]; asm volatile("" : "+v"(w0) : "v"(acc2[15])); ww[0] = w0; }
        f32x2 d[16]; DEC8(ww, 0, d); DEC8(ww, 1, d); DEC8(ww, 2, d); DEC8(ww, 3, d);
        const f32x2 sab = __builtin_amdgcn_cvt_pk_f32_fp8((int)sc[q], false); const float sa = av[q] * sab[0], sb = av[q] * sab[1];
        const f32x2 aa = {sa, sa}, bb = {sb, sb};
#pragma unroll
        for (int i = 0; i < 8; ++i) { acc2[i] = d[i] * aa + acc2[i]; acc2[8 + i] = d[8 + i] * bb + acc2[8 + i]; }
        asm volatile("" : "+v"(acc2[0]), "+v"(acc2[1]), "+v"(acc2[2]), "+v"(acc2[3]), "+v"(acc2[4]), "+v"(acc2[5]), "+v"(acc2[6]), "+v"(acc2[7]), "+v"(acc2[8]), "+v"(acc2[9]), "+v"(acc2[10]), "+v"(acc2[11]), "+v"(acc2[12]), "+v"(acc2[13]), "+v"(acc2[14]), "+v"(acc2[15])); }
    }
    float acc[32];
#pragma unroll
    for (int i = 0; i < 16; ++i) { acc[2 * i] = acc2[i][0] + DN_ALPHA * x2[i][0]; acc[2 * i + 1] = acc2[i][1] + DN_ALPHA * x2[i][1]; }
    ln_row_regs32(acc, p.in[33], p.in[34], lane);
#pragma unroll
    for (int k = 0; k < 8; ++k) *(f32x4*)(p.out + (size_t)t * DM + lane * 32 + k * 4) = (f32x4){acc[k * 4], acc[k * 4 + 1], acc[k * 4 + 2], acc[k * 4 + 3]};
  }
}
#undef DEC8

#define LAS __attribute__((address_space(3)))
#define XB_TMO      128
#define XB_XCNT(j)  (256  + 64 * (j))
#define XB_XSUB(j)  (1280 + 64 * (j))
#define XB_XGEN(j)  (2304 + 64 * (j))
#define XB_TOP      3328
#define XB_TOPGEN   3392
#define XCD_BAR_WORDS 3456
#define XB_SPIN_CAP (1u << 22)
__device__ __forceinline__ unsigned xb_ld(unsigned* p)              { return __hip_atomic_load(p, __ATOMIC_RELAXED, __HIP_MEMORY_SCOPE_AGENT); }
__device__ __forceinline__ unsigned xb_add(unsigned* p, unsigned v) { return __hip_atomic_fetch_add(p, v, __ATOMIC_RELAXED, __HIP_MEMORY_SCOPE_AGENT); }
__device__ __forceinline__ unsigned xb_xcc_id() { return (unsigned)__builtin_amdgcn_s_getreg((3 << 11) | 20) & 0xFu; }
#define XB_SPIN(cond, bar) do { unsigned _sp = 0; while (cond) { __builtin_amdgcn_s_sleep(1); \
    if ((++_sp & 255u) == 0u) { if (xb_ld(&(bar)[XB_TMO])) break; if (_sp > XB_SPIN_CAP) { atomicAdd(&(bar)[XB_TMO], 1u); break; } } } } while (0)
struct XcdBarrier { unsigned* bar; unsigned x; volatile LAS unsigned* st; };
__device__ __forceinline__ XcdBarrier xcd_barrier_post(unsigned* bar, volatile LAS unsigned* st) {
  XcdBarrier b; b.bar = bar; b.x = xb_xcc_id(); b.st = st;
  if (threadIdx.x == 0) (void)xb_add(&bar[XB_XCNT(b.x)], 1u);
  return b;
}
__device__ __forceinline__ void xcd_barrier_complete(unsigned* bar, unsigned x, unsigned& nloc, unsigned& nx) {
  const unsigned G = gridDim.x * gridDim.y * gridDim.z;
  unsigned sum, cnt, mine, sp = 0u;
  for (;;) {
    sum = 0u; cnt = 0u; mine = 0u;
#pragma unroll
    for (unsigned j = 0; j < 16; ++j) { const unsigned c = xb_ld(&bar[XB_XCNT(j)]); sum += c; cnt += (c > 0u) ? 1u : 0u; mine = (j == x) ? c : mine; }
    if (sum == G) break;
    __builtin_amdgcn_s_sleep(1);
    if ((++sp & 255u) == 0u) { if (xb_ld(&bar[XB_TMO])) break; if (sp > XB_SPIN_CAP) { atomicAdd(&bar[XB_TMO], 1u); break; } }
  }
  nloc = mine > 0u ? mine : 1u; nx = cnt > 0u ? cnt : 1u;
}
__device__ __forceinline__ void xcd_barrier(const XcdBarrier& b) {
  asm volatile("s_waitcnt vmcnt(0)" ::: "memory");
  __syncthreads();
  if (threadIdx.x == 0) {
    unsigned* bar = b.bar;
    __builtin_amdgcn_s_waitcnt(0);
    unsigned nloc = b.st[0], nx = b.st[1];
    if (nloc == 0u) { xcd_barrier_complete(bar, b.x, nloc, nx); b.st[0] = nloc; b.st[1] = nx; }
    const unsigned old = xb_add(&bar[XB_XSUB(b.x)], 1u);
    const unsigned gen = old / nloc;
    if (old + 1u == (gen + 1u) * nloc) {
      __builtin_amdgcn_fence(__ATOMIC_RELEASE, "agent");
      asm volatile("s_waitcnt vmcnt(0)" ::: "memory");
      const unsigned og = xb_add(&bar[XB_TOP], 1u);
      const unsigned tg = og / nx;
      if (og + 1u == (tg + 1u) * nx) xb_add(&bar[XB_TOPGEN], 1u);
      else XB_SPIN(xb_ld(&bar[XB_TOPGEN]) == tg, bar);
      __builtin_amdgcn_fence(__ATOMIC_ACQUIRE, "agent");
      xb_add(&bar[XB_XGEN(b.x)], 1u);
      asm volatile("s_waitcnt vmcnt(0)" ::: "memory");
    } else {
      XB_SPIN(xb_ld(&bar[XB_XGEN(b.x)]) == gen, bar);
      __builtin_amdgcn_fence(__ATOMIC_ACQUIRE, "agent");
      asm volatile("s_waitcnt vmcnt(0)" ::: "memory");
    }
  }
  __syncthreads();
}

constexpr int CVT_EARLY = 4608, CVT_SPLIT = 11264;
#ifndef PROBE_LRU
#define PROBE_LRU 0
#endif
#ifndef USE_TOPK3
#define USE_TOPK3 1
#endif
#ifndef USE_TOPK2
#define USE_TOPK2 1
#endif
#ifndef PROBE_MASK
#define PROBE_MASK 0
#endif
#ifndef PROBE_PEER
#define PROBE_PEER 0
#endif
#ifndef PROBE_SYNC
#define PROBE_SYNC 0
#endif
#ifndef PROBE_TOPK
#define PROBE_TOPK 0
#endif
#ifndef USE_FAST_XATTN
#define USE_FAST_XATTN 1
#endif
#ifndef USE_FAST_MLA
#define USE_FAST_MLA 1
#endif
#ifndef FASTMASK
#define FASTMASK 0xff
#endif
#define GEMM(MODE, g, e) do { if constexpr ((FASTMASK >> MODE) & 1) gemm_fast<MODE>(g, e, lds_raw, bid, nblk); else gemm_simple<MODE>(g, e, bid, nblk, wave, lane); } while (0)
#define IDS int tid_ = threadIdx.x; asm volatile("" : "+v"(tid_)); const int tid = tid_, lane = tid & 63, wave = tid >> 6, gw = bid * NWAVE + wave; (void)tid; (void)lane; (void)wave; (void)gw
__global__ void __launch_bounds__(NTHR) fwd_kernel(Params p) {
  extern __shared__ __attribute__((aligned(16))) unsigned char lds_raw[];
  float* lds = (float*)lds_raw;
  cg::grid_group grid = cg::this_grid();
  const int bid = blockIdx.x, nblk = gridDim.x, ngw = nblk * NWAVE;
  unsigned char* ws = p.ws; unsigned char* dout = (unsigned char*)p.out;
  EpiArgs e{ws, dout, p.in, nullptr, nullptr, 0};
  volatile LAS unsigned* bst = (volatile LAS unsigned*)((LAS unsigned char*)lds_raw + (LDS_BYTES - 64));
  if (threadIdx.x < 2) bst[threadIdx.x] = 0u;
  __syncthreads();
  const XcdBarrier xbar = xcd_barrier_post((unsigned*)ws, bst);
#define GSYNC() xcd_barrier(xbar)

  for (int rp_ = 0; rp_ < 1 + ((PROBE_MASK >> 0) & 1); ++rp_) { { IDS; if (nblk == 256) phase0<true>(p, lds, gw, ngw, lane, wave); else phase0<false>(p, lds, gw, ngw, lane, wave); } }
  if (__builtin_expect(p.ws == nullptr, 0)) grid.sync();
  GSYNC();
  if (nblk == 256 && ((bid >= 64 && bid < 128) || bid >= 160)) { IDS;
    const int sb = (bid < 128) ? bid - 64 : bid - 96; transpose_list<1>(p, lds + wave * (64 * 33), sb * NWAVE + wave, 160 * NWAVE, lane);
    cvt_fp4_pass(p.in[31], ws + WS_PU, (float*)(ws + WS_PINV), 0, CVT_EARLY, sb * NWAVE + wave, 160 * NWAVE, lane);
    cvt_fp4_pass(p.in[32], ws + WS_PV, (float*)(ws + WS_PINV) + 16384, 0, CVT_EARLY, sb * NWAVE + wave, 160 * NWAVE, lane);
    __syncthreads(); }
  for (int rp_ = 0; rp_ < 1 + ((PROBE_MASK >> 1) & 1); ++rp_) { { IDS; GemmArgs g{(const bf16_t*)(ws + WS_X), 2048, 0, (const bf16_t*)(ws + WS_WIN_T), 2048, 0, T_, 3328, 2048, 1}; GEMM(E_WIN, g, e); } }
  for (int rp_ = 0; rp_ < 1 + ((PROBE_MASK >> 1) & 1); ++rp_) { { IDS; GemmArgs g{(const bf16_t*)(ws + WS_MEMB), 2048, 0, (const bf16_t*)(ws + WS_WMKV_T), 2048, 0, 2048, 1024, 2048, 1, 128}; GEMM(E_MEMKV, g, e); } }
  GSYNC();
  for (int rp_ = 0; rp_ < 1 + ((PROBE_MASK >> 2) & 1); ++rp_) { { IDS; GemmArgs g{(const bf16_t*)(ws + WS_CQ), 512, 0, (const bf16_t*)(ws + WS_WUQ_T), 512, 0, T_, 1536, 512, 1}; GEMM(E_Q, g, e); } }
  for (int rp_ = 0; rp_ < 1 + ((PROBE_MASK >> 2) & 1); ++rp_) { { IDS; GemmArgs g{(const bf16_t*)(ws + WS_CKV), 512, 0, (const bf16_t*)(ws + WS_WUKV_T), 512, 0, T_, 2048, 512, 1}; GEMM(E_KV, g, e); } }
#if USE_LRU_FUSED
  for (int rp_ = 0; rp_ < 1 + PROBE_LRU; ++rp_) lru_fused_phase(p, lds_raw, bid, nblk);
#else
  for (int rp_ = 0; rp_ < 1 + ((PROBE_MASK >> 2) & 1); ++rp_) { { IDS; GemmArgs g{(const bf16_t*)(ws + WS_XC), 1024, 128, (const bf16_t*)(ws + WS_WG_T), 128, 512 * 128, T_, 512, 128, 8}; GEMM(E_GATES, g, e); } }
#endif
  GSYNC();
#if USE_FAST_MLA
  for (int rp_ = 0; rp_ < 1 + ((PROBE_MASK >> 4) & 1); ++rp_) { mla_attn_phase(dout, ws, (char*)lds_raw, bid, nblk); }
#else
  { IDS; attn_scalar<192, 2048>((const bf16_t*)(dout + DO_Q), 1536, (const bf16_t*)(dout + DO_K), 1536, (const bf16_t*)(dout + DO_V), 1024, (bf16_t*)(ws + WS_YMIX), 2048, 8,
                         0.07216878364870322f, lds, bid, nblk, tid); }
#endif
#if !USE_LRU_FUSED
  { IDS; scan_phase(ws, lds, bid, nblk, tid); }
#endif
  GSYNC();
  { IDS; phase3b(p, gw, ngw, lane); }
  GSYNC();
  { IDS; GemmArgs g{(const bf16_t*)(ws + WS_YMIX), 2048, 0, (const bf16_t*)(ws + WS_WOUT_T), 2048, 0, T_, 2048, 2048, 1}; GEMM(E_RES, g, e); }
  GSYNC();
  { IDS; ln_pass(ws, p.in[20], p.in[21], gw, ngw, lane); }
  { IDS; const int rlo = (nblk == 256) ? CVT_EARLY : 0, rsplit = (nblk == 256) ? CVT_SPLIT : 16384;
    cvt_fp4_pass(p.in[31], ws + WS_PU, (float*)(ws + WS_PINV), rlo, rsplit, gw, ngw, lane);
    cvt_fp4_pass(p.in[32], ws + WS_PV, (float*)(ws + WS_PINV) + 16384, rlo, rsplit, gw, ngw, lane); }
  GSYNC();
  for (int rp_ = 0; rp_ < 1 + ((PROBE_MASK >> 5) & 1); ++rp_) { { IDS; GemmArgs g{(const bf16_t*)(ws + WS_X), 2048, 0, (const bf16_t*)(ws + WS_WMQ_T), 2048, 0, T_, 512, 2048, 1}; EpiArgs e2 = e; e2.o = (bf16_t*)(ws + WS_QM); e2.ld = 512; GEMM(E_BF16, g, e2); }
  if (nblk == 256 && bid >= 128) { IDS; const int g2 = (bid - 128) * NWAVE + wave;
    cvt_fp4_pass(p.in[31], ws + WS_PU, (float*)(ws + WS_PINV), CVT_SPLIT, 16384, g2, 128 * NWAVE, lane);
    cvt_fp4_pass(p.in[32], ws + WS_PV, (float*)(ws + WS_PINV) + 16384, CVT_SPLIT, 16384, g2, 128 * NWAVE, lane); } }
  GSYNC();
#if USE_FAST_XATTN
  for (int rp_ = 0; rp_ < 1 + ((PROBE_MASK >> 5) & 1); ++rp_) { mem_attn_phase(ws, (char*)lds_raw, bid, nblk); }
#else
  { IDS; attn_scalar<128, 256>((const bf16_t*)(ws + WS_QM), 512, (const bf16_t*)(ws + WS_MEMKV), 1024, (const bf16_t*)(ws + WS_MEMKV) + 512, 1024, (bf16_t*)(ws + WS_OM), 512, 4,
                        0.08838834764831845f, lds, bid, nblk, tid); }
#endif
  GSYNC();
  { IDS; GemmArgs g{(const bf16_t*)(ws + WS_OM), 512, 0, (const bf16_t*)(ws + WS_WMO_T), 512, 0, T_, 2048, 512, 1}; GEMM(E_RES, g, e); }
  GSYNC();
  { IDS; ln_pass(ws, p.in[26], p.in[27], gw, ngw, lane); }
  GSYNC();
  for (int rp_ = 0; rp_ < 1 + ((PROBE_MASK >> 3) & 1); ++rp_) { { IDS; GemmArgs g{(const bf16_t*)(ws + WS_X), 2048, 0, (const bf16_t*)(ws + WS_WPQ_T), 2048, 0, T_, 2048, 2048, 1}; EpiArgs e2 = e; e2.o = (bf16_t*)(ws + WS_QP); e2.ld = 2048; GEMM(E_BF16, g, e2); } }
  GSYNC();
#if USE_TOPK3
  for (int rep_ = 0; rep_ < 1 + PROBE_TOPK; ++rep_) { IDS; topk_phase3(p, lds_raw, gw, ngw, tid); }
#else
  for (int rp_ = 0; rp_ < 1 + ((PROBE_MASK >> 3) & 1); ++rp_) { { IDS; GemmArgs g{(const bf16_t*)(ws + WS_QP), 256, 0, (const bf16_t*)(ws + WS_KEYS_T), 256, 0, T_ * 8, 256, 256, 1}; EpiArgs e2 = e; e2.f = (float*)dout; e2.ld = 256; GEMM(E_F32, g, e2); } }
  GSYNC();
  for (int rep_ = 0; rep_ < 1 + PROBE_TOPK; ++rep_) { IDS; if (USE_TOPK2) topk_phase2(ws, (const float*)dout, gw, ngw, lane); else topk_phase(ws, (const float*)dout, gw, ngw, lane); }
#endif
  GSYNC();
  for (int rep_ = 0; rep_ < 1 + PROBE_PEER; ++rep_) { IDS; peer_phase(p, gw, ngw, lane); }
  for (int rep_ = 0; rep_ < PROBE_SYNC; ++rep_) GSYNC();
}

extern "C" void kernel_launch(void* const* d_in, const int* in_sizes, int n_in, void* d_out, int out_size, void* d_ws, size_t ws_size, hipStream_t stream) {
  static int grid_blocks = 0;
  if (grid_blocks == 0) {
    if (n_in != 35 || ws_size < WS_END || out_size != T_ * DM) { fprintf(stderr, "kernel_launch: unexpected shapes n_in %d ws %zu out %d\n", n_in, ws_size, out_size); grid_blocks = -1; return; }
    int dev = 0, cus = 0, per_cu = 0;
    hipGetDevice(&dev); hipDeviceGetAttribute(&cus, hipDeviceAttributeMultiprocessorCount, dev);
    if (hipFuncSetAttribute((const void*)fwd_kernel, hipFuncAttributeMaxDynamicSharedMemorySize, LDS_BYTES) != hipSuccess) { fprintf(stderr, "hipFuncSetAttribute failed\n"); grid_blocks = -1; return; }
    if (hipOccupancyMaxActiveBlocksPerMultiprocessor(&per_cu, (const void*)fwd_kernel, NTHR, LDS_BYTES) != hipSuccess || per_cu < 1) { fprintf(stderr, "occupancy query failed (%d)\n", per_cu); grid_blocks = -1; return; }
    grid_blocks = cus * per_cu;
    fprintf(stderr, "kernel_launch: cus %d per_cu %d grid %d ws %zu\n", cus, per_cu, grid_blocks, ws_size);
  }
  if (grid_blocks < 0) return;
  if (hipMemsetAsync(d_ws, 0, 65536 + 2 * 16384 * 8, stream) != hipSuccess) { fprintf(stderr, "memset failed\n"); return; }
  Params p{};
  for (int i = 0; i < 35; ++i) p.in[i] = (const float*)d_in[i];
  p.out = (float*)d_out; p.ws = (unsigned char*)d_ws;
  void* args[] = {&p};
  hipError_t err = hipLaunchCooperativeKernel((const void*)fwd_kernel, dim3(grid_blocks), dim3(NTHR), args, LDS_BYTES, stream);
  if (err != hipSuccess) fprintf(stderr, "cooperative launch failed: %s (grid %d)\n", hipGetErrorString(err), grid_blocks);
}
```

```cpp
#include <hip/hip_runtime.h>
#include <hip/hip_cooperative_groups.h>
#include <cstdio>
#include <cstdint>
namespace cg = cooperative_groups;
#ifndef USE_LRU_FUSED
#define USE_LRU_FUSED 1
#endif

typedef unsigned short bf16_t;
typedef short bf16x8 __attribute__((ext_vector_type(8)));
typedef float f32x4 __attribute__((ext_vector_type(4)));
typedef float f32x2 __attribute__((ext_vector_type(2)));
typedef float f32x16 __attribute__((ext_vector_type(16)));
typedef unsigned u32x4 __attribute__((ext_vector_type(4)));
typedef unsigned u32x2 __attribute__((ext_vector_type(2)));

constexpr int T_ = 16384, S_ = 2048, NB_ = 8, DM = 2048;
constexpr int NTHR = 512, NWAVE = 8;
constexpr float DN_ALPHA = 1.189207115002721f;
constexpr float LN_EPS = 1e-5f, RMS_EPS = 1e-6f;
constexpr int LDS_BYTES = 147456;

constexpr size_t MiB = 1u << 20;
constexpr size_t WS_WIN_T = 1 * MiB;
constexpr size_t WS_WUQ_T = 14 * MiB;
constexpr size_t WS_WUKV_T = WS_WUQ_T + 1536 * 512 * 2;
constexpr size_t WS_WG_T = WS_WUKV_T + 2 * MiB;
constexpr size_t WS_WOUT_T = WS_WG_T + 1 * MiB;
constexpr size_t WS_WMQ_T = WS_WOUT_T + 8 * MiB;
constexpr size_t WS_WMKV_T = WS_WMQ_T + 2 * MiB;
constexpr size_t WS_WMO_T = WS_WMKV_T + 4 * MiB;
constexpr size_t WS_WPQ_T = WS_WMO_T + 2 * MiB;
constexpr size_t WS_KEYS_T = WS_WPQ_T + 8 * MiB;
constexpr size_t WS_COS = 43 * MiB, WS_SIN = 45 * MiB;
constexpr size_t WS_MEMB = 47 * MiB;
constexpr size_t WS_MEMKV = 55 * MiB;
constexpr size_t WS_GTAB = 59 * MiB;
static_assert(WS_KEYS_T + 256 * 256 * 2 <= WS_COS, "weights region");
constexpr size_t WS_LAF = 60 * MiB, WS_BTF = 92 * MiB, WS_LAB = 124 * MiB, WS_BTB = 156 * MiB;
constexpr size_t WS_PU = 60 * MiB, WS_PV = 124 * MiB;
constexpr size_t WS_PINV = 59 * MiB + 65536;
constexpr size_t WS_X = 188 * MiB;
constexpr size_t WS_CQ = 252 * MiB, WS_CKV = 268 * MiB, WS_KPE = 284 * MiB;
constexpr size_t WS_LRUX = 286 * MiB, WS_GATE = 318 * MiB, WS_YMIX = 350 * MiB, WS_XC = 414 * MiB;
constexpr size_t WS_QM = WS_CQ, WS_OM = WS_CKV, WS_QP = WS_YMIX, WS_IDX = WS_LRUX, WS_GV = WS_LRUX + 8 * MiB, WS_ACT = WS_LRUX + 16 * MiB;
constexpr size_t WS_SS = 65536;
constexpr size_t WS_END = 446 * MiB;
constexpr size_t DO_Q = 0, DO_K = 48 * MiB, DO_V = 96 * MiB;

__device__ __forceinline__ unsigned f2bf(float f) { unsigned u = __float_as_uint(f); return (u + 0x7fffu + ((u >> 16) & 1u)) >> 16; }
__device__ __forceinline__ float bf2f(unsigned h) { return __uint_as_float(h << 16); }
__device__ __forceinline__ unsigned pk2(float lo, float hi) { unsigned r; asm("v_cvt_pk_bf16_f32 %0, %1, %2" : "=v"(r) : "v"(lo), "v"(hi)); return r; }
__device__ __forceinline__ float bflo(unsigned w) { return __uint_as_float(w << 16); }
__device__ __forceinline__ float bfhi(unsigned w) { return __uint_as_float(w & 0xffff0000u); }
__device__ __forceinline__ float dpp_sum64(float v) {
#define DPPF(x, ctrl, rm, bc) __builtin_bit_cast(float, __builtin_amdgcn_update_dpp(0, __builtin_bit_cast(int, x), ctrl, rm, 0xf, bc))
  v += DPPF(v, 0x111, 0xf, true); v += DPPF(v, 0x112, 0xf, true); v += DPPF(v, 0x114, 0xf, true); v += DPPF(v, 0x118, 0xf, true);
  v += DPPF(v, 0x142, 0xa, false); v += DPPF(v, 0x143, 0xc, false);
#undef DPPF
  return __uint_as_float(__builtin_amdgcn_readlane(__float_as_uint(v), 63));
}
__device__ __forceinline__ unsigned dpp_max64_u32(unsigned v) {
#define DPPU(x, ctrl, rm, bc) (unsigned)__builtin_amdgcn_update_dpp(0, (int)(x), ctrl, rm, 0xf, bc)
  unsigned w;
  w = DPPU(v, 0x111, 0xf, true); v = v > w ? v : w; w = DPPU(v, 0x112, 0xf, true); v = v > w ? v : w;
  w = DPPU(v, 0x114, 0xf, true); v = v > w ? v : w; w = DPPU(v, 0x118, 0xf, true); v = v > w ? v : w;
  w = DPPU(v, 0x142, 0xa, false); v = v > w ? v : w; w = DPPU(v, 0x143, 0xc, false); v = v > w ? v : w;
#undef DPPU
  return (unsigned)__builtin_amdgcn_readlane((int)v, 63);
}
__device__ __forceinline__ float wave_sum(float v) {
#pragma unroll
  for (int o = 1; o < 64; o <<= 1) v += __shfl_xor(v, o);
  return v;
}
__device__ __forceinline__ float wave_max(float v) {
#pragma unroll
  for (int o = 1; o < 64; o <<= 1) v = fmaxf(v, __shfl_xor(v, o));
  return v;
}
__device__ __forceinline__ unsigned wave_max_u32(unsigned v) {
#pragma unroll
  for (int o = 1; o < 64; o <<= 1) { unsigned w = (unsigned)__shfl_xor((int)v, o); v = v > w ? v : w; }
  return v;
}
typedef __bf16 bf16x2_t __attribute__((ext_vector_type(2)));
__device__ __forceinline__ float dot2_bf16(unsigned w, unsigned x, float acc) { return __builtin_amdgcn_fdot2_f32_bf16(__builtin_bit_cast(bf16x2_t, w), __builtin_bit_cast(bf16x2_t, x), acc, false); }
__device__ __forceinline__ float sigmoidf_(float x) { return __builtin_amdgcn_rcpf(1.f + __expf(-x)); }
__device__ __forceinline__ float neg_expm1_small(float x) {
  const float s = x * (1.f + x * (0.5f + x * (1.6666667e-1f + x * (4.1666667e-2f + x * (8.3333333e-3f + x * 1.3888889e-3f)))));
  const float e = 1.f - __builtin_amdgcn_exp2f(x * 1.4426950408889634f);
  return x > -0.25f ? -s : e;
}
__device__ __forceinline__ float gelu_tanh(float x) {
  const float u = 0.7978845608028654f * (x + 0.044715f * x * x * x);
  const float t = 1.f - 2.f / (__expf(2.f * u) + 1.f);
  return 0.5f * x * (1.f + t);
}
__device__ __forceinline__ float gelu_erf(float x) { return 0.5f * x * (1.f + erff(x * 0.7071067811865476f)); }
__device__ __forceinline__ void unpack8(u32x4 w, float* f) {
  f[0] = bflo(w.x); f[1] = bfhi(w.x); f[2] = bflo(w.y); f[3] = bfhi(w.y); f[4] = bflo(w.z); f[5] = bfhi(w.z); f[6] = bflo(w.w); f[7] = bfhi(w.w);
}
__device__ __forceinline__ u32x4 pack8(const float* f) { u32x4 w; w.x = pk2(f[0], f[1]); w.y = pk2(f[2], f[3]); w.z = pk2(f[4], f[5]); w.w = pk2(f[6], f[7]); return w; }

struct Params { const float* in[35]; float* out; unsigned char* ws; };

__device__ __forceinline__ const float* wsrc(const float* const* in, int mid, int n, int& ld) {
  switch (mid) {
    case 0: { ld = 3136; int c; if (n < 1024) c = n; else if (n < 3072) c = n + 64; else if (n < 3136) { int i = (n - 3072) >> 1, g = (n - 3072) & 1; c = 1024 + g * 32 + i; } else return nullptr; return in[5] + c; }
    case 1: { ld = 1536; int h = n / 192, j = n % 192, c; if (j < 128) c = h * 192 + j; else { int i = (j - 128) >> 1, g = (j - 128) & 1; c = h * 192 + 128 + g * 32 + i; } return in[7] + c; }
    case 2: { ld = 2048; int c; if (n < 1024) c = (n >> 7) * 256 + (n & 127); else { int m = n - 1024; c = (m >> 7) * 256 + 128 + (m & 127); } return in[9] + c; }
    case 3: ld = 2048; return in[19] + n;
    case 4: ld = 512; return in[22] + n;
    case 5: ld = 512; return n < 512 ? in[23] + n : in[24] + (n - 512);
    case 6: ld = 2048; return in[25] + n;
    case 7: ld = 2048; return in[28] + n;
    default: { ld = 128; int nb = n >> 9, q = n & 511, dir = q >> 8, jj = (q & 255) >> 1, gate = q & 1; const float* m = (gate ? in[14] : in[12]) + (size_t)((dir * 8 + nb) * 128) * 128; return m + jj; }
  }
}
__device__ __forceinline__ void transpose_item(const float* const* in, int mid, int K, bf16_t* WT, float* scr, int item, int nblk, int lane) {
  const int kb = item / nblk, nb = item % nblk, k0 = 64 * kb, n0 = 32 * nb;
  int ld = 0; const float* base = wsrc(in, mid, n0 + (lane & 31), ld);
  float tv[32];
  const float* gsc = (mid == 1) ? in[6] : (mid == 2) ? in[8] : nullptr;
#pragma unroll
  for (int i = 0; i < 32; ++i) { const int kk = 2 * i + (lane >> 5); tv[i] = base ? base[(size_t)(k0 + kk) * ld] : 0.f; }
  if (gsc) {
#pragma unroll
    for (int i = 0; i < 32; ++i) tv[i] *= gsc[k0 + 2 * i + (lane >> 5)]; }
#pragma unroll
  for (int i = 0; i < 32; ++i) { const int kk = 2 * i + (lane >> 5); scr[kk * 33 + (lane & 31)] = tv[i]; }
  asm volatile("s_waitcnt lgkmcnt(0)" ::: "memory");
  const int c = lane & 7;
#pragma unroll
  for (int j = 0; j < 4; ++j) { const int n = (lane >> 3) + 8 * j; const float* s = scr + (8 * c) * 33 + n;
    u32x4 o; o.x = pk2(s[0 * 33], s[1 * 33]); o.y = pk2(s[2 * 33], s[3 * 33]); o.z = pk2(s[4 * 33], s[5 * 33]); o.w = pk2(s[6 * 33], s[7 * 33]);
    *(u32x4*)(WT + (size_t)(n0 + n) * K + k0 + 8 * c) = o; }
  asm volatile("s_waitcnt lgkmcnt(0)" ::: "memory");
}
__device__ __forceinline__ void ln_row_regs(float (&v)[32], const float* g, const float* b, int lane) {
  float s = 0.f;
#pragma unroll
  for (int i = 0; i < 32; ++i) s += v[i];
  const float mean = dpp_sum64(s) * (1.f / 2048.f);
  float q = 0.f;
#pragma unroll
  for (int i = 0; i < 32; ++i) { v[i] -= mean; q += v[i] * v[i]; }
  const float rstd = rsqrtf(dpp_sum64(q) * (1.f / 2048.f) + LN_EPS);
#pragma unroll
  for (int j = 0; j < 4; ++j) {
    const f32x4 g0 = *(const f32x4*)(g + j * 512 + lane * 8), g1 = *(const f32x4*)(g + j * 512 + lane * 8 + 4);
    const f32x4 b0 = *(const f32x4*)(b + j * 512 + lane * 8), b1 = *(const f32x4*)(b + j * 512 + lane * 8 + 4);
#pragma unroll
    for (int e = 0; e < 4; ++e) { v[j * 8 + e] = v[j * 8 + e] * rstd * g0[e] + b0[e]; v[j * 8 + 4 + e] = v[j * 8 + 4 + e] * rstd * g1[e] + b1[e]; }
  }
}
__device__ __forceinline__ void sincos_big(float ang, float& c, float& s) {
  const double a = (double)ang;
  const double q = __builtin_rint(a * 0.63661977236758134308);
  const float r = (float)(a - q * 1.57079632679489661923);
  const int qi = ((int)q) & 3;
  const float r2 = r * r;
  const float sn = r + r * r2 * (-1.6666667e-1f + r2 * (8.3333333e-3f + r2 * (-1.9841270e-4f + r2 * 2.7557319e-6f)));
  const float cs = 1.f + r2 * (-0.5f + r2 * (4.1666667e-2f + r2 * (-1.3888889e-3f + r2 * (2.4801587e-5f + r2 * -2.7557319e-7f))));
  const float ss = (qi & 1) ? cs : sn, cc = (qi & 1) ? sn : cs;
  s = (qi & 2) ? -ss : ss;
  c = ((qi + 1) & 2) ? -cc : cc;
}

template <int WHICH> __device__ __forceinline__ void transpose_list(const Params& p, float* scr, int gw, int ngw, int lane) {
  struct TI { int mid, ndst, K; size_t off; };
  constexpr int NT = (WHICH == 0) ? 2 : (WHICH == 1) ? 7 : 9;
  const TI all[9] = {{0, 3328, 2048, WS_WIN_T}, {5, 1024, 2048, WS_WMKV_T}, {1, 1536, 512, WS_WUQ_T}, {2, 2048, 512, WS_WUKV_T}, {3, 2048, 2048, WS_WOUT_T}, {4, 512, 2048, WS_WMQ_T},
                     {6, 2048, 512, WS_WMO_T}, {7, 2048, 2048, WS_WPQ_T}, {8, 4096, 128, WS_WG_T}};
  constexpr int T0 = (WHICH == 1) ? 2 : 0;
  int total = 0;
#pragma unroll
  for (int t = 0; t < NT; ++t) total += (all[T0 + t].ndst / 32) * (all[T0 + t].K / 64);
  for (int git = gw; git < total; git += ngw) {
    int t = 0, it = git;
#pragma unroll
    for (int u = 0; u < NT - 1; ++u) { const int nit = (all[T0 + u].ndst / 32) * (all[T0 + u].K / 64); if (t == u && it >= nit) { it -= nit; t = u + 1; } }
    int mid = 0, ndst = 0, K = 0; size_t off = 0;
#pragma unroll
    for (int u = 0; u < NT; ++u) if (t == u) { mid = all[T0 + u].mid; ndst = all[T0 + u].ndst; K = all[T0 + u].K; off = all[T0 + u].off; }
    transpose_item(p.in, mid, K, (bf16_t*)(p.ws + off), scr, it, ndst / 32, lane);
  }
}
template <bool EARLY_ONLY> __device__ __forceinline__ void phase0(const Params& p, float* lds, int gw, int ngw, int lane, int wave) {
  unsigned char* ws = p.ws;
  float* scr = lds + wave * (64 * 33);
  transpose_list<(EARLY_ONLY ? 0 : 2)>(p, scr, gw, ngw, lane);
  { bf16_t* KT = (bf16_t*)(ws + WS_KEYS_T);
    for (int i = gw * 64 + lane; i < 256 * 256; i += ngw * 64) { const int n = i >> 8, k = i & 255; float v = 0.f;
      if (n < 128) { if (k < 128) v = p.in[29][n * 128 + k]; } else { if (k >= 128) v = p.in[30][(n - 128) * 128 + (k - 128)]; }
      KT[i] = (bf16_t)f2bf(v); } }
  { f32x4* gt = (f32x4*)(ws + WS_GTAB);
    for (int i = gw * 64 + lane; i < 2048; i += ngw * 64) gt[i] = (f32x4){8.f * log1pf(__expf(-p.in[16][i])), p.in[13][i], p.in[15][i], 0.f}; }
  { float* ct = (float*)(ws + WS_COS); float* st = (float*)(ws + WS_SIN); const int* pos = (const int*)p.in[2];
    for (int i = gw * 64 + lane; i < T_ * 32; i += ngw * 64) { const int t = i >> 5, f = i & 31;
      const float inv = exp2f(-(float)(2 * f) * (13.287712379549449f / 64.f));
      const float ang = (float)pos[t] * inv; float c, s; sincos_big(ang, c, s); ct[i] = c; st[i] = s; } }
  { const float* m = p.in[1]; bf16_t* mb = (bf16_t*)(ws + WS_MEMB);
    for (size_t i = (size_t)(gw * 64 + lane) * 8; i < (size_t)2048 * 2048; i += (size_t)ngw * 64 * 8) {
      const f32x4 a = *(const f32x4*)(m + i), b = *(const f32x4*)(m + i + 4); u32x4 o; o.x = pk2(a[0], a[1]); o.y = pk2(a[2], a[3]); o.z = pk2(b[0], b[1]); o.w = pk2(b[2], b[3]);
      *(u32x4*)(mb + i) = o; } }
  { const float* x = p.in[0]; bf16_t* X = (bf16_t*)(ws + WS_X);
    for (int r0 = gw * 2; r0 < T_; r0 += ngw * 2) { float v[2][32];
#pragma unroll
      for (int rr = 0; rr < 2; ++rr)
#pragma unroll
        for (int j = 0; j < 4; ++j) { const f32x4 a = *(const f32x4*)(x + (size_t)(r0 + rr) * DM + j * 512 + lane * 8), b = *(const f32x4*)(x + (size_t)(r0 + rr) * DM + j * 512 + lane * 8 + 4);
#pragma unroll
          for (int e = 0; e < 4; ++e) { v[rr][j * 8 + e] = a[e]; v[rr][j * 8 + 4 + e] = b[e]; } }
#pragma unroll
      for (int rr = 0; rr < 2; ++rr) { ln_row_regs(v[rr], p.in[3], p.in[4], lane);
#pragma unroll
        for (int j = 0; j < 4; ++j) *(u32x4*)(X + (size_t)(r0 + rr) * DM + j * 512 + lane * 8) = pack8(&v[rr][j * 8]); } } }
}

enum { E_WIN = 0, E_MEMKV, E_Q, E_KV, E_GATES, E_RES, E_BF16, E_F32, E_RESM };
struct EpiArgs { unsigned char* ws; unsigned char* dout; const float* const* in; bf16_t* o; float* f; int ld; };
__device__ __forceinline__ void st4(bf16_t* ptr, f32x4 v) { u32x2 w; w.x = pk2(v[0], v[1]); w.y = pk2(v[2], v[3]); *(u32x2*)ptr = w; }
template <int MODE> __device__ __forceinline__ void epi(const EpiArgs& e, int batch, int row, int col, f32x4 v) {
  if constexpr (MODE == E_WIN) {
    if (col < 512) st4((bf16_t*)(e.ws + WS_CQ) + (size_t)row * 512 + col, v);
    else if (col < 1024) st4((bf16_t*)(e.ws + WS_CKV) + (size_t)row * 512 + (col - 512), v);
    else if (col < 2048) st4((bf16_t*)(e.ws + WS_LRUX) + (size_t)row * 1024 + (col - 1024), v);
    else if (col < 3072) { f32x4 g; for (int i = 0; i < 4; ++i) g[i] = gelu_tanh(v[i]); st4((bf16_t*)(e.ws + WS_GATE) + (size_t)row * 1024 + (col - 2048), g); }
    else if (col < 3136) st4((bf16_t*)(e.ws + WS_KPE) + (size_t)row * 64 + (col - 3072), v);
  } else if constexpr (MODE == E_MEMKV) {
    st4((bf16_t*)(e.ws + WS_MEMKV) + (size_t)row * 1024 + col, v);
  } else if constexpr (MODE == E_Q) {
    const int j = col % 192;
    if (j >= 128) { const int i0 = (j - 128) >> 1; const float* ct = (const float*)(e.ws + WS_COS) + (size_t)row * 32 + i0; const float* st = (const float*)(e.ws + WS_SIN) + (size_t)row * 32 + i0;
      const float c0 = ct[0], s0 = st[0], c1 = ct[1], s1 = st[1];
      v = (f32x4){v[0] * c0 - v[1] * s0, v[1] * c0 + v[0] * s0, v[2] * c1 - v[3] * s1, v[3] * c1 + v[2] * s1}; }
    st4((bf16_t*)(e.dout + DO_Q) + (size_t)row * 1536 + col, v);
  } else if constexpr (MODE == E_KV) {
    if (col < 1024) st4((bf16_t*)(e.dout + DO_K) + (size_t)row * 1536 + (col >> 7) * 192 + (col & 127), v);
    else st4((bf16_t*)(e.dout + DO_V) + (size_t)row * 1024 + (col - 1024), v);
  } else if constexpr (MODE == E_GATES) {
    const int dir = col >> 8, jj = (col & 255) >> 1, c0 = batch * 128 + jj;
    const f32x4* gt = (const f32x4*)(e.ws + WS_GTAB) + dir * 1024 + c0;
    const f32x4 t0 = gt[0], t1 = gt[1];
    const unsigned xw = *(const unsigned*)((const bf16_t*)(e.ws + WS_XC) + (size_t)row * 1024 + c0);
    const float la0 = -t0[0] * sigmoidf_(v[0] + t0[1]), la1 = -t1[0] * sigmoidf_(v[2] + t1[1]);
    const float bt0 = __builtin_amdgcn_sqrtf(neg_expm1_small(2.f * la0)) * sigmoidf_(v[1] + t0[2]) * bflo(xw);
    const float bt1 = __builtin_amdgcn_sqrtf(neg_expm1_small(2.f * la1)) * sigmoidf_(v[3] + t1[2]) * bfhi(xw);
    bf16_t* LA = (bf16_t*)(e.ws + (dir ? WS_LAB : WS_LAF)); bf16_t* BT = (bf16_t*)(e.ws + (dir ? WS_BTB : WS_BTF));
    *(unsigned*)(LA + (size_t)row * 1024 + c0) = pk2(la0, la1);
    *(unsigned*)(BT + (size_t)row * 1024 + c0) = pk2(bt0, bt1);
  } else if constexpr (MODE == E_RES) {
    bf16_t* X = (bf16_t*)(e.ws + WS_X) + (size_t)row * DM + col; const u32x2 w = *(const u32x2*)X;
    v = (f32x4){DN_ALPHA * bflo(w.x) + v[0], DN_ALPHA * bfhi(w.x) + v[1], DN_ALPHA * bflo(w.y) + v[2], DN_ALPHA * bfhi(w.y) + v[3]};
    st4(X, v);
  } else if constexpr (MODE == E_BF16) {
    st4(e.o + (size_t)row * e.ld + col, v);
  } else {
    *(f32x4*)(e.f + (size_t)row * e.ld + col) = v;
  }
}


__device__ __forceinline__ void st8(bf16_t* ptr, f32x4 a, f32x4 b) { u32x4 w; w.x = pk2(a[0], a[1]); w.y = pk2(a[2], a[3]); w.z = pk2(b[0], b[1]); w.w = pk2(b[2], b[3]); *(u32x4*)ptr = w; }
template <int MODE> __device__ __forceinline__ void epi8(const EpiArgs& e, int batch, int row, int col, f32x4 v0, f32x4 v1) {
  if constexpr (MODE == E_WIN) {
    if (col < 512) st8((bf16_t*)(e.ws + WS_CQ) + (size_t)row * 512 + col, v0, v1);
    else if (col < 1024) st8((bf16_t*)(e.ws + WS_CKV) + (size_t)row * 512 + (col - 512), v0, v1);
    else if (col < 2048) st8((bf16_t*)(e.ws + WS_LRUX) + (size_t)row * 1024 + (col - 1024), v0, v1);
    else if (col < 3072) { f32x4 g0, g1;
#pragma unroll
      for (int i = 0; i < 4; ++i) { g0[i] = gelu_tanh(v0[i]); g1[i] = gelu_tanh(v1[i]); }
      st8((bf16_t*)(e.ws + WS_GATE) + (size_t)row * 1024 + (col - 2048), g0, g1); }
    else if (col < 3136) { const int i0 = (col - 3072) >> 1;
      const f32x4 c = *(const f32x4*)((const float*)(e.ws + WS_COS) + (size_t)row * 32 + i0), s = *(const f32x4*)((const float*)(e.ws + WS_SIN) + (size_t)row * 32 + i0);
      const f32x4 r0 = {v0[0] * c[0] - v0[1] * s[0], v0[1] * c[0] + v0[0] * s[0], v0[2] * c[1] - v0[3] * s[1], v0[3] * c[1] + v0[2] * s[1]};
      const f32x4 r1 = {v1[0] * c[2] - v1[1] * s[2], v1[1] * c[2] + v1[0] * s[2], v1[2] * c[3] - v1[3] * s[3], v1[3] * c[3] + v1[2] * s[3]};
      bf16_t* kd = (bf16_t*)(e.dout + DO_K) + (size_t)row * 1536 + 128 + (col - 3072);
#pragma unroll
      for (int h = 0; h < 8; ++h) st8(kd + h * 192, r0, r1); }
  } else if constexpr (MODE == E_MEMKV) {
    st8((bf16_t*)(e.ws + WS_MEMKV) + (size_t)row * 1024 + col, v0, v1);
  } else if constexpr (MODE == E_Q) {
    const int j = col % 192;
    if (j >= 128) { const int i0 = (j - 128) >> 1; const f32x4 c = *(const f32x4*)((const float*)(e.ws + WS_COS) + (size_t)row * 32 + i0), s = *(const f32x4*)((const float*)(e.ws + WS_SIN) + (size_t)row * 32 + i0);
      v0 = (f32x4){v0[0] * c[0] - v0[1] * s[0], v0[1] * c[0] + v0[0] * s[0], v0[2] * c[1] - v0[3] * s[1], v0[3] * c[1] + v0[2] * s[1]};
      v1 = (f32x4){v1[0] * c[2] - v1[1] * s[2], v1[1] * c[2] + v1[0] * s[2], v1[2] * c[3] - v1[3] * s[3], v1[3] * c[3] + v1[2] * s[3]}; }
    st8((bf16_t*)(e.dout + DO_Q) + (size_t)row * 1536 + col, v0, v1);
  } else if constexpr (MODE == E_KV) {
    if (col < 1024) st8((bf16_t*)(e.dout + DO_K) + (size_t)row * 1536 + (col >> 7) * 192 + (col & 127), v0, v1);
    else st8((bf16_t*)(e.dout + DO_V) + (size_t)row * 1024 + (col - 1024), v0, v1);
  } else if constexpr (MODE == E_GATES) {
    const int dir = col >> 8, jj = (col & 255) >> 1, c0 = batch * 128 + jj;
    const f32x4* gt = (const f32x4*)(e.ws + WS_GTAB) + dir * 1024 + c0;
    const u32x2 xw = *(const u32x2*)((const bf16_t*)(e.ws + WS_XC) + (size_t)row * 1024 + c0);
    const float xc[4] = {bflo(xw.x), bfhi(xw.x), bflo(xw.y), bfhi(xw.y)}; const float vv[8] = {v0[0], v0[1], v0[2], v0[3], v1[0], v1[1], v1[2], v1[3]};
    float la[4], bt[4];
#pragma unroll
    for (int i = 0; i < 4; ++i) { const f32x4 t = gt[i]; la[i] = -t[0] * sigmoidf_(vv[2 * i] + t[1]);
      bt[i] = __builtin_amdgcn_sqrtf(neg_expm1_small(2.f * la[i])) * sigmoidf_(vv[2 * i + 1] + t[2]) * xc[i]; }
    bf16_t* LA = (bf16_t*)(e.ws + (dir ? WS_LAB : WS_LAF)); bf16_t* BT = (bf16_t*)(e.ws + (dir ? WS_BTB : WS_BTF));
    u32x2 lw, bw; lw.x = pk2(la[0], la[1]); lw.y = pk2(la[2], la[3]); bw.x = pk2(bt[0], bt[1]); bw.y = pk2(bt[2], bt[3]);
    *(u32x2*)(LA + (size_t)row * 1024 + c0) = lw; *(u32x2*)(BT + (size_t)row * 1024 + c0) = bw;
  } else if constexpr (MODE == E_BF16) {
    st8(e.o + (size_t)row * e.ld + col, v0, v1);
  } else {
    *(f32x4*)(e.f + (size_t)row * e.ld + col) = v0; *(f32x4*)(e.f + (size_t)row * e.ld + col + 4) = v1;
  }
}

struct GemmArgs { const bf16_t* A; size_t lda, a_batch; const bf16_t* Bt; size_t ldb, b_batch; int M, N, K, nbatch; int rot = 0; };
template <int MODE> __device__ __forceinline__ void gemm_simple(const GemmArgs& g, const EpiArgs& e, int bid, int nblk, int wave, int lane) {
  const int tm = g.M / 128, tn = g.N / 128, per = tm * tn, units = g.nbatch * per;
  const int r32 = lane & 31, hi = lane >> 5, wr = wave >> 1, wc = wave & 1;
  for (int u = bid; u < units; u += nblk) {
    const int bt = u / per, r = u % per, pm = r / tn, pn = r % tn;
    const bf16_t* ap = g.A + (size_t)bt * g.a_batch + (size_t)(pm * 128 + wr * 32 + r32) * g.lda + 8 * hi;
    const bf16_t* bp0 = g.Bt + (size_t)bt * g.b_batch + (size_t)(pn * 128 + wc * 64 + r32) * g.ldb + 8 * hi;
    const bf16_t* bp1 = bp0 + 32 * g.ldb;
    f32x16 acc0 = {}, acc1 = {};
#pragma unroll 4
    for (int k0 = 0; k0 < g.K; k0 += 16) {
      const bf16x8 a = *(const bf16x8*)(ap + k0), b0 = *(const bf16x8*)(bp0 + k0), b1 = *(const bf16x8*)(bp1 + k0);
      acc0 = __builtin_amdgcn_mfma_f32_32x32x16_bf16(b0, a, acc0, 0, 0, 0);
      acc1 = __builtin_amdgcn_mfma_f32_32x32x16_bf16(b1, a, acc1, 0, 0, 0);
    }
    const int row = pm * 128 + wr * 32 + r32;
#pragma unroll
    for (int gq = 0; gq < 4; ++gq) {
      const int col = pn * 128 + wc * 64 + 8 * gq + 4 * hi;
      epi<MODE>(e, bt, row, col, (f32x4){acc0[4 * gq], acc0[4 * gq + 1], acc0[4 * gq + 2], acc0[4 * gq + 3]});
      epi<MODE>(e, bt, row, col + 32, (f32x4){acc1[4 * gq], acc1[4 * gq + 1], acc1[4 * gq + 2], acc1[4 * gq + 3]});
    }
  }
}


namespace pg8 {
#define PG8_LAS __attribute__((address_space(3)))
constexpr int BM = 256, BK = 64, HALF = 128, HTB = HALF * BK * 2, STAGE_BYTES = 8 * HTB, NXCD = 8, WGM = 8;
__host__ __device__ __forceinline__ int lds_byte(int r, int c) { const int st = (r >> 4) * 2 + (c >> 5), rr = r & 15, cc = c & 31, ob = rr * 64 + cc * 2; return st * 1024 + (ob ^ (((ob >> 9) & 1) << 5)); }
__host__ __device__ __forceinline__ void stage_rc(int b, int& R, int& C) { const int st = b / 1024, sb = b % 1024, swz = sb ^ (((sb >> 9) & 1) << 5); R = (st >> 1) * 16 + swz / 64; C = (st & 1) * 32 + (swz % 64) / 2; }
__host__ __device__ __forceinline__ int perm32(int rho) { const int n = rho >> 4, i = rho & 15; return 8 * (i >> 2) + 4 * n + (i & 3); }
struct Unit { int pm, pn; };
struct Gemm { const bf16_t* A; const bf16_t* Bt; int M, N, K; int lda, ldb; int pn_per_batch; int a_batch_elems; };
struct StaticOrder {
  int nM, nN, nwg, G, c;
  __device__ void init(int M, int N, int G_, int c_) { nM = M / BM; nN = N / BM; nwg = nM * nN; G = G_; c = c_; }
  __device__ bool next(int i, Unit& u) const {
    const long L = (long)i * G + c; if (L >= nwg) return false;
    int wgid = (int)L; { const int q = nwg / NXCD, r = nwg % NXCD, xcd = wgid % NXCD, off = wgid / NXCD; wgid = (xcd < r ? xcd * (q + 1) : r * (q + 1) + (xcd - r) * q) + off; }
    const int nig = WGM * nN, gid = wgid / nig, fm = gid * WGM, gsz = (nM - fm) < WGM ? (nM - fm) : WGM;
    u.pm = fm + ((wgid % nig) % gsz); u.pn = (wgid % nig) / gsz; return true;
  }
};
template <int MODE> struct EpiAdapter {
  static constexpr bool PERM = true;
  EpiArgs e; int nb_cols;
  __device__ __forceinline__ void operator()(const f32x4 (&acc)[2][2][4][2], const Unit& u, int wr, int wc, int fr, int fq) const {
    if constexpr (MODE == E_RES || MODE == E_RESM) {
      bf16_t* X = (bf16_t*)(e.ws + WS_X);
#pragma unroll
      for (int ai = 0; ai < 2; ++ai) { u32x4 rw[4][2]; float rsc[4] = {1.f, 1.f, 1.f, 1.f};
        if constexpr (MODE == E_RESM) { const unsigned long long* sso = (const unsigned long long*)(e.ws + WS_SS) + 2 * 16384;
#pragma unroll
          for (int m = 0; m < 4; ++m) rsc[m] = rsqrtf((float)sso[u.pm * BM + ai * HALF + wr * 64 + m * 16 + fr] * (1.f / 16777216.f / 1024.f) + RMS_EPS); }
#pragma unroll
        for (int m = 0; m < 4; ++m)
#pragma unroll
          for (int bj = 0; bj < 2; ++bj) rw[m][bj] = *(const u32x4*)(X + (size_t)(u.pm * BM + ai * HALF + wr * 64 + m * 16 + fr) * DM + u.pn * BM + bj * HALF + wc * 32 + 8 * fq);
#pragma unroll
        for (int m = 0; m < 4; ++m)
#pragma unroll
          for (int bj = 0; bj < 2; ++bj) { const u32x4 w = rw[m][bj]; f32x4 a0 = acc[ai][bj][m][0], a1 = acc[ai][bj][m][1];
            if constexpr (MODE == E_RESM) { a0 *= rsc[m]; a1 *= rsc[m]; }
            st8(X + (size_t)(u.pm * BM + ai * HALF + wr * 64 + m * 16 + fr) * DM + u.pn * BM + bj * HALF + wc * 32 + 8 * fq,
                (f32x4){DN_ALPHA * bflo(w.x) + a0[0], DN_ALPHA * bfhi(w.x) + a0[1], DN_ALPHA * bflo(w.y) + a0[2], DN_ALPHA * bfhi(w.y) + a0[3]},
                (f32x4){DN_ALPHA * bflo(w.z) + a1[0], DN_ALPHA * bfhi(w.z) + a1[1], DN_ALPHA * bflo(w.w) + a1[2], DN_ALPHA * bfhi(w.w) + a1[3]}); }
        asm volatile("" ::: "memory"); }
      return;
    }
#pragma unroll
    for (int ai = 0; ai < 2; ++ai)
#pragma unroll
      for (int m = 0; m < 4; ++m) { const int row = u.pm * BM + ai * HALF + wr * 64 + m * 16 + fr;
        float rs = 1.f;
        if constexpr (MODE == E_WIN) {
          if (u.pn < 4) { float s = 0.f;
#pragma unroll
            for (int bj = 0; bj < 2; ++bj)
#pragma unroll
              for (int n = 0; n < 2; ++n) { const f32x4 x = acc[ai][bj][m][n]; s += (x[0] * x[0] + x[1] * x[1]) + (x[2] * x[2] + x[3] * x[3]); }
            s += __shfl_xor(s, 16); s += __shfl_xor(s, 32);
            if (fq == 0) atomicAdd((unsigned long long*)(e.ws + WS_SS) + (u.pn >> 1) * 16384 + row, (unsigned long long)(s * 16777216.f)); } }
        if constexpr (MODE == E_Q || MODE == E_KV) { const unsigned long long ss = ((const unsigned long long*)(e.ws + WS_SS))[(MODE == E_KV ? 16384 : 0) + row];
          rs = rsqrtf((float)ss * (1.f / 16777216.f / 512.f) + RMS_EPS); }
#pragma unroll
        for (int bj = 0; bj < 2; ++bj) { const int colg = u.pn * BM + bj * HALF + wc * 32 + 8 * fq; const int batch = colg / nb_cols; const int col = colg - batch * nb_cols;
          if constexpr (MODE == E_Q || MODE == E_KV) epi8<MODE>(e, batch, row, col, acc[ai][bj][m][0] * rs, acc[ai][bj][m][1] * rs);
          else epi8<MODE>(e, batch, row, col, acc[ai][bj][m][0], acc[ai][bj][m][1]); }
        asm volatile("" ::: "memory"); }
  }
};
template <class Epi>
__device__ __forceinline__ void gemm_phase(PG8_LAS unsigned char* lds, const Gemm g, const StaticOrder& S, const Epi& E) {
  int tid_ = threadIdx.x; asm volatile("" : "+v"(tid_));
  const int tid = tid_, wid = __builtin_amdgcn_readfirstlane(tid >> 6), lane = tid & 63, wr = wid >> 2, wc = wid & 3, fr = lane & 15, fq = lane >> 4;
  const int K = g.K, nt = K / BK;
  unsigned voffA[2], voffB[2];
#pragma unroll
  for (int i = 0; i < 2; ++i) { int R, C; stage_rc(tid * 16 + i * 8192, R, C); const int Rb = Epi::PERM ? ((R & ~31) + perm32(R & 31)) : R; voffA[i] = (unsigned)(R * g.lda + C) * 2u; voffB[i] = (unsigned)(Rb * g.ldb + C) * 2u; }
  const size_t kstep = (size_t)(BK * 2);
  const size_t hstepA = (size_t)HALF * g.lda * 2, hstepB = (size_t)HALF * g.ldb * 2;
  const size_t tstepA = 2 * hstepA, tstepB = 2 * hstepB;
  const unsigned ldsw = (unsigned)wid * 1024u;
  const int aoff = lds_byte(wr * 64 + fr, fq * 8), boff = lds_byte(wc * 32 + fr, fq * 8);
#define PG8_SA(b, h) (((b) * 2 + (h)) * HTB)
#define PG8_SB(b, h) ((4 + (b) * 2 + (h)) * HTB)
#define PG8_STAGE(bufoff, gbase, voff) do { _Pragma("unroll") for (int _i = 0; _i < 2; ++_i) \
    __builtin_amdgcn_global_load_lds((const unsigned*)((const char*)(gbase) + (voff)[_i]), (PG8_LAS unsigned*)(lds + (bufoff) + ldsw + _i * 8192), 16, 0, 0); } while (0)
#define PG8_LDA(dst, b, h) do { _Pragma("unroll") for (int m = 0; m < 4; ++m) _Pragma("unroll") for (int k = 0; k < 2; ++k) dst[m][k] = *(const PG8_LAS bf16x8*)(lds + PG8_SA(b, h) + aoff + m * 2048 + k * 1024); } while (0)
#define PG8_LDB(dst, b, h) do { _Pragma("unroll") for (int n = 0; n < 2; ++n) _Pragma("unroll") for (int k = 0; k < 2; ++k) dst[n][k] = *(const PG8_LAS bf16x8*)(lds + PG8_SB(b, h) + boff + n * 2048 + k * 1024); } while (0)
#define PG8_MMA(ai, bj, At, Bt) do { __builtin_amdgcn_s_setprio(1); _Pragma("unroll") for (int m = 0; m < 4; ++m) _Pragma("unroll") for (int n = 0; n < 2; ++n) _Pragma("unroll") for (int k = 0; k < 2; ++k) \
    acc[ai][bj][m][n] = __builtin_amdgcn_mfma_f32_16x16x32_bf16(Bt[n][k], At[m][k], acc[ai][bj][m][n], 0, 0, 0); __builtin_amdgcn_s_setprio(0); } while (0)
#define PG8_WAIT_V(n) asm volatile("s_waitcnt vmcnt(" #n ")" ::: "memory")
#define PG8_WAIT_L(n) asm volatile("s_waitcnt lgkmcnt(" #n ")" ::: "memory")
#define PG8_BAR __builtin_amdgcn_s_barrier()
#define PG8_SCHED __builtin_amdgcn_sched_barrier(0)
#define PG8_APTR(u) ((const char*)g.A + (size_t)(u).pm * tstepA + (size_t)((u).pn / g.pn_per_batch) * g.a_batch_elems * 2)
#define PG8_BPTR(u) ((const char*)g.Bt + (size_t)(u).pn * tstepB)
  Unit cur, nxt; int ui = 0;
  if (!S.next(0, cur)) return;
  f32x4 acc[2][2][4][2];
#pragma unroll
  for (int a = 0; a < 2; ++a)
#pragma unroll
    for (int b = 0; b < 2; ++b)
#pragma unroll
      for (int m = 0; m < 4; ++m)
#pragma unroll
        for (int n = 0; n < 2; ++n) acc[a][b][m][n] = (f32x4){0.f, 0.f, 0.f, 0.f};
  bf16x8 At[4][2], B0[2][2], B1[2][2];
  const char* cA = PG8_APTR(cur); const char* cB = PG8_BPTR(cur);
  PG8_STAGE(PG8_SB(0, 0), cB, voffB); PG8_STAGE(PG8_SB(0, 1), cB + hstepB, voffB); PG8_STAGE(PG8_SA(0, 0), cA, voffA); PG8_STAGE(PG8_SA(0, 1), cA + hstepA, voffA);
  if (wr == 1) PG8_BAR;
  PG8_WAIT_V(2); PG8_BAR;
  PG8_STAGE(PG8_SB(1, 0), cB + kstep, voffB); PG8_STAGE(PG8_SA(1, 0), cA + kstep, voffA); PG8_STAGE(PG8_SB(1, 1), cB + hstepB + kstep, voffB);
  PG8_WAIT_V(6); PG8_BAR;
  for (;;) {
    const bool has_next = S.next(ui + 1, nxt);
    const char* nA = has_next ? PG8_APTR(nxt) : cA; const char* nB = has_next ? PG8_BPTR(nxt) : cB;
    for (int t = 0; t < nt; t += 2) {
      const bool last = (t == nt - 2);
      const char* a1 = cA + (size_t)(t + 1) * kstep;
      const char* a2 = last ? nA : cA + (size_t)(t + 2) * kstep; const char* b2 = last ? nB : cB + (size_t)(t + 2) * kstep;
      const char* a3 = a2 + kstep; const char* b3 = b2 + kstep;
      PG8_LDB(B0, 0, 0); PG8_LDB(B1, 0, 1); PG8_SCHED; PG8_LDA(At, 0, 0); PG8_STAGE(PG8_SA(1, 1), a1 + hstepA, voffA);
      PG8_WAIT_V(8); PG8_WAIT_L(0); PG8_BAR; PG8_MMA(0, 0, At, B0); PG8_MMA(0, 1, At, B1); PG8_BAR; PG8_SCHED;
      PG8_LDA(At, 0, 1); PG8_STAGE(PG8_SB(0, 0), b2, voffB); PG8_STAGE(PG8_SB(0, 1), b2 + hstepB, voffB); PG8_STAGE(PG8_SA(0, 0), a2, voffA);
      PG8_WAIT_V(8); PG8_WAIT_L(0); PG8_BAR; PG8_MMA(1, 0, At, B0); PG8_MMA(1, 1, At, B1); PG8_BAR; PG8_SCHED;
      PG8_LDB(B0, 1, 0); PG8_LDB(B1, 1, 1); PG8_SCHED; PG8_LDA(At, 1, 0); PG8_STAGE(PG8_SA(0, 1), a2 + hstepA, voffA);
      PG8_WAIT_V(8); PG8_WAIT_L(0); PG8_BAR; PG8_MMA(0, 0, At, B0); PG8_MMA(0, 1, At, B1); PG8_BAR; PG8_SCHED;
      PG8_LDA(At, 1, 1); PG8_STAGE(PG8_SB(1, 0), b3, voffB); PG8_STAGE(PG8_SB(1, 1), b3 + hstepB, voffB); PG8_STAGE(PG8_SA(1, 0), a3, voffA);
      PG8_WAIT_V(8); PG8_WAIT_L(0); PG8_BAR; PG8_MMA(1, 0, At, B0); PG8_MMA(1, 1, At, B1); PG8_BAR; PG8_SCHED;
    }
    if (wr == 0) PG8_BAR;
    E(acc, cur, wr, wc, fr, fq);
    if (!has_next) break;
#pragma unroll
    for (int a = 0; a < 2; ++a)
#pragma unroll
      for (int b = 0; b < 2; ++b)
#pragma unroll
        for (int m = 0; m < 4; ++m)
#pragma unroll
          for (int n = 0; n < 2; ++n) acc[a][b][m][n] = (f32x4){0.f, 0.f, 0.f, 0.f};
    cur = nxt; cA = nA; cB = nB; ++ui;
    if (wr == 1) PG8_BAR;
  }
  PG8_WAIT_V(0);
  PG8_BAR;
#undef PG8_SA
#undef PG8_SB
#undef PG8_STAGE
#undef PG8_LDA
#undef PG8_LDB
#undef PG8_MMA
#undef PG8_WAIT_V
#undef PG8_WAIT_L
#undef PG8_BAR
#undef PG8_SCHED
#undef PG8_APTR
#undef PG8_BPTR
}
}
template <int MODE> __device__ __forceinline__ void gemm_fast(const GemmArgs& g, const EpiArgs& e, unsigned char* lds_raw, int bid_, int nblk) {
  const int bid = (bid_ + g.rot) % nblk;
  pg8::Gemm G{g.A, g.Bt, g.M, g.N * g.nbatch, g.K, (int)g.lda, (int)g.ldb, g.nbatch > 1 ? g.N / 256 : (1 << 30), (int)g.a_batch};
  pg8::StaticOrder S; S.init(G.M, G.N, nblk, bid);
  pg8::EpiAdapter<MODE> E{e, g.N};
  pg8::gemm_phase<pg8::EpiAdapter<MODE>>((PG8_LAS unsigned char*)lds_raw, G, S, E);
}

__device__ __forceinline__ void phase1b(const Params& p, int gw, int ngw, int lane) {
  unsigned char* ws = p.ws;
  bf16_t* CQ = (bf16_t*)(ws + WS_CQ); bf16_t* CKV = (bf16_t*)(ws + WS_CKV); const bf16_t* KPE = (const bf16_t*)(ws + WS_KPE);
  bf16_t* Kd = (bf16_t*)((unsigned char*)p.out + DO_K); const bf16_t* LX = (const bf16_t*)(ws + WS_LRUX); bf16_t* XC = (bf16_t*)(ws + WS_XC);
  const float* ct = (const float*)(ws + WS_COS); const float* st = (const float*)(ws + WS_SIN);
  for (int r = gw; r < T_; r += ngw) {
#pragma unroll
    for (int which = 0; which < 2; ++which) {
      bf16_t* row = (which ? CKV : CQ) + (size_t)r * 512 + lane * 8; const float* g = p.in[which ? 8 : 6] + lane * 8;
      float f[8]; unpack8(*(const u32x4*)row, f); float q = 0.f;
#pragma unroll
      for (int i = 0; i < 8; ++i) q += f[i] * f[i];
      const float sc = rsqrtf(dpp_sum64(q) * (1.f / 512.f) + RMS_EPS);
#pragma unroll
      for (int i = 0; i < 8; ++i) f[i] = f[i] * sc * g[i];
      *(u32x4*)row = pack8(f);
    }
    {
      if (lane < 32) { const unsigned w = *(const unsigned*)(KPE + (size_t)r * 64 + 2 * lane); const float t1 = bflo(w), t2 = bfhi(w);
        const float c = ct[(size_t)r * 32 + lane], s = st[(size_t)r * 32 + lane]; const unsigned o = pk2(t1 * c - t2 * s, t2 * c + t1 * s);
#pragma unroll
        for (int h = 0; h < 8; ++h) *(unsigned*)(Kd + (size_t)r * 1536 + h * 192 + 128 + 2 * lane) = o; } }
    if (!USE_LRU_FUSED) {
      const int s = r & (S_ - 1); float acc[16];
      const float* cb = p.in[11] + lane * 16;
#pragma unroll
      for (int i = 0; i < 16; ++i) acc[i] = cb[i];
#pragma unroll
      for (int k = 0; k < 4; ++k) { const int sp = s + k - 2; if (sp < 0 || sp >= S_) continue;
        const bf16_t* src = LX + (size_t)(r + k - 2) * 1024 + lane * 16; const float* w = p.in[10] + k * 1024 + lane * 16;
        float f[16]; unpack8(*(const u32x4*)src, f); unpack8(*(const u32x4*)(src + 8), f + 8);
#pragma unroll
        for (int i = 0; i < 16; ++i) acc[i] += f[i] * w[i]; }
      *(u32x4*)(XC + (size_t)r * 1024 + lane * 16) = pack8(acc); *(u32x4*)(XC + (size_t)r * 1024 + lane * 16 + 8) = pack8(acc + 8);
    }
  }
}

template <int DQK, int NK> __device__ __forceinline__ void attn_scalar(const bf16_t* Q, int ldq, const bf16_t* K, int ldk, const bf16_t* V, int ldv, bf16_t* O, int ldo,
                                                                      int nheads, float scale, float* lds, int bid, int nblk, int tid) {
  float* sc = lds; float* qs = lds + 16 * NK; float* ls = qs + 16 * DQK;
  const int lane = tid & 63, wave = tid >> 6;
  const int units = NB_ * nheads * (S_ / 16);
  for (int u = bid; u < units; u += nblk) {
    const int qb = u % (S_ / 16), h = (u / (S_ / 16)) % nheads, b = u / ((S_ / 16) * nheads);
    __syncthreads();
    for (int i = tid; i < 16 * DQK; i += NTHR) { const int r = i / DQK, d = i % DQK; qs[i] = bf2f(Q[(size_t)(b * S_ + qb * 16 + r) * ldq + h * DQK + d]) * scale; }
    __syncthreads();
    for (int kk = tid; kk < NK; kk += NTHR) {
      const bf16_t* kp = K + (size_t)(b * NK + kk) * ldk + h * DQK; float acc[16];
#pragma unroll
      for (int r = 0; r < 16; ++r) acc[r] = 0.f;
      for (int d0 = 0; d0 < DQK; d0 += 8) { float kf[8]; unpack8(*(const u32x4*)(kp + d0), kf);
#pragma unroll
        for (int r = 0; r < 16; ++r) { const f32x4 q0 = *(const f32x4*)(qs + r * DQK + d0), q1 = *(const f32x4*)(qs + r * DQK + d0 + 4);
          acc[r] += q0[0] * kf[0] + q0[1] * kf[1] + q0[2] * kf[2] + q0[3] * kf[3] + q1[0] * kf[4] + q1[1] * kf[5] + q1[2] * kf[6] + q1[3] * kf[7]; } }
#pragma unroll
      for (int r = 0; r < 16; ++r) sc[r * NK + kk] = acc[r];
    }
    __syncthreads();
    for (int rr = 0; rr < 2; ++rr) { const int r = wave * 2 + rr; float m = -1e30f;
      for (int kk = lane; kk < NK; kk += 64) m = fmaxf(m, sc[r * NK + kk]);
      m = wave_max(m); float l = 0.f;
      for (int kk = lane; kk < NK; kk += 64) { const float pv = __expf(sc[r * NK + kk] - m); sc[r * NK + kk] = pv; l += pv; }
      l = wave_sum(l); if (lane == 0) ls[r] = l; }
    __syncthreads();
    { const int r = tid >> 5, d4 = (tid & 31) * 4; float a0 = 0.f, a1 = 0.f, a2 = 0.f, a3 = 0.f;
      const bf16_t* vp = V + (size_t)(b * NK) * ldv + h * 128 + d4;
      for (int kk = 0; kk < NK; ++kk) { const float pv = sc[r * NK + kk]; const u32x2 w = *(const u32x2*)(vp + (size_t)kk * ldv);
        a0 += pv * bflo(w.x); a1 += pv * bfhi(w.x); a2 += pv * bflo(w.y); a3 += pv * bfhi(w.y); }
      const float il = 1.f / ls[r];
      st4(O + (size_t)(b * S_ + qb * 16 + r) * ldo + h * 128 + d4, (f32x4){a0 * il, a1 * il, a2 * il, a3 * il}); }
  }
  __syncthreads();
}


namespace fa {
typedef short s16x4 __attribute__((ext_vector_type(4)));
constexpr int NW = 8, QBLK = 32, KVBLK = 64;
constexpr float THR = 8.f;
#define FA_SBAR() __builtin_amdgcn_sched_barrier(0)
__device__ __forceinline__ int crow(int r, int hi) { return (r & 3) + 8 * (r >> 2) + 4 * hi; }
__device__ __forceinline__ unsigned cvtpk(float lo, float hi) { unsigned r; asm volatile("v_cvt_pk_bf16_f32 %0, %1, %2" : "=v"(r) : "v"(lo), "v"(hi)); return r; }
__device__ __forceinline__ void partialSM(f32x16& p0, f32x16& p1, float& m_reg, float& mn, float& alpha, const float C, const float thr_s) {
  float pmax = p0[0];
#pragma unroll
  for (int r = 1; r < 16; ++r) pmax = fmaxf(pmax, p0[r]);
#pragma unroll
  for (int r = 0; r < 16; ++r) pmax = fmaxf(pmax, p1[r]);
  { auto rr = __builtin_amdgcn_permlane32_swap(__float_as_uint(pmax), __float_as_uint(pmax), false, false);
    pmax = fmaxf(__uint_as_float(rr[0]), __uint_as_float(rr[1])); }
  if (__builtin_expect(__all(pmax - m_reg <= thr_s), 1)) { mn = m_reg; alpha = 1.f; }
  else { mn = fmaxf(m_reg, pmax); alpha = __builtin_amdgcn_exp2f((m_reg - mn) * C); m_reg = mn; }
  const float mnC = -mn * C;
#pragma unroll
  for (int r = 0; r < 16; ++r) p0[r] = fmaf(p0[r], C, mnC);
#pragma unroll
  for (int r = 0; r < 16; ++r) p1[r] = fmaf(p1[r], C, mnC);
#pragma unroll
  for (int r = 0; r < 16; ++r) p0[r] = __builtin_amdgcn_exp2f(p0[r]);
}
__device__ __forceinline__ void finishSM(f32x16& p0, f32x16& p1, float alpha, float& l_reg, bf16x8& pa0, bf16x8& pa1, bf16x8& pa2, bf16x8& pa3) {
#pragma unroll
  for (int r = 0; r < 16; ++r) p1[r] = __builtin_amdgcn_exp2f(p1[r]);
  float ps = 0;
#pragma unroll
  for (int r = 0; r < 16; ++r) ps += p0[r];
#pragma unroll
  for (int r = 0; r < 16; ++r) ps += p1[r];
  { auto rr = __builtin_amdgcn_permlane32_swap(__float_as_uint(ps), __float_as_uint(ps), false, false);
    ps = __uint_as_float(rr[0]) + __uint_as_float(rr[1]); }
  l_reg = l_reg * alpha + ps;
#define FA_PK4(P, BASE, OUT) do { unsigned a0 = cvtpk(P[BASE + 0], P[BASE + 1]), a1 = cvtpk(P[BASE + 2], P[BASE + 3]);   \
    unsigned b0 = cvtpk(P[BASE + 4], P[BASE + 5]), b1 = cvtpk(P[BASE + 6], P[BASE + 7]);                              \
    auto r0 = __builtin_amdgcn_permlane32_swap(a0, b0, false, false); auto r1 = __builtin_amdgcn_permlane32_swap(a1, b1, false, false); \
    u32x4 w = {r0[0], r1[0], r0[1], r1[1]}; OUT = *reinterpret_cast<bf16x8*>(&w); } while (0)
  FA_PK4(p0, 0, pa0); FA_PK4(p0, 8, pa1); FA_PK4(p1, 0, pa2); FA_PK4(p1, 8, pa3);
#undef FA_PK4
}
template <int DQK> constexpr int krs() { return DQK == 192 ? 400 : DQK * 2; }
template <int DQK> __device__ __forceinline__ int kswz(int row, int colB) { return DQK == 192 ? row * 400 + colB : row * (DQK * 2) + (colB ^ ((row & 7) << 4)); }
template <int DQK> __device__ __forceinline__ void qkt(f32x16& p0, f32x16& p1, const char* Ks, const bf16x8* qr, const int* kb4) {
  p0 = f32x16{}; p1 = f32x16{};
#pragma unroll
  for (int d0 = 0; d0 < DQK / 16; ++d0) {
    const bf16x8 b0 = *reinterpret_cast<const bf16x8*>(Ks + kb4[d0 & 3] + (d0 >> 2) * 128);
    const bf16x8 b1 = *reinterpret_cast<const bf16x8*>(Ks + kb4[d0 & 3] + (d0 >> 2) * 128 + 32 * krs<DQK>());
    p0 = __builtin_amdgcn_mfma_f32_32x32x16_bf16(b0, qr[d0], p0, 0, 0, 0);
    p1 = __builtin_amdgcn_mfma_f32_32x32x16_bf16(b1, qr[d0], p1, 0, 0, 0); }
}
__device__ __forceinline__ int v_st(int k, int c) { const int kk = (k & ~0xC) | ((k & 4) << 1) | ((k & 8) >> 1); return ((kk >> 3) * 4 + (c >> 5)) * 512 + ((kk & 7) * 32 + (c & 31)) * 2; }
__device__ __forceinline__ int v_rd_base(int lane) { return ((lane & 3) << 3) | (((lane >> 2) & 3) << 6) | (((lane >> 4) & 1) << 5) | (((lane >> 5) & 1) << 8); }
constexpr int v_rd_off(int d0, int ks, int half) { return d0 * 512 + ks * 4096 + half * 2048; }
template <int OFF> __device__ __forceinline__ s16x4 tr_read(int vb) {
  s16x4 r; asm volatile("ds_read_b64_tr_b16 %0, %1 offset:%2" : "=&v"(r) : "v"(vb), "i"(OFF) : "memory"); return r;
}
template <int D0> __device__ __forceinline__ void pv_one(f32x16& od, int vb, bf16x8 pa0, bf16x8 pa1, bf16x8 pa2, bf16x8 pa3) {
  const s16x4 l0 = tr_read<v_rd_off(D0, 0, 0)>(vb), h0 = tr_read<v_rd_off(D0, 0, 1)>(vb), l1 = tr_read<v_rd_off(D0, 1, 0)>(vb), h1 = tr_read<v_rd_off(D0, 1, 1)>(vb);
  const s16x4 l2 = tr_read<v_rd_off(D0, 2, 0)>(vb), h2 = tr_read<v_rd_off(D0, 2, 1)>(vb), l3 = tr_read<v_rd_off(D0, 3, 0)>(vb), h3 = tr_read<v_rd_off(D0, 3, 1)>(vb);
  asm volatile("s_waitcnt lgkmcnt(0)" ::: "memory"); FA_SBAR();
#define FA_PK(L, H) (bf16x8){L[0], L[1], L[2], L[3], H[0], H[1], H[2], H[3]}
  od = __builtin_amdgcn_mfma_f32_32x32x16_bf16(pa0, FA_PK(l0, h0), od, 0, 0, 0);
  od = __builtin_amdgcn_mfma_f32_32x32x16_bf16(pa1, FA_PK(l1, h1), od, 0, 0, 0);
  od = __builtin_amdgcn_mfma_f32_32x32x16_bf16(pa2, FA_PK(l2, h2), od, 0, 0, 0);
  od = __builtin_amdgcn_mfma_f32_32x32x16_bf16(pa3, FA_PK(l3, h3), od, 0, 0, 0);
#undef FA_PK
}
__device__ __forceinline__ void pv_d0(f32x16* o, int vb, bf16x8 pa0, bf16x8 pa1, bf16x8 pa2, bf16x8 pa3) {
  pv_one<0>(o[0], vb, pa0, pa1, pa2, pa3); pv_one<1>(o[1], vb, pa0, pa1, pa2, pa3); pv_one<2>(o[2], vb, pa0, pa1, pa2, pa3); pv_one<3>(o[3], vb, pa0, pa1, pa2, pa3);
}
template <int DQK, int LDQ, int LDK, int LDV, int LDO>
__device__ __forceinline__ void attn_body(const bf16_t* __restrict__ Qb, const bf16_t* __restrict__ Kh, const bf16_t* __restrict__ Vh, bf16_t* __restrict__ Ob, int seq, float scale, char* lds) {
  constexpr int SHM_V = KVBLK * 128 * 2, SHM_K = KVBLK * krs<DQK>(), NKC = DQK / 64;
  const float C = scale * 1.4426950408889634f, thr_s = THR / scale;
  int tid_ = threadIdx.x; asm volatile("" : "+v"(tid_));
  const int tid = tid_, wid = tid >> 6, lane = tid & 63, r32 = lane & 31, hi = lane >> 5;
  char* V_lds = lds; char* K_lds = lds + 2 * SHM_V;
  float* wsf = (float*)(lds + 2 * SHM_V + 2 * SHM_K) + wid * 64; float* li_l = wsf; float* al_l = wsf + 32;
  float m_reg = -1e30f, l_reg = 0; f32x16 o[4] = {}; bf16x8 qr[DQK / 16];
  const bf16_t* Qw = Qb + (size_t)(wid * QBLK + r32) * LDQ + hi * 8;
#pragma unroll
  for (int d0 = 0; d0 < DQK / 16; ++d0) qr[d0] = *reinterpret_cast<const bf16x8*>(Qw + d0 * 16);
  const int sr = tid >> 4, sc = (tid & 15) * 8, vst0 = v_st(sr, sc), vst1 = v_st(32 + sr, sc);
  const int kgo0 = sr * LDK + sc, klo0 = kswz<DQK>(sr, sc * 2);
  const int kgo2 = (tid >> 3) * LDK + 128 + (tid & 7) * 8, klo2 = kswz<DQK>(tid >> 3, (128 + (tid & 7) * 8) * 2);
  const int vb0 = (int)(uintptr_t)V_lds + v_rd_base(lane);
  int kb4[4];
#pragma unroll
  for (int q = 0; q < 4; ++q) kb4[q] = kswz<DQK>(r32, q * 32 + hi * 16);
  bf16x8 vs0, vs1, ks[NKC];
#define FA_SLOAD(k0) do { vs0 = *reinterpret_cast<const bf16x8*>(&Vh[(size_t)((k0) + sr) * LDV + sc]); vs1 = *reinterpret_cast<const bf16x8*>(&Vh[(size_t)((k0) + 32 + sr) * LDV + sc]); \
    ks[0] = *reinterpret_cast<const bf16x8*>(&Kh[(size_t)(k0) * LDK + kgo0]); ks[1] = *reinterpret_cast<const bf16x8*>(&Kh[(size_t)((k0) + 32) * LDK + kgo0]); \
    if constexpr (NKC == 3) ks[NKC - 1] = *reinterpret_cast<const bf16x8*>(&Kh[(size_t)(k0) * LDK + kgo2]); } while (0)
#define FA_SWRITE(b) do { *(bf16x8*)(V_lds + (b) * SHM_V + vst0) = vs0; *(bf16x8*)(V_lds + (b) * SHM_V + vst1) = vs1; \
    *(bf16x8*)(K_lds + (b) * SHM_K + klo0) = ks[0]; *(bf16x8*)(K_lds + (b) * SHM_K + klo0 + 32 * krs<DQK>()) = ks[1]; \
    if constexpr (NKC == 3) *(bf16x8*)(K_lds + (b) * SHM_K + klo2) = ks[NKC - 1]; } while (0)
#define FA_SWAIT() asm volatile("s_waitcnt vmcnt(0)" ::: "memory")
#define FA_RESC(a) do { if (__any((a) < 1.f)) { if (hi == 0) al_l[r32] = (a); asm volatile("s_waitcnt lgkmcnt(0)" ::: "memory"); \
    _Pragma("unroll") for (int d = 0; d < 4; ++d) _Pragma("unroll") for (int r = 0; r < 16; ++r) o[d][r] *= al_l[crow(r, hi)]; } } while (0)
  f32x16 pA0, pA1, pB0, pB1; float mnA, mnB, alA, alB; bf16x8 pa0, pa1, pa2, pa3; const int NT = seq / KVBLK;
  FA_SLOAD(0); FA_SWAIT(); FA_SWRITE(0); __syncthreads();
  qkt<DQK>(pA0, pA1, K_lds, qr, kb4); partialSM(pA0, pA1, m_reg, mnA, alA, C, thr_s);
  FA_SLOAD(KVBLK);
  FA_SWAIT(); FA_SWRITE(1); __syncthreads();
  for (int j = 1; j + 1 < NT; j += 2) {
    FA_SBAR(); qkt<DQK>(pB0, pB1, K_lds + SHM_K, qr, kb4);
    finishSM(pA0, pA1, alA, l_reg, pa0, pa1, pa2, pa3); FA_SBAR();
    FA_SLOAD((j + 1) * KVBLK); FA_SBAR();
    pv_d0(o, vb0, pa0, pa1, pa2, pa3); partialSM(pB0, pB1, m_reg, mnB, alB, C, thr_s);
    __syncthreads(); FA_SWAIT(); FA_SWRITE(0);
    FA_RESC(alB); __syncthreads();
    FA_SBAR(); qkt<DQK>(pA0, pA1, K_lds, qr, kb4);
    finishSM(pB0, pB1, alB, l_reg, pa0, pa1, pa2, pa3); FA_SBAR();
    FA_SLOAD((j + 2) * KVBLK); FA_SBAR();
    pv_d0(o, vb0 + SHM_V, pa0, pa1, pa2, pa3); partialSM(pA0, pA1, m_reg, mnA, alA, C, thr_s);
    __syncthreads(); FA_SWAIT(); FA_SWRITE(1);
    FA_RESC(alA); __syncthreads();
  }
  FA_SBAR(); qkt<DQK>(pB0, pB1, K_lds + SHM_K, qr, kb4);
  finishSM(pA0, pA1, alA, l_reg, pa0, pa1, pa2, pa3); FA_SBAR();
  pv_d0(o, vb0, pa0, pa1, pa2, pa3); partialSM(pB0, pB1, m_reg, mnB, alB, C, thr_s);
  __syncthreads(); FA_RESC(alB);
  finishSM(pB0, pB1, alB, l_reg, pa0, pa1, pa2, pa3); FA_SBAR();
  pv_d0(o, vb0 + SHM_V, pa0, pa1, pa2, pa3);
  if (hi == 0) li_l[r32] = l_reg; asm volatile("s_waitcnt lgkmcnt(0)" ::: "memory");
  float rli[16];
#pragma unroll
  for (int r = 0; r < 16; ++r) rli[r] = __builtin_amdgcn_rcpf(li_l[crow(r, hi)]);
  bf16_t* Ow = Ob + (size_t)(wid * QBLK) * LDO;
#pragma unroll
  for (int r = 0; r < 16; ++r) { const int orow = crow(r, hi);
#pragma unroll
    for (int d0 = 0; d0 < 4; ++d0) Ow[(size_t)orow * LDO + d0 * 32 + r32] = (bf16_t)f2bf(o[d0][r] * rli[r]); }
  __syncthreads();
#undef FA_SLOAD
#undef FA_SWRITE
#undef FA_SWAIT
#undef FA_RESC
}
template <int DQK, int LDQ, int LDK, int LDV, int LDO>
__device__ __forceinline__ void attn_body3(const bf16_t* __restrict__ Qb, const bf16_t* __restrict__ Kh, const bf16_t* __restrict__ Vh, bf16_t* __restrict__ Ob, int seq, float scale, char* lds) {
  constexpr int SHM_V = KVBLK * 128 * 2, SHM_K = KVBLK * krs<DQK>(), NKC = DQK / 64;
  const float C = scale * 1.4426950408889634f, thr_s = THR / scale;
  int tid_ = threadIdx.x; asm volatile("" : "+v"(tid_));
  const int tid = tid_, wid = tid >> 6, lane = tid & 63, r32 = lane & 31, hi = lane >> 5;
  char* V_lds = lds; char* K_lds = lds + 3 * SHM_V;
  float* wsf = (float*)(lds + 3 * SHM_V + 3 * SHM_K) + wid * 64; float* li_l = wsf; float* al_l = wsf + 32;
  float m_reg = -1e30f, l_reg = 0; f32x16 o[4] = {}; bf16x8 qr[DQK / 16];
  const bf16_t* Qw = Qb + (size_t)(wid * QBLK + r32) * LDQ + hi * 8;
#pragma unroll
  for (int d0 = 0; d0 < DQK / 16; ++d0) qr[d0] = *reinterpret_cast<const bf16x8*>(Qw + d0 * 16);
  const int sr = tid >> 4, sc = (tid & 15) * 8, vst0 = v_st(sr, sc), vst1 = v_st(32 + sr, sc);
  const int kgo0 = sr * LDK + sc, klo0 = kswz<DQK>(sr, sc * 2);
  const int kgo2 = (tid >> 3) * LDK + 128 + (tid & 7) * 8, klo2 = kswz<DQK>(tid >> 3, (128 + (tid & 7) * 8) * 2);
  const int vb0 = (int)(uintptr_t)V_lds + v_rd_base(lane);
  int kb4[4];
#pragma unroll
  for (int q = 0; q < 4; ++q) kb4[q] = kswz<DQK>(r32, q * 32 + hi * 16);
  bf16x8 vs0, vs1, ks[NKC];
#define FA_SLOAD(k0) do { vs0 = *reinterpret_cast<const bf16x8*>(&Vh[(size_t)((k0) + sr) * LDV + sc]); vs1 = *reinterpret_cast<const bf16x8*>(&Vh[(size_t)((k0) + 32 + sr) * LDV + sc]); \
    ks[0] = *reinterpret_cast<const bf16x8*>(&Kh[(size_t)(k0) * LDK + kgo0]); ks[1] = *reinterpret_cast<const bf16x8*>(&Kh[(size_t)((k0) + 32) * LDK + kgo0]); \
    if constexpr (NKC == 3) ks[NKC - 1] = *reinterpret_cast<const bf16x8*>(&Kh[(size_t)(k0) * LDK + kgo2]); } while (0)
#define FA_SWRITE(b) do { *(bf16x8*)(V_lds + (b) * SHM_V + vst0) = vs0; *(bf16x8*)(V_lds + (b) * SHM_V + vst1) = vs1; \
    *(bf16x8*)(K_lds + (b) * SHM_K + klo0) = ks[0]; *(bf16x8*)(K_lds + (b) * SHM_K + klo0 + 32 * krs<DQK>()) = ks[1]; \
    if constexpr (NKC == 3) *(bf16x8*)(K_lds + (b) * SHM_K + klo2) = ks[NKC - 1]; } while (0)
#define FA_SWAIT() asm volatile("s_waitcnt vmcnt(0)" ::: "memory")
#define FA_RESC(a) do { if (__any((a) < 1.f)) { if (hi == 0) al_l[r32] = (a); asm volatile("s_waitcnt lgkmcnt(0)" ::: "memory"); \
    _Pragma("unroll") for (int d = 0; d < 4; ++d) _Pragma("unroll") for (int r = 0; r < 16; ++r) o[d][r] *= al_l[crow(r, hi)]; } } while (0)
  f32x16 pA0, pA1, pB0, pB1; float mnA, mnB, alA, alB; bf16x8 pa0, pa1, pa2, pa3; const int NT = seq / KVBLK;
  FA_SLOAD(0); FA_SWAIT(); FA_SWRITE(0); __syncthreads();
  qkt<DQK>(pA0, pA1, K_lds, qr, kb4); partialSM(pA0, pA1, m_reg, mnA, alA, C, thr_s);
  FA_SLOAD(KVBLK);
  FA_SWAIT(); FA_SWRITE(1); __syncthreads();
  int bk = 1, bv = 0, bw = 2;
#define FA_ROT() do { const int t_ = bv; bv = bk; bk = bw; bw = t_; } while (0)
  for (int j = 1; j + 1 < NT; j += 2) {
    FA_SBAR(); qkt<DQK>(pB0, pB1, K_lds + bk * SHM_K, qr, kb4);
    finishSM(pA0, pA1, alA, l_reg, pa0, pa1, pa2, pa3); FA_SBAR();
    FA_SLOAD((j + 1) * KVBLK); FA_SBAR();
    pv_d0(o, vb0 + bv * SHM_V, pa0, pa1, pa2, pa3); partialSM(pB0, pB1, m_reg, mnB, alB, C, thr_s);
    FA_SWAIT(); FA_SWRITE(bw);
    FA_RESC(alB); __syncthreads(); FA_ROT();
    FA_SBAR(); qkt<DQK>(pA0, pA1, K_lds + bk * SHM_K, qr, kb4);
    finishSM(pB0, pB1, alB, l_reg, pa0, pa1, pa2, pa3); FA_SBAR();
    FA_SLOAD((j + 2) * KVBLK); FA_SBAR();
    pv_d0(o, vb0 + bv * SHM_V, pa0, pa1, pa2, pa3); partialSM(pA0, pA1, m_reg, mnA, alA, C, thr_s);
    FA_SWAIT(); FA_SWRITE(bw);
    FA_RESC(alA); __syncthreads(); FA_ROT();
  }
  FA_SBAR(); qkt<DQK>(pB0, pB1, K_lds + bk * SHM_K, qr, kb4);
  finishSM(pA0, pA1, alA, l_reg, pa0, pa1, pa2, pa3); FA_SBAR();
  pv_d0(o, vb0 + bv * SHM_V, pa0, pa1, pa2, pa3); partialSM(pB0, pB1, m_reg, mnB, alB, C, thr_s);
  FA_RESC(alB);
  finishSM(pB0, pB1, alB, l_reg, pa0, pa1, pa2, pa3); FA_SBAR();
  pv_d0(o, vb0 + bk * SHM_V, pa0, pa1, pa2, pa3);
#undef FA_ROT
  if (hi == 0) li_l[r32] = l_reg; asm volatile("s_waitcnt lgkmcnt(0)" ::: "memory");
  float rli[16];
#pragma unroll
  for (int r = 0; r < 16; ++r) rli[r] = __builtin_amdgcn_rcpf(li_l[crow(r, hi)]);
  bf16_t* Ow = Ob + (size_t)(wid * QBLK) * LDO;
#pragma unroll
  for (int r = 0; r < 16; ++r) { const int orow = crow(r, hi);
#pragma unroll
    for (int d0 = 0; d0 < 4; ++d0) Ow[(size_t)orow * LDO + d0 * 32 + r32] = (bf16_t)f2bf(o[d0][r] * rli[r]); }
  __syncthreads();
#undef FA_SLOAD
#undef FA_SWRITE
#undef FA_SWAIT
#undef FA_RESC
}

template <int S> __device__ __forceinline__ void fin_chunk(f32x16& P0, f32x16& P1, float alpha, float& l_reg, float& ps, bf16x8& pa0, bf16x8& pa1, bf16x8& pa2, bf16x8& pa3) {
  if constexpr (S < 8) { P1[2 * S] = __builtin_amdgcn_exp2f(P1[2 * S]); P1[2 * S + 1] = __builtin_amdgcn_exp2f(P1[2 * S + 1]); }
  else if constexpr (S < 12) { constexpr int k = S - 8; ps += (P0[4 * k] + P0[4 * k + 1]) + (P0[4 * k + 2] + P0[4 * k + 3]); ps += (P1[4 * k] + P1[4 * k + 1]) + (P1[4 * k + 2] + P1[4 * k + 3]); }
  else if constexpr (S == 12) { auto rr = __builtin_amdgcn_permlane32_swap(__float_as_uint(ps), __float_as_uint(ps), false, false); l_reg = l_reg * alpha + (__uint_as_float(rr[0]) + __uint_as_float(rr[1])); }
  else if constexpr (S >= 13 && S <= 16) {
#define FA_PK4(P, BASE, OUT) do { unsigned a0 = cvtpk(P[BASE + 0], P[BASE + 1]), a1 = cvtpk(P[BASE + 2], P[BASE + 3]);   \
    unsigned b0 = cvtpk(P[BASE + 4], P[BASE + 5]), b1 = cvtpk(P[BASE + 6], P[BASE + 7]);                              \
    auto r0 = __builtin_amdgcn_permlane32_swap(a0, b0, false, false); auto r1 = __builtin_amdgcn_permlane32_swap(a1, b1, false, false); \
    u32x4 w = {r0[0], r1[0], r0[1], r1[1]}; OUT = *reinterpret_cast<bf16x8*>(&w); } while (0)
    if constexpr (S == 13) FA_PK4(P0, 0, pa0); else if constexpr (S == 14) FA_PK4(P0, 8, pa1); else if constexpr (S == 15) FA_PK4(P1, 0, pa2); else FA_PK4(P1, 8, pa3);
#undef FA_PK4
  }
}
template <int CH> __device__ __forceinline__ void par_chunk(f32x16& P0, f32x16& P1, float& m_reg, float& alpha, float& pm, float& mnC, const float C, const float thr_s) {
  if constexpr (CH < 8) { f32x16& P = (CH < 4) ? P0 : P1; constexpr int b = 4 * (CH & 3);
    if constexpr (CH == 0) pm = fmaxf(fmaxf(P[0], P[1]), fmaxf(P[2], P[3])); else pm = fmaxf(pm, fmaxf(fmaxf(P[b], P[b + 1]), fmaxf(P[b + 2], P[b + 3]))); }
  else if constexpr (CH == 8) {
    auto rr = __builtin_amdgcn_permlane32_swap(__float_as_uint(pm), __float_as_uint(pm), false, false); pm = fmaxf(__uint_as_float(rr[0]), __uint_as_float(rr[1]));
    const bool ok = __all(pm - m_reg <= thr_s);
    const float mn = ok ? m_reg : fmaxf(m_reg, pm);
    alpha = __builtin_amdgcn_exp2f((m_reg - mn) * C);
    m_reg = mn; mnC = -mn * C; }
  else if constexpr (CH < 13) { constexpr int k = CH - 9; f32x16& P = (k < 2) ? P0 : P1; constexpr int b = 8 * (k & 1);
#pragma unroll
    for (int r = 0; r < 8; ++r) { P[b + r] = fmaf(P[b + r], C, mnC); asm volatile("" : "+v"(P[b + r])); } }
  else { constexpr int lo = (CH == 13) ? 0 : (CH == 14) ? 6 : 11, hi_ = (CH == 13) ? 6 : (CH == 14) ? 11 : 16;
#pragma unroll
    for (int r = lo; r < hi_; ++r) { P0[r] = __builtin_amdgcn_exp2f(P0[r]); asm volatile("" : "+v"(P0[r])); } }
}
template <int DQK, int LDQ, int LDK, int LDV, int LDO>
__device__ __forceinline__ void attn_body4(const bf16_t* __restrict__ Qb, const bf16_t* __restrict__ Kh, const bf16_t* __restrict__ Vh, bf16_t* __restrict__ Ob, int seq, float scale, char* lds, unsigned long long* ssrow, const float* gam) {
  constexpr int SHM_V = KVBLK * 128 * 2, SHM_K = KVBLK * krs<DQK>(), NKC = DQK / 64, ND = DQK / 16;
  const float C = scale * 1.4426950408889634f, thr_s = THR / scale;
  int tid_ = threadIdx.x; asm volatile("" : "+v"(tid_));
  const int tid = tid_, wid = tid >> 6, lane = tid & 63, r32 = lane & 31, hi = lane >> 5;
  char* V_lds = lds; char* K_lds = lds + 3 * SHM_V;
  float* wsf = (float*)(lds + 3 * SHM_V + 3 * SHM_K) + wid * 64; float* li_l = wsf; float* al_l = wsf + 32;
  float m_reg = -1e30f, l_reg = 0; f32x16 o[4] = {}; bf16x8 qr[ND];
  const bf16_t* Qw = Qb + (size_t)(wid * QBLK + r32) * LDQ + hi * 8;
#pragma unroll
  for (int d0 = 0; d0 < ND; ++d0) qr[d0] = *reinterpret_cast<const bf16x8*>(Qw + d0 * 16);
  const int sr = tid >> 4, sc = (tid & 15) * 8, vst0 = v_st(sr, sc), vst1 = v_st(32 + sr, sc);
  const int kgo0 = sr * LDK + sc, klo0 = kswz<DQK>(sr, sc * 2);
  const int kgo2 = (tid >> 3) * LDK + 128 + (tid & 7) * 8, klo2 = kswz<DQK>(tid >> 3, (128 + (tid & 7) * 8) * 2);
  const int vb0 = (int)(uintptr_t)V_lds + v_rd_base(lane);
  int kb4[4];
#pragma unroll
  for (int q = 0; q < 4; ++q) kb4[q] = kswz<DQK>(r32, q * 32 + hi * 16);
  bf16x8 vs0, vs1, ks[NKC];
#define FA_SLOAD(k0) do { vs0 = *reinterpret_cast<const bf16x8*>(&Vh[(size_t)((k0) + sr) * LDV + sc]); vs1 = *reinterpret_cast<const bf16x8*>(&Vh[(size_t)((k0) + 32 + sr) * LDV + sc]); \
    ks[0] = *reinterpret_cast<const bf16x8*>(&Kh[(size_t)(k0) * LDK + kgo0]); ks[1] = *reinterpret_cast<const bf16x8*>(&Kh[(size_t)((k0) + 32) * LDK + kgo0]); \
    if constexpr (NKC == 3) ks[NKC - 1] = *reinterpret_cast<const bf16x8*>(&Kh[(size_t)(k0) * LDK + kgo2]); } while (0)
#define FA_SWRITE(b) do { *(bf16x8*)(V_lds + (b) * SHM_V + vst0) = vs0; *(bf16x8*)(V_lds + (b) * SHM_V + vst1) = vs1; \
    *(bf16x8*)(K_lds + (b) * SHM_K + klo0) = ks[0]; *(bf16x8*)(K_lds + (b) * SHM_K + klo0 + 32 * krs<DQK>()) = ks[1]; \
    if constexpr (NKC == 3) *(bf16x8*)(K_lds + (b) * SHM_K + klo2) = ks[NKC - 1]; } while (0)
#define FA_SWAIT() asm volatile("s_waitcnt vmcnt(0)" ::: "memory")
#define FA_RESC(a) do { if (__any((a) < 1.f)) { if (hi == 0) al_l[r32] = (a); asm volatile("s_waitcnt lgkmcnt(0)" ::: "memory"); \
    _Pragma("unroll") for (int d = 0; d < 4; ++d) _Pragma("unroll") for (int r = 0; r < 16; ++r) o[d][r] *= al_l[crow(r, hi)]; } } while (0)
#define FA_KF(KS, D0, H) (*reinterpret_cast<const bf16x8*>((KS) + kb4[(D0) & 3] + ((D0) >> 2) * 128 + (H) * 32 * krs<DQK>()))
#define FA_SEGA(PN0, PN1, KS, PO0, PO1, ALO) do { PN0 = f32x16{}; PN1 = f32x16{}; float ps_ = 0.f; bf16x8 fa_ = FA_KF(KS, 0, 0), fb_ = FA_KF(KS, 0, 1); \
    _Pragma("unroll") for (int d0 = 0; d0 < ND; ++d0) { bf16x8 na_ = fa_, nb_ = fb_; if (d0 + 1 < ND) { na_ = FA_KF(KS, d0 + 1, 0); nb_ = FA_KF(KS, d0 + 1, 1); } \
      PN0 = __builtin_amdgcn_mfma_f32_32x32x16_bf16(fa_, qr[d0], PN0, 0, 0, 0); FIN_CH(2 * d0, PO0, PO1, ALO, ps_); \
      PN1 = __builtin_amdgcn_mfma_f32_32x32x16_bf16(fb_, qr[d0], PN1, 0, 0, 0); FIN_CH(2 * d0 + 1, PO0, PO1, ALO, ps_); fa_ = na_; fb_ = nb_; FA_SBAR(); } } while (0)
#define FIN_CH(S, PO0, PO1, ALO, PS) do { switch (S) { \
    case 0: fin_chunk<0>(PO0, PO1, ALO, l_reg, PS, pa0, pa1, pa2, pa3); break; case 1: fin_chunk<1>(PO0, PO1, ALO, l_reg, PS, pa0, pa1, pa2, pa3); break; \
    case 2: fin_chunk<2>(PO0, PO1, ALO, l_reg, PS, pa0, pa1, pa2, pa3); break; case 3: fin_chunk<3>(PO0, PO1, ALO, l_reg, PS, pa0, pa1, pa2, pa3); break; \
    case 4: fin_chunk<4>(PO0, PO1, ALO, l_reg, PS, pa0, pa1, pa2, pa3); break; case 5: fin_chunk<5>(PO0, PO1, ALO, l_reg, PS, pa0, pa1, pa2, pa3); break; \
    case 6: fin_chunk<6>(PO0, PO1, ALO, l_reg, PS, pa0, pa1, pa2, pa3); break; case 7: fin_chunk<7>(PO0, PO1, ALO, l_reg, PS, pa0, pa1, pa2, pa3); break; \
    case 8: fin_chunk<8>(PO0, PO1, ALO, l_reg, PS, pa0, pa1, pa2, pa3); break; case 9: fin_chunk<9>(PO0, PO1, ALO, l_reg, PS, pa0, pa1, pa2, pa3); break; \
    case 10: fin_chunk<10>(PO0, PO1, ALO, l_reg, PS, pa0, pa1, pa2, pa3); break; case 11: fin_chunk<11>(PO0, PO1, ALO, l_reg, PS, pa0, pa1, pa2, pa3); break; \
    case 12: fin_chunk<12>(PO0, PO1, ALO, l_reg, PS, pa0, pa1, pa2, pa3); break; case 13: fin_chunk<13>(PO0, PO1, ALO, l_reg, PS, pa0, pa1, pa2, pa3); break; \
    case 14: fin_chunk<14>(PO0, PO1, ALO, l_reg, PS, pa0, pa1, pa2, pa3); break; case 15: fin_chunk<15>(PO0, PO1, ALO, l_reg, PS, pa0, pa1, pa2, pa3); break; \
    case 16: fin_chunk<16>(PO0, PO1, ALO, l_reg, PS, pa0, pa1, pa2, pa3); break; default: break; } } while (0)
#define FA_TR8(DST, D0, VB) do { DST[0] = tr_read<v_rd_off(D0, 0, 0)>(VB); DST[1] = tr_read<v_rd_off(D0, 0, 1)>(VB); DST[2] = tr_read<v_rd_off(D0, 1, 0)>(VB); DST[3] = tr_read<v_rd_off(D0, 1, 1)>(VB); \
    DST[4] = tr_read<v_rd_off(D0, 2, 0)>(VB); DST[5] = tr_read<v_rd_off(D0, 2, 1)>(VB); DST[6] = tr_read<v_rd_off(D0, 3, 0)>(VB); DST[7] = tr_read<v_rd_off(D0, 3, 1)>(VB); } while (0)
#define FA_PKV(F, i) (bf16x8){F[2 * (i)][0], F[2 * (i)][1], F[2 * (i)][2], F[2 * (i)][3], F[2 * (i) + 1][0], F[2 * (i) + 1][1], F[2 * (i) + 1][2], F[2 * (i) + 1][3]}
#define FA_PVB(D0, F, PN0, PN1, ALN) do { \
    o[D0] = __builtin_amdgcn_mfma_f32_32x32x16_bf16(pa0, FA_PKV(F, 0), o[D0], 0, 0, 0); par_chunk<4 * D0 + 0>(PN0, PN1, m_reg, ALN, pm_, mnC_, C, thr_s); \
    o[D0] = __builtin_amdgcn_mfma_f32_32x32x16_bf16(pa1, FA_PKV(F, 1), o[D0], 0, 0, 0); par_chunk<4 * D0 + 1>(PN0, PN1, m_reg, ALN, pm_, mnC_, C, thr_s); \
    o[D0] = __builtin_amdgcn_mfma_f32_32x32x16_bf16(pa2, FA_PKV(F, 2), o[D0], 0, 0, 0); par_chunk<4 * D0 + 2>(PN0, PN1, m_reg, ALN, pm_, mnC_, C, thr_s); \
    o[D0] = __builtin_amdgcn_mfma_f32_32x32x16_bf16(pa3, FA_PKV(F, 3), o[D0], 0, 0, 0); par_chunk<4 * D0 + 3>(PN0, PN1, m_reg, ALN, pm_, mnC_, C, thr_s); FA_SBAR(); } while (0)
#define FA_SEGB(VB, PN0, PN1, ALN) do { float pm_ = 0.f, mnC_ = 0.f; s16x4 fA_[8], fB_[8]; const int vb_ = (VB); \
    FA_TR8(fA_, 0, vb_); FA_TR8(fB_, 1, vb_); asm volatile("s_waitcnt lgkmcnt(8)" ::: "memory"); FA_SBAR(); FA_PVB(0, fA_, PN0, PN1, ALN); \
    FA_TR8(fA_, 2, vb_); asm volatile("s_waitcnt lgkmcnt(8)" ::: "memory"); FA_SBAR(); FA_PVB(1, fB_, PN0, PN1, ALN); \
    FA_TR8(fB_, 3, vb_); asm volatile("s_waitcnt lgkmcnt(8)" ::: "memory"); FA_SBAR(); FA_PVB(2, fA_, PN0, PN1, ALN); \
    asm volatile("s_waitcnt lgkmcnt(0)" ::: "memory"); FA_SBAR(); FA_PVB(3, fB_, PN0, PN1, ALN); } while (0)
  f32x16 pA0, pA1, pB0, pB1; float alA = 1.f, alB = 1.f; bf16x8 pa0, pa1, pa2, pa3; const int NT = seq / KVBLK;
  FA_SLOAD(0); FA_SWAIT(); FA_SWRITE(0); __syncthreads();
  { float mnA_, alA_; qkt<DQK>(pA0, pA1, K_lds, qr, kb4); partialSM(pA0, pA1, m_reg, mnA_, alA_, C, thr_s); alA = alA_; }
  FA_SLOAD(KVBLK);
  FA_SWAIT(); FA_SWRITE(1); __syncthreads();
  int bk = 1, bv = 0, bw = 2;
#define FA_ROT() do { const int t_ = bv; bv = bk; bk = bw; bw = t_; } while (0)
  for (int j = 1; j + 1 < NT; j += 2) {
    FA_SBAR(); FA_SEGA(pB0, pB1, K_lds + bk * SHM_K, pA0, pA1, alA);
    FA_SLOAD((j + 1) * KVBLK); FA_SBAR();
    FA_SEGB(vb0 + bv * SHM_V, pB0, pB1, alB);
    FA_SWAIT(); FA_SWRITE(bw);
    FA_RESC(alB); __syncthreads(); FA_ROT();
    FA_SBAR(); FA_SEGA(pA0, pA1, K_lds + bk * SHM_K, pB0, pB1, alB);
    FA_SLOAD((j + 2) * KVBLK); FA_SBAR();
    FA_SEGB(vb0 + bv * SHM_V, pA0, pA1, alA);
    FA_SWAIT(); FA_SWRITE(bw);
    FA_RESC(alA); __syncthreads(); FA_ROT();
  }
  FA_SBAR(); FA_SEGA(pB0, pB1, K_lds + bk * SHM_K, pA0, pA1, alA);
  FA_SEGB(vb0 + bv * SHM_V, pB0, pB1, alB);
  FA_RESC(alB);
  finishSM(pB0, pB1, alB, l_reg, pa0, pa1, pa2, pa3); FA_SBAR();
  pv_d0(o, vb0 + bk * SHM_V, pa0, pa1, pa2, pa3);
#undef FA_ROT
  if (hi == 0) li_l[r32] = l_reg; asm volatile("s_waitcnt lgkmcnt(0)" ::: "memory");
  float rli[16];
#pragma unroll
  for (int r = 0; r < 16; ++r) rli[r] = __builtin_amdgcn_rcpf(li_l[crow(r, hi)]);
  bf16_t* Ow = Ob + (size_t)(wid * QBLK) * LDO;
  const float gm[4] = {gam[r32], gam[32 + r32], gam[64 + r32], gam[96 + r32]};
#pragma unroll
  for (int r = 0; r < 16; ++r) { const int orow = crow(r, hi); float q = 0.f;
#pragma unroll
    for (int d0 = 0; d0 < 4; ++d0) { const float val = o[d0][r] * rli[r]; q += val * val; Ow[(size_t)orow * LDO + d0 * 32 + r32] = (bf16_t)f2bf(val * gm[d0]); }
    q += __shfl_xor(q, 1); q += __shfl_xor(q, 2); q += __shfl_xor(q, 4); q += __shfl_xor(q, 8); q += __shfl_xor(q, 16);
    if (r32 == 0) atomicAdd(ssrow + wid * QBLK + orow, (unsigned long long)(q * 16777216.f)); }
  __syncthreads();
#undef FA_SLOAD
#undef FA_SWRITE
#undef FA_SWAIT
#undef FA_RESC
#undef FA_KF
#undef FA_SEGA
#undef FIN_CH
#undef FA_TR8
#undef FA_PKV
#undef FA_PVB
#undef FA_SEGB
}
#undef FA_SBAR
}
__device__ __forceinline__ void mla_attn_phase(unsigned char* dout, unsigned char* ws, char* lds, int bid, int nblk, const float* gamma1) {
  for (int u = bid; u < NB_ * 8 * (S_ / 256); u += nblk) {
    const int qb = u & 7, h = (u >> 3) & 7, b = u >> 6;
    const bf16_t* Q = (const bf16_t*)(dout + DO_Q) + (size_t)(b * S_ + qb * 256) * 1536 + h * 192;
    const bf16_t* K = (const bf16_t*)(dout + DO_K) + (size_t)(b * S_) * 1536 + h * 192;
    const bf16_t* V = (const bf16_t*)(dout + DO_V) + (size_t)(b * S_) * 1024 + h * 128;
    bf16_t* O = (bf16_t*)(ws + WS_YMIX) + (size_t)(b * S_ + qb * 256) * 2048 + h * 128;
    fa::attn_body4<192, 1536, 1536, 1024, 2048>(Q, K, V, O, S_, 0.07216878364870322f, lds, (unsigned long long*)(ws + WS_SS) + 2 * 16384 + (b * S_ + qb * 256), gamma1 + h * 128);
  }
}

__device__ __forceinline__ void mem_attn_phase(unsigned char* ws, char* lds, int bid, int nblk) {
  for (int u = bid; u < NB_ * 4 * (S_ / 256); u += nblk) {
    const int qb = u & 7, h = (u >> 3) & 3, b = u >> 5;
    const bf16_t* Q = (const bf16_t*)(ws + WS_QM) + (size_t)(b * S_ + qb * 256) * 512 + h * 128;
    const bf16_t* K = (const bf16_t*)(ws + WS_MEMKV) + (size_t)(b * 256) * 1024 + h * 128;
    const bf16_t* V = K + 512;
    bf16_t* O = (bf16_t*)(ws + WS_OM) + (size_t)(b * S_ + qb * 256) * 512 + h * 128;
    fa::attn_body<128, 512, 1024, 1024, 512>(Q, K, V, O, 256, 0.08838834764831845f, lds);
  }
}
__device__ __forceinline__ void scan_phase(unsigned char* ws, float* lds, int bid, int nblk, int tid_in) {
  int tid = tid_in; asm volatile("" : "+v"(tid));
  f32x4* sA = (f32x4*)lds; f32x4* sB = sA + 512;
  const int cq = tid & 15, ch = tid >> 4;
  for (int it = bid; it < NB_ * 2 * 16; it += nblk) {
    const int cg_ = it & 15, dir = (it >> 4) & 1, b = it >> 5;
    const char* LA = (const char*)(ws + (dir ? WS_LAB : WS_LAF)) + ((size_t)b * S_ * 1024 + cg_ * 64) * 2;
    char* BT = (char*)(ws + (dir ? WS_BTB : WS_BTF)) + ((size_t)b * S_ * 1024 + cg_ * 64) * 2;
    const int sstep = dir ? -2048 : 2048;
    const unsigned off0 = (unsigned)((dir ? (S_ - 1 - ch * 64) : ch * 64) * 2048 + cq * 8);
    f32x4 A = {1.f, 1.f, 1.f, 1.f}, Bv = {0.f, 0.f, 0.f, 0.f};
    unsigned off = off0;
#pragma unroll 8
    for (int i = 0; i < 64; ++i) { const u32x2 lw = *(const u32x2*)(LA + off), bw = *(const u32x2*)(BT + off); off += sstep;
      const f32x4 a = {__expf(bflo(lw.x)), __expf(bfhi(lw.x)), __expf(bflo(lw.y)), __expf(bfhi(lw.y))}; const f32x4 bt = {bflo(bw.x), bfhi(bw.x), bflo(bw.y), bfhi(bw.y)};
      Bv = a * Bv + bt; A = A * a; }
    __syncthreads();
    sA[ch * 16 + cq] = A; sB[ch * 16 + cq] = Bv;
    __syncthreads();
    f32x4 h = {0.f, 0.f, 0.f, 0.f};
    for (int qq = 0; qq < ch; ++qq) h = sA[qq * 16 + cq] * h + sB[qq * 16 + cq];
    off = off0;
#pragma unroll 8
    for (int i = 0; i < 64; ++i) { const u32x2 lw = *(const u32x2*)(LA + off), bw = *(const u32x2*)(BT + off);
      const f32x4 a = {__expf(bflo(lw.x)), __expf(bfhi(lw.x)), __expf(bflo(lw.y)), __expf(bfhi(lw.y))}; const f32x4 bt = {bflo(bw.x), bfhi(bw.x), bflo(bw.y), bfhi(bw.y)};
      h = a * h + bt; u32x2 w; w.x = pk2(h[0], h[1]); w.y = pk2(h[2], h[3]); *(u32x2*)(BT + off) = w; off += sstep; }
  }
  __syncthreads();
}


__device__ __forceinline__ void lru_fused_phase(const Params& p, unsigned char* lds_raw, int bid, int nblk) {
  constexpr int RS = 272;
  constexpr int AST = 65;
  unsigned char* WL = lds_raw; unsigned char* XL = lds_raw + 128 * RS;
  f32x2* AB = (f32x2*)(lds_raw + 2 * 128 * RS); float* AG = (float*)(AB + 128 * AST);
  float* CAR = AG + 2 * 8 * 64;
  int tid_ = threadIdx.x; asm volatile("" : "+v"(tid_));
  const int tid = tid_, lane = tid & 63, wave = tid >> 6, r32 = lane & 31, hi = lane >> 5;
  unsigned char* ws = p.ws;
  const bf16_t* LX = (const bf16_t*)(ws + WS_LRUX);
  for (int it = bid; it < NB_ * 8 * 2 * 2; it += nblk) {
    const int half = it & 1, dir = (it >> 1) & 1, n = (it >> 2) & 7, b = it >> 5;
    const int ch0 = n * 128 + half * 64;
    __syncthreads();
    { const bf16_t* wg = (const bf16_t*)(ws + WS_WG_T) + (size_t)(n * 512 + dir * 256 + half * 128) * 128;
      for (int i = tid; i < 128 * 16; i += NTHR) { const int r = i >> 4, c8 = (i & 15) * 8; *(u32x4*)(WL + r * RS + c8 * 2) = *(const u32x4*)(wg + r * 128 + c8); } }
    if (tid < 64) CAR[tid] = 0.f;
    float cw0[4], cw1[4]; const float cb0 = p.in[11][n * 128 + 2 * lane], cb1 = p.in[11][n * 128 + 2 * lane + 1];
#pragma unroll
    for (int k = 0; k < 4; ++k) { cw0[k] = p.in[10][k * 1024 + n * 128 + 2 * lane]; cw1[k] = p.in[10][k * 1024 + n * 128 + 2 * lane + 1]; }
    bf16_t* H = (bf16_t*)(ws + (dir ? WS_BTB : WS_BTF));
    float tb0[16], tb1[16], tb2[16];
#pragma unroll
    for (int t = 0; t < 2; ++t)
#pragma unroll
      for (int g = 0; g < 4; ++g)
#pragma unroll
        for (int u = 0; u < 2; ++u) { const int jl = (wave & 1) * 32 + 16 * t + 4 * g + 2 * hi + u; const f32x4 tb = *((const f32x4*)(ws + WS_GTAB) + dir * 1024 + ch0 + jl);
          tb0[t * 8 + g * 2 + u] = tb[0]; tb1[t * 8 + g * 2 + u] = tb[1]; tb2[t * 8 + g * 2 + u] = tb[2]; }
    unsigned xr[19];
#define LRU_LOADX(C) do { const int q0_ = (dir ? S_ - 128 * ((C) + 1) : 128 * (C)) + wave * 16; \
      _Pragma("unroll") for (int j = 0; j < 19; ++j) { const int row = q0_ + j - 2, rc = row < 0 ? 0 : (row >= S_ ? S_ - 1 : row);        \
        const unsigned v_ = *(const unsigned*)(LX + (size_t)(b * S_ + rc) * 1024 + n * 128 + 2 * lane); xr[j] = (row == rc) ? v_ : 0u; } } while (0)
    LRU_LOADX(0);
    for (int c = 0; c < 16; ++c) {
      const int p0 = dir ? S_ - 128 * (c + 1) : 128 * c;
      {
#pragma unroll
        for (int i = 0; i < 16; ++i) { float s0 = cb0, s1 = cb1;
#pragma unroll
          for (int k = 0; k < 4; ++k) { s0 += bflo(xr[i + k]) * cw0[k]; s1 += bfhi(xr[i + k]) * cw1[k]; }
          *(unsigned*)(XL + (wave * 16 + i) * RS + lane * 4) = pk2(s0, s1); } }
      if (c + 1 < 16) LRU_LOADX(c + 1);
      __syncthreads();
      f32x16 acc[2] = {};
#pragma unroll
      for (int s = 0; s < 8; ++s) { const bf16x8 xf = *(const bf16x8*)(XL + ((wave >> 1) * 32 + r32) * RS + (16 * s + 8 * hi) * 2);
#pragma unroll
        for (int t = 0; t < 2; ++t) { const bf16x8 wf = *(const bf16x8*)(WL + ((wave & 1) * 64 + 32 * t + r32) * RS + (16 * s + 8 * hi) * 2);
          acc[t] = __builtin_amdgcn_mfma_f32_32x32x16_bf16(wf, xf, acc[t], 0, 0, 0); } }
      { const int pos = (wave >> 1) * 32 + r32;
#pragma unroll
        for (int t = 0; t < 2; ++t)
#pragma unroll
          for (int g = 0; g < 4; ++g) { const int jl = (wave & 1) * 32 + 16 * t + 4 * g + 2 * hi;
            const unsigned xw = *(const unsigned*)(XL + pos * RS + (half * 64 + jl) * 2);
#pragma unroll
            for (int u = 0; u < 2; ++u) { const int ti = t * 8 + g * 2 + u;
              const float e1 = __builtin_amdgcn_exp2f(-1.4426950408889634f * (acc[t][4 * g + 2 * u] + tb1[ti])), e2 = __builtin_amdgcn_exp2f(-1.4426950408889634f * (acc[t][4 * g + 2 * u + 1] + tb2[ti]));
              const float R = __builtin_amdgcn_rcpf((1.f + e1) * (1.f + e2)), sr = (1.f + e2) * R, si = (1.f + e1) * R;
              const float la = -tb0[ti] * sr, a = __builtin_amdgcn_exp2f(la * 1.4426950408889634f), x2 = 2.f * la;
              const float ser = -x2 * (1.f + x2 * (0.5f + x2 * (1.6666667e-1f + x2 * (4.1666667e-2f + x2 * (8.3333333e-3f + x2 * 1.3888889e-3f)))));
              const float om = x2 > -0.25f ? ser : 1.f - a * a;
              AB[pos * AST + jl + u] = (f32x2){a, __builtin_amdgcn_sqrtf(om) * si * (u ? bfhi(xw) : bflo(xw))}; } } }
      __syncthreads();
      { const int jl = tid & 63, sub = tid >> 6; float av[16], bv[16]; float A = 1.f, B = 0.f;
#pragma unroll
        for (int i = 0; i < 16; ++i) { const int tau = 16 * sub + i, pos = dir ? 127 - tau : tau; const f32x2 ab = AB[pos * AST + jl]; av[i] = ab[0]; bv[i] = ab[1]; B = av[i] * B + bv[i]; A *= av[i]; }
        AG[sub * 64 + jl] = A; AG[512 + sub * 64 + jl] = B;
        __syncthreads();
        float h = CAR[jl];
        for (int s2 = 0; s2 < sub; ++s2) h = AG[s2 * 64 + jl] * h + AG[512 + s2 * 64 + jl];
#pragma unroll
        for (int i = 0; i < 16; ++i) { const int tau = 16 * sub + i, pos = dir ? 127 - tau : tau; h = av[i] * h + bv[i];
          H[(size_t)(b * S_ + p0 + pos) * 1024 + ch0 + jl] = (bf16_t)(pk2(h, 0.f) & 0xffffu); }
        __syncthreads();
        if (sub == 7) CAR[jl] = h; }
    }
#undef LRU_LOADX
  }
  __syncthreads();
}

__device__ __forceinline__ void phase3b(const Params& p, int gw, int ngw, int lane) {
  unsigned char* ws = p.ws; bf16_t* Y = (bf16_t*)(ws + WS_YMIX);
  const bf16_t* HF = (const bf16_t*)(ws + WS_BTF); const bf16_t* HB = (const bf16_t*)(ws + WS_BTB); const bf16_t* G = (const bf16_t*)(ws + WS_GATE);
  for (int r = gw; r < T_; r += ngw) {
    { const size_t o = (size_t)r * 1024 + lane * 16; float a[16], b[16], gg[16];
      unpack8(*(const u32x4*)(HF + o), a); unpack8(*(const u32x4*)(HF + o + 8), a + 8);
      unpack8(*(const u32x4*)(HB + o), b); unpack8(*(const u32x4*)(HB + o + 8), b + 8);
      unpack8(*(const u32x4*)(G + o), gg); unpack8(*(const u32x4*)(G + o + 8), gg + 8);
      float q = 0.f;
#pragma unroll
      for (int i = 0; i < 16; ++i) { a[i] = (a[i] + b[i]) * gg[i]; q += a[i] * a[i]; }
      const float r1inv = __builtin_amdgcn_sqrtf((float)((const unsigned long long*)(ws + WS_SS))[2 * 16384 + r] * (1.f / 16777216.f / 1024.f) + RMS_EPS);
      const float sc = rsqrtf(dpp_sum64(q) * (1.f / 1024.f) + RMS_EPS) * r1inv; const float* g = p.in[18] + lane * 16;
#pragma unroll
      for (int i = 0; i < 16; ++i) a[i] = a[i] * sc * g[i];
      bf16_t* row = Y + (size_t)r * 2048 + 1024 + lane * 16; *(u32x4*)row = pack8(a); *(u32x4*)(row + 8) = pack8(a + 8); }
  }
}
__device__ __forceinline__ void ln_pass(unsigned char* ws, const float* g, const float* b, int gw, int ngw, int lane) {
  bf16_t* X = (bf16_t*)(ws + WS_X);
  for (int r0 = gw * 2; r0 < T_; r0 += ngw * 2) { u32x4 w[2][4]; float v[32];
#pragma unroll
    for (int rr = 0; rr < 2; ++rr)
#pragma unroll
      for (int j = 0; j < 4; ++j) w[rr][j] = *(const u32x4*)(X + (size_t)(r0 + rr) * DM + j * 512 + lane * 8);
#pragma unroll
    for (int rr = 0; rr < 2; ++rr) {
#pragma unroll
      for (int j = 0; j < 4; ++j) unpack8(w[rr][j], &v[j * 8]);
      ln_row_regs(v, g, b, lane);
#pragma unroll
      for (int j = 0; j < 4; ++j) *(u32x4*)(X + (size_t)(r0 + rr) * DM + j * 512 + lane * 8) = pack8(&v[j * 8]); } }
}
__device__ __forceinline__ void cvt_pass(const float* src, bf16_t* dst, size_t n, int gw, int ngw, int lane) {
  for (size_t i = (size_t)(gw * 64 + lane) * 8; i < n; i += (size_t)ngw * 64 * 8) {
    const f32x4 a = *(const f32x4*)(src + i), b = *(const f32x4*)(src + i + 4); u32x4 o; o.x = pk2(a[0], a[1]); o.y = pk2(a[2], a[3]); o.z = pk2(b[0], b[1]); o.w = pk2(b[2], b[3]);
    *(u32x4*)(dst + i) = o; }
}

__device__ __forceinline__ unsigned key_of(float s, unsigned tag, unsigned tagmask) {
  unsigned u = __float_as_uint(s); u = (u & 0x80000000u) ? ~u : (u | 0x80000000u); return (u & ~tagmask) | (tagmask - tag);
}
__device__ __forceinline__ float val_of(unsigned k, unsigned tagmask) { unsigned u = k & ~tagmask; u = (u & 0x80000000u) ? (u & 0x7fffffffu) : ~u; return __uint_as_float(u); }
__device__ __forceinline__ void topk_phase(unsigned char* ws, const float* SC, int gw, int ngw, int lane) {
  int* IDX = (int*)(ws + WS_IDX); float* GV = (float*)(ws + WS_GV);
  int ca = -1, cb = -1; { int n = 0; for (int a = 0; a < 16; ++a) for (int b = 0; b < 16; ++b) if ((a + 1) * (b + 1) <= 16) { if (n == lane) { ca = a; cb = b; } ++n; } }
  for (int pr = gw; pr < T_ * 8; pr += ngw) {
    const float* row = SC + (size_t)pr * 256;
    unsigned k1a = key_of(row[lane], lane, 127u), k1b = key_of(row[64 + lane], 64 + lane, 127u);
    unsigned k2a = key_of(row[128 + lane], lane, 127u), k2b = key_of(row[192 + lane], 64 + lane, 127u);
    unsigned t1 = 0u, t2 = 0u;
    for (int it = 0; it < 16; ++it) {
      const unsigned m1 = dpp_max64_u32(k1a > k1b ? k1a : k1b), m2 = dpp_max64_u32(k2a > k2b ? k2a : k2b);
      if (k1a == m1) k1a = 0u; if (k1b == m1) k1b = 0u; if (k2a == m2) k2a = 0u; if (k2b == m2) k2b = 0u;
      if (lane == it) { t1 = m1; t2 = m2; }
    }
    const unsigned ka = (unsigned)__shfl((int)t1, ca < 0 ? 0 : ca), kb = (unsigned)__shfl((int)t2, cb < 0 ? 0 : cb);
    const float va = val_of(ka, 127u), vb = val_of(kb, 127u); const int ia = 127 - (int)(ka & 127u), ib = 127 - (int)(kb & 127u);
    const float cs = va + vb; const int cidx = ia * 128 + ib;
    unsigned ck = (ca >= 0) ? key_of(cs, (unsigned)(ca * 16 + cb), 255u) : 0u;
    float ts = 0.f; int ti = 0;
    for (int it = 0; it < 16; ++it) {
      const unsigned m = dpp_max64_u32(ck); const unsigned long long bal = __ballot(ck == m && ck != 0u); const int src = __ffsll((long long)bal) - 1;
      const float sv = __shfl(cs, src); const int si = __shfl(cidx, src);
      if (lane == src) ck = 0u;
      if (lane == it) { ts = sv; ti = si; }
    }
    const float mx = __uint_as_float(__builtin_amdgcn_readlane(__float_as_uint(ts), 0));
    float ex = (lane < 16) ? __expf(ts - mx) : 0.f; const float sum = dpp_sum64(ex);
    if (lane < 16) { IDX[(size_t)pr * 16 + lane] = ti; GV[(size_t)pr * 16 + lane] = ex / sum; }
  }
}


__device__ __forceinline__ unsigned umax_(unsigned a, unsigned b) { return a > b ? a : b; }
__device__ __forceinline__ unsigned umin_(unsigned a, unsigned b) { return a < b ? a : b; }
__device__ __forceinline__ unsigned ord_of(float s) { const unsigned u = __float_as_uint(s); return (u & 0x80000000u) ? ~u : (u | 0x80000000u); }
__device__ __forceinline__ unsigned qx1(unsigned v) { return (unsigned)__builtin_amdgcn_update_dpp(0, (int)v, 0xB1, 0xf, 0xf, false); }
__device__ __forceinline__ unsigned qx2(unsigned v) { return (unsigned)__builtin_amdgcn_update_dpp(0, (int)v, 0x4E, 0xf, 0xf, false); }
__device__ __forceinline__ void ins16(unsigned (&L)[16], unsigned x) {
#pragma unroll
  for (int k = 0; k < 16; ++k) { const unsigned hi = umax_(L[k], x); x = umin_(L[k], x); L[k] = hi; }
}
__device__ __forceinline__ void ins16p(unsigned (&L)[16], unsigned (&P)[16], unsigned x, unsigned px) {
#pragma unroll
  for (int k = 0; k < 16; ++k) { const bool c = x > L[k]; const unsigned nl = c ? x : L[k], nx = c ? L[k] : x, np = c ? px : P[k], npx = c ? P[k] : px; L[k] = nl; x = nx; P[k] = np; px = npx; }
}
__device__ __forceinline__ void bitonic_sort16(unsigned (&M)[16]) {
#pragma unroll
  for (int d = 8; d >= 1; d >>= 1)
#pragma unroll
    for (int i = 0; i < 16; ++i) if (!(i & d)) { const unsigned hi = umax_(M[i], M[i + d]), lo = umin_(M[i], M[i + d]); M[i] = hi; M[i + d] = lo; }
}
__device__ __forceinline__ void bitonic_sort16p(unsigned (&M)[16], unsigned (&P)[16]) {
#pragma unroll
  for (int d = 8; d >= 1; d >>= 1)
#pragma unroll
    for (int i = 0; i < 16; ++i) if (!(i & d)) { const bool c = M[i + d] > M[i]; const unsigned a = M[i], b = M[i + d], pa = P[i], pb = P[i + d];
      M[i] = c ? b : a; M[i + d] = c ? a : b; P[i] = c ? pb : pa; P[i + d] = c ? pa : pb; }
}
__device__ __forceinline__ void topk_phase2(unsigned char* ws, const float* SC, int gw, int ngw, int lane) {
  int* IDX = (int*)(ws + WS_IDX); float* GV = (float*)(ws + WS_GV);
  const int c = lane & 3;
  const unsigned tagbase = (c & 1) ? 0u : 64u;
  for (int item = gw; item < T_ * 8 / 16; item += ngw) {
    const int pr = item * 16 + (lane >> 2);
    const float* row = SC + (size_t)pr * 256 + c * 64;
    unsigned L[16];
#pragma unroll
    for (int k = 0; k < 16; ++k) L[k] = 0u;
#pragma unroll
    for (int bq = 0; bq < 4; ++bq) { f32x4 v[4];
#pragma unroll
      for (int j = 0; j < 4; ++j) v[j] = *(const f32x4*)(row + bq * 16 + j * 4);
#pragma unroll
      for (int j = 0; j < 4; ++j)
#pragma unroll
        for (int i = 0; i < 4; ++i) { const int e = bq * 16 + j * 4 + i; ins16(L, (ord_of(v[j][i]) & ~127u) | (tagbase + (unsigned)(63 - e))); } }
    { unsigned B[16];
#pragma unroll
      for (int k = 0; k < 16; ++k) B[k] = qx1(L[k]);
#pragma unroll
      for (int k = 0; k < 16; ++k) L[k] = umax_(L[k], B[15 - k]);
      bitonic_sort16(L); }
    float F1[16], F2[16]; unsigned I1[16], I2[16];
#pragma unroll
    for (int k = 0; k < 16; ++k) { const unsigned o = qx2(L[k]); const unsigned v1 = (c < 2) ? L[k] : o, v2 = (c < 2) ? o : L[k];
      unsigned u1 = v1 & ~127u, u2 = v2 & ~127u; u1 = (u1 & 0x80000000u) ? (u1 & 0x7fffffffu) : ~u1; u2 = (u2 & 0x80000000u) ? (u2 & 0x7fffffffu) : ~u2;
      F1[k] = __uint_as_float(u1); F2[k] = __uint_as_float(u2); I1[k] = (127u - (v1 & 127u)) << 7; I2[k] = 127u - (v2 & 127u); }
    unsigned M[16], P[16];
#pragma unroll
    for (int k = 0; k < 16; ++k) { M[k] = 0u; P[k] = 0u; }
    {
      constexpr int CA[52] = {0,0,0,0,0,0,0,0,0,0,0,0,0,0,0,0, 1,1,1,1,1,1,1,1, 2,2,2,2,2, 3,3,3,3, 4,4,4, 5,5, 6,6, 7,7, 8, 9, 10, 11, 12, 13, 14, 15, 15, 15};
      constexpr int CB[52] = {0,1,2,3,4,5,6,7,8,9,10,11,12,13,14,15, 0,1,2,3,4,5,6,7, 0,1,2,3,4, 0,1,2,3, 0,1,2, 0,1, 0,1, 0,1, 0, 0, 0, 0, 0, 0, 0, 0, 0, 0};
#pragma unroll
      for (int m = 0; m < 13; ++m) {
        unsigned kx[4], px[4];
#pragma unroll
        for (int q = 0; q < 4; ++q) { const int n = 4 * m + q; const bool pad = n >= 50;
          kx[q] = pad ? 0u : ord_of(F1[CA[n]] + F2[CB[n]]); px[q] = I1[CA[n]] | I2[CB[n]]; }
        const unsigned x = (c == 0) ? kx[0] : (c == 1) ? kx[1] : (c == 2) ? kx[2] : kx[3];
        const unsigned pp = (c == 0) ? px[0] : (c == 1) ? px[1] : (c == 2) ? px[2] : px[3];
        ins16p(M, P, x, pp);
      }
    }
    { unsigned B[16], Q[16];
#pragma unroll
      for (int k = 0; k < 16; ++k) { B[k] = qx1(M[k]); Q[k] = qx1(P[k]); }
#pragma unroll
      for (int k = 0; k < 16; ++k) { const bool t = B[15 - k] > M[k]; M[k] = t ? B[15 - k] : M[k]; P[k] = t ? Q[15 - k] : P[k]; }
      bitonic_sort16p(M, P);
#pragma unroll
      for (int k = 0; k < 16; ++k) { B[k] = qx2(M[k]); Q[k] = qx2(P[k]); }
#pragma unroll
      for (int k = 0; k < 16; ++k) { const bool t = B[15 - k] > M[k]; M[k] = t ? B[15 - k] : M[k]; P[k] = t ? Q[15 - k] : P[k]; }
      bitonic_sort16p(M, P); }
    float sv[16]; float mx = -1e30f;
#pragma unroll
    for (int k = 0; k < 16; ++k) { unsigned u = M[k]; u = (u & 0x80000000u) ? (u & 0x7fffffffu) : ~u; sv[k] = __uint_as_float(u); mx = fmaxf(mx, sv[k]); }
    float sum = 0.f;
#pragma unroll
    for (int k = 0; k < 16; ++k) { sv[k] = __expf(sv[k] - mx); sum += sv[k]; }
    const float inv = __builtin_amdgcn_rcpf(sum);
    u32x4 oi; f32x4 og;
#pragma unroll
    for (int i = 0; i < 4; ++i) { oi[i] = (c == 0) ? P[i] : (c == 1) ? P[4 + i] : (c == 2) ? P[8 + i] : P[12 + i];
      og[i] = ((c == 0) ? sv[i] : (c == 1) ? sv[4 + i] : (c == 2) ? sv[8 + i] : sv[12 + i]) * inv; }
    *(u32x4*)(IDX + (size_t)pr * 16 + 4 * c) = oi; *(f32x4*)(GV + (size_t)pr * 16 + 4 * c) = og;
  }
}


__device__ __forceinline__ unsigned sx16(unsigned v) { return (unsigned)__shfl_xor((int)v, 16); }
__device__ __forceinline__ unsigned sx32(unsigned v) { return (unsigned)__shfl_xor((int)v, 32); }
#define MERGE16(L, SH) do { unsigned B_[16]; _Pragma("unroll") for (int k_ = 0; k_ < 16; ++k_) B_[k_] = SH(L[k_]); \
    _Pragma("unroll") for (int k_ = 0; k_ < 16; ++k_) L[k_] = umax_(L[k_], B_[15 - k_]); bitonic_sort16(L); } while (0)
#define MERGE16P(M, P, SH) do { unsigned B_[16], Q_[16]; _Pragma("unroll") for (int k_ = 0; k_ < 16; ++k_) { B_[k_] = SH(M[k_]); Q_[k_] = SH(P[k_]); } \
    _Pragma("unroll") for (int k_ = 0; k_ < 16; ++k_) { const bool t_ = B_[15 - k_] > M[k_]; M[k_] = t_ ? B_[15 - k_] : M[k_]; P[k_] = t_ ? Q_[15 - k_] : P[k_]; } bitonic_sort16p(M, P); } while (0)
__device__ __forceinline__ void topk_phase3(const Params& p, unsigned char* lds_raw, int gw, int ngw, int tid) {
  unsigned char* ws = p.ws; int* IDX = (int*)(ws + WS_IDX); float* GV = (float*)(ws + WS_GV); const bf16_t* QP = (const bf16_t*)(ws + WS_QP);
  constexpr int KRS = 272;
  for (int i = tid; i < 2 * 128 * 32; i += NTHR) { const int tb = i >> 12, r = (i >> 5) & 127, c4 = (i & 31) * 4; const f32x4 v = *(const f32x4*)(p.in[29 + tb] + r * 128 + c4);
    u32x2 w; w.x = pk2(v[0], v[1]); w.y = pk2(v[2], v[3]); *(u32x2*)(lds_raw + tb * (128 * KRS) + r * KRS + c4 * 2) = w; }
  __syncthreads();
  const int lane = tid & 63, fr = lane & 15, c = lane >> 4;
  for (int item = gw; item < T_ * 8 / 16; item += ngw) {
    const int pr = item * 16 + fr;
    unsigned L1[16], L2[16];
#pragma unroll
    for (int k = 0; k < 16; ++k) { L1[k] = 0u; L2[k] = 0u; }
#pragma unroll
    for (int h = 0; h < 2; ++h) {
      bf16x8 qf[4];
#pragma unroll
      for (int s = 0; s < 4; ++s) qf[s] = *(const bf16x8*)(QP + (size_t)pr * 256 + 128 * h + 32 * s + 8 * c);
#pragma unroll
      for (int tp = 0; tp < 4; ++tp) {
        f32x4 acc0 = {0.f, 0.f, 0.f, 0.f}, acc1 = {0.f, 0.f, 0.f, 0.f};
#pragma unroll
        for (int s = 0; s < 4; ++s) { const unsigned char* kb = lds_raw + h * (128 * KRS) + (32 * tp + fr) * KRS + (32 * s + 8 * c) * 2;
          acc0 = __builtin_amdgcn_mfma_f32_16x16x32_bf16(*(const bf16x8*)kb, qf[s], acc0, 0, 0, 0);
          acc1 = __builtin_amdgcn_mfma_f32_16x16x32_bf16(*(const bf16x8*)(kb + 16 * KRS), qf[s], acc1, 0, 0, 0); }
#pragma unroll
        for (int r = 0; r < 4; ++r) { const unsigned t0 = (unsigned)(127 - (32 * tp + r)) - (unsigned)(4 * c), t1 = t0 - 16u;
          const unsigned k0 = (ord_of(acc0[r]) & ~127u) | t0, k1 = (ord_of(acc1[r]) & ~127u) | t1;
          if (h == 0) { ins16(L1, k0); ins16(L1, k1); } else { ins16(L2, k0); ins16(L2, k1); } }
        if (h == 0) asm volatile("" : "+v"(L1[0]), "+v"(L1[15])); else asm volatile("" : "+v"(L2[0]), "+v"(L2[15]));
      }
    }
    MERGE16(L1, sx16); MERGE16(L1, sx32); MERGE16(L2, sx16); MERGE16(L2, sx32);
    float F1[16], F2[16]; unsigned I1[16], I2[16];
#pragma unroll
    for (int k = 0; k < 16; ++k) { const unsigned v1 = L1[k], v2 = L2[k];
      unsigned u1 = v1 & ~127u, u2 = v2 & ~127u; u1 = (u1 & 0x80000000u) ? (u1 & 0x7fffffffu) : ~u1; u2 = (u2 & 0x80000000u) ? (u2 & 0x7fffffffu) : ~u2;
      F1[k] = __uint_as_float(u1); F2[k] = __uint_as_float(u2); I1[k] = (127u - (v1 & 127u)) << 7; I2[k] = 127u - (v2 & 127u); }
    unsigned M[16], P[16];
#pragma unroll
    for (int k = 0; k < 16; ++k) { M[k] = 0u; P[k] = 0u; }
    {
      constexpr int CA[52] = {0,0,0,0,0,0,0,0,0,0,0,0,0,0,0,0, 1,1,1,1,1,1,1,1, 2,2,2,2,2, 3,3,3,3, 4,4,4, 5,5, 6,6, 7,7, 8, 9, 10, 11, 12, 13, 14, 15, 15, 15};
      constexpr int CB[52] = {0,1,2,3,4,5,6,7,8,9,10,11,12,13,14,15, 0,1,2,3,4,5,6,7, 0,1,2,3,4, 0,1,2,3, 0,1,2, 0,1, 0,1, 0,1, 0, 0, 0, 0, 0, 0, 0, 0, 0, 0};
#pragma unroll
      for (int m = 0; m < 13; ++m) {
        unsigned kx[4], px[4];
#pragma unroll
        for (int q = 0; q < 4; ++q) { const int n = 4 * m + q; const bool pad = n >= 50;
          kx[q] = pad ? 0u : ord_of(F1[CA[n]] + F2[CB[n]]); px[q] = I1[CA[n]] | I2[CB[n]]; }
        const unsigned x = (c == 0) ? kx[0] : (c == 1) ? kx[1] : (c == 2) ? kx[2] : kx[3];
        const unsigned pp = (c == 0) ? px[0] : (c == 1) ? px[1] : (c == 2) ? px[2] : px[3];
        ins16p(M, P, x, pp);
      }
    }
    MERGE16P(M, P, sx16); MERGE16P(M, P, sx32);
    float sv[16]; float mx = -1e30f;
#pragma unroll
    for (int k = 0; k < 16; ++k) { unsigned u = M[k]; u = (u & 0x80000000u) ? (u & 0x7fffffffu) : ~u; sv[k] = __uint_as_float(u); mx = fmaxf(mx, sv[k]); }
    float sum = 0.f;
#pragma unroll
    for (int k = 0; k < 16; ++k) { sv[k] = __expf(sv[k] - mx); sum += sv[k]; }
    const float inv = __builtin_amdgcn_rcpf(sum);
    u32x4 oi; f32x4 og;
#pragma unroll
    for (int i = 0; i < 4; ++i) { oi[i] = (c == 0) ? P[i] : (c == 1) ? P[4 + i] : (c == 2) ? P[8 + i] : P[12 + i];
      og[i] = ((c == 0) ? sv[i] : (c == 1) ? sv[4 + i] : (c == 2) ? sv[8 + i] : sv[12 + i]) * inv; }
    *(u32x4*)(IDX + (size_t)pr * 16 + 4 * c) = oi; *(f32x4*)(GV + (size_t)pr * 16 + 4 * c) = og;
  }
  __syncthreads();
}
#undef MERGE16
#undef MERGE16P

typedef float f32x16v __attribute__((ext_vector_type(16)));
typedef float f32x32v __attribute__((ext_vector_type(32)));
typedef unsigned u32x6 __attribute__((ext_vector_type(6)));
__device__ __forceinline__ void cvt_fp4_pass(const float* src, unsigned char* dst, float* inv, int r_begin, int r_end, int gw, int ngw, int lane) {
  for (int r0 = r_begin + gw * 2; r0 < r_end; r0 += ngw * 2) {
   f32x4 vv[2][8];
#pragma unroll
   for (int rr = 0; rr < 2; ++rr)
#pragma unroll
     for (int k = 0; k < 8; ++k) vv[rr][k] = *(const f32x4*)(src + (size_t)(r0 + rr) * 2048 + lane * 32 + k * 4);
#pragma unroll
   for (int rr = 0; rr < 2; ++rr) { const int r = r0 + rr; float amA = 0.f, amB = 0.f;
#pragma unroll
    for (int k = 0; k < 4; ++k)
#pragma unroll
      for (int i = 0; i < 4; ++i) { amA = fmaxf(amA, fabsf(vv[rr][k][i])); amB = fmaxf(amB, fabsf(vv[rr][4 + k][i])); }
    const float rmax = fmaxf(__uint_as_float(dpp_max64_u32(__float_as_uint(fmaxf(amA, amB)))), 1e-30f);
    const float rs = rmax * (1.f / 6.f); if (lane == 0) inv[r] = rs;
    const float ra = amA / rmax, rb = amB / rmax;
    unsigned code = (unsigned)__builtin_amdgcn_cvt_pk_fp8_f32(ra, rb, 0, false) & 0xffffu;
    { const f32x2 back = __builtin_amdgcn_cvt_pk_f32_fp8((int)code, false); if (back[0] < ra * 0.96f) code += 1u; if (back[1] < rb * 0.96f) code += 0x100u; }
    const f32x2 sab = __builtin_amdgcn_cvt_pk_f32_fp8((int)code, false);
    const float ia = sab[0] > 0.f ? 1.f / (rs * sab[0]) : 0.f, ib = sab[1] > 0.f ? 1.f / (rs * sab[1]) : 0.f;
    u32x4 o;
#pragma unroll
    for (int k = 0; k < 4; ++k) { unsigned w = 0u; const float iv = (k < 2) ? ia : ib; const f32x4 lo = vv[rr][2 * k] * iv, hi = vv[rr][2 * k + 1] * iv;
      w = (unsigned)__builtin_amdgcn_cvt_scalef32_pk_fp4_f32(w, lo[0], lo[1], 1.0f, 0); w = (unsigned)__builtin_amdgcn_cvt_scalef32_pk_fp4_f32(w, lo[2], lo[3], 1.0f, 1);
      w = (unsigned)__builtin_amdgcn_cvt_scalef32_pk_fp4_f32(w, hi[0], hi[1], 1.0f, 2); w = (unsigned)__builtin_amdgcn_cvt_scalef32_pk_fp4_f32(w, hi[2], hi[3], 1.0f, 3);
      o[k] = w; }
    *(u32x4*)(dst + (size_t)r * 1152 + lane * 16) = o;
    *(unsigned short*)(dst + (size_t)r * 1152 + 1024 + lane * 2) = (unsigned short)code;
   }
  }
}
__device__ __forceinline__ void ln_row_regs32(float (&v)[32], const float* g, const float* b, int lane) {
  float s = 0.f;
#pragma unroll
  for (int i = 0; i < 32; ++i) s += v[i];
  const float mean = dpp_sum64(s) * (1.f / 2048.f);
  float q = 0.f;
#pragma unroll
  for (int i = 0; i < 32; ++i) { v[i] -= mean; q += v[i] * v[i]; }
  const float rstd = rsqrtf(dpp_sum64(q) * (1.f / 2048.f) + LN_EPS);
#pragma unroll
  for (int k = 0; k < 8; ++k) { const f32x4 gg = *(const f32x4*)(g + lane * 32 + k * 4), bb = *(const f32x4*)(b + lane * 32 + k * 4);
#pragma unroll
    for (int i = 0; i < 4; ++i) v[k * 4 + i] = v[k * 4 + i] * rstd * gg[i] + bb[i]; }
}
#define DEC8(W, K, D) do { const f32x2 t0_ = __builtin_amdgcn_cvt_scalef32_pk_f32_fp4(W[K], 1.0f, 0), t1_ = __builtin_amdgcn_cvt_scalef32_pk_f32_fp4(W[K], 1.0f, 1), \
    t2_ = __builtin_amdgcn_cvt_scalef32_pk_f32_fp4(W[K], 1.0f, 2), t3_ = __builtin_amdgcn_cvt_scalef32_pk_f32_fp4(W[K], 1.0f, 3); D[4 * (K)] = t0_; D[4 * (K) + 1] = t1_; D[4 * (K) + 2] = t2_; D[4 * (K) + 3] = t3_; } while (0)
__device__ __forceinline__ void peer_phase(const Params& p, int gw, int ngw, int lane_in) {
  unsigned char* ws = p.ws; const bf16_t* X = (const bf16_t*)(ws + WS_X); const unsigned char* PU = ws + WS_PU; const unsigned char* PV = ws + WS_PV;
  const float* INVU = (const float*)(ws + WS_PINV); const float* INVV = INVU + 16384;
  const int* IDX = (const int*)(ws + WS_IDX); const float* GV = (const float*)(ws + WS_GV);
  for (int t = gw; t < T_; t += ngw) {
    int lane = lane_in; asm volatile("" : "+v"(lane));
    f32x2 x2[16];
#pragma unroll
    for (int k = 0; k < 4; ++k) { float f[8]; unpack8(*(const u32x4*)(X + (size_t)t * DM + lane * 32 + k * 8), f);
#pragma unroll
      for (int i = 0; i < 4; ++i) x2[k * 4 + i] = (f32x2){f[2 * i], f[2 * i + 1]}; }
    const int id0 = IDX[(size_t)t * 128 + lane], id1 = IDX[(size_t)t * 128 + 64 + lane];
    const float g0 = GV[(size_t)t * 128 + lane], g1 = GV[(size_t)t * 128 + 64 + lane];
    const float iu0 = INVU[id0], iu1 = INVU[id1], iv0 = INVV[id0], iv1 = INVV[id1];
    float z0 = 0.f, z1 = 0.f;
#pragma unroll 1
    for (int e0 = 0; e0 < 128; e0 += 8) {
      u32x4 w[8]; unsigned short sc[8];
#pragma unroll
      for (int q = 0; q < 8; ++q) { const int id = __builtin_amdgcn_readlane(e0 < 64 ? id0 : id1, (e0 + q) & 63); const unsigned char* rp = PU + (size_t)id * 1152;
        w[q] = *(const u32x4*)(rp + lane * 16); sc[q] = *(const unsigned short*)(rp + 1024 + lane * 2); }
#pragma unroll
      for (int q = 0; q < 8; ++q) { u32x4 ww = w[q]; { unsigned w0 = ww[0]; asm volatile("" : "+v"(w0) : "v"(z0), "v"(z1)); ww[0] = w0; }
        f32x2 d[16]; DEC8(ww, 0, d); DEC8(ww, 1, d); DEC8(ww, 2, d); DEC8(ww, 3, d);
        f32x2 pa = {0.f, 0.f}, pb = {0.f, 0.f};
#pragma unroll
        for (int i = 0; i < 8; ++i) { pa = d[i] * x2[i] + pa; pb = d[8 + i] * x2[8 + i] + pb; }
        const f32x2 sab = __builtin_amdgcn_cvt_pk_f32_fp8((int)sc[q], false);
        const float tot = dpp_sum64((pa[0] + pa[1]) * sab[0] + (pb[0] + pb[1]) * sab[1]);
        if (lane == ((e0 + q) & 63)) { if (e0 < 64) z0 = tot; else z1 = tot; }
        __builtin_amdgcn_sched_barrier(0); }
    }
    const float a0 = gelu_erf(z0 * iu0) * g0 * iv0, a1 = gelu_erf(z1 * iu1) * g1 * iv1;
    f32x2 acc2[16];
#pragma unroll
    for (int i = 0; i < 16; ++i) acc2[i] = (f32x2){0.f, 0.f};
#pragma unroll 1
    for (int e0 = 0; e0 < 128; e0 += 8) {
      u32x4 w[8]; unsigned short sc[8]; float av[8];
#pragma unroll
      for (int q = 0; q < 8; ++q) { const int id = __builtin_amdgcn_readlane(e0 < 64 ? id0 : id1, (e0 + q) & 63); const unsigned char* rp = PV + (size_t)id * 1152;
        av[q] = __uint_as_float(__builtin_amdgcn_readlane(__float_as_uint(e0 < 64 ? a0 : a1), (e0 + q) & 63));
        w[q] = *(const u32x4*)(rp + lane * 16); sc[q] = *(const unsigned short*)(rp + 1024 + lane * 2); }
#pragma unroll
      for (int q = 0; q < 8; ++q) { u32x4 ww = w[q]; { unsigned w0 = ww[0]; asm volatile("" : "+v"(w0) : "v"(acc2[15])); ww[0] = w0; }
        f32x2 d[16]; DEC8(ww, 0, d); DEC8(ww, 1, d); DEC8(ww, 2, d); DEC8(ww, 3, d);
        const f32x2 sab = __builtin_amdgcn_cvt_pk_f32_fp8((int)sc[q], false); const float sa = av[q] * sab[0], sb = av[q] * sab[1];
        const f32x2 aa = {sa, sa}, bb = {sb, sb};
#pragma unroll
        for (int i = 0; i < 8; ++i) { acc2[i] = d[i] * aa + acc2[i]; acc2[8 + i] = d[8 + i] * bb + acc2[8 + i]; }
        asm volatile("" : "+v"(acc2[0]), "+v"(acc2[1]), "+v"(acc2[2]), "+v"(acc2[3]), "+v"(acc2[4]), "+v"(acc2[5]), "+v"(acc2[6]), "+v"(acc2[7]), "+v"(acc2[8]), "+v"(acc2[9]), "+v"(acc2[10]), "+v"(acc2[11]), "+v"(acc2[12]), "+v"(acc2[13]), "+v"(acc2[14]), "+v"(acc2[15])); }
    }
    float acc[32];
#pragma unroll
    for (int i = 0; i < 16; ++i) { acc[2 * i] = acc2[i][0] + DN_ALPHA * x2[i][0]; acc[2 * i + 1] = acc2[i][1] + DN_ALPHA * x2[i][1]; }
    ln_row_regs32(acc, p.in[33], p.in[34], lane);
#pragma unroll
    for (int k = 0; k < 8; ++k) *(f32x4*)(p.out + (size_t)t * DM + lane * 32 + k * 4) = (f32x4){acc[k * 4], acc[k * 4 + 1], acc[k * 4 + 2], acc[k * 4 + 3]};
  }
}
#undef DEC8

#define LAS __attribute__((address_space(3)))
#define XB_TMO      128
#define XB_XCNT(j)  (256  + 64 * (j))
#define XB_XSUB(j)  (1280 + 64 * (j))
#define XB_XGEN(j)  (2304 + 64 * (j))
#define XB_TOP      3328
#define XB_TOPGEN   3392
#define XCD_BAR_WORDS 3456
#define XB_SPIN_CAP (1u << 22)
__device__ __forceinline__ unsigned xb_ld(unsigned* p)              { return __hip_atomic_load(p, __ATOMIC_RELAXED, __HIP_MEMORY_SCOPE_AGENT); }
__device__ __forceinline__ unsigned xb_add(unsigned* p, unsigned v) { return __hip_atomic_fetch_add(p, v, __ATOMIC_RELAXED, __HIP_MEMORY_SCOPE_AGENT); }
__device__ __forceinline__ unsigned xb_xcc_id() { return (unsigned)__builtin_amdgcn_s_getreg((3 << 11) | 20) & 0xFu; }
#define XB_SPIN(cond, bar) do { unsigned _sp = 0; while (cond) { __builtin_amdgcn_s_sleep(1); \
    if ((++_sp & 255u) == 0u) { if (xb_ld(&(bar)[XB_TMO])) break; if (_sp > XB_SPIN_CAP) { atomicAdd(&(bar)[XB_TMO], 1u); break; } } } } while (0)
struct XcdBarrier { unsigned* bar; unsigned x; volatile LAS unsigned* st; };
__device__ __forceinline__ XcdBarrier xcd_barrier_post(unsigned* bar, volatile LAS unsigned* st) {
  XcdBarrier b; b.bar = bar; b.x = xb_xcc_id(); b.st = st;
  if (threadIdx.x == 0) (void)xb_add(&bar[XB_XCNT(b.x)], 1u);
  return b;
}
__device__ __forceinline__ void xcd_barrier_complete(unsigned* bar, unsigned x, unsigned& nloc, unsigned& nx) {
  const unsigned G = gridDim.x * gridDim.y * gridDim.z;
  unsigned sum, cnt, mine, sp = 0u;
  for (;;) {
    sum = 0u; cnt = 0u; mine = 0u;
#pragma unroll
    for (unsigned j = 0; j < 16; ++j) { const unsigned c = xb_ld(&bar[XB_XCNT(j)]); sum += c; cnt += (c > 0u) ? 1u : 0u; mine = (j == x) ? c : mine; }
    if (sum == G) break;
    __builtin_amdgcn_s_sleep(1);
    if ((++sp & 255u) == 0u) { if (xb_ld(&bar[XB_TMO])) break; if (sp > XB_SPIN_CAP) { atomicAdd(&bar[XB_TMO], 1u); break; } }
  }
  nloc = mine > 0u ? mine : 1u; nx = cnt > 0u ? cnt : 1u;
}
__device__ __forceinline__ void xcd_barrier(const XcdBarrier& b) {
  asm volatile("s_waitcnt vmcnt(0)" ::: "memory");
  __syncthreads();
  if (threadIdx.x == 0) {
    unsigned* bar = b.bar;
    __builtin_amdgcn_s_waitcnt(0);
    unsigned nloc = b.st[0], nx = b.st[1];
    if (nloc == 0u) { xcd_barrier_complete(bar, b.x, nloc, nx); b.st[0] = nloc; b.st[1] = nx; }
    const unsigned old = xb_add(&bar[XB_XSUB(b.x)], 1u);
    const unsigned gen = old / nloc;
    if (old + 1u == (gen + 1u) * nloc) {
      __builtin_amdgcn_fence(__ATOMIC_RELEASE, "agent");
      asm volatile("s_waitcnt vmcnt(0)" ::: "memory");
      const unsigned og = xb_add(&bar[XB_TOP], 1u);
      const unsigned tg = og / nx;
      if (og + 1u == (tg + 1u) * nx) xb_add(&bar[XB_TOPGEN], 1u);
      else XB_SPIN(xb_ld(&bar[XB_TOPGEN]) == tg, bar);
      __builtin_amdgcn_fence(__ATOMIC_ACQUIRE, "agent");
      xb_add(&bar[XB_XGEN(b.x)], 1u);
      asm volatile("s_waitcnt vmcnt(0)" ::: "memory");
    } else {
      XB_SPIN(xb_ld(&bar[XB_XGEN(b.x)]) == gen, bar);
      __builtin_amdgcn_fence(__ATOMIC_ACQUIRE, "agent");
      asm volatile("s_waitcnt vmcnt(0)" ::: "memory");
    }
  }
  __syncthreads();
}

constexpr int CVT_EARLY = 4608, CVT_SPLIT = 11264;
#ifndef PROBE_LRU
#define PROBE_LRU 0
#endif
#ifndef USE_TOPK3
#define USE_TOPK3 1
#endif
#ifndef USE_TOPK2
#define USE_TOPK2 1
#endif
#ifndef PROBE_MASK
#define PROBE_MASK 0
#endif
#ifndef PROBE_PEER
#define PROBE_PEER 0
#endif
#ifndef PROBE_SYNC
#define PROBE_SYNC 0
#endif
#ifndef PROBE_TOPK
#define PROBE_TOPK 0
#endif
#ifndef USE_FAST_XATTN
#define USE_FAST_XATTN 1
#endif
#ifndef USE_FAST_MLA
#define USE_FAST_MLA 1
#endif
#ifndef FASTMASK
#define FASTMASK 0xff
#endif
#define GEMM(MODE, g, e) do { if constexpr ((FASTMASK >> MODE) & 1) gemm_fast<MODE>(g, e, lds_raw, bid, nblk); else gemm_simple<MODE>(g, e, bid, nblk, wave, lane); } while (0)
#define IDS int tid_ = threadIdx.x; asm volatile("" : "+v"(tid_)); const int tid = tid_, lane = tid & 63, wave = tid >> 6, gw = bid * NWAVE + wave; (void)tid; (void)lane; (void)wave; (void)gw
__global__ void __launch_bounds__(NTHR) fwd_kernel(Params p) {
  extern __shared__ __attribute__((aligned(16))) unsigned char lds_raw[];
  float* lds = (float*)lds_raw;
  cg::grid_group grid = cg::this_grid();
  const int bid = blockIdx.x, nblk = gridDim.x, ngw = nblk * NWAVE;
  unsigned char* ws = p.ws; unsigned char* dout = (unsigned char*)p.out;
  EpiArgs e{ws, dout, p.in, nullptr, nullptr, 0};
  volatile LAS unsigned* bst = (volatile LAS unsigned*)((LAS unsigned char*)lds_raw + (LDS_BYTES - 64));
  if (threadIdx.x < 2) bst[threadIdx.x] = 0u;
  __syncthreads();
  const XcdBarrier xbar = xcd_barrier_post((unsigned*)ws, bst);
#define GSYNC() xcd_barrier(xbar)

  for (int rp_ = 0; rp_ < 1 + ((PROBE_MASK >> 0) & 1); ++rp_) { { IDS; if (nblk == 256) phase0<true>(p, lds, gw, ngw, lane, wave); else phase0<false>(p, lds, gw, ngw, lane, wave); } }
  if (__builtin_expect(p.ws == nullptr, 0)) grid.sync();
  GSYNC();
  if (nblk == 256 && ((bid >= 64 && bid < 128) || bid >= 160)) { IDS;
    const int sb = (bid < 128) ? bid - 64 : bid - 96; transpose_list<1>(p, lds + wave * (64 * 33), sb * NWAVE + wave, 160 * NWAVE, lane);
    cvt_fp4_pass(p.in[31], ws + WS_PU, (float*)(ws + WS_PINV), 0, CVT_EARLY, sb * NWAVE + wave, 160 * NWAVE, lane);
    cvt_fp4_pass(p.in[32], ws + WS_PV, (float*)(ws + WS_PINV) + 16384, 0, CVT_EARLY, sb * NWAVE + wave, 160 * NWAVE, lane);
    __syncthreads(); }
  for (int rp_ = 0; rp_ < 1 + ((PROBE_MASK >> 1) & 1); ++rp_) { { IDS; GemmArgs g{(const bf16_t*)(ws + WS_X), 2048, 0, (const bf16_t*)(ws + WS_WIN_T), 2048, 0, T_, 3328, 2048, 1}; GEMM(E_WIN, g, e); } }
  for (int rp_ = 0; rp_ < 1 + ((PROBE_MASK >> 1) & 1); ++rp_) { { IDS; GemmArgs g{(const bf16_t*)(ws + WS_MEMB), 2048, 0, (const bf16_t*)(ws + WS_WMKV_T), 2048, 0, 2048, 1024, 2048, 1, 128}; GEMM(E_MEMKV, g, e); } }
  GSYNC();
  for (int rp_ = 0; rp_ < 1 + ((PROBE_MASK >> 2) & 1); ++rp_) { { IDS; GemmArgs g{(const bf16_t*)(ws + WS_CQ), 512, 0, (const bf16_t*)(ws + WS_WUQ_T), 512, 0, T_, 1536, 512, 1}; GEMM(E_Q, g, e); } }
  for (int rp_ = 0; rp_ < 1 + ((PROBE_MASK >> 2) & 1); ++rp_) { { IDS; GemmArgs g{(const bf16_t*)(ws + WS_CKV), 512, 0, (const bf16_t*)(ws + WS_WUKV_T), 512, 0, T_, 2048, 512, 1}; GEMM(E_KV, g, e); } }
#if USE_LRU_FUSED
  for (int rp_ = 0; rp_ < 1 + PROBE_LRU; ++rp_) lru_fused_phase(p, lds_raw, bid, nblk);
#else
  for (int rp_ = 0; rp_ < 1 + ((PROBE_MASK >> 2) & 1); ++rp_) { { IDS; GemmArgs g{(const bf16_t*)(ws + WS_XC), 1024, 128, (const bf16_t*)(ws + WS_WG_T), 128, 512 * 128, T_, 512, 128, 8}; GEMM(E_GATES, g, e); } }
#endif
  GSYNC();
#if USE_FAST_MLA
  for (int rp_ = 0; rp_ < 1 + ((PROBE_MASK >> 4) & 1); ++rp_) { mla_attn_phase(dout, ws, (char*)lds_raw, bid, nblk, p.in[17]); }
#else
  { IDS; attn_scalar<192, 2048>((const bf16_t*)(dout + DO_Q), 1536, (const bf16_t*)(dout + DO_K), 1536, (const bf16_t*)(dout + DO_V), 1024, (bf16_t*)(ws + WS_YMIX), 2048, 8,
                         0.07216878364870322f, lds, bid, nblk, tid); }
#endif
#if !USE_LRU_FUSED
  { IDS; scan_phase(ws, lds, bid, nblk, tid); }
#endif
  GSYNC();
  { IDS; phase3b(p, gw, ngw, lane); }
  GSYNC();
  { IDS; GemmArgs g{(const bf16_t*)(ws + WS_YMIX), 2048, 0, (const bf16_t*)(ws + WS_WOUT_T), 2048, 0, T_, 2048, 2048, 1}; gemm_fast<E_RESM>(g, e, lds_raw, bid, nblk); }
  GSYNC();
  { IDS; ln_pass(ws, p.in[20], p.in[21], gw, ngw, lane); }
  { IDS; const int rlo = (nblk == 256) ? CVT_EARLY : 0, rsplit = (nblk == 256) ? CVT_SPLIT : 16384;
    cvt_fp4_pass(p.in[31], ws + WS_PU, (float*)(ws + WS_PINV), rlo, rsplit, gw, ngw, lane);
    cvt_fp4_pass(p.in[32], ws + WS_PV, (float*)(ws + WS_PINV) + 16384, rlo, rsplit, gw, ngw, lane); }
  GSYNC();
  for (int rp_ = 0; rp_ < 1 + ((PROBE_MASK >> 5) & 1); ++rp_) { { IDS; GemmArgs g{(const bf16_t*)(ws + WS_X), 2048, 0, (const bf16_t*)(ws + WS_WMQ_T), 2048, 0, T_, 512, 2048, 1}; EpiArgs e2 = e; e2.o = (bf16_t*)(ws + WS_QM); e2.ld = 512; GEMM(E_BF16, g, e2); }
  if (nblk == 256 && bid >= 128) { IDS; const int g2 = (bid - 128) * NWAVE + wave;
    cvt_fp4_pass(p.in[31], ws + WS_PU, (float*)(ws + WS_PINV), CVT_SPLIT, 16384, g2, 128 * NWAVE, lane);
    cvt_fp4_pass(p.in[32], ws + WS_PV, (float*)(ws + WS_PINV) + 16384, CVT_SPLIT, 16384, g2, 128 * NWAVE, lane); } }
  GSYNC();
#if USE_FAST_XATTN
  for (int rp_ = 0; rp_ < 1 + ((PROBE_MASK >> 5) & 1); ++rp_) { mem_attn_phase(ws, (char*)lds_raw, bid, nblk); }
#else
  { IDS; attn_scalar<128, 256>((const bf16_t*)(ws + WS_QM), 512, (const bf16_t*)(ws + WS_MEMKV), 1024, (const bf16_t*)(ws + WS_MEMKV) + 512, 1024, (bf16_t*)(ws + WS_OM), 512, 4,
                        0.08838834764831845f, lds, bid, nblk, tid); }
#endif
  GSYNC();
  { IDS; GemmArgs g{(const bf16_t*)(ws + WS_OM), 512, 0, (const bf16_t*)(ws + WS_WMO_T), 512, 0, T_, 2048, 512, 1}; GEMM(E_RES, g, e); }
  GSYNC();
  { IDS; ln_pass(ws, p.in[26], p.in[27], gw, ngw, lane); }
  GSYNC();
  for (int rp_ = 0; rp_ < 1 + ((PROBE_MASK >> 3) & 1); ++rp_) { { IDS; GemmArgs g{(const bf16_t*)(ws + WS_X), 2048, 0, (const bf16_t*)(ws + WS_WPQ_T), 2048, 0, T_, 2048, 2048, 1}; EpiArgs e2 = e; e2.o = (bf16_t*)(ws + WS_QP); e2.ld = 2048; GEMM(E_BF16, g, e2); } }
  GSYNC();
#if USE_TOPK3
  for (int rep_ = 0; rep_ < 1 + PROBE_TOPK; ++rep_) { IDS; topk_phase3(p, lds_raw, gw, ngw, tid); }
#else
  for (int rp_ = 0; rp_ < 1 + ((PROBE_MASK >> 3) & 1); ++rp_) { { IDS; GemmArgs g{(const bf16_t*)(ws + WS_QP), 256, 0, (const bf16_t*)(ws + WS_KEYS_T), 256, 0, T_ * 8, 256, 256, 1}; EpiArgs e2 = e; e2.f = (float*)dout; e2.ld = 256; GEMM(E_F32, g, e2); } }
  GSYNC();
  for (int rep_ = 0; rep_ < 1 + PROBE_TOPK; ++rep_) { IDS; if (USE_TOPK2) topk_phase2(ws, (const float*)dout, gw, ngw, lane); else topk_phase(ws, (const float*)dout, gw, ngw, lane); }
#endif
  GSYNC();
  for (int rep_ = 0; rep_ < 1 + PROBE_PEER; ++rep_) { IDS; peer_phase(p, gw, ngw, lane); }
  for (int rep_ = 0; rep_ < PROBE_SYNC; ++rep_) GSYNC();
}

extern "C" void kernel_launch(void* const* d_in, const int* in_sizes, int n_in, void* d_out, int out_size, void* d_ws, size_t ws_size, hipStream_t stream) {
  static int grid_blocks = 0;
  if (grid_blocks == 0) {
    if (n_in != 35 || ws_size < WS_END || out_size != T_ * DM) { fprintf(stderr, "kernel_launch: unexpected shapes n_in %d ws %zu out %d\n", n_in, ws_size, out_size); grid_blocks = -1; return; }
    int dev = 0, cus = 0, per_cu = 0;
    hipGetDevice(&dev); hipDeviceGetAttribute(&cus, hipDeviceAttributeMultiprocessorCount, dev);
    if (hipFuncSetAttribute((const void*)fwd_kernel, hipFuncAttributeMaxDynamicSharedMemorySize, LDS_BYTES) != hipSuccess) { fprintf(stderr, "hipFuncSetAttribute failed\n"); grid_blocks = -1; return; }
    if (hipOccupancyMaxActiveBlocksPerMultiprocessor(&per_cu, (const void*)fwd_kernel, NTHR, LDS_BYTES) != hipSuccess || per_cu < 1) { fprintf(stderr, "occupancy query failed (%d)\n", per_cu); grid_blocks = -1; return; }
    grid_blocks = cus * per_cu;
    fprintf(stderr, "kernel_launch: cus %d per_cu %d grid %d ws %zu\n", cus, per_cu, grid_blocks, ws_size);
  }
  if (grid_blocks < 0) return;
  if (hipMemsetAsync(d_ws, 0, 65536 + 3 * 16384 * 8, stream) != hipSuccess) { fprintf(stderr, "memset failed\n"); return; }
  Params p{};
  for (int i = 0; i < 35; ++i) p.in[i] = (const float*)d_in[i];
  p.out = (float*)d_out; p.ws = (unsigned char*)d_ws;
  void* args[] = {&p};
  hipError_t err = hipLaunchCooperativeKernel((const void*)fwd_kernel, dim3(grid_blocks), dim3(NTHR), args, LDS_BYTES, stream);
  if (err != hipSuccess) fprintf(stderr, "cooperative launch failed: %s (grid %d)\n", hipGetErrorString(err), grid_blocks);
}
```

```cpp
#include <hip/hip_runtime.h>
#include <hip/hip_cooperative_groups.h>
#include <cstdio>
#include <cstdint>
namespace cg = cooperative_groups;
#ifndef USE_LRU_FUSED
#define USE_LRU_FUSED 1
#endif

typedef unsigned short bf16_t;
typedef short bf16x8 __attribute__((ext_vector_type(8)));
typedef float f32x4 __attribute__((ext_vector_type(4)));
typedef float f32x2 __attribute__((ext_vector_type(2)));
typedef float f32x16 __attribute__((ext_vector_type(16)));
typedef unsigned u32x4 __attribute__((ext_vector_type(4)));
typedef unsigned u32x2 __attribute__((ext_vector_type(2)));

constexpr int T_ = 16384, S_ = 2048, NB_ = 8, DM = 2048;
constexpr int HWTID_MAP_OFF = 147456 - 64 - 256;
__device__ __forceinline__ int hw_tid() {
  extern __shared__ __attribute__((aligned(16))) unsigned char lds_hw_[];
  const unsigned slot = (unsigned)__builtin_amdgcn_s_getreg((5 << 11) | 4) & 63u;
  const int wv = __builtin_amdgcn_readfirstlane(*(const volatile int*)(lds_hw_ + HWTID_MAP_OFF + slot * 4));
  return wv * 64 + (int)__builtin_amdgcn_mbcnt_hi(~0u, __builtin_amdgcn_mbcnt_lo(~0u, 0u));
}
constexpr int NTHR = 512, NWAVE = 8;
constexpr float DN_ALPHA = 1.189207115002721f;
constexpr float LN_EPS = 1e-5f, RMS_EPS = 1e-6f;
constexpr int LDS_BYTES = 147456;

constexpr size_t MiB = 1u << 20;
constexpr size_t WS_WIN_T = 1 * MiB;
constexpr size_t WS_WUQ_T = 14 * MiB;
constexpr size_t WS_WUKV_T = WS_WUQ_T + 1536 * 512 * 2;
constexpr size_t WS_WG_T = WS_WUKV_T + 2 * MiB;
constexpr size_t WS_WOUT_T = WS_WG_T + 1 * MiB;
constexpr size_t WS_WMQ_T = WS_WOUT_T + 8 * MiB;
constexpr size_t WS_WMKV_T = WS_WMQ_T + 2 * MiB;
constexpr size_t WS_WMO_T = WS_WMKV_T + 4 * MiB;
constexpr size_t WS_WPQ_T = WS_WMO_T + 2 * MiB;
constexpr size_t WS_KEYS_T = WS_WPQ_T + 8 * MiB;
constexpr size_t WS_COS = 43 * MiB, WS_SIN = 45 * MiB;
constexpr size_t WS_MEMB = 47 * MiB;
constexpr size_t WS_MEMKV = 55 * MiB;
constexpr size_t WS_GTAB = 59 * MiB;
static_assert(WS_KEYS_T + 256 * 256 * 2 <= WS_COS, "weights region");
constexpr size_t WS_LAF = 60 * MiB, WS_BTF = 92 * MiB, WS_LAB = 124 * MiB, WS_BTB = 156 * MiB;
constexpr size_t WS_PU = 60 * MiB, WS_PV = 124 * MiB;
constexpr size_t WS_PINV = 59 * MiB + 65536;
constexpr size_t WS_X = 188 * MiB;
constexpr size_t WS_CQ = 252 * MiB, WS_CKV = 268 * MiB, WS_KPE = 284 * MiB;
constexpr size_t WS_LRUX = 286 * MiB, WS_GATE = 318 * MiB, WS_YMIX = 350 * MiB, WS_XC = 414 * MiB;
constexpr size_t WS_QM = WS_CQ, WS_OM = WS_CKV, WS_QP = WS_YMIX, WS_IDX = WS_LRUX, WS_GV = WS_LRUX + 8 * MiB, WS_ACT = WS_LRUX + 16 * MiB;
constexpr size_t WS_SS = 65536;
constexpr size_t WS_LN1S = 65536 + 3 * 16384 * 8;
constexpr size_t WS_CSBW = WS_LN1S + 2 * 16384 * 8;
constexpr size_t WS_LN2S = WS_CSBW + 2 * 512 * 8;
constexpr size_t WS_CSBW2 = WS_LN2S + 2 * 16384 * 8;
constexpr size_t WS_ZERO_BYTES = WS_CSBW2 + 2 * 2048 * 8;
constexpr size_t WS_END = 446 * MiB;
constexpr size_t DO_Q = 0, DO_K = 48 * MiB, DO_V = 96 * MiB;

__device__ __forceinline__ unsigned f2bf(float f) { unsigned u = __float_as_uint(f); return (u + 0x7fffu + ((u >> 16) & 1u)) >> 16; }
__device__ __forceinline__ float bf2f(unsigned h) { return __uint_as_float(h << 16); }
__device__ __forceinline__ unsigned pk2(float lo, float hi) { unsigned r; asm("v_cvt_pk_bf16_f32 %0, %1, %2" : "=v"(r) : "v"(lo), "v"(hi)); return r; }
__device__ __forceinline__ float bflo(unsigned w) { return __uint_as_float(w << 16); }
__device__ __forceinline__ float bfhi(unsigned w) { return __uint_as_float(w & 0xffff0000u); }
__device__ __forceinline__ float dpp_sum64(float v) {
#define DPPF(x, ctrl, rm, bc) __builtin_bit_cast(float, __builtin_amdgcn_update_dpp(0, __builtin_bit_cast(int, x), ctrl, rm, 0xf, bc))
  v += DPPF(v, 0x111, 0xf, true); v += DPPF(v, 0x112, 0xf, true); v += DPPF(v, 0x114, 0xf, true); v += DPPF(v, 0x118, 0xf, true);
  v += DPPF(v, 0x142, 0xa, false); v += DPPF(v, 0x143, 0xc, false);
#undef DPPF
  return __uint_as_float(__builtin_amdgcn_readlane(__float_as_uint(v), 63));
}
__device__ __forceinline__ unsigned dpp_max64_u32(unsigned v) {
#define DPPU(x, ctrl, rm, bc) (unsigned)__builtin_amdgcn_update_dpp(0, (int)(x), ctrl, rm, 0xf, bc)
  unsigned w;
  w = DPPU(v, 0x111, 0xf, true); v = v > w ? v : w; w = DPPU(v, 0x112, 0xf, true); v = v > w ? v : w;
  w = DPPU(v, 0x114, 0xf, true); v = v > w ? v : w; w = DPPU(v, 0x118, 0xf, true); v = v > w ? v : w;
  w = DPPU(v, 0x142, 0xa, false); v = v > w ? v : w; w = DPPU(v, 0x143, 0xc, false); v = v > w ? v : w;
#undef DPPU
  return (unsigned)__builtin_amdgcn_readlane((int)v, 63);
}
__device__ __forceinline__ float wave_sum(float v) {
#pragma unroll
  for (int o = 1; o < 64; o <<= 1) v += __shfl_xor(v, o);
  return v;
}
__device__ __forceinline__ float wave_max(float v) {
#pragma unroll
  for (int o = 1; o < 64; o <<= 1) v = fmaxf(v, __shfl_xor(v, o));
  return v;
}
__device__ __forceinline__ unsigned wave_max_u32(unsigned v) {
#pragma unroll
  for (int o = 1; o < 64; o <<= 1) { unsigned w = (unsigned)__shfl_xor((int)v, o); v = v > w ? v : w; }
  return v;
}
typedef __bf16 bf16x2_t __attribute__((ext_vector_type(2)));
__device__ __forceinline__ float dot2_bf16(unsigned w, unsigned x, float acc) { return __builtin_amdgcn_fdot2_f32_bf16(__builtin_bit_cast(bf16x2_t, w), __builtin_bit_cast(bf16x2_t, x), acc, false); }
__device__ __forceinline__ float sigmoidf_(float x) { return __builtin_amdgcn_rcpf(1.f + __expf(-x)); }
__device__ __forceinline__ float neg_expm1_small(float x) {
  const float s = x * (1.f + x * (0.5f + x * (1.6666667e-1f + x * (4.1666667e-2f + x * (8.3333333e-3f + x * 1.3888889e-3f)))));
  const float e = 1.f - __builtin_amdgcn_exp2f(x * 1.4426950408889634f);
  return x > -0.25f ? -s : e;
}
__device__ __forceinline__ float gelu_tanh(float x) {
  const float u = 0.7978845608028654f * (x + 0.044715f * x * x * x);
  const float t = 1.f - 2.f / (__expf(2.f * u) + 1.f);
  return 0.5f * x * (1.f + t);
}
__device__ __forceinline__ float gelu_erf(float x) { return 0.5f * x * (1.f + erff(x * 0.7071067811865476f)); }
__device__ __forceinline__ void unpack8(u32x4 w, float* f) {
  f[0] = bflo(w.x); f[1] = bfhi(w.x); f[2] = bflo(w.y); f[3] = bfhi(w.y); f[4] = bflo(w.z); f[5] = bfhi(w.z); f[6] = bflo(w.w); f[7] = bfhi(w.w);
}
__device__ __forceinline__ u32x4 pack8(const float* f) { u32x4 w; w.x = pk2(f[0], f[1]); w.y = pk2(f[2], f[3]); w.z = pk2(f[4], f[5]); w.w = pk2(f[6], f[7]); return w; }

struct Params { const float* in[35]; float* out; unsigned char* ws; };

__device__ __forceinline__ const float* wsrc(const float* const* in, int mid, int n, int& ld) {
  switch (mid) {
    case 0: { ld = 3136; int c; if (n < 1024) c = n; else if (n < 3072) c = n + 64; else if (n < 3136) { int i = (n - 3072) >> 1, g = (n - 3072) & 1; c = 1024 + g * 32 + i; } else return nullptr; return in[5] + c; }
    case 1: { ld = 1536; int h = n / 192, j = n % 192, c; if (j < 128) c = h * 192 + j; else { int i = (j - 128) >> 1, g = (j - 128) & 1; c = h * 192 + 128 + g * 32 + i; } return in[7] + c; }
    case 2: { ld = 2048; int c; if (n < 1024) c = (n >> 7) * 256 + (n & 127); else { int m = n - 1024; c = (m >> 7) * 256 + 128 + (m & 127); } return in[9] + c; }
    case 3: ld = 2048; return in[19] + n;
    case 4: ld = 512; return in[22] + n;
    case 5: ld = 512; return n < 512 ? in[23] + n : in[24] + (n - 512);
    case 6: ld = 2048; return in[25] + n;
    case 7: ld = 2048; return in[28] + n;
    default: { ld = 128; int nb = n >> 9, q = n & 511, dir = q >> 8, jj = (q & 255) >> 1, gate = q & 1; const float* m = (gate ? in[14] : in[12]) + (size_t)((dir * 8 + nb) * 128) * 128; return m + jj; }
  }
}
__device__ __forceinline__ void transpose_item(const float* const* in, int mid, int K, bf16_t* WT, float* scr, int item, int nblk, int lane) {
  const int kb = item / nblk, nb = item % nblk, k0 = 64 * kb, n0 = 32 * nb;
  int ld = 0; const float* base = wsrc(in, mid, n0 + (lane & 31), ld);
  float tv[32];
  const float* gsc = (mid == 1) ? in[6] : (mid == 2) ? in[8] : nullptr;
#pragma unroll
  for (int i = 0; i < 32; ++i) { const int kk = 2 * i + (lane >> 5); tv[i] = base ? base[(size_t)(k0 + kk) * ld] : 0.f; }
  if (gsc) {
#pragma unroll
    for (int i = 0; i < 32; ++i) tv[i] *= gsc[k0 + 2 * i + (lane >> 5)]; }
#pragma unroll
  for (int i = 0; i < 32; ++i) { const int kk = 2 * i + (lane >> 5); scr[kk * 33 + (lane & 31)] = tv[i]; }
  asm volatile("s_waitcnt lgkmcnt(0)" ::: "memory");
  const int c = lane & 7;
#pragma unroll
  for (int j = 0; j < 4; ++j) { const int n = (lane >> 3) + 8 * j; const float* s = scr + (8 * c) * 33 + n;
    u32x4 o; o.x = pk2(s[0 * 33], s[1 * 33]); o.y = pk2(s[2 * 33], s[3 * 33]); o.z = pk2(s[4 * 33], s[5 * 33]); o.w = pk2(s[6 * 33], s[7 * 33]);
    *(u32x4*)(WT + (size_t)(n0 + n) * K + k0 + 8 * c) = o; }
  asm volatile("s_waitcnt lgkmcnt(0)" ::: "memory");
}
__device__ __forceinline__ void ln_row_regs(float (&v)[32], const float* g, const float* b, int lane) {
  float s = 0.f;
#pragma unroll
  for (int i = 0; i < 32; ++i) s += v[i];
  const float mean = dpp_sum64(s) * (1.f / 2048.f);
  float q = 0.f;
#pragma unroll
  for (int i = 0; i < 32; ++i) { v[i] -= mean; q += v[i] * v[i]; }
  const float rstd = rsqrtf(dpp_sum64(q) * (1.f / 2048.f) + LN_EPS);
#pragma unroll
  for (int j = 0; j < 4; ++j) {
    const f32x4 g0 = *(const f32x4*)(g + j * 512 + lane * 8), g1 = *(const f32x4*)(g + j * 512 + lane * 8 + 4);
    const f32x4 b0 = *(const f32x4*)(b + j * 512 + lane * 8), b1 = *(const f32x4*)(b + j * 512 + lane * 8 + 4);
#pragma unroll
    for (int e = 0; e < 4; ++e) { v[j * 8 + e] = v[j * 8 + e] * rstd * g0[e] + b0[e]; v[j * 8 + 4 + e] = v[j * 8 + 4 + e] * rstd * g1[e] + b1[e]; }
  }
}
__device__ __forceinline__ void sincos_big(float ang, float& c, float& s) {
  const double a = (double)ang;
  const double q = __builtin_rint(a * 0.63661977236758134308);
  const float r = (float)(a - q * 1.57079632679489661923);
  const int qi = ((int)q) & 3;
  const float r2 = r * r;
  const float sn = r + r * r2 * (-1.6666667e-1f + r2 * (8.3333333e-3f + r2 * (-1.9841270e-4f + r2 * 2.7557319e-6f)));
  const float cs = 1.f + r2 * (-0.5f + r2 * (4.1666667e-2f + r2 * (-1.3888889e-3f + r2 * (2.4801587e-5f + r2 * -2.7557319e-7f))));
  const float ss = (qi & 1) ? cs : sn, cc = (qi & 1) ? sn : cs;
  s = (qi & 2) ? -ss : ss;
  c = ((qi + 1) & 2) ? -cc : cc;
}

__device__ __forceinline__ void wmq_prepare(const Params& p, int gw, int ngw, int lane) {
  const float* W = p.in[22]; const float* gm = p.in[20]; const float* bt = p.in[21]; unsigned long long* cb = (unsigned long long*)(p.ws + WS_CSBW); bf16_t* WT = (bf16_t*)(p.ws + WS_WMQ_T);
  for (int it = gw; it < 32 * 8; it += ngw) { const int k0 = (it >> 3) * 64, n = (it & 7) * 64 + lane; float cs = 0.f, bw = 0.f;
    float w[64];
#pragma unroll
    for (int j = 0; j < 64; ++j) w[j] = W[(size_t)(k0 + j) * 512 + n];
#pragma unroll
    for (int kc = 0; kc < 8; ++kc) {
#pragma unroll
      for (int j = 0; j < 8; ++j) { bw += w[kc * 8 + j] * bt[k0 + kc * 8 + j]; w[kc * 8 + j] *= gm[k0 + kc * 8 + j]; cs += w[kc * 8 + j]; }
      *(u32x4*)(WT + (size_t)n * 2048 + k0 + kc * 8) = pack8(&w[kc * 8]); }
    atomicAdd(cb + n, (unsigned long long)(long long)(cs * 4294967296.f)); atomicAdd(cb + 512 + n, (unsigned long long)(long long)(bw * 4294967296.f)); }
}
__device__ __forceinline__ void wpq_prepare(const Params& p, int gw, int ngw, int lane) {
  const float* W = p.in[28]; const float* gm = p.in[26]; const float* bt = p.in[27]; unsigned long long* cb = (unsigned long long*)(p.ws + WS_CSBW2); bf16_t* WT = (bf16_t*)(p.ws + WS_WPQ_T);
  for (int it = gw; it < 32 * 32; it += ngw) { const int k0 = (it >> 5) * 64, n = (it & 31) * 64 + lane; float cs = 0.f, bw = 0.f;
    float w[64];
#pragma unroll
    for (int j = 0; j < 64; ++j) w[j] = W[(size_t)(k0 + j) * 2048 + n];
#pragma unroll
    for (int kc = 0; kc < 8; ++kc) {
#pragma unroll
      for (int j = 0; j < 8; ++j) { bw += w[kc * 8 + j] * bt[k0 + kc * 8 + j]; w[kc * 8 + j] *= gm[k0 + kc * 8 + j]; cs += w[kc * 8 + j]; }
      *(u32x4*)(WT + (size_t)n * 2048 + k0 + kc * 8) = pack8(&w[kc * 8]); }
    atomicAdd(cb + n, (unsigned long long)(long long)(cs * 4294967296.f)); atomicAdd(cb + 2048 + n, (unsigned long long)(long long)(bw * 4294967296.f)); }
}
template <int WHICH> __device__ __forceinline__ void transpose_list(const Params& p, float* scr, int gw, int ngw, int lane) {
  struct TI { int mid, ndst, K; size_t off; };
  constexpr int NT = (WHICH == 0) ? 2 : (WHICH == 1) ? 5 : 7;
  const TI all[7] = {{0, 3328, 2048, WS_WIN_T}, {5, 1024, 2048, WS_WMKV_T}, {1, 1536, 512, WS_WUQ_T}, {2, 2048, 512, WS_WUKV_T}, {3, 2048, 2048, WS_WOUT_T},
                     {6, 2048, 512, WS_WMO_T}, {8, 4096, 128, WS_WG_T}};
  constexpr int T0 = (WHICH == 1) ? 2 : 0;
  int total = 0;
#pragma unroll
  for (int t = 0; t < NT; ++t) total += (all[T0 + t].ndst / 32) * (all[T0 + t].K / 64);
  for (int git = gw; git < total; git += ngw) {
    int t = 0, it = git;
#pragma unroll
    for (int u = 0; u < NT - 1; ++u) { const int nit = (all[T0 + u].ndst / 32) * (all[T0 + u].K / 64); if (t == u && it >= nit) { it -= nit; t = u + 1; } }
    int mid = 0, ndst = 0, K = 0; size_t off = 0;
#pragma unroll
    for (int u = 0; u < NT; ++u) if (t == u) { mid = all[T0 + u].mid; ndst = all[T0 + u].ndst; K = all[T0 + u].K; off = all[T0 + u].off; }
    transpose_item(p.in, mid, K, (bf16_t*)(p.ws + off), scr, it, ndst / 32, lane);
  }
}
template <bool EARLY_ONLY> __device__ __forceinline__ void phase0(const Params& p, float* lds, int gw, int ngw, int lane, int wave) {
  unsigned char* ws = p.ws;
  float* scr = lds + wave * (64 * 33);
  transpose_list<(EARLY_ONLY ? 0 : 2)>(p, scr, gw, ngw, lane);
  if (!EARLY_ONLY) { wmq_prepare(p, gw, ngw, lane); wpq_prepare(p, gw, ngw, lane); }
  { bf16_t* KT = (bf16_t*)(ws + WS_KEYS_T);
    for (int i = gw * 64 + lane; i < 256 * 256; i += ngw * 64) { const int n = i >> 8, k = i & 255; float v = 0.f;
      if (n < 128) { if (k < 128) v = p.in[29][n * 128 + k]; } else { if (k >= 128) v = p.in[30][(n - 128) * 128 + (k - 128)]; }
      KT[i] = (bf16_t)f2bf(v); } }
  { f32x4* gt = (f32x4*)(ws + WS_GTAB);
    for (int i = gw * 64 + lane; i < 2048; i += ngw * 64) gt[i] = (f32x4){8.f * log1pf(__expf(-p.in[16][i])), p.in[13][i], p.in[15][i], 0.f}; }
  { float* ct = (float*)(ws + WS_COS); float* st = (float*)(ws + WS_SIN); const int* pos = (const int*)p.in[2];
    for (int i = gw * 64 + lane; i < T_ * 32; i += ngw * 64) { const int t = i >> 5, f = i & 31;
      const float inv = exp2f(-(float)(2 * f) * (13.287712379549449f / 64.f));
      const float ang = (float)pos[t] * inv; float c, s; sincos_big(ang, c, s); ct[i] = c; st[i] = s; } }
  { const float* m = p.in[1]; bf16_t* mb = (bf16_t*)(ws + WS_MEMB);
    for (size_t i = (size_t)(gw * 64 + lane) * 8; i < (size_t)2048 * 2048; i += (size_t)ngw * 64 * 8) {
      const f32x4 a = *(const f32x4*)(m + i), b = *(const f32x4*)(m + i + 4); u32x4 o; o.x = pk2(a[0], a[1]); o.y = pk2(a[2], a[3]); o.z = pk2(b[0], b[1]); o.w = pk2(b[2], b[3]);
      *(u32x4*)(mb + i) = o; } }
  { const float* x = p.in[0]; bf16_t* X = (bf16_t*)(ws + WS_X);
    for (int r0 = gw * 2; r0 < T_; r0 += ngw * 2) { float v[2][32];
#pragma unroll
      for (int rr = 0; rr < 2; ++rr)
#pragma unroll
        for (int j = 0; j < 4; ++j) { const f32x4 a = *(const f32x4*)(x + (size_t)(r0 + rr) * DM + j * 512 + lane * 8), b = *(const f32x4*)(x + (size_t)(r0 + rr) * DM + j * 512 + lane * 8 + 4);
#pragma unroll
          for (int e = 0; e < 4; ++e) { v[rr][j * 8 + e] = a[e]; v[rr][j * 8 + 4 + e] = b[e]; } }
#pragma unroll
      for (int rr = 0; rr < 2; ++rr) { ln_row_regs(v[rr], p.in[3], p.in[4], lane);
#pragma unroll
        for (int j = 0; j < 4; ++j) *(u32x4*)(X + (size_t)(r0 + rr) * DM + j * 512 + lane * 8) = pack8(&v[rr][j * 8]); } } }
}

enum { E_WIN = 0, E_MEMKV, E_Q, E_KV, E_GATES, E_RES, E_BF16, E_F32, E_RESM, E_LNQ };
struct EpiArgs { unsigned char* ws; unsigned char* dout; const float* const* in; bf16_t* o; float* f; int ld; const long long* lnst = nullptr; const long long* csbw = nullptr; int ncs = 0; };
__device__ __forceinline__ void st4(bf16_t* ptr, f32x4 v) { u32x2 w; w.x = pk2(v[0], v[1]); w.y = pk2(v[2], v[3]); *(u32x2*)ptr = w; }
template <int MODE> __device__ __forceinline__ void epi(const EpiArgs& e, int batch, int row, int col, f32x4 v) {
  if constexpr (MODE == E_WIN) {
    if (col < 512) st4((bf16_t*)(e.ws + WS_CQ) + (size_t)row * 512 + col, v);
    else if (col < 1024) st4((bf16_t*)(e.ws + WS_CKV) + (size_t)row * 512 + (col - 512), v);
    else if (col < 2048) st4((bf16_t*)(e.ws + WS_LRUX) + (size_t)row * 1024 + (col - 1024), v);
    else if (col < 3072) { f32x4 g; for (int i = 0; i < 4; ++i) g[i] = gelu_tanh(v[i]); st4((bf16_t*)(e.ws + WS_GATE) + (size_t)row * 1024 + (col - 2048), g); }
    else if (col < 3136) st4((bf16_t*)(e.ws + WS_KPE) + (size_t)row * 64 + (col - 3072), v);
  } else if constexpr (MODE == E_MEMKV) {
    st4((bf16_t*)(e.ws + WS_MEMKV) + (size_t)row * 1024 + col, v);
  } else if constexpr (MODE == E_Q) {
    const int j = col % 192;
    if (j >= 128) { const int i0 = (j - 128) >> 1; const float* ct = (const float*)(e.ws + WS_COS) + (size_t)row * 32 + i0; const float* st = (const float*)(e.ws + WS_SIN) + (size_t)row * 32 + i0;
      const float c0 = ct[0], s0 = st[0], c1 = ct[1], s1 = st[1];
      v = (f32x4){v[0] * c0 - v[1] * s0, v[1] * c0 + v[0] * s0, v[2] * c1 - v[3] * s1, v[3] * c1 + v[2] * s1}; }
    st4((bf16_t*)(e.dout + DO_Q) + (size_t)row * 1536 + col, v);
  } else if constexpr (MODE == E_KV) {
    if (col < 1024) st4((bf16_t*)(e.dout + DO_K) + (size_t)row * 1536 + (col >> 7) * 192 + (col & 127), v);
    else st4((bf16_t*)(e.dout + DO_V) + (size_t)row * 1024 + (col - 1024), v);
  } else if constexpr (MODE == E_GATES) {
    const int dir = col >> 8, jj = (col & 255) >> 1, c0 = batch * 128 + jj;
    const f32x4* gt = (const f32x4*)(e.ws + WS_GTAB) + dir * 1024 + c0;
    const f32x4 t0 = gt[0], t1 = gt[1];
    const unsigned xw = *(const unsigned*)((const bf16_t*)(e.ws + WS_XC) + (size_t)row * 1024 + c0);
    const float la0 = -t0[0] * sigmoidf_(v[0] + t0[1]), la1 = -t1[0] * sigmoidf_(v[2] + t1[1]);
    const float bt0 = __builtin_amdgcn_sqrtf(neg_expm1_small(2.f * la0)) * sigmoidf_(v[1] + t0[2]) * bflo(xw);
    const float bt1 = __builtin_amdgcn_sqrtf(neg_expm1_small(2.f * la1)) * sigmoidf_(v[3] + t1[2]) * bfhi(xw);
    bf16_t* LA = (bf16_t*)(e.ws + (dir ? WS_LAB : WS_LAF)); bf16_t* BT = (bf16_t*)(e.ws + (dir ? WS_BTB : WS_BTF));
    *(unsigned*)(LA + (size_t)row * 1024 + c0) = pk2(la0, la1);
    *(unsigned*)(BT + (size_t)row * 1024 + c0) = pk2(bt0, bt1);
  } else if constexpr (MODE == E_RES) {
    bf16_t* X = (bf16_t*)(e.ws + WS_X) + (size_t)row * DM + col; const u32x2 w = *(const u32x2*)X;
    v = (f32x4){DN_ALPHA * bflo(w.x) + v[0], DN_ALPHA * bfhi(w.x) + v[1], DN_ALPHA * bflo(w.y) + v[2], DN_ALPHA * bfhi(w.y) + v[3]};
    st4(X, v);
  } else if constexpr (MODE == E_BF16) {
    st4(e.o + (size_t)row * e.ld + col, v);
  } else {
    *(f32x4*)(e.f + (size_t)row * e.ld + col) = v;
  }
}


__device__ __forceinline__ void st8(bf16_t* ptr, f32x4 a, f32x4 b) { u32x4 w; w.x = pk2(a[0], a[1]); w.y = pk2(a[2], a[3]); w.z = pk2(b[0], b[1]); w.w = pk2(b[2], b[3]); *(u32x4*)ptr = w; }
template <int MODE> __device__ __forceinline__ void epi8(const EpiArgs& e, int batch, int row, int col, f32x4 v0, f32x4 v1) {
  if constexpr (MODE == E_WIN) {
    if (col < 512) st8((bf16_t*)(e.ws + WS_CQ) + (size_t)row * 512 + col, v0, v1);
    else if (col < 1024) st8((bf16_t*)(e.ws + WS_CKV) + (size_t)row * 512 + (col - 512), v0, v1);
    else if (col < 2048) st8((bf16_t*)(e.ws + WS_LRUX) + (size_t)row * 1024 + (col - 1024), v0, v1);
    else if (col < 3072) { f32x4 g0, g1;
#pragma unroll
      for (int i = 0; i < 4; ++i) { g0[i] = gelu_tanh(v0[i]); g1[i] = gelu_tanh(v1[i]); }
      st8((bf16_t*)(e.ws + WS_GATE) + (size_t)row * 1024 + (col - 2048), g0, g1); }
    else if (col < 3136) { const int i0 = (col - 3072) >> 1;
      const f32x4 c = *(const f32x4*)((const float*)(e.ws + WS_COS) + (size_t)row * 32 + i0), s = *(const f32x4*)((const float*)(e.ws + WS_SIN) + (size_t)row * 32 + i0);
      const f32x4 r0 = {v0[0] * c[0] - v0[1] * s[0], v0[1] * c[0] + v0[0] * s[0], v0[2] * c[1] - v0[3] * s[1], v0[3] * c[1] + v0[2] * s[1]};
      const f32x4 r1 = {v1[0] * c[2] - v1[1] * s[2], v1[1] * c[2] + v1[0] * s[2], v1[2] * c[3] - v1[3] * s[3], v1[3] * c[3] + v1[2] * s[3]};
      bf16_t* kd = (bf16_t*)(e.dout + DO_K) + (size_t)row * 1536 + 128 + (col - 3072);
#pragma unroll
      for (int h = 0; h < 8; ++h) st8(kd + h * 192, r0, r1); }
  } else if constexpr (MODE == E_MEMKV) {
    st8((bf16_t*)(e.ws + WS_MEMKV) + (size_t)row * 1024 + col, v0, v1);
  } else if constexpr (MODE == E_Q) {
    const int j = col % 192;
    if (j >= 128) { const int i0 = (j - 128) >> 1; const f32x4 c = *(const f32x4*)((const float*)(e.ws + WS_COS) + (size_t)row * 32 + i0), s = *(const f32x4*)((const float*)(e.ws + WS_SIN) + (size_t)row * 32 + i0);
      v0 = (f32x4){v0[0] * c[0] - v0[1] * s[0], v0[1] * c[0] + v0[0] * s[0], v0[2] * c[1] - v0[3] * s[1], v0[3] * c[1] + v0[2] * s[1]};
      v1 = (f32x4){v1[0] * c[2] - v1[1] * s[2], v1[1] * c[2] + v1[0] * s[2], v1[2] * c[3] - v1[3] * s[3], v1[3] * c[3] + v1[2] * s[3]}; }
    st8((bf16_t*)(e.dout + DO_Q) + (size_t)row * 1536 + col, v0, v1);
  } else if constexpr (MODE == E_KV) {
    if (col < 1024) st8((bf16_t*)(e.dout + DO_K) + (size_t)row * 1536 + (col >> 7) * 192 + (col & 127), v0, v1);
    else st8((bf16_t*)(e.dout + DO_V) + (size_t)row * 1024 + (col - 1024), v0, v1);
  } else if constexpr (MODE == E_GATES) {
    const int dir = col >> 8, jj = (col & 255) >> 1, c0 = batch * 128 + jj;
    const f32x4* gt = (const f32x4*)(e.ws + WS_GTAB) + dir * 1024 + c0;
    const u32x2 xw = *(const u32x2*)((const bf16_t*)(e.ws + WS_XC) + (size_t)row * 1024 + c0);
    const float xc[4] = {bflo(xw.x), bfhi(xw.x), bflo(xw.y), bfhi(xw.y)}; const float vv[8] = {v0[0], v0[1], v0[2], v0[3], v1[0], v1[1], v1[2], v1[3]};
    float la[4], bt[4];
#pragma unroll
    for (int i = 0; i < 4; ++i) { const f32x4 t = gt[i]; la[i] = -t[0] * sigmoidf_(vv[2 * i] + t[1]);
      bt[i] = __builtin_amdgcn_sqrtf(neg_expm1_small(2.f * la[i])) * sigmoidf_(vv[2 * i + 1] + t[2]) * xc[i]; }
    bf16_t* LA = (bf16_t*)(e.ws + (dir ? WS_LAB : WS_LAF)); bf16_t* BT = (bf16_t*)(e.ws + (dir ? WS_BTB : WS_BTF));
    u32x2 lw, bw; lw.x = pk2(la[0], la[1]); lw.y = pk2(la[2], la[3]); bw.x = pk2(bt[0], bt[1]); bw.y = pk2(bt[2], bt[3]);
    *(u32x2*)(LA + (size_t)row * 1024 + c0) = lw; *(u32x2*)(BT + (size_t)row * 1024 + c0) = bw;
  } else if constexpr (MODE == E_BF16) {
    st8(e.o + (size_t)row * e.ld + col, v0, v1);
  } else {
    *(f32x4*)(e.f + (size_t)row * e.ld + col) = v0; *(f32x4*)(e.f + (size_t)row * e.ld + col + 4) = v1;
  }
}

struct GemmArgs { const bf16_t* A; size_t lda, a_batch; const bf16_t* Bt; size_t ldb, b_batch; int M, N, K, nbatch; int rot = 0; };
template <int MODE> __device__ __forceinline__ void gemm_simple(const GemmArgs& g, const EpiArgs& e, int bid, int nblk, int wave, int lane) {
  const int tm = g.M / 128, tn = g.N / 128, per = tm * tn, units = g.nbatch * per;
  const int r32 = lane & 31, hi = lane >> 5, wr = wave >> 1, wc = wave & 1;
  for (int u = bid; u < units; u += nblk) {
    const int bt = u / per, r = u % per, pm = r / tn, pn = r % tn;
    const bf16_t* ap = g.A + (size_t)bt * g.a_batch + (size_t)(pm * 128 + wr * 32 + r32) * g.lda + 8 * hi;
    const bf16_t* bp0 = g.Bt + (size_t)bt * g.b_batch + (size_t)(pn * 128 + wc * 64 + r32) * g.ldb + 8 * hi;
    const bf16_t* bp1 = bp0 + 32 * g.ldb;
    f32x16 acc0 = {}, acc1 = {};
#pragma unroll 4
    for (int k0 = 0; k0 < g.K; k0 += 16) {
      const bf16x8 a = *(const bf16x8*)(ap + k0), b0 = *(const bf16x8*)(bp0 + k0), b1 = *(const bf16x8*)(bp1 + k0);
      acc0 = __builtin_amdgcn_mfma_f32_32x32x16_bf16(b0, a, acc0, 0, 0, 0);
      acc1 = __builtin_amdgcn_mfma_f32_32x32x16_bf16(b1, a, acc1, 0, 0, 0);
    }
    const int row = pm * 128 + wr * 32 + r32;
#pragma unroll
    for (int gq = 0; gq < 4; ++gq) {
      const int col = pn * 128 + wc * 64 + 8 * gq + 4 * hi;
      epi<MODE>(e, bt, row, col, (f32x4){acc0[4 * gq], acc0[4 * gq + 1], acc0[4 * gq + 2], acc0[4 * gq + 3]});
      epi<MODE>(e, bt, row, col + 32, (f32x4){acc1[4 * gq], acc1[4 * gq + 1], acc1[4 * gq + 2], acc1[4 * gq + 3]});
    }
  }
}


namespace pg8 {
#define PG8_LAS __attribute__((address_space(3)))
constexpr int BM = 256, BK = 64, HALF = 128, HTB = HALF * BK * 2, STAGE_BYTES = 8 * HTB, NXCD = 8, WGM = 8;
__host__ __device__ __forceinline__ int lds_byte(int r, int c) { const int st = (r >> 4) * 2 + (c >> 5), rr = r & 15, cc = c & 31, ob = rr * 64 + cc * 2; return st * 1024 + (ob ^ (((ob >> 9) & 1) << 5)); }
__host__ __device__ __forceinline__ void stage_rc(int b, int& R, int& C) { const int st = b / 1024, sb = b % 1024, swz = sb ^ (((sb >> 9) & 1) << 5); R = (st >> 1) * 16 + swz / 64; C = (st & 1) * 32 + (swz % 64) / 2; }
__host__ __device__ __forceinline__ int perm32(int rho) { const int n = rho >> 4, i = rho & 15; return 8 * (i >> 2) + 4 * n + (i & 3); }
struct Unit { int pm, pn; };
struct Gemm { const bf16_t* A; const bf16_t* Bt; int M, N, K; int lda, ldb; int pn_per_batch; int a_batch_elems; };
struct StaticOrder {
  int nM, nN, nwg, G, c;
  __device__ void init(int M, int N, int G_, int c_) { nM = M / BM; nN = N / BM; nwg = nM * nN; G = G_; c = c_; }
  __device__ bool next(int i, Unit& u) const {
    const long L = (long)i * G + c; if (L >= nwg) return false;
    int wgid = (int)L; { const int q = nwg / NXCD, r = nwg % NXCD, xcd = wgid % NXCD, off = wgid / NXCD; wgid = (xcd < r ? xcd * (q + 1) : r * (q + 1) + (xcd - r) * q) + off; }
    const int nig = WGM * nN, gid = wgid / nig, fm = gid * WGM, gsz = (nM - fm) < WGM ? (nM - fm) : WGM;
    u.pm = fm + ((wgid % nig) % gsz); u.pn = (wgid % nig) / gsz; return true;
  }
};
template <int MODE> struct EpiAdapter {
  static constexpr bool PERM = true;
  EpiArgs e; int nb_cols; PG8_LAS unsigned char* lds;
  __device__ __forceinline__ void operator()(const f32x4 (&acc)[2][2][4][2], const Unit& u, int wr, int wc, int fr, int fq) const {
    if constexpr (MODE == E_LNQ) {
      const long long* st = e.lnst; const long long* cb = e.csbw;
      f32x4 cs[2][2], bw[2][2];
#pragma unroll
      for (int bj = 0; bj < 2; ++bj)
#pragma unroll
        for (int n = 0; n < 2; ++n)
#pragma unroll
          for (int i = 0; i < 4; ++i) { const int col = u.pn * BM + bj * HALF + wc * 32 + 8 * fq + 4 * n + i; cs[bj][n][i] = (float)cb[col] * (1.f / 4294967296.f); bw[bj][n][i] = (float)cb[e.ncs + col] * (1.f / 4294967296.f); }
#pragma unroll
      for (int ai = 0; ai < 2; ++ai)
#pragma unroll
        for (int m = 0; m < 4; ++m) { const int row = u.pm * BM + ai * HALF + wr * 64 + m * 16 + fr;
          const float mu = (float)st[row] * (1.f / 16777216.f / 2048.f), rr = rsqrtf((float)st[16384 + row] * (1.f / 16777216.f / 2048.f) - mu * mu + LN_EPS);
#pragma unroll
          for (int bj = 0; bj < 2; ++bj)
            st8(e.o + (size_t)row * e.ld + u.pn * BM + bj * HALF + wc * 32 + 8 * fq, (acc[ai][bj][m][0] - mu * cs[bj][0]) * rr + bw[bj][0], (acc[ai][bj][m][1] - mu * cs[bj][1]) * rr + bw[bj][1]);
          asm volatile("" ::: "memory"); }
      return;
    }
    if constexpr (MODE == E_RES || MODE == E_RESM) {
      bf16_t* X = (bf16_t*)(e.ws + WS_X);
      f32x4 lg[2][2], lb[2][2];
      if constexpr (MODE == E_RES) {
#pragma unroll
        for (int bj = 0; bj < 2; ++bj)
#pragma unroll
          for (int n = 0; n < 2; ++n) { const int col = u.pn * BM + bj * HALF + wc * 32 + 8 * fq + 4 * n; lg[bj][n] = *(const f32x4*)(e.in[20] + col); lb[bj][n] = *(const f32x4*)(e.in[21] + col); } }
#pragma unroll
      for (int ai = 0; ai < 2; ++ai) { u32x4 rw[4][2]; float rsc[4] = {1.f, 1.f, 1.f, 1.f}; float s1[4] = {0.f, 0.f, 0.f, 0.f}, s2[4] = {0.f, 0.f, 0.f, 0.f}; float lmu[4], lrr[4];
        if constexpr (MODE == E_RES) { const long long* st = (const long long*)(e.ws + WS_LN1S);
#pragma unroll
          for (int m = 0; m < 4; ++m) { const int row = u.pm * BM + ai * HALF + wr * 64 + m * 16 + fr; lmu[m] = (float)st[row] * (1.f / 16777216.f / 2048.f);
            lrr[m] = rsqrtf((float)st[16384 + row] * (1.f / 16777216.f / 2048.f) - lmu[m] * lmu[m] + LN_EPS); } }
        if constexpr (MODE == E_RESM) { const unsigned long long* sso = (const unsigned long long*)(e.ws + WS_SS) + 2 * 16384;
#pragma unroll
          for (int m = 0; m < 4; ++m) rsc[m] = rsqrtf((float)sso[u.pm * BM + ai * HALF + wr * 64 + m * 16 + fr] * (1.f / 16777216.f / 1024.f) + RMS_EPS); }
#pragma unroll
        for (int m = 0; m < 4; ++m)
#pragma unroll
          for (int bj = 0; bj < 2; ++bj) rw[m][bj] = *(const u32x4*)(X + (size_t)(u.pm * BM + ai * HALF + wr * 64 + m * 16 + fr) * DM + u.pn * BM + bj * HALF + wc * 32 + 8 * fq);
#pragma unroll
        for (int m = 0; m < 4; ++m)
#pragma unroll
          for (int bj = 0; bj < 2; ++bj) { const u32x4 w = rw[m][bj]; f32x4 a0 = acc[ai][bj][m][0], a1 = acc[ai][bj][m][1];
            if constexpr (MODE == E_RESM) { a0 *= rsc[m]; a1 *= rsc[m]; }
            f32x4 x0 = {bflo(w.x), bfhi(w.x), bflo(w.y), bfhi(w.y)}, x1 = {bflo(w.z), bfhi(w.z), bflo(w.w), bfhi(w.w)};
            if constexpr (MODE == E_RES) { x0 = (x0 - lmu[m]) * lrr[m] * lg[bj][0] + lb[bj][0]; x1 = (x1 - lmu[m]) * lrr[m] * lg[bj][1] + lb[bj][1]; }
            const f32x4 o0 = DN_ALPHA * x0 + a0, o1 = DN_ALPHA * x1 + a1;
            { s1[m] += (o0[0] + o0[1]) + (o0[2] + o0[3]) + (o1[0] + o1[1]) + (o1[2] + o1[3]);
              s2[m] += (o0[0] * o0[0] + o0[1] * o0[1]) + (o0[2] * o0[2] + o0[3] * o0[3]) + (o1[0] * o1[0] + o1[1] * o1[1]) + (o1[2] * o1[2] + o1[3] * o1[3]); }
            st8(X + (size_t)(u.pm * BM + ai * HALF + wr * 64 + m * 16 + fr) * DM + u.pn * BM + bj * HALF + wc * 32 + 8 * fq, o0, o1); }
        {
          typedef float f32x2v __attribute__((ext_vector_type(2)));
          PG8_LAS f32x2v* P = (PG8_LAS f32x2v*)(lds + STAGE_BYTES);
#pragma unroll
          for (int m = 0; m < 4; ++m) { float a = s1[m], b = s2[m]; a += __shfl_xor(a, 16); a += __shfl_xor(a, 32); b += __shfl_xor(b, 16); b += __shfl_xor(b, 32);
            if (fq == 0) P[(ai * HALF + wr * 64 + m * 16 + fr) * 4 + wc] = (f32x2v){a, b}; } }
        asm volatile("" ::: "memory"); }
      {
        typedef float f32x2v __attribute__((ext_vector_type(2)));
        PG8_LAS f32x2v* P = (PG8_LAS f32x2v*)(lds + STAGE_BYTES);
        asm volatile("s_waitcnt lgkmcnt(0)" ::: "memory"); __builtin_amdgcn_s_barrier(); asm volatile("" ::: "memory");
        const int wid = wr * 4 + wc, lane = fq * 16 + fr;
        if (lane < 32) { const int row = wid * 32 + lane; const f32x2v a = P[row * 4 + 0], b = P[row * 4 + 1], c = P[row * 4 + 2], d = P[row * 4 + 3];
          unsigned long long* st = (unsigned long long*)(e.ws + (MODE == E_RESM ? WS_LN1S : WS_LN2S)) + u.pm * BM + row;
          atomicAdd(st, (unsigned long long)(long long)(((a.x + b.x) + (c.x + d.x)) * 16777216.f)); atomicAdd(st + 16384, (unsigned long long)(((a.y + b.y) + (c.y + d.y)) * 16777216.f)); }
      }
      return;
    }
#pragma unroll
    for (int ai = 0; ai < 2; ++ai)
#pragma unroll
      for (int m = 0; m < 4; ++m) { const int row = u.pm * BM + ai * HALF + wr * 64 + m * 16 + fr;
        float rs = 1.f;
        if constexpr (MODE == E_WIN) {
          if (u.pn < 4) { float s = 0.f;
#pragma unroll
            for (int bj = 0; bj < 2; ++bj)
#pragma unroll
              for (int n = 0; n < 2; ++n) { const f32x4 x = acc[ai][bj][m][n]; s += (x[0] * x[0] + x[1] * x[1]) + (x[2] * x[2] + x[3] * x[3]); }
            s += __shfl_xor(s, 16); s += __shfl_xor(s, 32);
            if (fq == 0) atomicAdd((unsigned long long*)(e.ws + WS_SS) + (u.pn >> 1) * 16384 + row, (unsigned long long)(s * 16777216.f)); } }
        if constexpr (MODE == E_Q || MODE == E_KV) { const unsigned long long ss = ((const unsigned long long*)(e.ws + WS_SS))[(MODE == E_KV ? 16384 : 0) + row];
          rs = rsqrtf((float)ss * (1.f / 16777216.f / 512.f) + RMS_EPS); }
#pragma unroll
        for (int bj = 0; bj < 2; ++bj) { const int colg = u.pn * BM + bj * HALF + wc * 32 + 8 * fq; const int batch = colg / nb_cols; const int col = colg - batch * nb_cols;
          if constexpr (MODE == E_Q || MODE == E_KV) epi8<MODE>(e, batch, row, col, acc[ai][bj][m][0] * rs, acc[ai][bj][m][1] * rs);
          else epi8<MODE>(e, batch, row, col, acc[ai][bj][m][0], acc[ai][bj][m][1]); }
        asm volatile("" ::: "memory"); }
  }
};
template <class Epi>
__device__ __forceinline__ void gemm_phase(PG8_LAS unsigned char* lds, const Gemm g, const StaticOrder& S, const Epi& E) {
  int tid_ = hw_tid(); asm volatile("" : "+v"(tid_));
  const int tid = tid_, wid = __builtin_amdgcn_readfirstlane(tid >> 6), lane = tid & 63, wr = wid >> 2, wc = wid & 3, fr = lane & 15, fq = lane >> 4;
  const int K = g.K, nt = K / BK;
  unsigned voffA[2], voffB[2];
#pragma unroll
  for (int i = 0; i < 2; ++i) { int R, C; stage_rc(tid * 16 + i * 8192, R, C); const int Rb = Epi::PERM ? ((R & ~31) + perm32(R & 31)) : R; voffA[i] = (unsigned)(R * g.lda + C) * 2u; voffB[i] = (unsigned)(Rb * g.ldb + C) * 2u; }
  const size_t kstep = (size_t)(BK * 2);
  const size_t hstepA = (size_t)HALF * g.lda * 2, hstepB = (size_t)HALF * g.ldb * 2;
  const size_t tstepA = 2 * hstepA, tstepB = 2 * hstepB;
  const unsigned ldsw = (unsigned)wid * 1024u;
  const int aoff = lds_byte(wr * 64 + fr, fq * 8), boff = lds_byte(wc * 32 + fr, fq * 8);
#define PG8_SA(b, h) (((b) * 2 + (h)) * HTB)
#define PG8_SB(b, h) ((4 + (b) * 2 + (h)) * HTB)
#define PG8_STAGE(bufoff, gbase, voff) do { _Pragma("unroll") for (int _i = 0; _i < 2; ++_i) \
    __builtin_amdgcn_global_load_lds((const unsigned*)((const char*)(gbase) + (voff)[_i]), (PG8_LAS unsigned*)(lds + (bufoff) + ldsw + _i * 8192), 16, 0, 0); } while (0)
#define PG8_LDA(dst, b, h) do { _Pragma("unroll") for (int m = 0; m < 4; ++m) _Pragma("unroll") for (int k = 0; k < 2; ++k) dst[m][k] = *(const PG8_LAS bf16x8*)(lds + PG8_SA(b, h) + aoff + m * 2048 + k * 1024); } while (0)
#define PG8_LDB(dst, b, h) do { _Pragma("unroll") for (int n = 0; n < 2; ++n) _Pragma("unroll") for (int k = 0; k < 2; ++k) dst[n][k] = *(const PG8_LAS bf16x8*)(lds + PG8_SB(b, h) + boff + n * 2048 + k * 1024); } while (0)
#define PG8_MMA(ai, bj, At, Bt) do { __builtin_amdgcn_s_setprio(1); _Pragma("unroll") for (int m = 0; m < 4; ++m) _Pragma("unroll") for (int n = 0; n < 2; ++n) _Pragma("unroll") for (int k = 0; k < 2; ++k) \
    acc[ai][bj][m][n] = __builtin_amdgcn_mfma_f32_16x16x32_bf16(Bt[n][k], At[m][k], acc[ai][bj][m][n], 0, 0, 0); __builtin_amdgcn_s_setprio(0); } while (0)
#define PG8_WAIT_V(n) asm volatile("s_waitcnt vmcnt(" #n ")" ::: "memory")
#define PG8_WAIT_L(n) asm volatile("s_waitcnt lgkmcnt(" #n ")" ::: "memory")
#define PG8_BAR __builtin_amdgcn_s_barrier()
#define PG8_SCHED __builtin_amdgcn_sched_barrier(0)
#define PG8_APTR(u) ((const char*)g.A + (size_t)(u).pm * tstepA + (size_t)((u).pn / g.pn_per_batch) * g.a_batch_elems * 2)
#define PG8_BPTR(u) ((const char*)g.Bt + (size_t)(u).pn * tstepB)
  Unit cur, nxt; int ui = 0;
  if (!S.next(0, cur)) return;
  f32x4 acc[2][2][4][2];
#pragma unroll
  for (int a = 0; a < 2; ++a)
#pragma unroll
    for (int b = 0; b < 2; ++b)
#pragma unroll
      for (int m = 0; m < 4; ++m)
#pragma unroll
        for (int n = 0; n < 2; ++n) acc[a][b][m][n] = (f32x4){0.f, 0.f, 0.f, 0.f};
  bf16x8 At[4][2], B0[2][2], B1[2][2];
  const char* cA = PG8_APTR(cur); const char* cB = PG8_BPTR(cur);
  PG8_STAGE(PG8_SB(0, 0), cB, voffB); PG8_STAGE(PG8_SB(0, 1), cB + hstepB, voffB); PG8_STAGE(PG8_SA(0, 0), cA, voffA); PG8_STAGE(PG8_SA(0, 1), cA + hstepA, voffA);
  if (wr == 1) PG8_BAR;
  PG8_WAIT_V(2); PG8_BAR;
  PG8_STAGE(PG8_SB(1, 0), cB + kstep, voffB); PG8_STAGE(PG8_SA(1, 0), cA + kstep, voffA); PG8_STAGE(PG8_SB(1, 1), cB + hstepB + kstep, voffB);
  PG8_WAIT_V(6); PG8_BAR;
  for (;;) {
    const bool has_next = S.next(ui + 1, nxt);
    const char* nA = has_next ? PG8_APTR(nxt) : cA; const char* nB = has_next ? PG8_BPTR(nxt) : cB;
    for (int t = 0; t < nt; t += 2) {
      const bool last = (t == nt - 2);
      const char* a1 = cA + (size_t)(t + 1) * kstep;
      const char* a2 = last ? nA : cA + (size_t)(t + 2) * kstep; const char* b2 = last ? nB : cB + (size_t)(t + 2) * kstep;
      const char* a3 = a2 + kstep; const char* b3 = b2 + kstep;
      PG8_LDB(B0, 0, 0); PG8_LDB(B1, 0, 1); PG8_SCHED; PG8_LDA(At, 0, 0); PG8_STAGE(PG8_SA(1, 1), a1 + hstepA, voffA);
      PG8_WAIT_V(8); PG8_WAIT_L(0); PG8_BAR; PG8_MMA(0, 0, At, B0); PG8_MMA(0, 1, At, B1); PG8_BAR; PG8_SCHED;
      PG8_LDA(At, 0, 1); PG8_STAGE(PG8_SB(0, 0), b2, voffB); PG8_STAGE(PG8_SB(0, 1), b2 + hstepB, voffB); PG8_STAGE(PG8_SA(0, 0), a2, voffA);
      PG8_WAIT_V(8); PG8_WAIT_L(0); PG8_BAR; PG8_MMA(1, 0, At, B0); PG8_MMA(1, 1, At, B1); PG8_BAR; PG8_SCHED;
      PG8_LDB(B0, 1, 0); PG8_LDB(B1, 1, 1); PG8_SCHED; PG8_LDA(At, 1, 0); PG8_STAGE(PG8_SA(0, 1), a2 + hstepA, voffA);
      PG8_WAIT_V(8); PG8_WAIT_L(0); PG8_BAR; PG8_MMA(0, 0, At, B0); PG8_MMA(0, 1, At, B1); PG8_BAR; PG8_SCHED;
      PG8_LDA(At, 1, 1); PG8_STAGE(PG8_SB(1, 0), b3, voffB); PG8_STAGE(PG8_SB(1, 1), b3 + hstepB, voffB); PG8_STAGE(PG8_SA(1, 0), a3, voffA);
      PG8_WAIT_V(8); PG8_WAIT_L(0); PG8_BAR; PG8_MMA(1, 0, At, B0); PG8_MMA(1, 1, At, B1); PG8_BAR; PG8_SCHED;
    }
    if (wr == 0) PG8_BAR;
    E(acc, cur, wr, wc, fr, fq);
    if (!has_next) break;
#pragma unroll
    for (int a = 0; a < 2; ++a)
#pragma unroll
      for (int b = 0; b < 2; ++b)
#pragma unroll
        for (int m = 0; m < 4; ++m)
#pragma unroll
          for (int n = 0; n < 2; ++n) acc[a][b][m][n] = (f32x4){0.f, 0.f, 0.f, 0.f};
    cur = nxt; cA = nA; cB = nB; ++ui;
    if (wr == 1) PG8_BAR;
  }
  PG8_WAIT_V(0);
  PG8_BAR;
#undef PG8_SA
#undef PG8_SB
#undef PG8_STAGE
#undef PG8_LDA
#undef PG8_LDB
#undef PG8_MMA
#undef PG8_WAIT_V
#undef PG8_WAIT_L
#undef PG8_BAR
#undef PG8_SCHED
#undef PG8_APTR
#undef PG8_BPTR
}
}
template <int MODE> __device__ __forceinline__ void gemm_fast(const GemmArgs& g, const EpiArgs& e, unsigned char* lds_raw, int bid_, int nblk) {
  const int bid = (bid_ + g.rot) % nblk;
  pg8::Gemm G{g.A, g.Bt, g.M, g.N * g.nbatch, g.K, (int)g.lda, (int)g.ldb, g.nbatch > 1 ? g.N / 256 : (1 << 30), (int)g.a_batch};
  pg8::StaticOrder S; S.init(G.M, G.N, nblk, bid);
  pg8::EpiAdapter<MODE> E{e, g.N, (PG8_LAS unsigned char*)lds_raw};
  pg8::gemm_phase<pg8::EpiAdapter<MODE>>((PG8_LAS unsigned char*)lds_raw, G, S, E);
}

__device__ __forceinline__ void phase1b(const Params& p, int gw, int ngw, int lane) {
  unsigned char* ws = p.ws;
  bf16_t* CQ = (bf16_t*)(ws + WS_CQ); bf16_t* CKV = (bf16_t*)(ws + WS_CKV); const bf16_t* KPE = (const bf16_t*)(ws + WS_KPE);
  bf16_t* Kd = (bf16_t*)((unsigned char*)p.out + DO_K); const bf16_t* LX = (const bf16_t*)(ws + WS_LRUX); bf16_t* XC = (bf16_t*)(ws + WS_XC);
  const float* ct = (const float*)(ws + WS_COS); const float* st = (const float*)(ws + WS_SIN);
  for (int r = gw; r < T_; r += ngw) {
#pragma unroll
    for (int which = 0; which < 2; ++which) {
      bf16_t* row = (which ? CKV : CQ) + (size_t)r * 512 + lane * 8; const float* g = p.in[which ? 8 : 6] + lane * 8;
      float f[8]; unpack8(*(const u32x4*)row, f); float q = 0.f;
#pragma unroll
      for (int i = 0; i < 8; ++i) q += f[i] * f[i];
      const float sc = rsqrtf(dpp_sum64(q) * (1.f / 512.f) + RMS_EPS);
#pragma unroll
      for (int i = 0; i < 8; ++i) f[i] = f[i] * sc * g[i];
      *(u32x4*)row = pack8(f);
    }
    {
      if (lane < 32) { const unsigned w = *(const unsigned*)(KPE + (size_t)r * 64 + 2 * lane); const float t1 = bflo(w), t2 = bfhi(w);
        const float c = ct[(size_t)r * 32 + lane], s = st[(size_t)r * 32 + lane]; const unsigned o = pk2(t1 * c - t2 * s, t2 * c + t1 * s);
#pragma unroll
        for (int h = 0; h < 8; ++h) *(unsigned*)(Kd + (size_t)r * 1536 + h * 192 + 128 + 2 * lane) = o; } }
    if (!USE_LRU_FUSED) {
      const int s = r & (S_ - 1); float acc[16];
      const float* cb = p.in[11] + lane * 16;
#pragma unroll
      for (int i = 0; i < 16; ++i) acc[i] = cb[i];
#pragma unroll
      for (int k = 0; k < 4; ++k) { const int sp = s + k - 2; if (sp < 0 || sp >= S_) continue;
        const bf16_t* src = LX + (size_t)(r + k - 2) * 1024 + lane * 16; const float* w = p.in[10] + k * 1024 + lane * 16;
        float f[16]; unpack8(*(const u32x4*)src, f); unpack8(*(const u32x4*)(src + 8), f + 8);
#pragma unroll
        for (int i = 0; i < 16; ++i) acc[i] += f[i] * w[i]; }
      *(u32x4*)(XC + (size_t)r * 1024 + lane * 16) = pack8(acc); *(u32x4*)(XC + (size_t)r * 1024 + lane * 16 + 8) = pack8(acc + 8);
    }
  }
}

template <int DQK, int NK> __device__ __forceinline__ void attn_scalar(const bf16_t* Q, int ldq, const bf16_t* K, int ldk, const bf16_t* V, int ldv, bf16_t* O, int ldo,
                                                                      int nheads, float scale, float* lds, int bid, int nblk, int tid) {
  float* sc = lds; float* qs = lds + 16 * NK; float* ls = qs + 16 * DQK;
  const int lane = tid & 63, wave = tid >> 6;
  const int units = NB_ * nheads * (S_ / 16);
  for (int u = bid; u < units; u += nblk) {
    const int qb = u % (S_ / 16), h = (u / (S_ / 16)) % nheads, b = u / ((S_ / 16) * nheads);
    __syncthreads();
    for (int i = tid; i < 16 * DQK; i += NTHR) { const int r = i / DQK, d = i % DQK; qs[i] = bf2f(Q[(size_t)(b * S_ + qb * 16 + r) * ldq + h * DQK + d]) * scale; }
    __syncthreads();
    for (int kk = tid; kk < NK; kk += NTHR) {
      const bf16_t* kp = K + (size_t)(b * NK + kk) * ldk + h * DQK; float acc[16];
#pragma unroll
      for (int r = 0; r < 16; ++r) acc[r] = 0.f;
      for (int d0 = 0; d0 < DQK; d0 += 8) { float kf[8]; unpack8(*(const u32x4*)(kp + d0), kf);
#pragma unroll
        for (int r = 0; r < 16; ++r) { const f32x4 q0 = *(const f32x4*)(qs + r * DQK + d0), q1 = *(const f32x4*)(qs + r * DQK + d0 + 4);
          acc[r] += q0[0] * kf[0] + q0[1] * kf[1] + q0[2] * kf[2] + q0[3] * kf[3] + q1[0] * kf[4] + q1[1] * kf[5] + q1[2] * kf[6] + q1[3] * kf[7]; } }
#pragma unroll
      for (int r = 0; r < 16; ++r) sc[r * NK + kk] = acc[r];
    }
    __syncthreads();
    for (int rr = 0; rr < 2; ++rr) { const int r = wave * 2 + rr; float m = -1e30f;
      for (int kk = lane; kk < NK; kk += 64) m = fmaxf(m, sc[r * NK + kk]);
      m = wave_max(m); float l = 0.f;
      for (int kk = lane; kk < NK; kk += 64) { const float pv = __expf(sc[r * NK + kk] - m); sc[r * NK + kk] = pv; l += pv; }
      l = wave_sum(l); if (lane == 0) ls[r] = l; }
    __syncthreads();
    { const int r = tid >> 5, d4 = (tid & 31) * 4; float a0 = 0.f, a1 = 0.f, a2 = 0.f, a3 = 0.f;
      const bf16_t* vp = V + (size_t)(b * NK) * ldv + h * 128 + d4;
      for (int kk = 0; kk < NK; ++kk) { const float pv = sc[r * NK + kk]; const u32x2 w = *(const u32x2*)(vp + (size_t)kk * ldv);
        a0 += pv * bflo(w.x); a1 += pv * bfhi(w.x); a2 += pv * bflo(w.y); a3 += pv * bfhi(w.y); }
      const float il = 1.f / ls[r];
      st4(O + (size_t)(b * S_ + qb * 16 + r) * ldo + h * 128 + d4, (f32x4){a0 * il, a1 * il, a2 * il, a3 * il}); }
  }
  __syncthreads();
}


namespace fa {
typedef short s16x4 __attribute__((ext_vector_type(4)));
constexpr int NW = 8, QBLK = 32, KVBLK = 64;
constexpr float THR = 8.f;
#define FA_SBAR() __builtin_amdgcn_sched_barrier(0)
__device__ __forceinline__ int crow(int r, int hi) { return (r & 3) + 8 * (r >> 2) + 4 * hi; }
__device__ __forceinline__ unsigned cvtpk(float lo, float hi) { unsigned r; asm volatile("v_cvt_pk_bf16_f32 %0, %1, %2" : "=v"(r) : "v"(lo), "v"(hi)); return r; }
__device__ __forceinline__ void partialSM(f32x16& p0, f32x16& p1, float& m_reg, float& mn, float& alpha, const float C, const float thr_s) {
  float pmax = p0[0];
#pragma unroll
  for (int r = 1; r < 16; ++r) pmax = fmaxf(pmax, p0[r]);
#pragma unroll
  for (int r = 0; r < 16; ++r) pmax = fmaxf(pmax, p1[r]);
  { auto rr = __builtin_amdgcn_permlane32_swap(__float_as_uint(pmax), __float_as_uint(pmax), false, false);
    pmax = fmaxf(__uint_as_float(rr[0]), __uint_as_float(rr[1])); }
  if (__builtin_expect(__all(pmax - m_reg <= thr_s), 1)) { mn = m_reg; alpha = 1.f; }
  else { mn = fmaxf(m_reg, pmax); alpha = __builtin_amdgcn_exp2f((m_reg - mn) * C); m_reg = mn; }
  const float mnC = -mn * C;
#pragma unroll
  for (int r = 0; r < 16; ++r) p0[r] = fmaf(p0[r], C, mnC);
#pragma unroll
  for (int r = 0; r < 16; ++r) p1[r] = fmaf(p1[r], C, mnC);
#pragma unroll
  for (int r = 0; r < 16; ++r) p0[r] = __builtin_amdgcn_exp2f(p0[r]);
}
__device__ __forceinline__ void finishSM(f32x16& p0, f32x16& p1, float alpha, float& l_reg, bf16x8& pa0, bf16x8& pa1, bf16x8& pa2, bf16x8& pa3) {
#pragma unroll
  for (int r = 0; r < 16; ++r) p1[r] = __builtin_amdgcn_exp2f(p1[r]);
  float ps = 0;
#pragma unroll
  for (int r = 0; r < 16; ++r) ps += p0[r];
#pragma unroll
  for (int r = 0; r < 16; ++r) ps += p1[r];
  { auto rr = __builtin_amdgcn_permlane32_swap(__float_as_uint(ps), __float_as_uint(ps), false, false);
    ps = __uint_as_float(rr[0]) + __uint_as_float(rr[1]); }
  l_reg = l_reg * alpha + ps;
#define FA_PK4(P, BASE, OUT) do { unsigned a0 = cvtpk(P[BASE + 0], P[BASE + 1]), a1 = cvtpk(P[BASE + 2], P[BASE + 3]);   \
    unsigned b0 = cvtpk(P[BASE + 4], P[BASE + 5]), b1 = cvtpk(P[BASE + 6], P[BASE + 7]);                              \
    auto r0 = __builtin_amdgcn_permlane32_swap(a0, b0, false, false); auto r1 = __builtin_amdgcn_permlane32_swap(a1, b1, false, false); \
    u32x4 w = {r0[0], r1[0], r0[1], r1[1]}; OUT = *reinterpret_cast<bf16x8*>(&w); } while (0)
  FA_PK4(p0, 0, pa0); FA_PK4(p0, 8, pa1); FA_PK4(p1, 0, pa2); FA_PK4(p1, 8, pa3);
#undef FA_PK4
}
template <int DQK> constexpr int krs() { return DQK == 192 ? 400 : DQK * 2; }
template <int DQK> __device__ __forceinline__ int kswz(int row, int colB) { return DQK == 192 ? row * 400 + colB : row * (DQK * 2) + (colB ^ ((row & 7) << 4)); }
template <int DQK> __device__ __forceinline__ void qkt(f32x16& p0, f32x16& p1, const char* Ks, const bf16x8* qr, const int* kb4) {
  p0 = f32x16{}; p1 = f32x16{};
#pragma unroll
  for (int d0 = 0; d0 < DQK / 16; ++d0) {
    const bf16x8 b0 = *reinterpret_cast<const bf16x8*>(Ks + kb4[d0 & 3] + (d0 >> 2) * 128);
    const bf16x8 b1 = *reinterpret_cast<const bf16x8*>(Ks + kb4[d0 & 3] + (d0 >> 2) * 128 + 32 * krs<DQK>());
    p0 = __builtin_amdgcn_mfma_f32_32x32x16_bf16(b0, qr[d0], p0, 0, 0, 0);
    p1 = __builtin_amdgcn_mfma_f32_32x32x16_bf16(b1, qr[d0], p1, 0, 0, 0); }
}
__device__ __forceinline__ int v_st(int k, int c) { const int kk = (k & ~0xC) | ((k & 4) << 1) | ((k & 8) >> 1); return ((kk >> 3) * 4 + (c >> 5)) * 512 + ((kk & 7) * 32 + (c & 31)) * 2; }
__device__ __forceinline__ int v_rd_base(int lane) { return ((lane & 3) << 3) | (((lane >> 2) & 3) << 6) | (((lane >> 4) & 1) << 5) | (((lane >> 5) & 1) << 8); }
constexpr int v_rd_off(int d0, int ks, int half) { return d0 * 512 + ks * 4096 + half * 2048; }
template <int OFF> __device__ __forceinline__ s16x4 tr_read(int vb) {
  s16x4 r; asm volatile("ds_read_b64_tr_b16 %0, %1 offset:%2" : "=&v"(r) : "v"(vb), "i"(OFF) : "memory"); return r;
}
template <int D0> __device__ __forceinline__ void pv_one(f32x16& od, int vb, bf16x8 pa0, bf16x8 pa1, bf16x8 pa2, bf16x8 pa3) {
  const s16x4 l0 = tr_read<v_rd_off(D0, 0, 0)>(vb), h0 = tr_read<v_rd_off(D0, 0, 1)>(vb), l1 = tr_read<v_rd_off(D0, 1, 0)>(vb), h1 = tr_read<v_rd_off(D0, 1, 1)>(vb);
  const s16x4 l2 = tr_read<v_rd_off(D0, 2, 0)>(vb), h2 = tr_read<v_rd_off(D0, 2, 1)>(vb), l3 = tr_read<v_rd_off(D0, 3, 0)>(vb), h3 = tr_read<v_rd_off(D0, 3, 1)>(vb);
  asm volatile("s_waitcnt lgkmcnt(0)" ::: "memory"); FA_SBAR();
#define FA_PK(L, H) (bf16x8){L[0], L[1], L[2], L[3], H[0], H[1], H[2], H[3]}
  od = __builtin_amdgcn_mfma_f32_32x32x16_bf16(pa0, FA_PK(l0, h0), od, 0, 0, 0);
  od = __builtin_amdgcn_mfma_f32_32x32x16_bf16(pa1, FA_PK(l1, h1), od, 0, 0, 0);
  od = __builtin_amdgcn_mfma_f32_32x32x16_bf16(pa2, FA_PK(l2, h2), od, 0, 0, 0);
  od = __builtin_amdgcn_mfma_f32_32x32x16_bf16(pa3, FA_PK(l3, h3), od, 0, 0, 0);
#undef FA_PK
}
__device__ __forceinline__ void pv_d0(f32x16* o, int vb, bf16x8 pa0, bf16x8 pa1, bf16x8 pa2, bf16x8 pa3) {
  pv_one<0>(o[0], vb, pa0, pa1, pa2, pa3); pv_one<1>(o[1], vb, pa0, pa1, pa2, pa3); pv_one<2>(o[2], vb, pa0, pa1, pa2, pa3); pv_one<3>(o[3], vb, pa0, pa1, pa2, pa3);
}
template <int DQK, int LDQ, int LDK, int LDV, int LDO>
__device__ __forceinline__ void attn_body(const bf16_t* __restrict__ Qb, const bf16_t* __restrict__ Kh, const bf16_t* __restrict__ Vh, bf16_t* __restrict__ Ob, int seq, float scale, char* lds) {
  constexpr int SHM_V = KVBLK * 128 * 2, SHM_K = KVBLK * krs<DQK>(), NKC = DQK / 64;
  const float C = scale * 1.4426950408889634f, thr_s = THR / scale;
  int tid_ = hw_tid(); asm volatile("" : "+v"(tid_));
  const int tid = tid_, wid = tid >> 6, lane = tid & 63, r32 = lane & 31, hi = lane >> 5;
  char* V_lds = lds; char* K_lds = lds + 2 * SHM_V;
  float* wsf = (float*)(lds + 2 * SHM_V + 2 * SHM_K) + wid * 64; float* li_l = wsf; float* al_l = wsf + 32;
  float m_reg = -1e30f, l_reg = 0; f32x16 o[4] = {}; bf16x8 qr[DQK / 16];
  const bf16_t* Qw = Qb + (size_t)(wid * QBLK + r32) * LDQ + hi * 8;
#pragma unroll
  for (int d0 = 0; d0 < DQK / 16; ++d0) qr[d0] = *reinterpret_cast<const bf16x8*>(Qw + d0 * 16);
  const int sr = tid >> 4, sc = (tid & 15) * 8, vst0 = v_st(sr, sc), vst1 = v_st(32 + sr, sc);
  const int kgo0 = sr * LDK + sc, klo0 = kswz<DQK>(sr, sc * 2);
  const int kgo2 = (tid >> 3) * LDK + 128 + (tid & 7) * 8, klo2 = kswz<DQK>(tid >> 3, (128 + (tid & 7) * 8) * 2);
  const int vb0 = (int)(uintptr_t)V_lds + v_rd_base(lane);
  int kb4[4];
#pragma unroll
  for (int q = 0; q < 4; ++q) kb4[q] = kswz<DQK>(r32, q * 32 + hi * 16);
  bf16x8 vs0, vs1, ks[NKC];
#define FA_SLOAD(k0) do { vs0 = *reinterpret_cast<const bf16x8*>(&Vh[(size_t)((k0) + sr) * LDV + sc]); vs1 = *reinterpret_cast<const bf16x8*>(&Vh[(size_t)((k0) + 32 + sr) * LDV + sc]); \
    ks[0] = *reinterpret_cast<const bf16x8*>(&Kh[(size_t)(k0) * LDK + kgo0]); ks[1] = *reinterpret_cast<const bf16x8*>(&Kh[(size_t)((k0) + 32) * LDK + kgo0]); \
    if constexpr (NKC == 3) ks[NKC - 1] = *reinterpret_cast<const bf16x8*>(&Kh[(size_t)(k0) * LDK + kgo2]); } while (0)
#define FA_SWRITE(b) do { *(bf16x8*)(V_lds + (b) * SHM_V + vst0) = vs0; *(bf16x8*)(V_lds + (b) * SHM_V + vst1) = vs1; \
    *(bf16x8*)(K_lds + (b) * SHM_K + klo0) = ks[0]; *(bf16x8*)(K_lds + (b) * SHM_K + klo0 + 32 * krs<DQK>()) = ks[1]; \
    if constexpr (NKC == 3) *(bf16x8*)(K_lds + (b) * SHM_K + klo2) = ks[NKC - 1]; } while (0)
#define FA_SWAIT() asm volatile("s_waitcnt vmcnt(0)" ::: "memory")
#define FA_RESC(a) do { if (__any((a) < 1.f)) { if (hi == 0) al_l[r32] = (a); asm volatile("s_waitcnt lgkmcnt(0)" ::: "memory"); \
    _Pragma("unroll") for (int d = 0; d < 4; ++d) _Pragma("unroll") for (int r = 0; r < 16; ++r) o[d][r] *= al_l[crow(r, hi)]; } } while (0)
  f32x16 pA0, pA1, pB0, pB1; float mnA, mnB, alA, alB; bf16x8 pa0, pa1, pa2, pa3; const int NT = seq / KVBLK;
  FA_SLOAD(0); FA_SWAIT(); FA_SWRITE(0); __syncthreads();
  qkt<DQK>(pA0, pA1, K_lds, qr, kb4); partialSM(pA0, pA1, m_reg, mnA, alA, C, thr_s);
  FA_SLOAD(KVBLK);
  FA_SWAIT(); FA_SWRITE(1); __syncthreads();
  for (int j = 1; j + 1 < NT; j += 2) {
    FA_SBAR(); qkt<DQK>(pB0, pB1, K_lds + SHM_K, qr, kb4);
    finishSM(pA0, pA1, alA, l_reg, pa0, pa1, pa2, pa3); FA_SBAR();
    FA_SLOAD((j + 1) * KVBLK); FA_SBAR();
    pv_d0(o, vb0, pa0, pa1, pa2, pa3); partialSM(pB0, pB1, m_reg, mnB, alB, C, thr_s);
    __syncthreads(); FA_SWAIT(); FA_SWRITE(0);
    FA_RESC(alB); __syncthreads();
    FA_SBAR(); qkt<DQK>(pA0, pA1, K_lds, qr, kb4);
    finishSM(pB0, pB1, alB, l_reg, pa0, pa1, pa2, pa3); FA_SBAR();
    FA_SLOAD((j + 2) * KVBLK); FA_SBAR();
    pv_d0(o, vb0 + SHM_V, pa0, pa1, pa2, pa3); partialSM(pA0, pA1, m_reg, mnA, alA, C, thr_s);
    __syncthreads(); FA_SWAIT(); FA_SWRITE(1);
    FA_RESC(alA); __syncthreads();
  }
  FA_SBAR(); qkt<DQK>(pB0, pB1, K_lds + SHM_K, qr, kb4);
  finishSM(pA0, pA1, alA, l_reg, pa0, pa1, pa2, pa3); FA_SBAR();
  pv_d0(o, vb0, pa0, pa1, pa2, pa3); partialSM(pB0, pB1, m_reg, mnB, alB, C, thr_s);
  __syncthreads(); FA_RESC(alB);
  finishSM(pB0, pB1, alB, l_reg, pa0, pa1, pa2, pa3); FA_SBAR();
  pv_d0(o, vb0 + SHM_V, pa0, pa1, pa2, pa3);
  if (hi == 0) li_l[r32] = l_reg; asm volatile("s_waitcnt lgkmcnt(0)" ::: "memory");
  float rli[16];
#pragma unroll
  for (int r = 0; r < 16; ++r) rli[r] = __builtin_amdgcn_rcpf(li_l[crow(r, hi)]);
  bf16_t* Ow = Ob + (size_t)(wid * QBLK) * LDO;
#pragma unroll
  for (int r = 0; r < 16; ++r) { const int orow = crow(r, hi);
#pragma unroll
    for (int d0 = 0; d0 < 4; ++d0) Ow[(size_t)orow * LDO + d0 * 32 + r32] = (bf16_t)f2bf(o[d0][r] * rli[r]); }
  __syncthreads();
#undef FA_SLOAD
#undef FA_SWRITE
#undef FA_SWAIT
#undef FA_RESC
}
template <int DQK, int LDQ, int LDK, int LDV, int LDO>
__device__ __forceinline__ void attn_body3(const bf16_t* __restrict__ Qb, const bf16_t* __restrict__ Kh, const bf16_t* __restrict__ Vh, bf16_t* __restrict__ Ob, int seq, float scale, char* lds, unsigned long long* ssrow, const float* gam) {
  constexpr int SHM_V = KVBLK * 128 * 2, SHM_K = KVBLK * krs<DQK>(), NKC = DQK / 64;
  const float C = scale * 1.4426950408889634f, thr_s = THR / scale;
  int tid_ = hw_tid(); asm volatile("" : "+v"(tid_));
  const int tid = tid_, wid = tid >> 6, lane = tid & 63, r32 = lane & 31, hi = lane >> 5;
  char* V_lds = lds; char* K_lds = lds + 3 * SHM_V;
  float* wsf = (float*)(lds + 3 * SHM_V + 3 * SHM_K) + wid * 64; float* li_l = wsf; float* al_l = wsf + 32;
  float m_reg = -1e30f, l_reg = 0; f32x16 o[4] = {}; bf16x8 qr[DQK / 16];
  const bf16_t* Qw = Qb + (size_t)(wid * QBLK + r32) * LDQ + hi * 8;
#pragma unroll
  for (int d0 = 0; d0 < DQK / 16; ++d0) qr[d0] = *reinterpret_cast<const bf16x8*>(Qw + d0 * 16);
  const int sr = tid >> 4, sc = (tid & 15) * 8, vst0 = v_st(sr, sc), vst1 = v_st(32 + sr, sc);
  const int kgo0 = sr * LDK + sc, klo0 = kswz<DQK>(sr, sc * 2);
  const int kgo2 = (tid >> 3) * LDK + 128 + (tid & 7) * 8, klo2 = kswz<DQK>(tid >> 3, (128 + (tid & 7) * 8) * 2);
  const int vb0 = (int)(uintptr_t)V_lds + v_rd_base(lane);
  int kb4[4];
#pragma unroll
  for (int q = 0; q < 4; ++q) kb4[q] = kswz<DQK>(r32, q * 32 + hi * 16);
  bf16x8 vs0, vs1, ks[NKC];
#define FA_SLOAD(k0) do { vs0 = *reinterpret_cast<const bf16x8*>(&Vh[(size_t)((k0) + sr) * LDV + sc]); vs1 = *reinterpret_cast<const bf16x8*>(&Vh[(size_t)((k0) + 32 + sr) * LDV + sc]); \
    ks[0] = *reinterpret_cast<const bf16x8*>(&Kh[(size_t)(k0) * LDK + kgo0]); ks[1] = *reinterpret_cast<const bf16x8*>(&Kh[(size_t)((k0) + 32) * LDK + kgo0]); \
    if constexpr (NKC == 3) ks[NKC - 1] = *reinterpret_cast<const bf16x8*>(&Kh[(size_t)(k0) * LDK + kgo2]); } while (0)
#define FA_SLOADK(k0) do { ks[0] = *reinterpret_cast<const bf16x8*>(&Kh[(size_t)(k0) * LDK + kgo0]); ks[1] = *reinterpret_cast<const bf16x8*>(&Kh[(size_t)((k0) + 32) * LDK + kgo0]); \
    if constexpr (NKC == 3) ks[NKC - 1] = *reinterpret_cast<const bf16x8*>(&Kh[(size_t)(k0) * LDK + kgo2]); } while (0)
#define FA_SLOADV(k0) do { vs0 = *reinterpret_cast<const bf16x8*>(&Vh[(size_t)((k0) + sr) * LDV + sc]); vs1 = *reinterpret_cast<const bf16x8*>(&Vh[(size_t)((k0) + 32 + sr) * LDV + sc]); } while (0)
#define FA_SWRITE(b) do { *(bf16x8*)(V_lds + (b) * SHM_V + vst0) = vs0; *(bf16x8*)(V_lds + (b) * SHM_V + vst1) = vs1; \
    *(bf16x8*)(K_lds + (b) * SHM_K + klo0) = ks[0]; *(bf16x8*)(K_lds + (b) * SHM_K + klo0 + 32 * krs<DQK>()) = ks[1]; \
    if constexpr (NKC == 3) *(bf16x8*)(K_lds + (b) * SHM_K + klo2) = ks[NKC - 1]; } while (0)
#define FA_SWAIT() asm volatile("s_waitcnt vmcnt(0)" ::: "memory")
#define FA_RESC(a) do { if (__any((a) < 1.f)) { if (hi == 0) al_l[r32] = (a); asm volatile("s_waitcnt lgkmcnt(0)" ::: "memory"); \
    _Pragma("unroll") for (int d = 0; d < 4; ++d) _Pragma("unroll") for (int r = 0; r < 16; ++r) o[d][r] *= al_l[crow(r, hi)]; } } while (0)
  f32x16 pA0, pA1, pB0, pB1; float mnA, mnB, alA, alB; bf16x8 pa0, pa1, pa2, pa3; const int NT = seq / KVBLK;
  FA_SLOAD(0); FA_SWAIT(); FA_SWRITE(0); __syncthreads();
  qkt<DQK>(pA0, pA1, K_lds, qr, kb4); partialSM(pA0, pA1, m_reg, mnA, alA, C, thr_s);
  FA_SLOAD(KVBLK);
  FA_SWAIT(); FA_SWRITE(1); __syncthreads();
  int bk = 1, bv = 0, bw = 2;
#define FA_ROT() do { const int t_ = bv; bv = bk; bk = bw; bw = t_; } while (0)
  for (int j = 1; j + 1 < NT; j += 2) {
    FA_SLOADK((j + 1) * KVBLK); FA_SBAR();
    qkt<DQK>(pB0, pB1, K_lds + bk * SHM_K, qr, kb4);
    finishSM(pA0, pA1, alA, l_reg, pa0, pa1, pa2, pa3); FA_SBAR();
    FA_SLOADV((j + 1) * KVBLK); FA_SBAR();
    pv_d0(o, vb0 + bv * SHM_V, pa0, pa1, pa2, pa3); partialSM(pB0, pB1, m_reg, mnB, alB, C, thr_s);
    FA_SWAIT(); FA_SWRITE(bw);
    FA_RESC(alB); __syncthreads(); FA_ROT();
    FA_SLOADK((j + 2) * KVBLK); FA_SBAR();
    qkt<DQK>(pA0, pA1, K_lds + bk * SHM_K, qr, kb4);
    finishSM(pB0, pB1, alB, l_reg, pa0, pa1, pa2, pa3); FA_SBAR();
    FA_SLOADV((j + 2) * KVBLK); FA_SBAR();
    pv_d0(o, vb0 + bv * SHM_V, pa0, pa1, pa2, pa3); partialSM(pA0, pA1, m_reg, mnA, alA, C, thr_s);
    FA_SWAIT(); FA_SWRITE(bw);
    FA_RESC(alA); __syncthreads(); FA_ROT();
  }
  FA_SBAR(); qkt<DQK>(pB0, pB1, K_lds + bk * SHM_K, qr, kb4);
  finishSM(pA0, pA1, alA, l_reg, pa0, pa1, pa2, pa3); FA_SBAR();
  pv_d0(o, vb0 + bv * SHM_V, pa0, pa1, pa2, pa3); partialSM(pB0, pB1, m_reg, mnB, alB, C, thr_s);
  FA_RESC(alB);
  finishSM(pB0, pB1, alB, l_reg, pa0, pa1, pa2, pa3); FA_SBAR();
  pv_d0(o, vb0 + bk * SHM_V, pa0, pa1, pa2, pa3);
#undef FA_ROT
  if (hi == 0) li_l[r32] = l_reg; asm volatile("s_waitcnt lgkmcnt(0)" ::: "memory");
  float rli[16];
#pragma unroll
  for (int r = 0; r < 16; ++r) rli[r] = __builtin_amdgcn_rcpf(li_l[crow(r, hi)]);
  bf16_t* Ow = Ob + (size_t)(wid * QBLK) * LDO;
  const float gm[4] = {gam[r32], gam[32 + r32], gam[64 + r32], gam[96 + r32]};
#pragma unroll
  for (int r = 0; r < 16; ++r) { const int orow = crow(r, hi); float q = 0.f;
#pragma unroll
    for (int d0 = 0; d0 < 4; ++d0) { const float val = o[d0][r] * rli[r]; q += val * val; Ow[(size_t)orow * LDO + d0 * 32 + r32] = (bf16_t)f2bf(val * gm[d0]); }
    q += __shfl_xor(q, 1); q += __shfl_xor(q, 2); q += __shfl_xor(q, 4); q += __shfl_xor(q, 8); q += __shfl_xor(q, 16);
    if (r32 == 0) atomicAdd(ssrow + wid * QBLK + orow, (unsigned long long)(q * 16777216.f)); }
  __syncthreads();
#undef FA_SLOAD
#undef FA_SLOADK
#undef FA_SLOADV
#undef FA_SWRITE
#undef FA_SWAIT
#undef FA_RESC
}

template <int S> __device__ __forceinline__ void fin_chunk(f32x16& P0, f32x16& P1, float alpha, float& l_reg, float& ps, bf16x8& pa0, bf16x8& pa1, bf16x8& pa2, bf16x8& pa3) {
  if constexpr (S < 8) { P1[2 * S] = __builtin_amdgcn_exp2f(P1[2 * S]); P1[2 * S + 1] = __builtin_amdgcn_exp2f(P1[2 * S + 1]); }
  else if constexpr (S < 12) { constexpr int k = S - 8; ps += (P0[4 * k] + P0[4 * k + 1]) + (P0[4 * k + 2] + P0[4 * k + 3]); ps += (P1[4 * k] + P1[4 * k + 1]) + (P1[4 * k + 2] + P1[4 * k + 3]); }
  else if constexpr (S == 12) { auto rr = __builtin_amdgcn_permlane32_swap(__float_as_uint(ps), __float_as_uint(ps), false, false); l_reg = l_reg * alpha + (__uint_as_float(rr[0]) + __uint_as_float(rr[1])); }
  else if constexpr (S >= 13 && S <= 16) {
#define FA_PK4(P, BASE, OUT) do { unsigned a0 = cvtpk(P[BASE + 0], P[BASE + 1]), a1 = cvtpk(P[BASE + 2], P[BASE + 3]);   \
    unsigned b0 = cvtpk(P[BASE + 4], P[BASE + 5]), b1 = cvtpk(P[BASE + 6], P[BASE + 7]);                              \
    auto r0 = __builtin_amdgcn_permlane32_swap(a0, b0, false, false); auto r1 = __builtin_amdgcn_permlane32_swap(a1, b1, false, false); \
    u32x4 w = {r0[0], r1[0], r0[1], r1[1]}; OUT = *reinterpret_cast<bf16x8*>(&w); } while (0)
    if constexpr (S == 13) FA_PK4(P0, 0, pa0); else if constexpr (S == 14) FA_PK4(P0, 8, pa1); else if constexpr (S == 15) FA_PK4(P1, 0, pa2); else FA_PK4(P1, 8, pa3);
#undef FA_PK4
  }
}
template <int CH> __device__ __forceinline__ void par_chunk(f32x16& P0, f32x16& P1, float& m_reg, float& alpha, float& pm, float& mnC, const float C, const float thr_s) {
  if constexpr (CH < 8) { f32x16& P = (CH < 4) ? P0 : P1; constexpr int b = 4 * (CH & 3);
    if constexpr (CH == 0) pm = fmaxf(fmaxf(P[0], P[1]), fmaxf(P[2], P[3])); else pm = fmaxf(pm, fmaxf(fmaxf(P[b], P[b + 1]), fmaxf(P[b + 2], P[b + 3]))); }
  else if constexpr (CH == 8) {
    auto rr = __builtin_amdgcn_permlane32_swap(__float_as_uint(pm), __float_as_uint(pm), false, false); pm = fmaxf(__uint_as_float(rr[0]), __uint_as_float(rr[1]));
    const bool ok = __all(pm - m_reg <= thr_s);
    const float mn = ok ? m_reg : fmaxf(m_reg, pm);
    alpha = __builtin_amdgcn_exp2f((m_reg - mn) * C);
    m_reg = mn; mnC = -mn * C; }
  else if constexpr (CH < 13) { constexpr int k = CH - 9; f32x16& P = (k < 2) ? P0 : P1; constexpr int b = 8 * (k & 1);
#pragma unroll
    for (int r = 0; r < 8; ++r) { P[b + r] = fmaf(P[b + r], C, mnC); asm volatile("" : "+v"(P[b + r])); } }
  else { constexpr int lo = (CH == 13) ? 0 : (CH == 14) ? 6 : 11, hi_ = (CH == 13) ? 6 : (CH == 14) ? 11 : 16;
#pragma unroll
    for (int r = lo; r < hi_; ++r) { P0[r] = __builtin_amdgcn_exp2f(P0[r]); asm volatile("" : "+v"(P0[r])); } }
}
template <int DQK, int LDQ, int LDK, int LDV, int LDO>
__device__ __forceinline__ void attn_body4(const bf16_t* __restrict__ Qb, const bf16_t* __restrict__ Kh, const bf16_t* __restrict__ Vh, bf16_t* __restrict__ Ob, int seq, float scale, char* lds, unsigned long long* ssrow, const float* gam) {
  constexpr int SHM_V = KVBLK * 128 * 2, SHM_K = KVBLK * krs<DQK>(), NKC = DQK / 64, ND = DQK / 16;
  const float C = scale * 1.4426950408889634f, thr_s = THR / scale;
  int tid_ = hw_tid(); asm volatile("" : "+v"(tid_));
  const int tid = tid_, wid = tid >> 6, lane = tid & 63, r32 = lane & 31, hi = lane >> 5;
  char* V_lds = lds; char* K_lds = lds + 3 * SHM_V;
  float* wsf = (float*)(lds + 3 * SHM_V + 3 * SHM_K) + wid * 64; float* li_l = wsf; float* al_l = wsf + 32;
  float m_reg = -1e30f, l_reg = 0; f32x16 o[4] = {}; bf16x8 qr[ND];
  const bf16_t* Qw = Qb + (size_t)(wid * QBLK + r32) * LDQ + hi * 8;
#pragma unroll
  for (int d0 = 0; d0 < ND; ++d0) qr[d0] = *reinterpret_cast<const bf16x8*>(Qw + d0 * 16);
  const int sr = tid >> 4, sc = (tid & 15) * 8, vst0 = v_st(sr, sc), vst1 = v_st(32 + sr, sc);
  const int kgo0 = sr * LDK + sc, klo0 = kswz<DQK>(sr, sc * 2);
  const int kgo2 = (tid >> 3) * LDK + 128 + (tid & 7) * 8, klo2 = kswz<DQK>(tid >> 3, (128 + (tid & 7) * 8) * 2);
  const int vb0 = (int)(uintptr_t)V_lds + v_rd_base(lane);
  int kb4[4];
#pragma unroll
  for (int q = 0; q < 4; ++q) kb4[q] = kswz<DQK>(r32, q * 32 + hi * 16);
  bf16x8 vs0, vs1, ks[NKC];
#define FA_SLOAD(k0) do { vs0 = *reinterpret_cast<const bf16x8*>(&Vh[(size_t)((k0) + sr) * LDV + sc]); vs1 = *reinterpret_cast<const bf16x8*>(&Vh[(size_t)((k0) + 32 + sr) * LDV + sc]); \
    ks[0] = *reinterpret_cast<const bf16x8*>(&Kh[(size_t)(k0) * LDK + kgo0]); ks[1] = *reinterpret_cast<const bf16x8*>(&Kh[(size_t)((k0) + 32) * LDK + kgo0]); \
    if constexpr (NKC == 3) ks[NKC - 1] = *reinterpret_cast<const bf16x8*>(&Kh[(size_t)(k0) * LDK + kgo2]); } while (0)
#define FA_SWRITE(b) do { *(bf16x8*)(V_lds + (b) * SHM_V + vst0) = vs0; *(bf16x8*)(V_lds + (b) * SHM_V + vst1) = vs1; \
    *(bf16x8*)(K_lds + (b) * SHM_K + klo0) = ks[0]; *(bf16x8*)(K_lds + (b) * SHM_K + klo0 + 32 * krs<DQK>()) = ks[1]; \
    if constexpr (NKC == 3) *(bf16x8*)(K_lds + (b) * SHM_K + klo2) = ks[NKC - 1]; } while (0)
#define FA_SWAIT() asm volatile("s_waitcnt vmcnt(0)" ::: "memory")
#define FA_RESC(a) do { if (__any((a) < 1.f)) { if (hi == 0) al_l[r32] = (a); asm volatile("s_waitcnt lgkmcnt(0)" ::: "memory"); \
    _Pragma("unroll") for (int d = 0; d < 4; ++d) _Pragma("unroll") for (int r = 0; r < 16; ++r) o[d][r] *= al_l[crow(r, hi)]; } } while (0)
#define FA_KF(KS, D0, H) (*reinterpret_cast<const bf16x8*>((KS) + kb4[(D0) & 3] + ((D0) >> 2) * 128 + (H) * 32 * krs<DQK>()))
#define FA_SEGA(PN0, PN1, KS, PO0, PO1, ALO) do { PN0 = f32x16{}; PN1 = f32x16{}; float ps_ = 0.f; bf16x8 fa_ = FA_KF(KS, 0, 0), fb_ = FA_KF(KS, 0, 1); \
    _Pragma("unroll") for (int d0 = 0; d0 < ND; ++d0) { bf16x8 na_ = fa_, nb_ = fb_; if (d0 + 1 < ND) { na_ = FA_KF(KS, d0 + 1, 0); nb_ = FA_KF(KS, d0 + 1, 1); } \
      PN0 = __builtin_amdgcn_mfma_f32_32x32x16_bf16(fa_, qr[d0], PN0, 0, 0, 0); FIN_CH(2 * d0, PO0, PO1, ALO, ps_); \
      PN1 = __builtin_amdgcn_mfma_f32_32x32x16_bf16(fb_, qr[d0], PN1, 0, 0, 0); FIN_CH(2 * d0 + 1, PO0, PO1, ALO, ps_); fa_ = na_; fb_ = nb_; FA_SBAR(); } } while (0)
#define FIN_CH(S, PO0, PO1, ALO, PS) do { switch (S) { \
    case 0: fin_chunk<0>(PO0, PO1, ALO, l_reg, PS, pa0, pa1, pa2, pa3); break; case 1: fin_chunk<1>(PO0, PO1, ALO, l_reg, PS, pa0, pa1, pa2, pa3); break; \
    case 2: fin_chunk<2>(PO0, PO1, ALO, l_reg, PS, pa0, pa1, pa2, pa3); break; case 3: fin_chunk<3>(PO0, PO1, ALO, l_reg, PS, pa0, pa1, pa2, pa3); break; \
    case 4: fin_chunk<4>(PO0, PO1, ALO, l_reg, PS, pa0, pa1, pa2, pa3); break; case 5: fin_chunk<5>(PO0, PO1, ALO, l_reg, PS, pa0, pa1, pa2, pa3); break; \
    case 6: fin_chunk<6>(PO0, PO1, ALO, l_reg, PS, pa0, pa1, pa2, pa3); break; case 7: fin_chunk<7>(PO0, PO1, ALO, l_reg, PS, pa0, pa1, pa2, pa3); break; \
    case 8: fin_chunk<8>(PO0, PO1, ALO, l_reg, PS, pa0, pa1, pa2, pa3); break; case 9: fin_chunk<9>(PO0, PO1, ALO, l_reg, PS, pa0, pa1, pa2, pa3); break; \
    case 10: fin_chunk<10>(PO0, PO1, ALO, l_reg, PS, pa0, pa1, pa2, pa3); break; case 11: fin_chunk<11>(PO0, PO1, ALO, l_reg, PS, pa0, pa1, pa2, pa3); break; \
    case 12: fin_chunk<12>(PO0, PO1, ALO, l_reg, PS, pa0, pa1, pa2, pa3); break; case 13: fin_chunk<13>(PO0, PO1, ALO, l_reg, PS, pa0, pa1, pa2, pa3); break; \
    case 14: fin_chunk<14>(PO0, PO1, ALO, l_reg, PS, pa0, pa1, pa2, pa3); break; case 15: fin_chunk<15>(PO0, PO1, ALO, l_reg, PS, pa0, pa1, pa2, pa3); break; \
    case 16: fin_chunk<16>(PO0, PO1, ALO, l_reg, PS, pa0, pa1, pa2, pa3); break; default: break; } } while (0)
#define FA_TR8(DST, D0, VB) do { DST[0] = tr_read<v_rd_off(D0, 0, 0)>(VB); DST[1] = tr_read<v_rd_off(D0, 0, 1)>(VB); DST[2] = tr_read<v_rd_off(D0, 1, 0)>(VB); DST[3] = tr_read<v_rd_off(D0, 1, 1)>(VB); \
    DST[4] = tr_read<v_rd_off(D0, 2, 0)>(VB); DST[5] = tr_read<v_rd_off(D0, 2, 1)>(VB); DST[6] = tr_read<v_rd_off(D0, 3, 0)>(VB); DST[7] = tr_read<v_rd_off(D0, 3, 1)>(VB); } while (0)
#define FA_PKV(F, i) (bf16x8){F[2 * (i)][0], F[2 * (i)][1], F[2 * (i)][2], F[2 * (i)][3], F[2 * (i) + 1][0], F[2 * (i) + 1][1], F[2 * (i) + 1][2], F[2 * (i) + 1][3]}
#define FA_PVB(D0, F, PN0, PN1, ALN) do { \
    o[D0] = __builtin_amdgcn_mfma_f32_32x32x16_bf16(pa0, FA_PKV(F, 0), o[D0], 0, 0, 0); par_chunk<4 * D0 + 0>(PN0, PN1, m_reg, ALN, pm_, mnC_, C, thr_s); \
    o[D0] = __builtin_amdgcn_mfma_f32_32x32x16_bf16(pa1, FA_PKV(F, 1), o[D0], 0, 0, 0); par_chunk<4 * D0 + 1>(PN0, PN1, m_reg, ALN, pm_, mnC_, C, thr_s); \
    o[D0] = __builtin_amdgcn_mfma_f32_32x32x16_bf16(pa2, FA_PKV(F, 2), o[D0], 0, 0, 0); par_chunk<4 * D0 + 2>(PN0, PN1, m_reg, ALN, pm_, mnC_, C, thr_s); \
    o[D0] = __builtin_amdgcn_mfma_f32_32x32x16_bf16(pa3, FA_PKV(F, 3), o[D0], 0, 0, 0); par_chunk<4 * D0 + 3>(PN0, PN1, m_reg, ALN, pm_, mnC_, C, thr_s); FA_SBAR(); } while (0)
#define FA_SEGB(VB, PN0, PN1, ALN) do { float pm_ = 0.f, mnC_ = 0.f; s16x4 fA_[8], fB_[8]; const int vb_ = (VB); \
    FA_TR8(fA_, 0, vb_); FA_TR8(fB_, 1, vb_); asm volatile("s_waitcnt lgkmcnt(8)" ::: "memory"); FA_SBAR(); FA_PVB(0, fA_, PN0, PN1, ALN); \
    FA_TR8(fA_, 2, vb_); asm volatile("s_waitcnt lgkmcnt(8)" ::: "memory"); FA_SBAR(); FA_PVB(1, fB_, PN0, PN1, ALN); \
    FA_TR8(fB_, 3, vb_); asm volatile("s_waitcnt lgkmcnt(8)" ::: "memory"); FA_SBAR(); FA_PVB(2, fA_, PN0, PN1, ALN); \
    asm volatile("s_waitcnt lgkmcnt(0)" ::: "memory"); FA_SBAR(); FA_PVB(3, fB_, PN0, PN1, ALN); } while (0)
  f32x16 pA0, pA1, pB0, pB1; float alA = 1.f, alB = 1.f; bf16x8 pa0, pa1, pa2, pa3; const int NT = seq / KVBLK;
  FA_SLOAD(0); FA_SWAIT(); FA_SWRITE(0); __syncthreads();
  { float mnA_, alA_; qkt<DQK>(pA0, pA1, K_lds, qr, kb4); partialSM(pA0, pA1, m_reg, mnA_, alA_, C, thr_s); alA = alA_; }
  FA_SLOAD(KVBLK);
  FA_SWAIT(); FA_SWRITE(1); __syncthreads();
  int bk = 1, bv = 0, bw = 2;
#define FA_ROT() do { const int t_ = bv; bv = bk; bk = bw; bw = t_; } while (0)
  for (int j = 1; j + 1 < NT; j += 2) {
    FA_SBAR(); FA_SEGA(pB0, pB1, K_lds + bk * SHM_K, pA0, pA1, alA);
    FA_SLOAD((j + 1) * KVBLK); FA_SBAR();
    FA_SEGB(vb0 + bv * SHM_V, pB0, pB1, alB);
    FA_SWAIT(); FA_SWRITE(bw);
    FA_RESC(alB); __syncthreads(); FA_ROT();
    FA_SBAR(); FA_SEGA(pA0, pA1, K_lds + bk * SHM_K, pB0, pB1, alB);
    FA_SLOAD((j + 2) * KVBLK); FA_SBAR();
    FA_SEGB(vb0 + bv * SHM_V, pA0, pA1, alA);
    FA_SWAIT(); FA_SWRITE(bw);
    FA_RESC(alA); __syncthreads(); FA_ROT();
  }
  FA_SBAR(); FA_SEGA(pB0, pB1, K_lds + bk * SHM_K, pA0, pA1, alA);
  FA_SEGB(vb0 + bv * SHM_V, pB0, pB1, alB);
  FA_RESC(alB);
  finishSM(pB0, pB1, alB, l_reg, pa0, pa1, pa2, pa3); FA_SBAR();
  pv_d0(o, vb0 + bk * SHM_V, pa0, pa1, pa2, pa3);
#undef FA_ROT
  if (hi == 0) li_l[r32] = l_reg; asm volatile("s_waitcnt lgkmcnt(0)" ::: "memory");
  float rli[16];
#pragma unroll
  for (int r = 0; r < 16; ++r) rli[r] = __builtin_amdgcn_rcpf(li_l[crow(r, hi)]);
  bf16_t* Ow = Ob + (size_t)(wid * QBLK) * LDO;
  const float gm[4] = {gam[r32], gam[32 + r32], gam[64 + r32], gam[96 + r32]};
#pragma unroll
  for (int r = 0; r < 16; ++r) { const int orow = crow(r, hi); float q = 0.f;
#pragma unroll
    for (int d0 = 0; d0 < 4; ++d0) { const float val = o[d0][r] * rli[r]; q += val * val; Ow[(size_t)orow * LDO + d0 * 32 + r32] = (bf16_t)f2bf(val * gm[d0]); }
    q += __shfl_xor(q, 1); q += __shfl_xor(q, 2); q += __shfl_xor(q, 4); q += __shfl_xor(q, 8); q += __shfl_xor(q, 16);
    if (r32 == 0) atomicAdd(ssrow + wid * QBLK + orow, (unsigned long long)(q * 16777216.f)); }
  __syncthreads();
#undef FA_SLOAD
#undef FA_SWRITE
#undef FA_SWAIT
#undef FA_RESC
#undef FA_KF
#undef FA_SEGA
#undef FIN_CH
#undef FA_TR8
#undef FA_PKV
#undef FA_PVB
#undef FA_SEGB
}
#undef FA_SBAR
}
__device__ __forceinline__ void mla_attn_phase(unsigned char* dout, unsigned char* ws, char* lds, int bid, int nblk, const float* gamma1, int last = NB_ * 8 * (S_ / 256)) {
  for (int u = bid; u < last; u += nblk) {
    const int qb = u & 7, h = (u >> 3) & 7, b = u >> 6;
    const bf16_t* Q = (const bf16_t*)(dout + DO_Q) + (size_t)(b * S_ + qb * 256) * 1536 + h * 192;
    const bf16_t* K = (const bf16_t*)(dout + DO_K) + (size_t)(b * S_) * 1536 + h * 192;
    const bf16_t* V = (const bf16_t*)(dout + DO_V) + (size_t)(b * S_) * 1024 + h * 128;
    bf16_t* O = (bf16_t*)(ws + WS_YMIX) + (size_t)(b * S_ + qb * 256) * 2048 + h * 128;
    fa::attn_body3<192, 1536, 1536, 1024, 2048>(Q, K, V, O, S_, 0.07216878364870322f, lds, (unsigned long long*)(ws + WS_SS) + 2 * 16384 + (b * S_ + qb * 256), gamma1 + h * 128);
  }
}

__device__ __forceinline__ void mem_attn_phase(unsigned char* ws, char* lds, int bid, int nblk, int last = NB_ * 4 * (S_ / 256)) {
  for (int u = bid; u < last; u += nblk) {
    const int qb = u & 7, h = (u >> 3) & 3, b = u >> 5;
    const bf16_t* Q = (const bf16_t*)(ws + WS_QM) + (size_t)(b * S_ + qb * 256) * 512 + h * 128;
    const bf16_t* K = (const bf16_t*)(ws + WS_MEMKV) + (size_t)(b * 256) * 1024 + h * 128;
    const bf16_t* V = K + 512;
    bf16_t* O = (bf16_t*)(ws + WS_OM) + (size_t)(b * S_ + qb * 256) * 512 + h * 128;
    fa::attn_body<128, 512, 1024, 1024, 512>(Q, K, V, O, 256, 0.08838834764831845f, lds);
  }
}
__device__ __forceinline__ void scan_phase(unsigned char* ws, float* lds, int bid, int nblk, int tid_in) {
  int tid = tid_in; asm volatile("" : "+v"(tid));
  f32x4* sA = (f32x4*)lds; f32x4* sB = sA + 512;
  const int cq = tid & 15, ch = tid >> 4;
  for (int it = bid; it < NB_ * 2 * 16; it += nblk) {
    const int cg_ = it & 15, dir = (it >> 4) & 1, b = it >> 5;
    const char* LA = (const char*)(ws + (dir ? WS_LAB : WS_LAF)) + ((size_t)b * S_ * 1024 + cg_ * 64) * 2;
    char* BT = (char*)(ws + (dir ? WS_BTB : WS_BTF)) + ((size_t)b * S_ * 1024 + cg_ * 64) * 2;
    const int sstep = dir ? -2048 : 2048;
    const unsigned off0 = (unsigned)((dir ? (S_ - 1 - ch * 64) : ch * 64) * 2048 + cq * 8);
    f32x4 A = {1.f, 1.f, 1.f, 1.f}, Bv = {0.f, 0.f, 0.f, 0.f};
    unsigned off = off0;
#pragma unroll 8
    for (int i = 0; i < 64; ++i) { const u32x2 lw = *(const u32x2*)(LA + off), bw = *(const u32x2*)(BT + off); off += sstep;
      const f32x4 a = {__expf(bflo(lw.x)), __expf(bfhi(lw.x)), __expf(bflo(lw.y)), __expf(bfhi(lw.y))}; const f32x4 bt = {bflo(bw.x), bfhi(bw.x), bflo(bw.y), bfhi(bw.y)};
      Bv = a * Bv + bt; A = A * a; }
    __syncthreads();
    sA[ch * 16 + cq] = A; sB[ch * 16 + cq] = Bv;
    __syncthreads();
    f32x4 h = {0.f, 0.f, 0.f, 0.f};
    for (int qq = 0; qq < ch; ++qq) h = sA[qq * 16 + cq] * h + sB[qq * 16 + cq];
    off = off0;
#pragma unroll 8
    for (int i = 0; i < 64; ++i) { const u32x2 lw = *(const u32x2*)(LA + off), bw = *(const u32x2*)(BT + off);
      const f32x4 a = {__expf(bflo(lw.x)), __expf(bfhi(lw.x)), __expf(bflo(lw.y)), __expf(bfhi(lw.y))}; const f32x4 bt = {bflo(bw.x), bfhi(bw.x), bflo(bw.y), bfhi(bw.y)};
      h = a * h + bt; u32x2 w; w.x = pk2(h[0], h[1]); w.y = pk2(h[2], h[3]); *(u32x2*)(BT + off) = w; off += sstep; }
  }
  __syncthreads();
}


__device__ __forceinline__ void lru_fused_phase(const Params& p, unsigned char* lds_raw, int bid, int nblk, int last = NB_ * 8 * 2 * 2) {
  constexpr int RS = 272;
  constexpr int AST = 65;
  unsigned char* WL = lds_raw; unsigned char* XL = lds_raw + 128 * RS;
  f32x2* AB = (f32x2*)(lds_raw + 2 * 128 * RS); float* AG = (float*)(AB + 128 * AST);
  float* CAR = AG + 2 * 8 * 64;
  int tid_ = hw_tid(); asm volatile("" : "+v"(tid_));
  const int tid = tid_, lane = tid & 63, wave = tid >> 6, r32 = lane & 31, hi = lane >> 5;
  unsigned char* ws = p.ws;
  const bf16_t* LX = (const bf16_t*)(ws + WS_LRUX);
  for (int it = bid; it < last; it += nblk) {
    const int half = it & 1, dir = (it >> 1) & 1, n = (it >> 2) & 7, b = it >> 5;
    const int ch0 = n * 128 + half * 64;
    __syncthreads();
    { const bf16_t* wg = (const bf16_t*)(ws + WS_WG_T) + (size_t)(n * 512 + dir * 256 + half * 128) * 128;
      for (int i = tid; i < 128 * 16; i += NTHR) { const int r = i >> 4, c8 = (i & 15) * 8; *(u32x4*)(WL + r * RS + c8 * 2) = *(const u32x4*)(wg + r * 128 + c8); } }
    if (tid < 64) CAR[tid] = 0.f;
    float cw0[4], cw1[4]; const float cb0 = p.in[11][n * 128 + 2 * lane], cb1 = p.in[11][n * 128 + 2 * lane + 1];
#pragma unroll
    for (int k = 0; k < 4; ++k) { cw0[k] = p.in[10][k * 1024 + n * 128 + 2 * lane]; cw1[k] = p.in[10][k * 1024 + n * 128 + 2 * lane + 1]; }
    bf16_t* H = (bf16_t*)(ws + (dir ? WS_BTB : WS_BTF));
    float tb0[16], tb1[16], tb2[16];
#pragma unroll
    for (int t = 0; t < 2; ++t)
#pragma unroll
      for (int g = 0; g < 4; ++g)
#pragma unroll
        for (int u = 0; u < 2; ++u) { const int jl = (wave & 1) * 32 + 16 * t + 4 * g + 2 * hi + u; const f32x4 tb = *((const f32x4*)(ws + WS_GTAB) + dir * 1024 + ch0 + jl);
          tb0[t * 8 + g * 2 + u] = tb[0]; tb1[t * 8 + g * 2 + u] = tb[1]; tb2[t * 8 + g * 2 + u] = tb[2]; }
    unsigned xr[19];
#define LRU_LOADX(C) do { const int q0_ = (dir ? S_ - 128 * ((C) + 1) : 128 * (C)) + wave * 16; \
      _Pragma("unroll") for (int j = 0; j < 19; ++j) { const int row = q0_ + j - 2, rc = row < 0 ? 0 : (row >= S_ ? S_ - 1 : row);        \
        const unsigned v_ = *(const unsigned*)(LX + (size_t)(b * S_ + rc) * 1024 + n * 128 + 2 * lane); xr[j] = (row == rc) ? v_ : 0u; } } while (0)
    LRU_LOADX(0);
    for (int c = 0; c < 16; ++c) {
      const int p0 = dir ? S_ - 128 * (c + 1) : 128 * c;
      {
#pragma unroll
        for (int i = 0; i < 16; ++i) { float s0 = cb0, s1 = cb1;
#pragma unroll
          for (int k = 0; k < 4; ++k) { s0 += bflo(xr[i + k]) * cw0[k]; s1 += bfhi(xr[i + k]) * cw1[k]; }
          *(unsigned*)(XL + (wave * 16 + i) * RS + lane * 4) = pk2(s0, s1); } }
      if (c + 1 < 16) LRU_LOADX(c + 1);
      __syncthreads();
      f32x16 acc[2] = {};
#pragma unroll
      for (int s = 0; s < 8; ++s) { const bf16x8 xf = *(const bf16x8*)(XL + ((wave >> 1) * 32 + r32) * RS + (16 * s + 8 * hi) * 2);
#pragma unroll
        for (int t = 0; t < 2; ++t) { const bf16x8 wf = *(const bf16x8*)(WL + ((wave & 1) * 64 + 32 * t + r32) * RS + (16 * s + 8 * hi) * 2);
          acc[t] = __builtin_amdgcn_mfma_f32_32x32x16_bf16(wf, xf, acc[t], 0, 0, 0); } }
      { const int pos = (wave >> 1) * 32 + r32;
#pragma unroll
        for (int t = 0; t < 2; ++t)
#pragma unroll
          for (int g = 0; g < 4; ++g) { const int jl = (wave & 1) * 32 + 16 * t + 4 * g + 2 * hi;
            const unsigned xw = *(const unsigned*)(XL + pos * RS + (half * 64 + jl) * 2);
#pragma unroll
            for (int u = 0; u < 2; ++u) { const int ti = t * 8 + g * 2 + u;
              const float e1 = __builtin_amdgcn_exp2f(-1.4426950408889634f * (acc[t][4 * g + 2 * u] + tb1[ti])), e2 = __builtin_amdgcn_exp2f(-1.4426950408889634f * (acc[t][4 * g + 2 * u + 1] + tb2[ti]));
              const float R = __builtin_amdgcn_rcpf((1.f + e1) * (1.f + e2)), sr = (1.f + e2) * R, si = (1.f + e1) * R;
              const float la = -tb0[ti] * sr, a = __builtin_amdgcn_exp2f(la * 1.4426950408889634f), x2 = 2.f * la;
              const float ser = -x2 * (1.f + x2 * (0.5f + x2 * (1.6666667e-1f + x2 * (4.1666667e-2f + x2 * (8.3333333e-3f + x2 * 1.3888889e-3f)))));
              const float om = x2 > -0.25f ? ser : 1.f - a * a;
              AB[pos * AST + jl + u] = (f32x2){a, __builtin_amdgcn_sqrtf(om) * si * (u ? bfhi(xw) : bflo(xw))}; } } }
      __syncthreads();
      { const int jl = tid & 63, sub = tid >> 6; float av[16], bv[16]; float A = 1.f, B = 0.f;
#pragma unroll
        for (int i = 0; i < 16; ++i) { const int tau = 16 * sub + i, pos = dir ? 127 - tau : tau; const f32x2 ab = AB[pos * AST + jl]; av[i] = ab[0]; bv[i] = ab[1]; B = av[i] * B + bv[i]; A *= av[i]; }
        AG[sub * 64 + jl] = A; AG[512 + sub * 64 + jl] = B;
        __syncthreads();
        float h = CAR[jl];
        for (int s2 = 0; s2 < sub; ++s2) h = AG[s2 * 64 + jl] * h + AG[512 + s2 * 64 + jl];
#pragma unroll
        for (int i = 0; i < 16; ++i) { const int tau = 16 * sub + i, pos = dir ? 127 - tau : tau; h = av[i] * h + bv[i];
          H[(size_t)(b * S_ + p0 + pos) * 1024 + ch0 + jl] = (bf16_t)(pk2(h, 0.f) & 0xffffu); }
        __syncthreads();
        if (sub == 7) CAR[jl] = h; }
    }
#undef LRU_LOADX
  }
  __syncthreads();
}

__device__ __forceinline__ void phase3b(const Params& p, int gw, int ngw, int lane, int last = T_) {
  unsigned char* ws = p.ws; bf16_t* Y = (bf16_t*)(ws + WS_YMIX);
  const bf16_t* HF = (const bf16_t*)(ws + WS_BTF); const bf16_t* HB = (const bf16_t*)(ws + WS_BTB); const bf16_t* G = (const bf16_t*)(ws + WS_GATE);
  for (int r = gw; r < last; r += ngw) {
    { const size_t o = (size_t)r * 1024 + lane * 16; float a[16], b[16], gg[16];
      unpack8(*(const u32x4*)(HF + o), a); unpack8(*(const u32x4*)(HF + o + 8), a + 8);
      unpack8(*(const u32x4*)(HB + o), b); unpack8(*(const u32x4*)(HB + o + 8), b + 8);
      unpack8(*(const u32x4*)(G + o), gg); unpack8(*(const u32x4*)(G + o + 8), gg + 8);
      float q = 0.f;
#pragma unroll
      for (int i = 0; i < 16; ++i) { a[i] = (a[i] + b[i]) * gg[i]; q += a[i] * a[i]; }
      const float r1inv = __builtin_amdgcn_sqrtf((float)((const unsigned long long*)(ws + WS_SS))[2 * 16384 + r] * (1.f / 16777216.f / 1024.f) + RMS_EPS);
      const float sc = rsqrtf(dpp_sum64(q) * (1.f / 1024.f) + RMS_EPS) * r1inv; const float* g = p.in[18] + lane * 16;
#pragma unroll
      for (int i = 0; i < 16; ++i) a[i] = a[i] * sc * g[i];
      bf16_t* row = Y + (size_t)r * 2048 + 1024 + lane * 16; *(u32x4*)row = pack8(a); *(u32x4*)(row + 8) = pack8(a + 8); }
  }
}
__device__ __forceinline__ void ln_pass(unsigned char* ws, const float* g, const float* b, int gw, int ngw, int lane, int last = T_) {
  bf16_t* X = (bf16_t*)(ws + WS_X);
  for (int r0 = gw * 2; r0 < last; r0 += ngw * 2) { u32x4 w[2][4]; float v[32];
#pragma unroll
    for (int rr = 0; rr < 2; ++rr)
#pragma unroll
      for (int j = 0; j < 4; ++j) w[rr][j] = *(const u32x4*)(X + (size_t)(r0 + rr) * DM + j * 512 + lane * 8);
#pragma unroll
    for (int rr = 0; rr < 2; ++rr) {
#pragma unroll
      for (int j = 0; j < 4; ++j) unpack8(w[rr][j], &v[j * 8]);
      ln_row_regs(v, g, b, lane);
#pragma unroll
      for (int j = 0; j < 4; ++j) *(u32x4*)(X + (size_t)(r0 + rr) * DM + j * 512 + lane * 8) = pack8(&v[j * 8]); } }
}
__device__ __forceinline__ void cvt_pass(const float* src, bf16_t* dst, size_t n, int gw, int ngw, int lane) {
  for (size_t i = (size_t)(gw * 64 + lane) * 8; i < n; i += (size_t)ngw * 64 * 8) {
    const f32x4 a = *(const f32x4*)(src + i), b = *(const f32x4*)(src + i + 4); u32x4 o; o.x = pk2(a[0], a[1]); o.y = pk2(a[2], a[3]); o.z = pk2(b[0], b[1]); o.w = pk2(b[2], b[3]);
    *(u32x4*)(dst + i) = o; }
}

__device__ __forceinline__ unsigned key_of(float s, unsigned tag, unsigned tagmask) {
  unsigned u = __float_as_uint(s); u = (u & 0x80000000u) ? ~u : (u | 0x80000000u); return (u & ~tagmask) | (tagmask - tag);
}
__device__ __forceinline__ float val_of(unsigned k, unsigned tagmask) { unsigned u = k & ~tagmask; u = (u & 0x80000000u) ? (u & 0x7fffffffu) : ~u; return __uint_as_float(u); }
__device__ __forceinline__ void topk_phase(unsigned char* ws, const float* SC, int gw, int ngw, int lane) {
  int* IDX = (int*)(ws + WS_IDX); float* GV = (float*)(ws + WS_GV);
  int ca = -1, cb = -1; { int n = 0; for (int a = 0; a < 16; ++a) for (int b = 0; b < 16; ++b) if ((a + 1) * (b + 1) <= 16) { if (n == lane) { ca = a; cb = b; } ++n; } }
  for (int pr = gw; pr < T_ * 8; pr += ngw) {
    const float* row = SC + (size_t)pr * 256;
    unsigned k1a = key_of(row[lane], lane, 127u), k1b = key_of(row[64 + lane], 64 + lane, 127u);
    unsigned k2a = key_of(row[128 + lane], lane, 127u), k2b = key_of(row[192 + lane], 64 + lane, 127u);
    unsigned t1 = 0u, t2 = 0u;
    for (int it = 0; it < 16; ++it) {
      const unsigned m1 = dpp_max64_u32(k1a > k1b ? k1a : k1b), m2 = dpp_max64_u32(k2a > k2b ? k2a : k2b);
      if (k1a == m1) k1a = 0u; if (k1b == m1) k1b = 0u; if (k2a == m2) k2a = 0u; if (k2b == m2) k2b = 0u;
      if (lane == it) { t1 = m1; t2 = m2; }
    }
    const unsigned ka = (unsigned)__shfl((int)t1, ca < 0 ? 0 : ca), kb = (unsigned)__shfl((int)t2, cb < 0 ? 0 : cb);
    const float va = val_of(ka, 127u), vb = val_of(kb, 127u); const int ia = 127 - (int)(ka & 127u), ib = 127 - (int)(kb & 127u);
    const float cs = va + vb; const int cidx = ia * 128 + ib;
    unsigned ck = (ca >= 0) ? key_of(cs, (unsigned)(ca * 16 + cb), 255u) : 0u;
    float ts = 0.f; int ti = 0;
    for (int it = 0; it < 16; ++it) {
      const unsigned m = dpp_max64_u32(ck); const unsigned long long bal = __ballot(ck == m && ck != 0u); const int src = __ffsll((long long)bal) - 1;
      const float sv = __shfl(cs, src); const int si = __shfl(cidx, src);
      if (lane == src) ck = 0u;
      if (lane == it) { ts = sv; ti = si; }
    }
    const float mx = __uint_as_float(__builtin_amdgcn_readlane(__float_as_uint(ts), 0));
    float ex = (lane < 16) ? __expf(ts - mx) : 0.f; const float sum = dpp_sum64(ex);
    if (lane < 16) { IDX[(size_t)pr * 16 + lane] = ti; GV[(size_t)pr * 16 + lane] = ex / sum; }
  }
}


__device__ __forceinline__ unsigned umax_(unsigned a, unsigned b) { return a > b ? a : b; }
__device__ __forceinline__ unsigned umin_(unsigned a, unsigned b) { return a < b ? a : b; }
__device__ __forceinline__ unsigned ord_of(float s) { const unsigned u = __float_as_uint(s); return (u & 0x80000000u) ? ~u : (u | 0x80000000u); }
__device__ __forceinline__ unsigned qx1(unsigned v) { return (unsigned)__builtin_amdgcn_update_dpp(0, (int)v, 0xB1, 0xf, 0xf, false); }
__device__ __forceinline__ unsigned qx2(unsigned v) { return (unsigned)__builtin_amdgcn_update_dpp(0, (int)v, 0x4E, 0xf, 0xf, false); }
__device__ __forceinline__ void ins16(unsigned (&L)[16], unsigned x) {
#pragma unroll
  for (int k = 0; k < 16; ++k) { const unsigned hi = umax_(L[k], x); x = umin_(L[k], x); L[k] = hi; }
}
__device__ __forceinline__ void ins16p(unsigned (&L)[16], unsigned (&P)[16], unsigned x, unsigned px) {
#pragma unroll
  for (int k = 0; k < 16; ++k) { const bool c = x > L[k]; const unsigned nl = c ? x : L[k], nx = c ? L[k] : x, np = c ? px : P[k], npx = c ? P[k] : px; L[k] = nl; x = nx; P[k] = np; px = npx; }
}
__device__ __forceinline__ void bitonic_sort16(unsigned (&M)[16]) {
#pragma unroll
  for (int d = 8; d >= 1; d >>= 1)
#pragma unroll
    for (int i = 0; i < 16; ++i) if (!(i & d)) { const unsigned hi = umax_(M[i], M[i + d]), lo = umin_(M[i], M[i + d]); M[i] = hi; M[i + d] = lo; }
}
__device__ __forceinline__ void bitonic_sort16p(unsigned (&M)[16], unsigned (&P)[16]) {
#pragma unroll
  for (int d = 8; d >= 1; d >>= 1)
#pragma unroll
    for (int i = 0; i < 16; ++i) if (!(i & d)) { const bool c = M[i + d] > M[i]; const unsigned a = M[i], b = M[i + d], pa = P[i], pb = P[i + d];
      M[i] = c ? b : a; M[i + d] = c ? a : b; P[i] = c ? pb : pa; P[i + d] = c ? pa : pb; }
}
__device__ __forceinline__ void topk_phase2(unsigned char* ws, const float* SC, int gw, int ngw, int lane) {
  int* IDX = (int*)(ws + WS_IDX); float* GV = (float*)(ws + WS_GV);
  const int c = lane & 3;
  const unsigned tagbase = (c & 1) ? 0u : 64u;
  for (int item = gw; item < T_ * 8 / 16; item += ngw) {
    const int pr = item * 16 + (lane >> 2);
    const float* row = SC + (size_t)pr * 256 + c * 64;
    unsigned L[16];
#pragma unroll
    for (int k = 0; k < 16; ++k) L[k] = 0u;
#pragma unroll
    for (int bq = 0; bq < 4; ++bq) { f32x4 v[4];
#pragma unroll
      for (int j = 0; j < 4; ++j) v[j] = *(const f32x4*)(row + bq * 16 + j * 4);
#pragma unroll
      for (int j = 0; j < 4; ++j)
#pragma unroll
        for (int i = 0; i < 4; ++i) { const int e = bq * 16 + j * 4 + i; ins16(L, (ord_of(v[j][i]) & ~127u) | (tagbase + (unsigned)(63 - e))); } }
    { unsigned B[16];
#pragma unroll
      for (int k = 0; k < 16; ++k) B[k] = qx1(L[k]);
#pragma unroll
      for (int k = 0; k < 16; ++k) L[k] = umax_(L[k], B[15 - k]);
      bitonic_sort16(L); }
    float F1[16], F2[16]; unsigned I1[16], I2[16];
#pragma unroll
    for (int k = 0; k < 16; ++k) { const unsigned o = qx2(L[k]); const unsigned v1 = (c < 2) ? L[k] : o, v2 = (c < 2) ? o : L[k];
      unsigned u1 = v1 & ~127u, u2 = v2 & ~127u; u1 = (u1 & 0x80000000u) ? (u1 & 0x7fffffffu) : ~u1; u2 = (u2 & 0x80000000u) ? (u2 & 0x7fffffffu) : ~u2;
      F1[k] = __uint_as_float(u1); F2[k] = __uint_as_float(u2); I1[k] = (127u - (v1 & 127u)) << 7; I2[k] = 127u - (v2 & 127u); }
    unsigned M[16], P[16];
#pragma unroll
    for (int k = 0; k < 16; ++k) { M[k] = 0u; P[k] = 0u; }
    {
      constexpr int CA[52] = {0,0,0,0,0,0,0,0,0,0,0,0,0,0,0,0, 1,1,1,1,1,1,1,1, 2,2,2,2,2, 3,3,3,3, 4,4,4, 5,5, 6,6, 7,7, 8, 9, 10, 11, 12, 13, 14, 15, 15, 15};
      constexpr int CB[52] = {0,1,2,3,4,5,6,7,8,9,10,11,12,13,14,15, 0,1,2,3,4,5,6,7, 0,1,2,3,4, 0,1,2,3, 0,1,2, 0,1, 0,1, 0,1, 0, 0, 0, 0, 0, 0, 0, 0, 0, 0};
#pragma unroll
      for (int m = 0; m < 13; ++m) {
        unsigned kx[4], px[4];
#pragma unroll
        for (int q = 0; q < 4; ++q) { const int n = 4 * m + q; const bool pad = n >= 50;
          kx[q] = pad ? 0u : ord_of(F1[CA[n]] + F2[CB[n]]); px[q] = I1[CA[n]] | I2[CB[n]]; }
        const unsigned x = (c == 0) ? kx[0] : (c == 1) ? kx[1] : (c == 2) ? kx[2] : kx[3];
        const unsigned pp = (c == 0) ? px[0] : (c == 1) ? px[1] : (c == 2) ? px[2] : px[3];
        ins16p(M, P, x, pp);
      }
    }
    { unsigned B[16], Q[16];
#pragma unroll
      for (int k = 0; k < 16; ++k) { B[k] = qx1(M[k]); Q[k] = qx1(P[k]); }
#pragma unroll
      for (int k = 0; k < 16; ++k) { const bool t = B[15 - k] > M[k]; M[k] = t ? B[15 - k] : M[k]; P[k] = t ? Q[15 - k] : P[k]; }
      bitonic_sort16p(M, P);
#pragma unroll
      for (int k = 0; k < 16; ++k) { B[k] = qx2(M[k]); Q[k] = qx2(P[k]); }
#pragma unroll
      for (int k = 0; k < 16; ++k) { const bool t = B[15 - k] > M[k]; M[k] = t ? B[15 - k] : M[k]; P[k] = t ? Q[15 - k] : P[k]; }
      bitonic_sort16p(M, P); }
    float sv[16]; float mx = -1e30f;
#pragma unroll
    for (int k = 0; k < 16; ++k) { unsigned u = M[k]; u = (u & 0x80000000u) ? (u & 0x7fffffffu) : ~u; sv[k] = __uint_as_float(u); mx = fmaxf(mx, sv[k]); }
    float sum = 0.f;
#pragma unroll
    for (int k = 0; k < 16; ++k) { sv[k] = __expf(sv[k] - mx); sum += sv[k]; }
    const float inv = __builtin_amdgcn_rcpf(sum);
    u32x4 oi; f32x4 og;
#pragma unroll
    for (int i = 0; i < 4; ++i) { oi[i] = (c == 0) ? P[i] : (c == 1) ? P[4 + i] : (c == 2) ? P[8 + i] : P[12 + i];
      og[i] = ((c == 0) ? sv[i] : (c == 1) ? sv[4 + i] : (c == 2) ? sv[8 + i] : sv[12 + i]) * inv; }
    *(u32x4*)(IDX + (size_t)pr * 16 + 4 * c) = oi; *(f32x4*)(GV + (size_t)pr * 16 + 4 * c) = og;
  }
}


__device__ __forceinline__ unsigned sx16(unsigned v) { return (unsigned)__shfl_xor((int)v, 16); }
__device__ __forceinline__ unsigned sx32(unsigned v) { return (unsigned)__shfl_xor((int)v, 32); }
#define MERGE16(L, SH) do { unsigned B_[16]; _Pragma("unroll") for (int k_ = 0; k_ < 16; ++k_) B_[k_] = SH(L[k_]); \
    _Pragma("unroll") for (int k_ = 0; k_ < 16; ++k_) L[k_] = umax_(L[k_], B_[15 - k_]); bitonic_sort16(L); } while (0)
#define MERGE16P(M, P, SH) do { unsigned B_[16], Q_[16]; _Pragma("unroll") for (int k_ = 0; k_ < 16; ++k_) { B_[k_] = SH(M[k_]); Q_[k_] = SH(P[k_]); } \
    _Pragma("unroll") for (int k_ = 0; k_ < 16; ++k_) { const bool t_ = B_[15 - k_] > M[k_]; M[k_] = t_ ? B_[15 - k_] : M[k_]; P[k_] = t_ ? Q_[15 - k_] : P[k_]; } bitonic_sort16p(M, P); } while (0)
template <int PART> __device__ __forceinline__ void topk_phase3(const Params& p, unsigned char* lds_raw, int gw, int ngw, int tid, int last = T_ * 8 / 16) {
  unsigned char* ws = p.ws; int* IDX = (int*)(ws + WS_IDX); float* GV = (float*)(ws + WS_GV); const bf16_t* QP = (const bf16_t*)(ws + WS_QP);
  constexpr int KRS = 272;
  if constexpr (PART == 0) {
    for (int i = tid; i < 2 * 128 * 32; i += NTHR) { const int tb = i >> 12, r = (i >> 5) & 127, c4 = (i & 31) * 4; const f32x4 v = *(const f32x4*)(p.in[29 + tb] + r * 128 + c4);
      u32x2 w; w.x = pk2(v[0], v[1]); w.y = pk2(v[2], v[3]); *(u32x2*)(lds_raw + tb * (128 * KRS) + r * KRS + c4 * 2) = w; }
    __syncthreads();
    return; }
  const int lane = tid & 63, fr = lane & 15, c = lane >> 4;
  for (int item = gw; item < last; item += ngw) {
    const int pr = item * 16 + fr;
    unsigned L1[16], L2[16];
#pragma unroll
    for (int k = 0; k < 16; ++k) { L1[k] = 0u; L2[k] = 0u; }
#pragma unroll
    for (int h = 0; h < 2; ++h) {
      bf16x8 qf[4];
#pragma unroll
      for (int s = 0; s < 4; ++s) qf[s] = *(const bf16x8*)(QP + (size_t)pr * 256 + 128 * h + 32 * s + 8 * c);
#pragma unroll
      for (int tp = 0; tp < 4; ++tp) {
        f32x4 acc0 = {0.f, 0.f, 0.f, 0.f}, acc1 = {0.f, 0.f, 0.f, 0.f};
#pragma unroll
        for (int s = 0; s < 4; ++s) { const unsigned char* kb = lds_raw + h * (128 * KRS) + (32 * tp + fr) * KRS + (32 * s + 8 * c) * 2;
          acc0 = __builtin_amdgcn_mfma_f32_16x16x32_bf16(*(const bf16x8*)kb, qf[s], acc0, 0, 0, 0);
          acc1 = __builtin_amdgcn_mfma_f32_16x16x32_bf16(*(const bf16x8*)(kb + 16 * KRS), qf[s], acc1, 0, 0, 0); }
#pragma unroll
        for (int r = 0; r < 4; ++r) { const unsigned t0 = (unsigned)(127 - (32 * tp + r)) - (unsigned)(4 * c), t1 = t0 - 16u;
          const unsigned k0 = (ord_of(acc0[r]) & ~127u) | t0, k1 = (ord_of(acc1[r]) & ~127u) | t1;
          if (h == 0) { ins16(L1, k0); ins16(L1, k1); } else { ins16(L2, k0); ins16(L2, k1); } }
        if (h == 0) asm volatile("" : "+v"(L1[0]), "+v"(L1[15])); else asm volatile("" : "+v"(L2[0]), "+v"(L2[15]));
      }
    }
    MERGE16(L1, sx16); MERGE16(L1, sx32); MERGE16(L2, sx16); MERGE16(L2, sx32);
    float F1[16], F2[16]; unsigned I1[16], I2[16];
#pragma unroll
    for (int k = 0; k < 16; ++k) { const unsigned v1 = L1[k], v2 = L2[k];
      unsigned u1 = v1 & ~127u, u2 = v2 & ~127u; u1 = (u1 & 0x80000000u) ? (u1 & 0x7fffffffu) : ~u1; u2 = (u2 & 0x80000000u) ? (u2 & 0x7fffffffu) : ~u2;
      F1[k] = __uint_as_float(u1); F2[k] = __uint_as_float(u2); I1[k] = (127u - (v1 & 127u)) << 7; I2[k] = 127u - (v2 & 127u); }
    unsigned M[16], P[16];
#pragma unroll
    for (int k = 0; k < 16; ++k) { M[k] = 0u; P[k] = 0u; }
    {
      constexpr int CA[52] = {0,0,0,0,0,0,0,0,0,0,0,0,0,0,0,0, 1,1,1,1,1,1,1,1, 2,2,2,2,2, 3,3,3,3, 4,4,4, 5,5, 6,6, 7,7, 8, 9, 10, 11, 12, 13, 14, 15, 15, 15};
      constexpr int CB[52] = {0,1,2,3,4,5,6,7,8,9,10,11,12,13,14,15, 0,1,2,3,4,5,6,7, 0,1,2,3,4, 0,1,2,3, 0,1,2, 0,1, 0,1, 0,1, 0, 0, 0, 0, 0, 0, 0, 0, 0, 0};
#pragma unroll
      for (int m = 0; m < 13; ++m) {
        unsigned kx[4], px[4];
#pragma unroll
        for (int q = 0; q < 4; ++q) { const int n = 4 * m + q; const bool pad = n >= 50;
          kx[q] = pad ? 0u : ord_of(F1[CA[n]] + F2[CB[n]]); px[q] = I1[CA[n]] | I2[CB[n]]; }
        const unsigned x = (c == 0) ? kx[0] : (c == 1) ? kx[1] : (c == 2) ? kx[2] : kx[3];
        const unsigned pp = (c == 0) ? px[0] : (c == 1) ? px[1] : (c == 2) ? px[2] : px[3];
        ins16p(M, P, x, pp);
      }
    }
    MERGE16P(M, P, sx16); MERGE16P(M, P, sx32);
    float sv[16]; float mx = -1e30f;
#pragma unroll
    for (int k = 0; k < 16; ++k) { unsigned u = M[k]; u = (u & 0x80000000u) ? (u & 0x7fffffffu) : ~u; sv[k] = __uint_as_float(u); mx = fmaxf(mx, sv[k]); }
    float sum = 0.f;
#pragma unroll
    for (int k = 0; k < 16; ++k) { sv[k] = __expf(sv[k] - mx); sum += sv[k]; }
    const float inv = __builtin_amdgcn_rcpf(sum);
    u32x4 oi; f32x4 og;
#pragma unroll
    for (int i = 0; i < 4; ++i) { oi[i] = (c == 0) ? P[i] : (c == 1) ? P[4 + i] : (c == 2) ? P[8 + i] : P[12 + i];
      og[i] = ((c == 0) ? sv[i] : (c == 1) ? sv[4 + i] : (c == 2) ? sv[8 + i] : sv[12 + i]) * inv; }
    { const float* INVU = (const float*)(ws + WS_PINV); const float* INVV = INVU + 16384; f32x4 ou;
#pragma unroll
      for (int i = 0; i < 4; ++i) { ou[i] = INVU[oi[i]]; og[i] *= INVV[oi[i]]; }
      *(f32x4*)((float*)(ws + WS_ACT) + (size_t)pr * 16 + 4 * c) = ou; }
    *(u32x4*)(IDX + (size_t)pr * 16 + 4 * c) = oi; *(f32x4*)(GV + (size_t)pr * 16 + 4 * c) = og;
  }
  if constexpr (PART != 1) __syncthreads();
}
#undef MERGE16
#undef MERGE16P

typedef float f32x16v __attribute__((ext_vector_type(16)));
typedef float f32x32v __attribute__((ext_vector_type(32)));
typedef unsigned u32x6 __attribute__((ext_vector_type(6)));
typedef int i32x8 __attribute__((ext_vector_type(8)));
__device__ __forceinline__ void cvt_fp4_pass(const float* src, unsigned char* dst, float* inv, int r_begin, int r_end, int gw, int ngw, int lane, bool vperm = false) {
  for (int r0 = r_begin + gw * 2; r0 < r_end; r0 += ngw * 2) {
   f32x4 vv[2][8];
#pragma unroll
   for (int rr = 0; rr < 2; ++rr)
#pragma unroll
     for (int k = 0; k < 8; ++k) vv[rr][k] = *(const f32x4*)(src + (size_t)(r0 + rr) * 2048 + (vperm ? k * 256 + lane * 4 : lane * 32 + k * 4));
#pragma unroll
   for (int rr = 0; rr < 2; ++rr) { const int r = r0 + rr; float amA = 0.f, amB = 0.f;
#pragma unroll
    for (int k = 0; k < 4; ++k)
#pragma unroll
      for (int i = 0; i < 4; ++i) { amA = fmaxf(amA, fabsf(vv[rr][k][i])); amB = fmaxf(amB, fabsf(vv[rr][4 + k][i])); }
    const float rmax = fmaxf(__uint_as_float(dpp_max64_u32(__float_as_uint(fmaxf(amA, amB)))), 1e-30f);
    const float rs = rmax * (1.f / 6.f); if (lane == 0) inv[r] = rs;
    const float ia = 1.f / rs, ib = ia;
    u32x4 o;
#pragma unroll
    for (int k = 0; k < 4; ++k) { unsigned w = 0u; const float iv = (k < 2) ? ia : ib; const f32x4 lo = vv[rr][2 * k] * iv, hi = vv[rr][2 * k + 1] * iv;
      w = (unsigned)__builtin_amdgcn_cvt_scalef32_pk_fp4_f32(w, lo[0], lo[1], 1.0f, 0); w = (unsigned)__builtin_amdgcn_cvt_scalef32_pk_fp4_f32(w, lo[2], lo[3], 1.0f, 1);
      w = (unsigned)__builtin_amdgcn_cvt_scalef32_pk_fp4_f32(w, hi[0], hi[1], 1.0f, 2); w = (unsigned)__builtin_amdgcn_cvt_scalef32_pk_fp4_f32(w, hi[2], hi[3], 1.0f, 3);
      o[k] = w; }
    *(u32x4*)(dst + (size_t)r * 1024 + lane * 16) = o;
   }
  }
}
__device__ __forceinline__ void ln_row_regs32(float (&v)[32], const float* g, const float* b, int lane) {
  float s = 0.f;
#pragma unroll
  for (int i = 0; i < 32; ++i) s += v[i];
  const float mean = dpp_sum64(s) * (1.f / 2048.f);
  float q = 0.f;
#pragma unroll
  for (int i = 0; i < 32; ++i) { v[i] -= mean; q += v[i] * v[i]; }
  const float rstd = rsqrtf(dpp_sum64(q) * (1.f / 2048.f) + LN_EPS);
#pragma unroll
  for (int k = 0; k < 8; ++k) { const f32x4 gg = *(const f32x4*)(g + lane * 32 + k * 4), bb = *(const f32x4*)(b + lane * 32 + k * 4);
#pragma unroll
    for (int i = 0; i < 4; ++i) v[k * 4 + i] = v[k * 4 + i] * rstd * gg[i] + bb[i]; }
}
__device__ __forceinline__ void ln_row_regs32_lds(float (&v)[32], const f32x4* LG, const f32x4* LB, int lane) {
  float s = 0.f;
#pragma unroll
  for (int i = 0; i < 32; ++i) s += v[i];
  const float mean = dpp_sum64(s) * (1.f / 2048.f);
  float q = 0.f;
#pragma unroll
  for (int i = 0; i < 32; ++i) { v[i] -= mean; q += v[i] * v[i]; }
  const float rstd = rsqrtf(dpp_sum64(q) * (1.f / 2048.f) + LN_EPS);
#pragma unroll
  for (int k = 0; k < 8; ++k) { const f32x4 gg = LG[k * 64 + lane], bb = LB[k * 64 + lane];
#pragma unroll
    for (int i = 0; i < 4; ++i) v[k * 4 + i] = v[k * 4 + i] * rstd * gg[i] + bb[i]; }
}
#define DEC8(W, K, D) do { const f32x2 t0_ = __builtin_amdgcn_cvt_scalef32_pk_f32_fp4(W[K], 1.0f, 0), t1_ = __builtin_amdgcn_cvt_scalef32_pk_f32_fp4(W[K], 1.0f, 1), \
    t2_ = __builtin_amdgcn_cvt_scalef32_pk_f32_fp4(W[K], 1.0f, 2), t3_ = __builtin_amdgcn_cvt_scalef32_pk_f32_fp4(W[K], 1.0f, 3); D[4 * (K)] = t0_; D[4 * (K) + 1] = t1_; D[4 * (K) + 2] = t2_; D[4 * (K) + 3] = t3_; } while (0)
constexpr int PEER_LDS_OFF = 69632;
__device__ __forceinline__ void peer_stage_params(const Params& p, char* lds_raw, int tid) {
  f32x4* LG = (f32x4*)(lds_raw + PEER_LDS_OFF + 8 * 3072);
  LG[tid] = *(const f32x4*)(p.in[33] + tid * 4); LG[512 + tid] = *(const f32x4*)(p.in[34] + tid * 4); LG[1024 + tid] = *(const f32x4*)(p.in[26] + tid * 4); LG[1536 + tid] = *(const f32x4*)(p.in[27] + tid * 4);
}
__device__ __forceinline__ void peer_phase(const Params& p, char* lds_raw_in, int wave, int gw, int ngw, int lane_in, int last = T_) {
  char* lds_raw = lds_raw_in + PEER_LDS_OFF;
  unsigned char* ws = p.ws; const bf16_t* X = (const bf16_t*)(ws + WS_X); const unsigned char* PU = ws + WS_PU; const unsigned char* PV = ws + WS_PV;
  const float* INVU = (const float*)(ws + WS_PINV); const float* INVV = INVU + 16384;
  const int* IDX = (const int*)(ws + WS_IDX); const float* GV = (const float*)(ws + WS_GV);
  f32x4* LG = (f32x4*)(lds_raw + 8 * 3072); f32x4* LB = LG + 512;
  const f32x4* LG2 = LG + 1024; const f32x4* LB2 = LG + 1536;
  for (int t = gw; t < last; t += ngw) {
    int lane = lane_in; asm volatile("" : "+v"(lane));
    char* XQ = lds_raw + wave * 3072; float* ZL = (float*)(XQ + 2048);
    const int r16 = lane & 15, kb = lane >> 4;
    u32x2 xw[8];
#pragma unroll
    for (int k = 0; k < 8; ++k) xw[k] = *(const u32x2*)(X + (size_t)t * DM + k * 256 + lane * 4);
    {
      const float mu2 = (float)((const long long*)(ws + WS_LN2S))[t] * (1.f / 16777216.f / 2048.f);
      const float rr2 = rsqrtf((float)((const long long*)(ws + WS_LN2S))[16384 + t] * (1.f / 16777216.f / 2048.f) - mu2 * mu2 + LN_EPS);
#pragma unroll
      for (int k = 0; k < 8; ++k) { const f32x4 g = LG2[k * 64 + lane], bb = LB2[k * 64 + lane];
        xw[k].x = pk2((bflo(xw[k].x) - mu2) * rr2 * g[0] + bb[0], (bfhi(xw[k].x) - mu2) * rr2 * g[1] + bb[1]);
        xw[k].y = pk2((bflo(xw[k].y) - mu2) * rr2 * g[2] + bb[2], (bfhi(xw[k].y) - mu2) * rr2 * g[3] + bb[3]); } }
#pragma unroll
    for (int k = 0; k < 8; ++k) {
      int a = __builtin_amdgcn_cvt_pk_fp8_f32(bflo(xw[k].x), bfhi(xw[k].x), 0, false); a = __builtin_amdgcn_cvt_pk_fp8_f32(bflo(xw[k].y), bfhi(xw[k].y), a, true);
      *(unsigned*)(XQ + k * 256 + lane * 4) = (unsigned)a; }
    const int id0 = IDX[(size_t)t * 128 + lane], id1 = IDX[(size_t)t * 128 + 64 + lane];
    const float g0 = GV[(size_t)t * 128 + lane], g1 = GV[(size_t)t * 128 + 64 + lane];
    const float iu0 = ((const float*)(ws + WS_ACT))[(size_t)t * 128 + lane], iu1 = ((const float*)(ws + WS_ACT))[(size_t)t * 128 + 64 + lane];
    const int rsel = r16 & 7, hh = r16 >> 3;
    i32x8 bq[8];
#pragma unroll
    for (int m = 0; m < 8; ++m) { const u32x4 b0_ = *(const u32x4*)(XQ + 256 * m + 128 * (r16 & 1) + 16 * kb), b1_ = *(const u32x4*)(XQ + 256 * m + 128 * (r16 & 1) + 64 + 16 * kb);
      bq[m] = (i32x8){(int)b0_[0], (int)b0_[1], (int)b0_[2], (int)b0_[3], (int)b1_[0], (int)b1_[1], (int)b1_[2], (int)b1_[3]}; }
    u32x4 wq[3][8]; f32x4 accl = {0.f, 0.f, 0.f, 0.f};
#define PG_LOAD(BUF, G) do { const int idg_ = __shfl((G) < 8 ? id0 : id1, (8 * (G) + rsel) & 63); unsigned ro_ = (unsigned)(idg_ * 1024 + 64 * hh + 16 * kb); \
      asm volatile("" : "+v"(ro_) : "v"(accl)); \
      _Pragma("unroll") for (int m = 0; m < 8; ++m) wq[BUF][m] = *(const u32x4*)(PU + ro_ + 128 * m); } while (0)
#define PG_MF(BUF, m) do { const u32x4 a_ = wq[BUF][m]; const i32x8 a8_ = {(int)a_[0], (int)a_[1], (int)a_[2], (int)a_[3], 0, 0, 0, 0}; \
      accn_ = __builtin_amdgcn_mfma_scale_f32_16x16x128_f8f6f4(a8_, bq[m], accn_, 4, 0, 0, 0x7f7f7f7f, 0, 0x7f7f7f7f); } while (0)
#define PG_STEP(G) do { if ((G) + 2 < 16) PG_LOAD(((G) + 2) % 3, (G) + 2); \
      __builtin_amdgcn_sched_barrier(0); \
      f32x4 accn_ = {0.f, 0.f, 0.f, 0.f}; PG_MF((G) % 3, 0); PG_MF((G) % 3, 1); PG_MF((G) % 3, 2); PG_MF((G) % 3, 3); PG_MF((G) % 3, 4); PG_MF((G) % 3, 5); PG_MF((G) % 3, 6); PG_MF((G) % 3, 7); \
      __builtin_amdgcn_sched_barrier(0); \
      if (r16 == 0 && kb < 2) *(f32x4*)(ZL + 8 * (G) + 4 * kb) = accn_; if (r16 == 1 && kb >= 2) *(f32x4*)(ZL + 128 + 8 * (G) + 4 * (kb - 2)) = accn_; accl = accn_; } while (0)
    PG_LOAD(0, 0); PG_LOAD(1, 1);
    PG_STEP(0); PG_STEP(1); PG_STEP(2); PG_STEP(3); PG_STEP(4); PG_STEP(5); PG_STEP(6); PG_STEP(7);
    PG_STEP(8); PG_STEP(9); PG_STEP(10); PG_STEP(11); PG_STEP(12); PG_STEP(13); PG_STEP(14); PG_STEP(15);
#undef PG_LOAD
#undef PG_MF
#undef PG_STEP
    const float z0 = ZL[lane] + ZL[128 + lane], z1 = ZL[64 + lane] + ZL[192 + lane];
    const float a0 = gelu_erf(z0 * iu0) * g0, a1 = gelu_erf(z1 * iu1) * g1;
    f32x2 acc2[16];
#pragma unroll
    for (int i = 0; i < 16; ++i) acc2[i] = (f32x2){0.f, 0.f};
#pragma unroll 1
    for (int e0 = 0; e0 < 128; e0 += 16) {
      u32x4 w[16]; float av[16];
#pragma unroll
      for (int q = 0; q < 16; ++q) { const int id = __builtin_amdgcn_readlane(e0 < 64 ? id0 : id1, (e0 + q) & 63); const unsigned char* rp = PV + (size_t)id * 1024;
        av[q] = __uint_as_float(__builtin_amdgcn_readlane(__float_as_uint(e0 < 64 ? a0 : a1), (e0 + q) & 63));
        w[q] = *(const u32x4*)(rp + lane * 16); }
#pragma unroll
      for (int q = 0; q < 16; ++q) { u32x4 ww = w[q]; { unsigned w0 = ww[0]; asm volatile("" : "+v"(w0) : "v"(acc2[15])); ww[0] = w0; }
        f32x2 d[16]; DEC8(ww, 0, d); DEC8(ww, 1, d); DEC8(ww, 2, d); DEC8(ww, 3, d);
        const f32x2 aa = {av[q], av[q]}, bb = aa;
#pragma unroll
        for (int i = 0; i < 8; ++i) { acc2[i] = d[i] * aa + acc2[i]; acc2[8 + i] = d[8 + i] * bb + acc2[8 + i]; }
        asm volatile("" : "+v"(acc2[0]), "+v"(acc2[1]), "+v"(acc2[2]), "+v"(acc2[3]), "+v"(acc2[4]), "+v"(acc2[5]), "+v"(acc2[6]), "+v"(acc2[7]), "+v"(acc2[8]), "+v"(acc2[9]), "+v"(acc2[10]), "+v"(acc2[11]), "+v"(acc2[12]), "+v"(acc2[13]), "+v"(acc2[14]), "+v"(acc2[15])); }
    }
    float acc[32];
#pragma unroll
    for (int k = 0; k < 8; ++k) { acc[k * 4] = acc2[2 * k][0] + DN_ALPHA * bflo(xw[k].x); acc[k * 4 + 1] = acc2[2 * k][1] + DN_ALPHA * bfhi(xw[k].x);
      acc[k * 4 + 2] = acc2[2 * k + 1][0] + DN_ALPHA * bflo(xw[k].y); acc[k * 4 + 3] = acc2[2 * k + 1][1] + DN_ALPHA * bfhi(xw[k].y); }
    ln_row_regs32_lds(acc, LG, LB, lane);
#pragma unroll
    for (int k = 0; k < 8; ++k) *(f32x4*)(p.out + (size_t)t * DM + k * 256 + lane * 4) = (f32x4){acc[k * 4], acc[k * 4 + 1], acc[k * 4 + 2], acc[k * 4 + 3]};
  }
}
#undef DEC8

#define LAS __attribute__((address_space(3)))
#define XB_TMO      128
#define XB_XCNT(j)  (256  + 64 * (j))
#define XB_XSUB(j)  (1280 + 64 * (j))
#define XB_XGEN(j)  (2304 + 64 * (j))
#define XB_TOP      3328
#define XB_TOPGEN   3392
#define XCD_BAR_WORDS 3456
#define XB_TMAP(j)  (3520 + (j))
#define XB_TBAD     3536
#define XB_TSUB(j)  (3584 + 64 * (j))
#define XB_TGEN(j)  (4096 + 64 * (j))
#define XB_CVTD     4608
#define XB_PCTR(j)  (5120 + 64 * (j))
#define XB_SPIN_CAP (1u << 22)
__device__ __forceinline__ unsigned xb_ld(unsigned* p)              { return __hip_atomic_load(p, __ATOMIC_RELAXED, __HIP_MEMORY_SCOPE_AGENT); }
__device__ __forceinline__ unsigned xb_add(unsigned* p, unsigned v) { return __hip_atomic_fetch_add(p, v, __ATOMIC_RELAXED, __HIP_MEMORY_SCOPE_AGENT); }
__device__ __forceinline__ unsigned xb_xcc_id() { return (unsigned)__builtin_amdgcn_s_getreg((3 << 11) | 20) & 0xFu; }
#define XB_SPIN(cond, bar) do { unsigned _sp = 0; while (cond) { __builtin_amdgcn_s_sleep(1); \
    if ((++_sp & 255u) == 0u) { if (xb_ld(&(bar)[XB_TMO])) break; if (_sp > XB_SPIN_CAP) { atomicAdd(&(bar)[XB_TMO], 1u); break; } } } } while (0)
struct XcdBarrier { unsigned* bar; unsigned x; volatile LAS unsigned* st; };
__device__ __forceinline__ XcdBarrier xcd_barrier_post(unsigned* bar, volatile LAS unsigned* st) {
  XcdBarrier b; b.bar = bar; b.x = xb_xcc_id(); b.st = st;
  if (hw_tid() == 0) (void)xb_add(&bar[XB_XCNT(b.x)], 1u);
  return b;
}
__device__ __forceinline__ void xcd_barrier_complete(unsigned* bar, unsigned x, unsigned& nloc, unsigned& nx) {
  const unsigned G = gridDim.x * gridDim.y * gridDim.z;
  unsigned sum, cnt, mine, sp = 0u;
  for (;;) {
    sum = 0u; cnt = 0u; mine = 0u;
#pragma unroll
    for (unsigned j = 0; j < 16; ++j) { const unsigned c = xb_ld(&bar[XB_XCNT(j)]); sum += c; cnt += (c > 0u) ? 1u : 0u; mine = (j == x) ? c : mine; }
    if (sum == G) break;
    __builtin_amdgcn_s_sleep(1);
    if ((++sp & 255u) == 0u) { if (xb_ld(&bar[XB_TMO])) break; if (sp > XB_SPIN_CAP) { atomicAdd(&bar[XB_TMO], 1u); break; } }
  }
  nloc = mine > 0u ? mine : 1u; nx = cnt > 0u ? cnt : 1u;
}
__device__ __forceinline__ void xcd_barrier(const XcdBarrier& b, bool team = false) {
  asm volatile("s_waitcnt vmcnt(0)" ::: "memory");
  __syncthreads();
  if (hw_tid() == 0) {
    unsigned* bar = b.bar;
    __builtin_amdgcn_s_waitcnt(0);
    unsigned nloc = b.st[0], nx = b.st[1];
    if (nloc == 0u) { xcd_barrier_complete(bar, b.x, nloc, nx); b.st[0] = nloc; b.st[1] = nx; }
    if (team) nloc = 32u;
    unsigned* sub = &bar[team ? XB_TSUB(blockIdx.x & 7u) : XB_XSUB(b.x)]; unsigned* gw_ = &bar[team ? XB_TGEN(blockIdx.x & 7u) : XB_XGEN(b.x)];
    const unsigned old = xb_add(sub, 1u);
    const unsigned gen = old / nloc;
    if (old + 1u == (gen + 1u) * nloc) {
      __builtin_amdgcn_fence(__ATOMIC_RELEASE, "agent");
      asm volatile("s_waitcnt vmcnt(0)" ::: "memory");
      if (!team) {
        const unsigned og = xb_add(&bar[XB_TOP], 1u);
        const unsigned tg = og / nx;
        if (og + 1u == (tg + 1u) * nx) xb_add(&bar[XB_TOPGEN], 1u);
        else XB_SPIN(xb_ld(&bar[XB_TOPGEN]) == tg, bar); }
      __builtin_amdgcn_fence(__ATOMIC_ACQUIRE, "agent");
      xb_add(gw_, 1u);
      asm volatile("s_waitcnt vmcnt(0)" ::: "memory");
    } else {
      XB_SPIN(xb_ld(gw_) == gen, bar);
      __builtin_amdgcn_fence(__ATOMIC_ACQUIRE, "agent");
      asm volatile("s_waitcnt vmcnt(0)" ::: "memory");
    }
  }
  __syncthreads();
}

constexpr int CVT_EARLY = 4608, CVT_SPLIT = 13312;
#ifndef PROBE_LRU
#define PROBE_LRU 0
#endif
#ifndef USE_TOPK3
#define USE_TOPK3 1
#endif
#ifndef USE_TOPK2
#define USE_TOPK2 1
#endif
#ifndef PROBE_MASK
#define PROBE_MASK 0
#endif
#ifndef PROBE_PEER
#define PROBE_PEER 0
#endif
#ifndef PROBE_SYNC
#define PROBE_SYNC 0
#endif
#ifndef PROBE_TOPK
#define PROBE_TOPK 0
#endif
#ifndef USE_FAST_XATTN
#define USE_FAST_XATTN 1
#endif
#ifndef USE_FAST_MLA
#define USE_FAST_MLA 1
#endif
#ifndef FASTMASK
#define FASTMASK 0xff
#endif
#define GEMM(MODE, g, e) do { if constexpr ((FASTMASK >> MODE) & 1) gemm_fast<MODE>(g, e, lds_raw, bid, nblk); else gemm_simple<MODE>(g, e, bid, nblk, wave, lane); } while (0)
#define IDS int tid_ = hw_tid(); asm volatile("" : "+v"(tid_)); const int tid = tid_, lane = tid & 63, wave = tid >> 6, gw = bid * NWAVE + wave; (void)tid; (void)lane; (void)wave; (void)gw
__global__ void __launch_bounds__(NTHR) fwd_kernel(Params p) {
  extern __shared__ __attribute__((aligned(16))) unsigned char lds_raw[];
  float* lds = (float*)lds_raw;
  cg::grid_group grid = cg::this_grid();
  const int bid = blockIdx.x, nblk = gridDim.x, ngw = nblk * NWAVE;
  unsigned char* ws = p.ws; unsigned char* dout = (unsigned char*)p.out;
  EpiArgs e{ws, dout, p.in, nullptr, nullptr, 0};
  volatile LAS unsigned* bst = (volatile LAS unsigned*)((LAS unsigned char*)lds_raw + (LDS_BYTES - 64));
  if (threadIdx.x < 2) bst[threadIdx.x] = 0u;
  if ((threadIdx.x & 63) == 0) *(volatile int*)(lds_raw + HWTID_MAP_OFF + ((unsigned)__builtin_amdgcn_s_getreg((5 << 11) | 4) & 63u) * 4) = (int)(threadIdx.x >> 6);
  __syncthreads();
  const XcdBarrier xbar = xcd_barrier_post((unsigned*)ws, bst);
#define GSYNC() xcd_barrier(xbar)
  if (hw_tid() == 0) {
    unsigned* bar = (unsigned*)ws; const unsigned prev = atomicCAS(&bar[XB_TMAP(blockIdx.x & 7)], 0u, xbar.x + 1u);
    if ((prev != 0u && prev != xbar.x + 1u) || gridDim.x != 256u) atomicOr(&bar[XB_TBAD], 1u); }
  const bool tm = (nblk == 256); const int team = bid & 7, tli = bid >> 3;

  for (int rp_ = 0; rp_ < 1 + ((PROBE_MASK >> 0) & 1); ++rp_) { { IDS; if (nblk == 256) phase0<true>(p, lds, gw, ngw, lane, wave); else phase0<false>(p, lds, gw, ngw, lane, wave); } }
  if (__builtin_expect(p.ws == nullptr, 0)) grid.sync();
  GSYNC();
  if (hw_tid() == 0) { unsigned* bar = (unsigned*)ws; unsigned ok = (xb_ld(&bar[XB_TBAD]) == 0u) ? 1u : 0u;
#pragma unroll
    for (int j = 0; j < 8; ++j) { const unsigned mj = xb_ld(&bar[XB_TMAP(j)]); if (mj == 0u) ok = 0u;
#pragma unroll
      for (int k = 0; k < 8; ++k) if (k < j && xb_ld(&bar[XB_TMAP(k)]) == mj) ok = 0u; }
    bst[2] = ok; }
  __syncthreads();
  const bool team_ok = __builtin_amdgcn_readfirstlane((int)bst[2]) != 0;
#define TSYNC() xcd_barrier(xbar, team_ok)
  if (nblk == 256 && ((bid >= 64 && bid < 128) || bid >= 160)) { IDS;
    const int sb = (bid < 128) ? bid - 64 : bid - 96; transpose_list<1>(p, lds + wave * (64 * 33), sb * NWAVE + wave, 160 * NWAVE, lane); wmq_prepare(p, sb * NWAVE + wave, 160 * NWAVE, lane); wpq_prepare(p, sb * NWAVE + wave, 160 * NWAVE, lane);
    cvt_fp4_pass(p.in[31], ws + WS_PU, (float*)(ws + WS_PINV), 0, CVT_EARLY, sb * NWAVE + wave, 160 * NWAVE, lane);
    cvt_fp4_pass(p.in[32], ws + WS_PV, (float*)(ws + WS_PINV) + 16384, 0, CVT_EARLY, sb * NWAVE + wave, 160 * NWAVE, lane, true);
    __syncthreads(); }
  for (int rp_ = 0; rp_ < 1 + ((PROBE_MASK >> 1) & 1); ++rp_) { { IDS; GemmArgs g{(const bf16_t*)(ws + WS_X), 2048, 0, (const bf16_t*)(ws + WS_WIN_T), 2048, 0, T_, 3328, 2048, 1}; GEMM(E_WIN, g, e); } }
  for (int rp_ = 0; rp_ < 1 + ((PROBE_MASK >> 1) & 1); ++rp_) { { IDS; GemmArgs g{(const bf16_t*)(ws + WS_MEMB), 2048, 0, (const bf16_t*)(ws + WS_WMKV_T), 2048, 0, 2048, 1024, 2048, 1, 128}; GEMM(E_MEMKV, g, e); } }
  GSYNC();
  for (int rp_ = 0; rp_ < 1 + ((PROBE_MASK >> 2) & 1); ++rp_) { { IDS; GemmArgs g{(const bf16_t*)(ws + WS_CQ), 512, 0, (const bf16_t*)(ws + WS_WUQ_T), 512, 0, T_, 1536, 512, 1}; GEMM(E_Q, g, e); } }
  for (int rp_ = 0; rp_ < 1 + ((PROBE_MASK >> 2) & 1); ++rp_) { { IDS; GemmArgs g{(const bf16_t*)(ws + WS_CKV), 512, 0, (const bf16_t*)(ws + WS_WUKV_T), 512, 0, T_, 2048, 512, 1}; GEMM(E_KV, g, e); } }
#if USE_LRU_FUSED
  for (int rp_ = 0; rp_ < 1 + PROBE_LRU; ++rp_) lru_fused_phase(p, lds_raw, tm ? team * 32 + tli : bid, tm ? 32 : nblk, tm ? team * 32 + 32 : NB_ * 8 * 2 * 2);
#else
  for (int rp_ = 0; rp_ < 1 + ((PROBE_MASK >> 2) & 1); ++rp_) { { IDS; GemmArgs g{(const bf16_t*)(ws + WS_XC), 1024, 128, (const bf16_t*)(ws + WS_WG_T), 128, 512 * 128, T_, 512, 128, 8}; GEMM(E_GATES, g, e); } }
#endif
  TSYNC();
#if USE_FAST_MLA
  for (int rp_ = 0; rp_ < 1 + ((PROBE_MASK >> 4) & 1); ++rp_) { mla_attn_phase(dout, ws, (char*)lds_raw, tm ? team * 64 + tli : bid, tm ? 32 : nblk, p.in[17], tm ? team * 64 + 64 : NB_ * 8 * (S_ / 256)); }
#else
  { IDS; attn_scalar<192, 2048>((const bf16_t*)(dout + DO_Q), 1536, (const bf16_t*)(dout + DO_K), 1536, (const bf16_t*)(dout + DO_V), 1024, (bf16_t*)(ws + WS_YMIX), 2048, 8,
                         0.07216878364870322f, lds, bid, nblk, tid); }
#endif
#if !USE_LRU_FUSED
  { IDS; scan_phase(ws, lds, bid, nblk, tid); }
#endif
  TSYNC();
  { IDS; phase3b(p, tm ? team * 2048 + tli * NWAVE + wave : gw, tm ? 256 : ngw, lane, tm ? team * 2048 + 2048 : T_); }
  TSYNC();
  { IDS; GemmArgs g{(const bf16_t*)(ws + WS_YMIX), 2048, 0, (const bf16_t*)(ws + WS_WOUT_T), 2048, 0, T_, 2048, 2048, 1}; gemm_fast<E_RESM>(g, e, lds_raw, bid, nblk); }
  TSYNC();
  for (int rp_ = 0; rp_ < 1 + ((PROBE_MASK >> 5) & 1); ++rp_) { { IDS; GemmArgs g{(const bf16_t*)(ws + WS_X), 2048, 0, (const bf16_t*)(ws + WS_WMQ_T), 2048, 0, T_, 512, 2048, 1}; EpiArgs e2 = e; e2.o = (bf16_t*)(ws + WS_QM); e2.ld = 512; e2.lnst = (const long long*)(ws + WS_LN1S); e2.csbw = (const long long*)(ws + WS_CSBW); e2.ncs = 512; gemm_fast<E_LNQ>(g, e2, lds_raw, bid, nblk); }
  { IDS; const bool sp = (nblk == 256); const int g2 = sp ? (bid & 127) * NWAVE + wave : gw, n2 = sp ? 128 * NWAVE : ngw; const int r0 = sp ? CVT_EARLY : 0;
    if (!sp || bid >= 128) {
      cvt_fp4_pass(p.in[31], ws + WS_PU, (float*)(ws + WS_PINV), r0, 16384, g2, n2, lane);
      cvt_fp4_pass(p.in[32], ws + WS_PV, (float*)(ws + WS_PINV) + 16384, r0, 16384, g2, n2, lane, true); } } }
  if (nblk != 256) TSYNC();
#if USE_FAST_XATTN
  { int xf = bid, xs = nblk, xl = NB_ * 4 * (S_ / 256);
    if (nblk == 256) { xs = 8; xf = (bid & 7) * 32 + (bid >> 6) * 16 + ((bid >> 3) & 7); xl = bid < 128 ? xf + 16 : 0; }
    mem_attn_phase(ws, (char*)lds_raw, xf, xs, xl); }
#else
  { IDS; attn_scalar<128, 256>((const bf16_t*)(ws + WS_QM), 512, (const bf16_t*)(ws + WS_MEMKV), 1024, (const bf16_t*)(ws + WS_MEMKV) + 512, 1024, (bf16_t*)(ws + WS_OM), 512, 4,
                        0.08838834764831845f, lds, bid, nblk, tid); }
#endif
  TSYNC();
  if (team_ok && tli == 0 && hw_tid() == 0) xb_add(&((unsigned*)ws)[XB_CVTD], 1u);
  { IDS; GemmArgs g{(const bf16_t*)(ws + WS_OM), 512, 0, (const bf16_t*)(ws + WS_WMO_T), 512, 0, T_, 2048, 512, 1}; GEMM(E_RES, g, e); }
  TSYNC();
  for (int rp_ = 0; rp_ < 1 + ((PROBE_MASK >> 3) & 1); ++rp_) { { IDS; GemmArgs g{(const bf16_t*)(ws + WS_X), 2048, 0, (const bf16_t*)(ws + WS_WPQ_T), 2048, 0, T_, 2048, 2048, 1}; EpiArgs e2 = e; e2.o = (bf16_t*)(ws + WS_QP); e2.ld = 2048; e2.lnst = (const long long*)(ws + WS_LN2S); e2.csbw = (const long long*)(ws + WS_CSBW2); e2.ncs = 2048; gemm_fast<E_LNQ>(g, e2, lds_raw, bid, nblk); } }
  TSYNC();
#if USE_TOPK3
  if (team_ok) {
    if (hw_tid() == 0) { unsigned* bar = (unsigned*)ws; XB_SPIN(xb_ld(&bar[XB_CVTD]) < 8u, bar); __builtin_amdgcn_fence(__ATOMIC_ACQUIRE, "agent"); asm volatile("s_waitcnt vmcnt(0)" ::: "memory"); }
    __syncthreads(); }
  { IDS; peer_stage_params(p, (char*)lds_raw, tid); topk_phase3<0>(p, lds_raw, gw, ngw, tid); }
  { IDS; const int base = tm ? team * 1024 : 0, cnt = tm ? 1024 : T_ * 8 / 16; unsigned* ctr = &((unsigned*)ws)[XB_PCTR(tm ? team : 8)];
    for (;;) {
      int it_ = 0; if (lane == 0) it_ = (int)xb_add(ctr, 1u); it_ = __builtin_amdgcn_readfirstlane(it_);
      if (it_ >= cnt) break;
      const int item = base + it_;
      topk_phase3<1>(p, lds_raw, item, 1 << 30, tid, item + 1);
      asm volatile("s_waitcnt vmcnt(0)" ::: "memory");
      peer_phase(p, (char*)lds_raw, wave, 2 * item, 1, lane, 2 * item + 2); } }
#else
  for (int rp_ = 0; rp_ < 1 + ((PROBE_MASK >> 3) & 1); ++rp_) { { IDS; GemmArgs g{(const bf16_t*)(ws + WS_QP), 256, 0, (const bf16_t*)(ws + WS_KEYS_T), 256, 0, T_ * 8, 256, 256, 1}; EpiArgs e2 = e; e2.f = (float*)dout; e2.ld = 256; GEMM(E_F32, g, e2); } }
  GSYNC();
  for (int rep_ = 0; rep_ < 1 + PROBE_TOPK; ++rep_) { IDS; if (USE_TOPK2) topk_phase2(ws, (const float*)dout, gw, ngw, lane); else topk_phase(ws, (const float*)dout, gw, ngw, lane); }
#endif
  for (int rep_ = 0; rep_ < PROBE_SYNC; ++rep_) GSYNC();
}

extern "C" void kernel_launch(void* const* d_in, const int* in_sizes, int n_in, void* d_out, int out_size, void* d_ws, size_t ws_size, hipStream_t stream) {
  static int grid_blocks = 0;
  if (grid_blocks == 0) {
    if (n_in != 35 || ws_size < WS_END || out_size != T_ * DM) { fprintf(stderr, "kernel_launch: unexpected shapes n_in %d ws %zu out %d\n", n_in, ws_size, out_size); grid_blocks = -1; return; }
    int dev = 0, cus = 0, per_cu = 0;
    hipGetDevice(&dev); hipDeviceGetAttribute(&cus, hipDeviceAttributeMultiprocessorCount, dev);
    if (hipFuncSetAttribute((const void*)fwd_kernel, hipFuncAttributeMaxDynamicSharedMemorySize, LDS_BYTES) != hipSuccess) { fprintf(stderr, "hipFuncSetAttribute failed\n"); grid_blocks = -1; return; }
    if (hipOccupancyMaxActiveBlocksPerMultiprocessor(&per_cu, (const void*)fwd_kernel, NTHR, LDS_BYTES) != hipSuccess || per_cu < 1) { fprintf(stderr, "occupancy query failed (%d)\n", per_cu); grid_blocks = -1; return; }
    grid_blocks = cus * per_cu;
    fprintf(stderr, "kernel_launch: cus %d per_cu %d grid %d ws %zu\n", cus, per_cu, grid_blocks, ws_size);
  }
  if (grid_blocks < 0) return;
  if (hipMemsetAsync(d_ws, 0, WS_ZERO_BYTES, stream) != hipSuccess) { fprintf(stderr, "memset failed\n"); return; }
  Params p{};
  for (int i = 0; i < 35; ++i) p.in[i] = (const float*)d_in[i];
  p.out = (float*)d_out; p.ws = (unsigned char*)d_ws;
  void* args[] = {&p};
  hipError_t err = hipLaunchCooperativeKernel((const void*)fwd_kernel, dim3(grid_blocks), dim3(NTHR), args, LDS_BYTES, stream);
  if (err != hipSuccess) fprintf(stderr, "cooperative launch failed: %s (grid %d)\n", hipGetErrorString(err), grid_blocks);
}
```
